# Optimizing an MI355X kernel written in HIP

```python
import math
import jax, jax.numpy as jnp
from jax import lax
import numpy as np

D_MODEL = 1024
BATCH = 8
SEQ = 2048
DEPTH = 1
DEC_BATCH = 128
DEC_SEQ = 8
PAST_LEN = 16384
PAGE_SIZE = 128

H_A = 4
DK_A = D_MODEL // 16
DV_A = D_MODEL // 8
GATE_RANK = 16
GATE_NORM = 16.0
H_B = 4
DK_B = D_MODEL // 8
DV_B = D_MODEL // 8
D_FF = -(-8 * D_MODEL // (3 * 256)) * 256
CHUNK = 32
EPS = 1e-6
SPLIT_SIZES = (H_A * DK_A, H_A * DK_A, H_A * DV_A, H_A * DV_A, GATE_RANK,
               H_B * DK_B, H_B * DK_B, H_B * DV_B, H_B * DV_B)
D_IN = sum(SPLIT_SIZES)

kernel_name = "hymba_gla_hgrn2_step"


def rmsnorm(x, g):
    xf = x.astype(jnp.float32)
    y = xf * lax.rsqrt(jnp.mean(xf * xf, axis=-1, keepdims=True) + EPS) * g.astype(jnp.float32)
    return y.astype(x.dtype)


def head_rmsnorm(o, g):
    return o * lax.rsqrt(jnp.mean(o * o, axis=-1, keepdims=True) + EPS) * g.astype(jnp.float32)


def chunk_gated_linear(q, k, v, log_a, s0):
    B, T, H, K = q.shape
    n = -(-T // CHUNK)
    pad = n * CHUNK - T
    f32 = jnp.float32
    q, k, v, log_a = (t.astype(f32) for t in (q, k, v, log_a))
    if pad:
        pw = ((0, 0), (0, pad), (0, 0), (0, 0))
        q, k, v, log_a = (jnp.pad(t, pw) for t in (q, k, v, log_a))

    def to_chunks(t):
        return t.reshape(B, n, CHUNK, H, t.shape[-1]).transpose(1, 0, 3, 2, 4)

    qc, kc, vc = to_chunks(q), to_chunks(k), to_chunks(v)
    bc = jnp.cumsum(to_chunks(log_a), axis=3)
    mask = jnp.tril(jnp.ones((CHUNK, CHUNK), dtype=bool))

    def step(S, xs):
        qi, ki, vi, bi = xs
        q_in = qi * jnp.exp(bi)
        k_in = ki * jnp.exp(-bi)
        att = jnp.where(mask, jnp.einsum('bhtk,bhsk->bhts', q_in, k_in), 0.0)
        o = jnp.einsum('bhtk,bhkv->bhtv', q_in, S) + jnp.einsum('bhts,bhsv->bhtv', att, vi)
        b_last = bi[:, :, -1:, :]
        S = jnp.exp(b_last[:, :, 0, :])[..., None] * S + jnp.einsum(
            'bhsk,bhsv->bhkv', ki * jnp.exp(b_last - bi), vi)
        return S, o

    S, o = lax.scan(step, s0.astype(f32), (qc, kc, vc, bc))
    o = o.transpose(1, 0, 3, 2, 4).reshape(B, n * CHUNK, H, -1)[:, :T]
    return o, S


def mixer(h, s_gla, s_hgrn, w_in, w_a2, b_a, lb, onorm_a, onorm_b, w_o):
    B, T, _ = h.shape
    idx, acc = [], 0
    for s in SPLIT_SIZES[:-1]:
        acc += s
        idx.append(acc)
    p = h @ w_in
    qa, ka, va, ga, lra, qb, fb, ib, gb = jnp.split(p.astype(jnp.float32), idx, axis=-1)

    qa = qa.reshape(B, T, H_A, DK_A) * (DK_A ** -0.5)
    ka = ka.reshape(B, T, H_A, DK_A)
    va = va.reshape(B, T, H_A, DV_A)
    log_alpha = jax.nn.log_sigmoid(lra @ w_a2.astype(jnp.float32) + b_a.astype(jnp.float32)) / GATE_NORM
    log_alpha = log_alpha.reshape(B, T, H_A, DK_A)
    oa, sa = chunk_gated_linear(qa, ka, va, log_alpha, s_gla)
    oa = head_rmsnorm(oa, onorm_a) * jax.nn.silu(ga.reshape(B, T, H_A, DV_A))

    qb = jax.nn.silu(qb.reshape(B, T, H_B, DK_B))
    f = lb + (1.0 - lb) * jax.nn.sigmoid(fb.reshape(B, T, H_B, DK_B))
    kb = 1.0 - f
    ib = ib.reshape(B, T, H_B, DV_B)
    ob, sb = chunk_gated_linear(qb, kb, ib, jnp.log(f), s_hgrn)
    ob = head_rmsnorm(ob, onorm_b) * jax.nn.silu(gb.reshape(B, T, H_B, DV_B))

    o = jnp.concatenate([oa.reshape(B, T, H_A * DV_A), ob.reshape(B, T, H_B * DV_B)], axis=-1)
    return o.astype(h.dtype) @ w_o, sa, sb


def swiglu(h, w1, w3, w2):
    return (jax.nn.silu(h @ w1) * (h @ w3)) @ w2


def trunk(x, s_gla, s_hgrn, norm_mix, w_in, w_a2, b_a, lb_all, onorm_a, onorm_b, w_o,
          norm_ffn, w1, w3, w2, norm_final):
    sa_list, sb_list = [], []
    for l in range(DEPTH):
        lb = lb_all[l].reshape(H_B, DK_B)
        m, sa, sb = mixer(rmsnorm(x, norm_mix[l]), s_gla[l], s_hgrn[l], w_in[l], w_a2[l], b_a[l],
                          lb, onorm_a[l], onorm_b[l], w_o[l])
        x = x + m
        x = x + swiglu(rmsnorm(x, norm_ffn[l]), w1[l], w3[l], w2[l])
        sa_list.append(sa)
        sb_list.append(sb)
    return rmsnorm(x, norm_final), jnp.stack(sa_list), jnp.stack(sb_list)


def setup_inputs(seed: int = 0) -> dict:
    key = jax.random.key(seed)
    ks = jax.random.split(key, 20)
    f32 = jnp.float32
    nrm = lambda k, shape, s: jax.random.normal(k, shape, f32) * s
    return {
        "x_prompt": nrm(ks[0], (BATCH, SEQ, D_MODEL), 1.0),
        "x_sample": nrm(ks[1], (DEC_BATCH, DEC_SEQ, D_MODEL), 1.0),
        "state_gla": nrm(ks[2], (DEPTH, DEC_BATCH, H_A, DK_A, DV_A), 2.0),
        "state_hgrn": nrm(ks[3], (DEPTH, DEC_BATCH, H_B, DK_B, DV_B), 0.5),
        "norm_mix": 1.0 + nrm(ks[4], (DEPTH, D_MODEL), 0.02),
        "w_in": nrm(ks[5], (DEPTH, D_MODEL, D_IN), D_MODEL ** -0.5),
        "w_a2": nrm(ks[6], (DEPTH, GATE_RANK, H_A * DK_A), GATE_RANK ** -0.5),
        "b_a": nrm(ks[7], (DEPTH, H_A * DK_A), 0.01),
        "lb_param": nrm(ks[8], (DEPTH + 1, H_B * DK_B), 1.0),
        "onorm_a": 1.0 + nrm(ks[9], (DEPTH, DV_A), 0.02),
        "onorm_b": 1.0 + nrm(ks[10], (DEPTH, DV_B), 0.02),
        "w_o": nrm(ks[11], (DEPTH, D_MODEL, D_MODEL), D_MODEL ** -0.5),
        "norm_ffn": 1.0 + nrm(ks[12], (DEPTH, D_MODEL), 0.02),
        "w1": nrm(ks[13], (DEPTH, D_MODEL, D_FF), D_MODEL ** -0.5),
        "w3": nrm(ks[14], (DEPTH, D_MODEL, D_FF), D_MODEL ** -0.5),
        "w2": nrm(ks[15], (DEPTH, D_FF, D_MODEL), D_FF ** -0.5),
        "norm_final": 1.0 + nrm(ks[16], (D_MODEL,), 0.02),
    }


def reference(x_prompt, x_sample, state_gla, state_hgrn, norm_mix, w_in, w_a2, b_a, lb_param,
              onorm_a, onorm_b, w_o, norm_ffn, w1, w3, w2, norm_final):
    lb_all = jnp.cumsum(jax.nn.softmax(lb_param.astype(jnp.float32), axis=0), axis=0)
    zeros_a = jnp.zeros((DEPTH, BATCH, H_A, DK_A, DV_A), jnp.float32)
    zeros_b = jnp.zeros((DEPTH, BATCH, H_B, DK_B, DV_B), jnp.float32)
    weights = (norm_mix, w_in, w_a2, b_a, lb_all, onorm_a, onorm_b, w_o, norm_ffn, w1, w3, w2, norm_final)
    y_prompt, sa_p, sb_p = trunk(x_prompt, zeros_a, zeros_b, *weights)
    y_sample, sa_s, sb_s = trunk(x_sample, state_gla, state_hgrn, *weights)
    return (y_prompt, y_sample, sa_p, sb_p, sa_s, sb_s)
```

```cpp
#include <hip/hip_runtime.h>
#include <hip/hip_cooperative_groups.h>
#include <cstdio>
#include <cstdint>
namespace cg = cooperative_groups;
namespace pg8 {
#define PG8_LAS __attribute__((address_space(3)))
typedef unsigned short bf16_t;
typedef short bf16x8 __attribute__((ext_vector_type(8)));
typedef float f32x4 __attribute__((ext_vector_type(4)));
typedef unsigned u32x4 __attribute__((ext_vector_type(4)));
constexpr int BM = 256, BK = 64, HALF = 128, HTB = HALF * BK * 2  , STAGE_BYTES = 8 * HTB, NXCD = 8, WGM = 8;

__host__ __device__ __forceinline__ int lds_byte(int r, int c) { const int st = (r >> 4) * 2 + (c >> 5), rr = r & 15, cc = c & 31, ob = rr * 64 + cc * 2; return st * 1024 + (ob ^ (((ob >> 9) & 1) << 5)); }
__host__ __device__ __forceinline__ void stage_rc(int b, int& R, int& C) { const int st = b / 1024, sb = b % 1024, swz = sb ^ (((sb >> 9) & 1) << 5); R = (st >> 1) * 16 + swz / 64; C = (st & 1) * 32 + (swz % 64) / 2; }
__host__ __device__ __forceinline__ int perm32(int rho) { const int n = rho >> 4, i = rho & 15; return 8 * (i >> 2) + 4 * n + (i & 3); }

struct Unit { int pm, pn; };
struct Gemm { const bf16_t* A; const bf16_t* Bt; int M, N, K; };

struct StaticOrder {
    int nM, nN, nwg, G, c;
    __host__ __device__ void init(int M, int N, int G_, int c_) { nM = M / BM; nN = N / BM; nwg = nM * nN; G = G_; c = c_; }
    __host__ __device__ bool next(int i, Unit& u) const {
        const long L = (long)i * G + c; if (L >= nwg) return false;
        int wgid = (int)L; { const int q = nwg / NXCD, r = nwg % NXCD, xcd = wgid % NXCD, off = wgid / NXCD; wgid = (xcd < r ? xcd * (q + 1) : r * (q + 1) + (xcd - r) * q) + off; }
        const int nig = WGM * nN, gid = wgid / nig, fm = gid * WGM, gsz = (nM - fm) < WGM ? (nM - fm) : WGM;
        u.pm = fm + ((wgid % nig) % gsz); u.pn = (wgid % nig) / gsz; return true;
    }
    __device__ __forceinline__ void a_ready(const Unit&) const {}
    __device__ __forceinline__ void done(const Unit&) const {}
};

__device__ __forceinline__ unsigned cvt_pk_bf16(float lo, float hi) { unsigned r; asm volatile("v_cvt_pk_bf16_f32 %0, %1, %2" : "=v"(r) : "v"(lo), "v"(hi)); return r; }
typedef float f32x2 __attribute__((ext_vector_type(2)));


template <class Epi, class Sched, bool ALIGN_EPI = false, bool SP2 = false>
__device__ __forceinline__ void gemm_phase(PG8_LAS unsigned char* lds, const Gemm g, const Sched& S, const Epi& E) {
    const int tid = threadIdx.x, wid = __builtin_amdgcn_readfirstlane(tid >> 6), lane = tid & 63, wr = wid >> 2, wc = wid & 3, fr = lane & 15, fq = lane >> 4;
    const int K = g.K, nt = K / BK;
    unsigned voffA[2], voffB[2];
#pragma unroll
    for (int i = 0; i < 2; ++i) { int R, C; stage_rc(tid * 16 + i * 8192, R, C); const int Rb = Epi::PERM ? ((R & ~31) + perm32(R & 31)) : R;
        voffA[i] = (unsigned)(R * K + C) * 2u; voffB[i] = (unsigned)(Rb * K + C) * 2u; }
    const size_t kstep = (size_t)(BK * 2);
    const size_t hstep = (size_t)HALF * K * 2;
    const size_t tstep = 2 * hstep;
    const unsigned ldsw = (unsigned)wid * 1024u;
    const int aoff = lds_byte(wr * 64 + fr, fq * 8), boff = lds_byte(wc * 32 + fr, fq * 8);
#define PG8_SA(b, h) (((b) * 2 + (h)) * HTB)
#define PG8_SB(b, h) ((4 + (b) * 2 + (h)) * HTB)
#define PG8_STAGE(bufoff, gbase, voff) do { _Pragma("unroll") for (int _i = 0; _i < 2; ++_i) \
        __builtin_amdgcn_global_load_lds((const unsigned*)((const char*)(gbase) + (voff)[_i]), (PG8_LAS unsigned*)(lds + (bufoff) + ldsw + _i * 8192), 16, 0, 0); } while (0)
#define PG8_LDA(dst, b, h) do { _Pragma("unroll") for (int m = 0; m < 4; ++m) _Pragma("unroll") for (int k = 0; k < 2; ++k) dst[m][k] = *(const PG8_LAS bf16x8*)(lds + PG8_SA(b, h) + aoff + m * 2048 + k * 1024); } while (0)
#define PG8_LDB(dst, b, h) do { _Pragma("unroll") for (int n = 0; n < 2; ++n) _Pragma("unroll") for (int k = 0; k < 2; ++k) dst[n][k] = *(const PG8_LAS bf16x8*)(lds + PG8_SB(b, h) + boff + n * 2048 + k * 1024); } while (0)
#define PG8_MMA(ai, bj, At, Bt) do { __builtin_amdgcn_s_setprio(1); _Pragma("unroll") for (int m = 0; m < 4; ++m) _Pragma("unroll") for (int n = 0; n < 2; ++n) _Pragma("unroll") for (int k = 0; k < 2; ++k) \
        acc[ai][bj][m][n] = __builtin_amdgcn_mfma_f32_16x16x32_bf16(Bt[n][k], At[m][k], acc[ai][bj][m][n], 0, 0, 0); __builtin_amdgcn_s_setprio(0); } while (0)
#define PG8_WAIT_V(n) asm volatile("s_waitcnt vmcnt(" #n ")" ::: "memory")
#define PG8_WAIT_L(n) asm volatile("s_waitcnt lgkmcnt(" #n ")" ::: "memory")
#define PG8_BAR __builtin_amdgcn_s_barrier()
#define PG8_SCHED __builtin_amdgcn_sched_barrier(0)
    Unit cur, nxt; int ui = 0;
    if (!S.next(0, cur)) return;
    f32x4 acc[2][2][4][2];
#pragma unroll
    for (int a = 0; a < 2; ++a)
#pragma unroll
        for (int b = 0; b < 2; ++b)
#pragma unroll
            for (int m = 0; m < 4; ++m)
#pragma unroll
                for (int n = 0; n < 2; ++n) acc[a][b][m][n] = (f32x4){0.f, 0.f, 0.f, 0.f};
    bf16x8 At[4][2], B0[2][2], B1[2][2];
    const char* cA = (const char*)g.A + (size_t)cur.pm * tstep; const char* cB = (const char*)g.Bt + (size_t)cur.pn * tstep;
    S.a_ready(cur);
    if constexpr (SP2) {
        PG8_STAGE(PG8_SB(0, 0), cB, voffB); PG8_STAGE(PG8_SB(0, 1), cB + hstep, voffB); PG8_STAGE(PG8_SA(0, 0), cA, voffA); PG8_STAGE(PG8_SA(0, 1), cA + hstep, voffA);
        if (wr == 1) PG8_BAR;
        PG8_WAIT_V(2); PG8_BAR;
        PG8_STAGE(PG8_SB(1, 0), cB + kstep, voffB); PG8_STAGE(PG8_SA(1, 0), cA + kstep, voffA); PG8_STAGE(PG8_SB(1, 1), cB + hstep + kstep, voffB);
        PG8_WAIT_V(6); PG8_BAR;
    } else {
        PG8_STAGE(PG8_SB(0, 0), cB, voffB); PG8_STAGE(PG8_SA(0, 0), cA, voffA); PG8_STAGE(PG8_SB(0, 1), cB + hstep, voffB); PG8_STAGE(PG8_SA(0, 1), cA + hstep, voffA);
        if (wr == 1) PG8_BAR;
        PG8_WAIT_V(4); PG8_BAR;
        PG8_STAGE(PG8_SB(1, 0), cB + kstep, voffB); PG8_STAGE(PG8_SA(1, 0), cA + kstep, voffA); PG8_STAGE(PG8_SB(1, 1), cB + hstep + kstep, voffB);
        PG8_WAIT_V(6); PG8_BAR;
    }
    for (;;) {
        const bool has_next = S.next(ui + 1, nxt);
        const char* nA = has_next ? (const char*)g.A + (size_t)nxt.pm * tstep : cA; const char* nB = has_next ? (const char*)g.Bt + (size_t)nxt.pn * tstep : cB;
        for (int t = 0; t < nt; t += 2) {
            const bool last = (t == nt - 2);
            const char* a1 = cA + (size_t)(t + 1) * kstep;
            const char* a2 = last ? nA : cA + (size_t)(t + 2) * kstep; const char* b2 = last ? nB : cB + (size_t)(t + 2) * kstep;
            const char* a3 = a2 + kstep; const char* b3 = b2 + kstep;
            if (last && has_next) S.a_ready(nxt);
            if constexpr (SP2) {
            PG8_LDB(B0, 0, 0); PG8_LDB(B1, 0, 1); PG8_SCHED; PG8_LDA(At, 0, 0); PG8_STAGE(PG8_SA(1, 1), a1 + hstep, voffA);
            PG8_WAIT_V(8); PG8_WAIT_L(0); PG8_BAR; PG8_MMA(0, 0, At, B0); PG8_MMA(0, 1, At, B1); PG8_BAR; PG8_SCHED;
            PG8_LDA(At, 0, 1); PG8_STAGE(PG8_SB(0, 0), b2, voffB); PG8_STAGE(PG8_SB(0, 1), b2 + hstep, voffB); PG8_STAGE(PG8_SA(0, 0), a2, voffA);
            PG8_WAIT_V(8); PG8_WAIT_L(0); PG8_BAR; PG8_MMA(1, 0, At, B0); PG8_MMA(1, 1, At, B1); PG8_BAR; PG8_SCHED;
            PG8_LDB(B0, 1, 0); PG8_LDB(B1, 1, 1); PG8_SCHED; PG8_LDA(At, 1, 0); PG8_STAGE(PG8_SA(0, 1), a2 + hstep, voffA);
            PG8_WAIT_V(8); PG8_WAIT_L(0); PG8_BAR; PG8_MMA(0, 0, At, B0); PG8_MMA(0, 1, At, B1); PG8_BAR; PG8_SCHED;
            PG8_LDA(At, 1, 1); PG8_STAGE(PG8_SB(1, 0), b3, voffB); PG8_STAGE(PG8_SB(1, 1), b3 + hstep, voffB); PG8_STAGE(PG8_SA(1, 0), a3, voffA);
            PG8_WAIT_V(8); PG8_WAIT_L(0); PG8_BAR; PG8_MMA(1, 0, At, B0); PG8_MMA(1, 1, At, B1); PG8_BAR; PG8_SCHED;
            } else {
            PG8_LDB(B0, 0, 0); PG8_SCHED; PG8_LDA(At, 0, 0); PG8_STAGE(PG8_SA(1, 1), a1 + hstep, voffA);
            PG8_WAIT_L(8); PG8_BAR; PG8_WAIT_L(0); PG8_MMA(0, 0, At, B0); PG8_BAR; PG8_SCHED;
            PG8_LDB(B1, 0, 1); PG8_STAGE(PG8_SB(0, 0), b2, voffB);
            PG8_BAR; PG8_WAIT_L(0); PG8_MMA(0, 1, At, B1); PG8_BAR;
            PG8_LDA(At, 0, 1); PG8_STAGE(PG8_SA(0, 0), a2, voffA);
            PG8_BAR; PG8_WAIT_L(0); PG8_MMA(1, 0, At, B0); PG8_BAR; PG8_SCHED;
            PG8_STAGE(PG8_SB(0, 1), b2 + hstep, voffB);
            PG8_WAIT_V(6); PG8_BAR; PG8_MMA(1, 1, At, B1); PG8_BAR;
            PG8_LDB(B0, 1, 0); PG8_SCHED; PG8_LDA(At, 1, 0); PG8_STAGE(PG8_SA(0, 1), a2 + hstep, voffA);
            PG8_WAIT_L(8); PG8_BAR; PG8_WAIT_L(0); PG8_MMA(0, 0, At, B0); PG8_BAR; PG8_SCHED;
            PG8_LDB(B1, 1, 1); PG8_STAGE(PG8_SB(1, 0), b3, voffB);
            PG8_BAR; PG8_WAIT_L(0); PG8_MMA(0, 1, At, B1); PG8_BAR;
            PG8_LDA(At, 1, 1); PG8_STAGE(PG8_SA(1, 0), a3, voffA);
            PG8_BAR; PG8_WAIT_L(0); PG8_MMA(1, 0, At, B0); PG8_BAR; PG8_SCHED;
            PG8_STAGE(PG8_SB(1, 1), b3 + hstep, voffB);
            PG8_WAIT_V(6); PG8_BAR; PG8_MMA(1, 1, At, B1); PG8_BAR;
            }
        }
        if constexpr (ALIGN_EPI) { if (wr == 0) PG8_BAR; }
        if constexpr (!Epi::AFTER_DRAIN) { E(acc, cur, wr, wc, fr, fq); S.done(cur); }
        if (!has_next) break;
#pragma unroll
        for (int a = 0; a < 2; ++a)
#pragma unroll
            for (int b = 0; b < 2; ++b)
#pragma unroll
                for (int m = 0; m < 4; ++m)
#pragma unroll
                    for (int n = 0; n < 2; ++n) acc[a][b][m][n] = (f32x4){0.f, 0.f, 0.f, 0.f};
        cur = nxt; cA = nA; cB = nB; ++ui;
        if constexpr (ALIGN_EPI) { if (wr == 1) PG8_BAR; }
    }
    PG8_WAIT_V(0);
    if constexpr (!ALIGN_EPI) { if (wr == 0) PG8_BAR; }
    PG8_BAR;
    if constexpr (Epi::AFTER_DRAIN) { E.fused(acc, cur, wr, wc, fr, fq, lds, wid, lane); S.done(cur); }
#undef PG8_SA
#undef PG8_SB
#undef PG8_STAGE
#undef PG8_LDA
#undef PG8_LDB
#undef PG8_MMA
#undef PG8_WAIT_V
#undef PG8_WAIT_L
#undef PG8_BAR
#undef PG8_SCHED
}
}

#ifndef MK_N_LAUNCHES
#define MK_N_LAUNCHES 1
#endif
#define LAS __attribute__((address_space(3)))
using pg8::bf16_t; using pg8::bf16x8; using pg8::f32x4; using pg8::u32x4;
typedef float f32x16 __attribute__((ext_vector_type(16)));
typedef __bf16 bf16x2_t __attribute__((ext_vector_type(2)));
typedef float f32x2_t __attribute__((ext_vector_type(2)));
typedef unsigned u32x2 __attribute__((ext_vector_type(2)));

constexpr int NWAVES = 8, NTHR = 512;
constexpr int D = 1024, MP = 16384, MS = 1024, M = MP + MS, NIN = 3840, PLD = 3584, FF = 2816, NUP = 2 * FF;
constexpr float EPS = 1e-6f;
constexpr size_t MiB = 1u << 20;
constexpr size_t WS_WIN = 0, WS_WO = 8 * MiB, WS_W13 = 10 * MiB, WS_W2 = 21 * MiB, WS_RSTD1 = 27 * MiB, WS_SSQ2 = 28 * MiB, WS_LRA = 32 * MiB, WS_DCH = 34 * MiB,
                 WS_KDTS = 37 * MiB, WS_XB = 45 * MiB, WS_FB = 79 * MiB, WS_P = 113 * MiB, WS_END = 233 * MiB;
static_assert(WS_P + (size_t)(M + 32) * PLD * 2 <= WS_END && WS_XB + (size_t)M * D * 2 <= WS_FB && WS_FB + (size_t)M * 512 * 4 <= WS_P, "ws map");
constexpr size_t OUT_Y = 0, OUT_SAP = 17825792, OUT_SBP = 18087936, OUT_SAS = 18612224, OUT_SBS = 22806528;
constexpr int LDS_BYTES = 147456;

__device__ __forceinline__ unsigned pk_bf16(float lo, float hi) { f32x2_t v = {lo, hi}; bf16x2_t b = __builtin_convertvector(v, bf16x2_t); return __builtin_bit_cast(unsigned, b); }
__device__ __forceinline__ float bf_lo(unsigned u) { return __uint_as_float(u << 16); }
__device__ __forceinline__ float bf_hi(unsigned u) { return __uint_as_float(u & 0xffff0000u); }
__device__ __forceinline__ float bf_f(unsigned short u) { return __uint_as_float(((unsigned)u) << 16); }
__device__ __forceinline__ float wave_sum(float v) {
#pragma unroll
    for (int o = 1; o < 64; o <<= 1) v += __shfl_xor(v, o);
    return v;
}
#define LDS_WAIT() asm volatile("s_waitcnt lgkmcnt(0)" ::: "memory")
#define WG_BAR() do { asm volatile("s_waitcnt lgkmcnt(0)" ::: "memory"); __builtin_amdgcn_s_barrier(); asm volatile("" ::: "memory"); } while (0)
#define MFMA32(a, b, c) __builtin_amdgcn_mfma_f32_32x32x16_bf16((a), (b), (c), 0, 0, 0)
#define MFMA16(a, b, c) __builtin_amdgcn_mfma_f32_16x16x32_bf16((a), (b), (c), 0, 0, 0)

struct Ptrs {
    const float* in[17]; float* out;
    bf16_t *WinT, *WoT, *W13T, *W2T, *XB, *P, *KDTS, *OF, *X1B, *HID;
    float *RSTD1, *SSQ2, *LRA, *DCH, *FB, *OY;
};

namespace pg8 {
struct EpiIn {
    static constexpr bool PERM = true, AFTER_DRAIN = false;
    bf16_t* P; float* FB; float* LRA; const float* rstd;
    __device__ __forceinline__ void operator()(const f32x4 (&acc)[2][2][4][2], const Unit& u, int wr, int wc, int fr, int fq) const {
        const int row0 = u.pm * BM + wr * 64 + fr, ct = wc * 32 + 8 * fq;
#pragma unroll
        for (int ai = 0; ai < 2; ++ai)
#pragma unroll
            for (int m = 0; m < 4; ++m) {
                const int row = row0 + ai * HALF + m * 16; const float rs = rstd[row];
#pragma unroll
                for (int bj = 0; bj < 2; ++bj) {
                    const f32x4 v0 = acc[ai][bj][m][0] * rs, v1 = acc[ai][bj][m][1] * rs; const int cl = bj * HALF + ct;
                    if (u.pn == 8 || u.pn == 9) { float* o = FB + (size_t)row * 512 + (u.pn - 8) * BM + cl; *(f32x4*)o = v0; *(f32x4*)(o + 4) = v1; }
                    else if (u.pn == 14) { if (cl < 16) { float* o = LRA + (size_t)row * 16 + cl; *(f32x4*)o = v0; *(f32x4*)(o + 4) = v1; } }
                    else { u32x4 w; w.x = cvt_pk_bf16(v0[0], v0[1]); w.y = cvt_pk_bf16(v0[2], v0[3]); w.z = cvt_pk_bf16(v1[0], v1[1]); w.w = cvt_pk_bf16(v1[2], v1[3]);
                           *(u32x4*)(P + (size_t)row * 3584 + u.pn * BM + cl) = w; }
                }
            }
    }
};
struct EpiRes1 {
    static constexpr bool PERM = true, AFTER_DRAIN = false;
    const float* xp; const float* xs; float* Y; bf16_t* X1B; float* SSQ;
    __device__ __forceinline__ void operator()(const f32x4 (&acc)[2][2][4][2], const Unit& u, int wr, int wc, int fr, int fq) const {
        const int row0 = u.pm * BM + wr * 64 + fr, ct = u.pn * BM + wc * 32 + 8 * fq;
#pragma unroll
        for (int ai = 0; ai < 2; ++ai)
#pragma unroll
            for (int m = 0; m < 4; ++m) {
                const int row = row0 + ai * HALF + m * 16;
                const float* xr = row < 16384 ? xp + (size_t)row * 1024 : xs + (size_t)(row - 16384) * 1024;
                float ss = 0.f;
#pragma unroll
                for (int bj = 0; bj < 2; ++bj) {
                    const int col = ct + bj * HALF;
                    const f32x4 v0 = acc[ai][bj][m][0] + *(const f32x4*)(xr + col), v1 = acc[ai][bj][m][1] + *(const f32x4*)(xr + col + 4);
                    *(f32x4*)(Y + (size_t)row * 1024 + col) = v0; *(f32x4*)(Y + (size_t)row * 1024 + col + 4) = v1;
                    u32x4 w; w.x = cvt_pk_bf16(v0[0], v0[1]); w.y = cvt_pk_bf16(v0[2], v0[3]); w.z = cvt_pk_bf16(v1[0], v1[1]); w.w = cvt_pk_bf16(v1[2], v1[3]);
                    *(u32x4*)(X1B + (size_t)row * 1024 + col) = w;
                    ss += (v0[0] * v0[0] + v0[1] * v0[1]) + (v0[2] * v0[2] + v0[3] * v0[3]) + (v1[0] * v1[0] + v1[1] * v1[1]) + (v1[2] * v1[2] + v1[3] * v1[3]);
                }
                ss += __shfl_xor(ss, 16); ss += __shfl_xor(ss, 32);
                if (fq == 0) SSQ[(size_t)row * 16 + u.pn * 4 + wc] = ss;
            }
    }
};
struct EpiSwiglu {
    static constexpr bool PERM = true, AFTER_DRAIN = false;
    bf16_t* H; const float* SSQ;
    __device__ __forceinline__ void operator()(const f32x4 (&acc)[2][2][4][2], const Unit& u, int wr, int wc, int fr, int fq) const {
        const int row0 = u.pm * BM + wr * 64 + fr, hc = u.pn * 128 + wc * 16 + fq * 4;
#pragma unroll
        for (int ai = 0; ai < 2; ++ai)
#pragma unroll
            for (int m = 0; m < 4; ++m) {
                const int row = row0 + ai * HALF + m * 16;
                const f32x4* sp = (const f32x4*)(SSQ + (size_t)row * 16);
                const f32x4 s0 = sp[0], s1 = sp[1], s2 = sp[2], s3 = sp[3];
                const float tot = ((s0[0] + s0[1]) + (s0[2] + s0[3])) + ((s1[0] + s1[1]) + (s1[2] + s1[3])) + ((s2[0] + s2[1]) + (s2[2] + s2[3])) + ((s3[0] + s3[1]) + (s3[2] + s3[3]));
                const float rs = 1.0f / sqrtf(tot * (1.0f / 1024.0f) + 1e-6f);
#pragma unroll
                for (int bj = 0; bj < 2; ++bj) {
                    const f32x4 a = acc[ai][bj][m][0] * rs, b = acc[ai][bj][m][1] * rs; float h[4];
#pragma unroll
                    for (int e = 0; e < 4; ++e) h[e] = a[e] / (1.0f + __expf(-a[e])) * b[e];
                    unsigned lo = cvt_pk_bf16(h[0], h[1]), hi = cvt_pk_bf16(h[2], h[3]);
                    *(unsigned long long*)(H + (size_t)row * 2816 + hc + bj * 64) = (unsigned long long)lo | ((unsigned long long)hi << 32);
                }
            }
    }
};
struct EpiRes2 {
    static constexpr bool PERM = true, AFTER_DRAIN = false;
    float* Y;
    __device__ __forceinline__ void operator()(const f32x4 (&acc)[2][2][4][2], const Unit& u, int wr, int wc, int fr, int fq) const {
        const int row0 = u.pm * BM + wr * 64 + fr, ct = u.pn * BM + wc * 32 + 8 * fq;
#pragma unroll
        for (int ai = 0; ai < 2; ++ai)
#pragma unroll
            for (int m = 0; m < 4; ++m) {
                float* yr = Y + (size_t)(row0 + ai * HALF + m * 16) * 1024;
#pragma unroll
                for (int bj = 0; bj < 2; ++bj) {
                    const int col = ct + bj * HALF;
                    const f32x4 v0 = acc[ai][bj][m][0] + *(const f32x4*)(yr + col), v1 = acc[ai][bj][m][1] + *(const f32x4*)(yr + col + 4);
                    *(f32x4*)(yr + col) = v0; *(f32x4*)(yr + col + 4) = v1;
                }
            }
    }
};
}

__device__ __forceinline__ void tr_item(const float* colp, int ldw, const float* gain, int k0, int dcol, bf16_t* WT, int K, int nrow0, LAS float* scr, int lane) {
#pragma unroll 8
    for (int i = 0; i < 32; ++i) {
        const int kk = 2 * i + (lane >> 5); float v = 0.f;
        if (colp) { v = colp[(size_t)(k0 + kk) * ldw]; if (gain) v *= gain[k0 + kk]; }
        scr[kk * 33 + dcol] = v;
    }
    LDS_WAIT();
    const int c = lane & 7;
#pragma unroll
    for (int j = 0; j < 4; ++j) {
        const int n = (lane >> 3) + 8 * j; const LAS float* s = scr + (8 * c) * 33 + n;
        u32x4 o; o.x = pk_bf16(s[0 * 33], s[1 * 33]); o.y = pk_bf16(s[2 * 33], s[3 * 33]); o.z = pk_bf16(s[4 * 33], s[5 * 33]); o.w = pk_bf16(s[6 * 33], s[7 * 33]);
        *(u32x4*)(WT + (size_t)(nrow0 + n) * K + k0 + 8 * c) = o;
    }
    LDS_WAIT();
}
__device__ __forceinline__ void p0_prologue(const Ptrs& c, LAS unsigned char* lds, int G, int wave, int lane) {
    LAS float* scr = (LAS float*)(lds + wave * 16384);
    const int gw = blockIdx.x * NWAVES + wave, NGW = G * NWAVES, l31 = lane & 31;
    constexpr int I_IN = 16 * 120, I_O = 16 * 32, I_13 = 16 * 176, I_2 = 44 * 32, NITEMS = I_IN + I_O + I_13 + I_2;
    for (int it = gw; it < NITEMS; it += NGW) {
        int r = it;
        if (r < I_IN) { const int kb = r / 120, nb = r % 120, n = nb * 32 + l31;
            const int oc = n < 1536 ? n : (n < 3584 ? n + 16 : (n < 3600 ? n - 3584 + 1536 : -1));
            tr_item(oc >= 0 ? c.in[5] + oc : nullptr, 3600, c.in[4], kb * 64, l31, c.WinT, 1024, nb * 32, scr, lane); continue; }
        r -= I_IN;
        if (r < I_O) { const int kb = r / 32, nb = r % 32; tr_item(c.in[11] + nb * 32 + l31, 1024, nullptr, kb * 64, l31, c.WoT, 1024, nb * 32, scr, lane); continue; }
        r -= I_O;
        if (r < I_13) { const int kb = r / 176, nb = r % 176; const bool is3 = l31 >= 16; const int hcol = nb * 16 + (l31 & 15);
            tr_item((is3 ? c.in[14] : c.in[13]) + hcol, 2816, c.in[12], kb * 64, ((l31 & 15) >> 2) * 8 + (is3 ? 4 : 0) + (l31 & 3), c.W13T, 1024, nb * 32, scr, lane); continue; }
        r -= I_13;
        { const int kb = r / 32, nb = r % 32; tr_item(c.in[15] + nb * 32 + l31, 1024, nullptr, kb * 64, l31, c.W2T, 2816, nb * 32, scr, lane); }
    }
    for (int m = gw; m < M; m += NGW) {
        const float* xr = m < MP ? c.in[0] + (size_t)m * D : c.in[1] + (size_t)(m - MP) * D;
        f32x4 v[4]; float s = 0.f;
#pragma unroll
        for (int j = 0; j < 4; ++j) { v[j] = *(const f32x4*)(xr + 4 * lane + 256 * j); s += (v[j][0] * v[j][0] + v[j][1] * v[j][1]) + (v[j][2] * v[j][2] + v[j][3] * v[j][3]); }
        s = wave_sum(s);
#pragma unroll
        for (int j = 0; j < 4; ++j) { u32x2 w; w.x = pk_bf16(v[j][0], v[j][1]); w.y = pk_bf16(v[j][2], v[j][3]); *(u32x2*)(c.XB + (size_t)m * D + 4 * lane + 256 * j) = w; }
        if (lane == 0) c.RSTD1[m] = 1.0f / sqrtf(s * (1.0f / D) + EPS);
    }
}

__device__ __forceinline__ int crow(int i, int h) { return (i & 3) + 8 * (i >> 2) + 4 * h; }
template <int K, bool GLA>
__device__ __forceinline__ void pre_item(const Ptrs& c, int row0, int ntok, int hh, int item, bf16_t* kdt_base, int kdt_stride,
                                         const LAS float* wa2_l, const LAS float* ba_l, const LAS float* lb_l, int lane) {
    const int r = lane & 31, kg = lane >> 5;
    const bool valid = r < ntok;
    const int row = row0 + (valid ? r : 0);
    constexpr int NJ = K / 16;
    const int qcol0 = GLA ? hh * 64 : 1536 + hh * 128, kcol0 = 256 + hh * 64, vcol0 = GLA ? 512 + hh * 128 : 2560 + hh * 128, ocol0 = (GLA ? hh : 4 + hh) * 128;
    bf16_t* Prow = c.P + (size_t)row * PLD;
    float lra[16]; u32x4 kreg[NJ];
    if constexpr (GLA) {
#pragma unroll
        for (int i = 0; i < 4; ++i) { const f32x4 t = *(const f32x4*)(c.LRA + (size_t)row * 16 + 4 * i); lra[4 * i] = t[0]; lra[4 * i + 1] = t[1]; lra[4 * i + 2] = t[2]; lra[4 * i + 3] = t[3]; }
#pragma unroll
        for (int j = 0; j < NJ; ++j) kreg[j] = *(const u32x4*)(Prow + kcol0 + 16 * j + 8 * kg);
        asm volatile("s_waitcnt vmcnt(0)" ::: "memory");
    }
    f32x16 att;
#pragma unroll
    for (int i = 0; i < 16; ++i) att[i] = 0.f;
    float* dch = c.DCH + (size_t)item * 128;
#pragma unroll
    for (int j = 0; j < NJ; ++j) {
        const int cl = 16 * j + 8 * kg;
        float la[8], kv[8], qv[8];
        if constexpr (GLA) {
            const LAS float* wl = wa2_l + hh * 64 + cl;
            f32x4 a0 = *(const LAS f32x4*)(ba_l + hh * 64 + cl), a1 = *(const LAS f32x4*)(ba_l + hh * 64 + cl + 4);
#pragma unroll
            for (int rr = 0; rr < 16; ++rr) { const f32x4 w0 = *(const LAS f32x4*)(wl + rr * 256), w1 = *(const LAS f32x4*)(wl + rr * 256 + 4); a0 += w0 * lra[rr]; a1 += w1 * lra[rr]; }
#pragma unroll
            for (int e = 0; e < 8; ++e) { const float x = e < 4 ? a0[e & 3] : a1[e & 3]; la[e] = (fminf(x, 0.f) - __logf(1.0f + __expf(-fabsf(x)))) * 0.0625f; }
            const u32x4 kr = kreg[j];
            kv[0] = bf_lo(kr.x); kv[1] = bf_hi(kr.x); kv[2] = bf_lo(kr.y); kv[3] = bf_hi(kr.y); kv[4] = bf_lo(kr.z); kv[5] = bf_hi(kr.z); kv[6] = bf_lo(kr.w); kv[7] = bf_hi(kr.w);
        } else {
            const float* fp = c.FB + (size_t)row * 512 + hh * 128 + cl;
            const f32x4 f0 = *(const f32x4*)fp, f1 = *(const f32x4*)(fp + 4);
            const f32x4 l0 = *(const LAS f32x4*)(lb_l + hh * 128 + cl), l1 = *(const LAS f32x4*)(lb_l + hh * 128 + cl + 4);
#pragma unroll
            for (int e = 0; e < 8; ++e) {
                const float x = e < 4 ? f0[e & 3] : f1[e & 3], lb = e < 4 ? l0[e & 3] : l1[e & 3];
                const float ex = __expf(-fabsf(x)), inv = 1.0f / (1.0f + ex);
                const float sg = x >= 0.f ? inv : ex * inv, ng = x >= 0.f ? ex * inv : inv;
                la[e] = __logf(lb + (1.0f - lb) * sg); kv[e] = (1.0f - lb) * ng;
            }
        }
        {
            const u32x4 qr = *(const u32x4*)(Prow + qcol0 + cl);
            qv[0] = bf_lo(qr.x); qv[1] = bf_hi(qr.x); qv[2] = bf_lo(qr.y); qv[3] = bf_hi(qr.y); qv[4] = bf_lo(qr.z); qv[5] = bf_hi(qr.z); qv[6] = bf_lo(qr.w); qv[7] = bf_hi(qr.w);
        }
        float qi[8], ki[8], kd[8], bl[8];
#pragma unroll
        for (int e = 0; e < 8; ++e) {
            float q = GLA ? qv[e] * 0.125f : qv[e] / (1.0f + __expf(-qv[e]));
            float k = kv[e], a = la[e];
            if (!valid) { q = 0.f; k = 0.f; a = 0.f; }
#pragma unroll
            for (int off = 1; off < 32; off <<= 1) { const float t = __shfl_up(a, off, 32); if (r >= off) a += t; }
            const float b_last = __shfl(a, 31, 32);
            qi[e] = q * __expf(a); ki[e] = k * __expf(-a); kd[e] = k * __expf(b_last - a); bl[e] = b_last;
        }
        u32x4 qp, kp;
        qp.x = pk_bf16(qi[0], qi[1]); qp.y = pk_bf16(qi[2], qi[3]); qp.z = pk_bf16(qi[4], qi[5]); qp.w = pk_bf16(qi[6], qi[7]);
        kp.x = pk_bf16(ki[0], ki[1]); kp.y = pk_bf16(ki[2], ki[3]); kp.z = pk_bf16(ki[4], ki[5]); kp.w = pk_bf16(ki[6], ki[7]);
        att = MFMA32(__builtin_bit_cast(bf16x8, kp), __builtin_bit_cast(bf16x8, qp), att);
        if (valid) *(u32x4*)(Prow + qcol0 + cl) = qp;
#pragma unroll
        for (int e = 0; e < 8; e += 2) {
            const unsigned pkd = pk_bf16(kd[e], kd[e + 1]);
            const int L0 = (cl + e) * 32 + r, L1 = L0 + 32;
            kdt_base[(size_t)(L0 / K) * kdt_stride + (L0 % K)] = (bf16_t)(pkd & 0xffffu);
            kdt_base[(size_t)(L1 / K) * kdt_stride + (L1 % K)] = (bf16_t)(pkd >> 16);
        }
        if (r == 0) {
            f32x4 d0, d1;
#pragma unroll
            for (int e = 0; e < 4; ++e) { d0[e] = __expf(bl[e]); d1[e] = __expf(bl[e + 4]); }
            *(f32x4*)(dch + cl) = d0; *(f32x4*)(dch + cl + 4) = d1;
        }
    }
#pragma unroll
    for (int i = 0; i < 16; ++i) if (crow(i, kg) > r) att[i] = 0.f;
    u32x4 pa0, pa1;
    pa0.x = pk_bf16(att[0], att[1]); pa0.y = pk_bf16(att[2], att[3]); pa0.z = pk_bf16(att[4], att[5]); pa0.w = pk_bf16(att[6], att[7]);
    pa1.x = pk_bf16(att[8], att[9]); pa1.y = pk_bf16(att[10], att[11]); pa1.z = pk_bf16(att[12], att[13]); pa1.w = pk_bf16(att[14], att[15]);
    const bf16_t* Pv = c.P + (size_t)row0 * PLD + vcol0 + r;
    float* Oy = c.OY + (size_t)row0 * 1024 + ocol0 + r;
#pragma unroll
    for (int vb = 0; vb < 4; ++vb) {
        unsigned short vs[16];
#pragma unroll
        for (int i = 0; i < 16; ++i) { int s = crow(i, kg); s = s < ntok ? s : ntok - 1; vs[i] = Pv[(size_t)s * PLD + vb * 32]; }
        u32x4 b0, b1;
        b0.x = vs[0] | ((unsigned)vs[1] << 16); b0.y = vs[2] | ((unsigned)vs[3] << 16); b0.z = vs[4] | ((unsigned)vs[5] << 16); b0.w = vs[6] | ((unsigned)vs[7] << 16);
        b1.x = vs[8] | ((unsigned)vs[9] << 16); b1.y = vs[10] | ((unsigned)vs[11] << 16); b1.z = vs[12] | ((unsigned)vs[13] << 16); b1.w = vs[14] | ((unsigned)vs[15] << 16);
        f32x16 o;
#pragma unroll
        for (int i = 0; i < 16; ++i) o[i] = 0.f;
        o = MFMA32(__builtin_bit_cast(bf16x8, pa0), __builtin_bit_cast(bf16x8, b0), o);
        o = MFMA32(__builtin_bit_cast(bf16x8, pa1), __builtin_bit_cast(bf16x8, b1), o);
#pragma unroll
        for (int i = 0; i < 16; ++i) { const int t = crow(i, kg); if (t < ntok) Oy[(size_t)t * 1024 + vb * 32] = o[i]; }
    }
}
__device__ __forceinline__ void p2_prepass(const Ptrs& c, LAS unsigned char* lds, int G, int tid, int wave, int lane) {
    LAS float* wa2_l = (LAS float*)lds; LAS float* ba_l = wa2_l + 4096; LAS float* lb_l = ba_l + 256;
    for (int i = tid; i < 4096; i += NTHR) wa2_l[i] = c.in[6][i];
    if (tid < 256) ba_l[tid] = c.in[7][tid];
    { const float p0 = c.in[8][tid], p1 = c.in[8][512 + tid]; lb_l[tid] = 1.0f / (1.0f + __expf(p1 - p0)); }
    WG_BAR();
    const int gw = blockIdx.x * NWAVES + wave, NGW = G * NWAVES;
    for (int it = gw; it < 4096 + 1024; it += NGW) {
        int row0, ntok, h; bf16_t* kdt; int kst;
        if (it < 4096) { h = it & 7; const int ch = (it >> 3) & 63, b = it >> 9; row0 = b * 2048 + ch * 32; ntok = 32; kst = PLD;
                         kdt = c.P + (size_t)row0 * PLD + (h < 4 ? 256 + h * 64 : 2048 + (h - 4) * 128); }
        else { const int j = it - 4096; h = j & 7; row0 = MP + (j >> 3) * 8; ntok = 8; kst = h < 4 ? 64 : 128; kdt = c.KDTS + (size_t)j * 4096; }
        if (h < 4) pre_item<64, true>(c, row0, ntok, h, it, kdt, kst, wa2_l, ba_l, lb_l, lane);
        else pre_item<128, false>(c, row0, ntok, h - 4, it, kdt, kst, wa2_l, ba_l, lb_l, lane);
    }
}

template <int K>
__device__ __forceinline__ void seq_item(const Ptrs& c, LAS unsigned char* lds, int row0, int nch, int ntok, int h8, const float* S0, float* Sout,
                                         const bf16_t* kdt0, int kdt_rstride, size_t kdt_cstep, const float* dch0, size_t dch_cstep, const float* gain, int tid, int wave, int lane) {
    constexpr int QROW = 2 * K + 16, KOFF = 8704, DOFF = 18944, BUFB = 19456, SSQOFF = 2 * BUFB, NMB = K / 16, NPC = 4 * K;
    const int n = lane & 15, q = lane >> 4, col = 16 * wave + n;
    const bool gla = h8 < 4; const int hh = h8 & 3;
    const int qcol0 = gla ? hh * 64 : 1536 + hh * 128, vcol0 = gla ? 512 + hh * 128 : 2560 + hh * 128, gcol0 = gla ? 1024 + hh * 128 : 3072 + hh * 128, ocol = h8 * 128 + col;
    const float gv = gain[col];
    f32x4 S[NMB];
#pragma unroll
    for (int mb = 0; mb < NMB; ++mb)
#pragma unroll
        for (int i = 0; i < 4; ++i) S[mb][i] = S0 ? S0[(size_t)(16 * mb + 4 * q + i) * 128 + col] : 0.f;
    const int prow = tid / (K / 8), pc8 = tid % (K / 8);
    u32x4 sq = {0u, 0u, 0u, 0u}, sk = {0u, 0u, 0u, 0u}; f32x4 sd = {0.f, 0.f, 0.f, 0.f};
    float oiC[8], oiN[8]; unsigned short gC[8], gN[8], vC[8], vN[8];
#define SEQ_LOAD_STAGE(ci) do { if (tid < NPC) { sq = *(const u32x4*)(c.P + (size_t)(row0 + 32 * (ci) + prow) * PLD + qcol0 + pc8 * 8); \
            sk = *(const u32x4*)(kdt0 + (size_t)(ci) * kdt_cstep + (size_t)prow * kdt_rstride + pc8 * 8); } \
        if (tid < K / 4) sd = *(const f32x4*)(dch0 + (size_t)(ci) * dch_cstep + tid * 4); } while (0)
#define SEQ_STORE_STAGE(buf) do { LAS unsigned char* B_ = lds + (buf) * BUFB; if (tid < NPC) { *(LAS u32x4*)(B_ + prow * QROW + pc8 * 16) = sq; *(LAS u32x4*)(B_ + KOFF + (tid >> 2) * 80 + (tid & 3) * 16) = sk; } \
        if (tid < K / 4) *(LAS f32x4*)(B_ + DOFF + tid * 16) = sd; } while (0)
#define SEQ_LOAD_PRV(ci, OI, GG, VV) do { const int rb_ = row0 + 32 * (ci); \
        _Pragma("unroll") for (int x_ = 0; x_ < 8; ++x_) { const int t_ = 16 * (x_ >> 2) + 4 * q + (x_ & 3); const bool ok_ = t_ < ntok; \
            OI[x_] = ok_ ? c.OY[(size_t)(rb_ + t_) * 1024 + ocol] : 0.f; GG[x_] = ok_ ? c.P[(size_t)(rb_ + t_) * PLD + gcol0 + col] : (unsigned short)0; \
            const int s_ = 8 * q + x_; VV[x_] = s_ < ntok ? c.P[(size_t)(rb_ + s_) * PLD + vcol0 + col] : (unsigned short)0; } } while (0)
    SEQ_LOAD_STAGE(0); SEQ_LOAD_PRV(0, oiC, gC, vC);
    SEQ_STORE_STAGE(0);
    if (nch > 1) { SEQ_LOAD_STAGE(1); SEQ_LOAD_PRV(1, oiN, gN, vN); }
    WG_BAR();
    for (int ci = 0; ci < nch; ++ci) {
        const LAS unsigned char* B = lds + (ci & 1) * BUFB;
        LAS float* ssq = (LAS float*)(lds + SSQOFF + (ci & 1) * 1024);
        f32x4 o[2] = {{0.f, 0.f, 0.f, 0.f}, {0.f, 0.f, 0.f, 0.f}};
#pragma unroll
        for (int js = 0; js < K / 32; ++js) {
            u32x4 sb; sb.x = pk_bf16(S[2 * js][0], S[2 * js][1]); sb.y = pk_bf16(S[2 * js][2], S[2 * js][3]); sb.z = pk_bf16(S[2 * js + 1][0], S[2 * js + 1][1]); sb.w = pk_bf16(S[2 * js + 1][2], S[2 * js + 1][3]);
#pragma unroll
            for (int mb2 = 0; mb2 < 2; ++mb2) {
                const LAS unsigned char* qp = B + (16 * mb2 + n) * QROW + (32 * js + 4 * q) * 2;
                const u32x2 lo = *(const LAS u32x2*)qp, hi = *(const LAS u32x2*)(qp + 32);
                u32x4 qa; qa.x = lo.x; qa.y = lo.y; qa.z = hi.x; qa.w = hi.y;
                o[mb2] = MFMA16(__builtin_bit_cast(bf16x8, qa), __builtin_bit_cast(bf16x8, sb), o[mb2]);
            }
        }
#pragma unroll
        for (int x = 0; x < 8; ++x) {
            o[x >> 2][x & 3] += oiC[x];
            float p = o[x >> 2][x & 3] * o[x >> 2][x & 3];
            p += __shfl_xor(p, 1); p += __shfl_xor(p, 2); p += __shfl_xor(p, 4); p += __shfl_xor(p, 8);
            if (n == 0) ssq[(16 * (x >> 2) + 4 * q + (x & 3)) * 8 + wave] = p;
        }
        {
            u32x4 vb; vb.x = vC[0] | ((unsigned)vC[1] << 16); vb.y = vC[2] | ((unsigned)vC[3] << 16); vb.z = vC[4] | ((unsigned)vC[5] << 16); vb.w = vC[6] | ((unsigned)vC[7] << 16);
#pragma unroll
            for (int mb = 0; mb < NMB; ++mb) {
                const u32x4 ka = *(const LAS u32x4*)(B + KOFF + (16 * mb + n) * 80 + q * 16);
                const f32x4 dv = *(const LAS f32x4*)(B + DOFF + (16 * mb + 4 * q) * 4);
                S[mb] = S[mb] * dv;
                S[mb] = MFMA16(__builtin_bit_cast(bf16x8, ka), __builtin_bit_cast(bf16x8, vb), S[mb]);
            }
        }
        unsigned short gF[8];
#pragma unroll
        for (int x = 0; x < 8; ++x) gF[x] = gC[x];
        if (ci + 1 < nch) {
            SEQ_STORE_STAGE((ci + 1) & 1);
#pragma unroll
            for (int x = 0; x < 8; ++x) { oiC[x] = oiN[x]; gC[x] = gN[x]; vC[x] = vN[x]; }
        }
        if (ci + 2 < nch) { SEQ_LOAD_STAGE(ci + 2); SEQ_LOAD_PRV(ci + 2, oiN, gN, vN); }
        WG_BAR();
        const int rb = row0 + 32 * ci;
#pragma unroll
        for (int x = 0; x < 8; ++x) {
            const int t = 16 * (x >> 2) + 4 * q + (x & 3);
            const f32x4 t0 = *(const LAS f32x4*)(ssq + t * 8), t1 = *(const LAS f32x4*)(ssq + t * 8 + 4);
            const float tot = ((t0[0] + t0[1]) + (t0[2] + t0[3])) + ((t1[0] + t1[1]) + (t1[2] + t1[3]));
            const float rs = 1.0f / sqrtf(tot * (1.0f / 128.0f) + EPS), g = bf_f(gF[x]);
            const float val = o[x >> 2][x & 3] * rs * gv * (g / (1.0f + __expf(-g)));
            if (t < ntok) c.OF[(size_t)(rb + t) * 1024 + ocol] = (bf16_t)(pk_bf16(val, 0.f) & 0xffffu);
        }
    }
#pragma unroll
    for (int mb = 0; mb < NMB; ++mb)
#pragma unroll
        for (int i = 0; i < 4; ++i) Sout[(size_t)(16 * mb + 4 * q + i) * 128 + col] = S[mb][i];
#undef SEQ_LOAD_STAGE
#undef SEQ_STORE_STAGE
#undef SEQ_LOAD_PRV
}
__device__ __forceinline__ void seq_dispatch(const Ptrs& c, LAS unsigned char* lds, int item, int tid, int wave, int lane) {
    int row0, nch, ntok, h8; const float* S0; float* Sout; const bf16_t* kdt0; int kst; size_t kcs, dcs; const float* dch0;
    if (item < 64) {
        const int b = item >> 3; h8 = item & 7; const int hh = h8 & 3; row0 = b * 2048; nch = 64; ntok = 32; S0 = nullptr;
        Sout = h8 < 4 ? c.out + OUT_SAP + (size_t)(b * 4 + hh) * 64 * 128 : c.out + OUT_SBP + (size_t)(b * 4 + hh) * 128 * 128;
        kdt0 = c.P + (size_t)row0 * PLD + (h8 < 4 ? 256 + hh * 64 : 2048 + hh * 128); kst = PLD; kcs = (size_t)32 * PLD;
        dch0 = c.DCH + (size_t)(b * 64 * 8 + h8) * 128; dcs = 8 * 128;
    } else {
        const int j = item - 64, b = j >> 3; h8 = j & 7; const int hh = h8 & 3; row0 = MP + b * 8; nch = 1; ntok = 8;
        S0 = h8 < 4 ? c.in[2] + (size_t)(b * 4 + hh) * 64 * 128 : c.in[3] + (size_t)(b * 4 + hh) * 128 * 128;
        Sout = h8 < 4 ? c.out + OUT_SAS + (size_t)(b * 4 + hh) * 64 * 128 : c.out + OUT_SBS + (size_t)(b * 4 + hh) * 128 * 128;
        kdt0 = c.KDTS + (size_t)j * 4096; kst = h8 < 4 ? 64 : 128; kcs = 0; dch0 = c.DCH + (size_t)(4096 + j) * 128; dcs = 0;
    }
    if (h8 < 4) seq_item<64>(c, lds, row0, nch, ntok, h8, S0, Sout, kdt0, kst, kcs, dch0, dcs, c.in[9], tid, wave, lane);
    else seq_item<128>(c, lds, row0, nch, ntok, h8, S0, Sout, kdt0, kst, kcs, dch0, dcs, c.in[10], tid, wave, lane);
}

struct Args { const float* in[17]; float* out; unsigned char* ws; int ph_lo, ph_hi; };
constexpr int NPHASE = 8;
__global__ void __launch_bounds__(NTHR, 2) hymba_fwd(Args args) {
    extern __shared__ __attribute__((aligned(16))) unsigned char lds_raw[];
    LAS unsigned char* lds = (LAS unsigned char*)lds_raw;
    const int tid = threadIdx.x, lane = tid & 63, wave = __builtin_amdgcn_readfirstlane(tid >> 6), G = gridDim.x;
    Ptrs c;
#pragma unroll
    for (int i = 0; i < 17; ++i) c.in[i] = args.in[i];
    c.out = args.out;
    unsigned char* ws = args.ws;
    c.WinT = (bf16_t*)(ws + WS_WIN); c.WoT = (bf16_t*)(ws + WS_WO); c.W13T = (bf16_t*)(ws + WS_W13); c.W2T = (bf16_t*)(ws + WS_W2);
    c.XB = (bf16_t*)(ws + WS_XB); c.OF = (bf16_t*)(ws + WS_XB); c.P = (bf16_t*)(ws + WS_P); c.HID = (bf16_t*)(ws + WS_P); c.KDTS = (bf16_t*)(ws + WS_KDTS);
    c.X1B = (bf16_t*)(ws + WS_FB); c.FB = (float*)(ws + WS_FB);
    c.RSTD1 = (float*)(ws + WS_RSTD1); c.SSQ2 = (float*)(ws + WS_SSQ2); c.LRA = (float*)(ws + WS_LRA); c.DCH = (float*)(ws + WS_DCH); c.OY = args.out + OUT_Y;
    const int lo = args.ph_lo, hi = args.ph_hi;
#define IN(k) (lo <= (k) && (k) < hi)
#define SEAM(k) do { if (IN(k) && IN((k) + 1)) cg::this_grid().sync(); } while (0)
    if (IN(0)) { p0_prologue(c, lds, G, wave, lane); }
    SEAM(0);
    if (IN(1)) {
        pg8::Gemm g{c.XB, c.WinT, M, NIN, D}; pg8::StaticOrder S; S.init(M, NIN, G, (int)blockIdx.x);
        pg8::EpiIn E{c.P, c.FB, c.LRA, c.RSTD1};
        pg8::gemm_phase<pg8::EpiIn, pg8::StaticOrder, true, true>(lds, g, S, E);
    }
    SEAM(1);
    if (IN(2)) { p2_prepass(c, lds, G, tid, wave, lane); }
    SEAM(2);
    if (IN(3)) {
        const int wg = blockIdx.x;
        if (G > 64) { if (wg < 64) seq_dispatch(c, lds, wg, tid, wave, lane); else for (int j = wg - 64; j < 1024; j += G - 64) seq_dispatch(c, lds, 64 + j, tid, wave, lane); }
        else for (int it = wg; it < 64 + 1024; it += G) seq_dispatch(c, lds, it, tid, wave, lane);
    }
    SEAM(3);
    if (IN(4)) {
        pg8::Gemm g{c.OF, c.WoT, M, D, D}; pg8::StaticOrder S; S.init(M, D, G, (int)blockIdx.x);
        pg8::EpiRes1 E{c.in[0], c.in[1], c.OY, c.X1B, c.SSQ2};
        pg8::gemm_phase<pg8::EpiRes1, pg8::StaticOrder, true, true>(lds, g, S, E);
    }
    SEAM(4);
    if (IN(5)) {
        pg8::Gemm g{c.X1B, c.W13T, M, NUP, D}; pg8::StaticOrder S; S.init(M, NUP, G, (int)blockIdx.x);
        pg8::EpiSwiglu E{c.HID, c.SSQ2};
        pg8::gemm_phase<pg8::EpiSwiglu, pg8::StaticOrder, true, true>(lds, g, S, E);
    }
    SEAM(5);
    if (IN(6)) {
        pg8::Gemm g{c.HID, c.W2T, M, D, FF}; pg8::StaticOrder S; S.init(M, D, G, (int)blockIdx.x);
        pg8::EpiRes2 E{c.OY};
        pg8::gemm_phase<pg8::EpiRes2, pg8::StaticOrder, true, true>(lds, g, S, E);
    }
    SEAM(6);
    if (IN(7)) {
        const int gw = blockIdx.x * NWAVES + wave, NGW = G * NWAVES;
        f32x4 gn[4];
#pragma unroll
        for (int j = 0; j < 4; ++j) gn[j] = *(const f32x4*)(c.in[16] + 4 * lane + 256 * j);
        for (int m = gw; m < M; m += NGW) {
            float* yr = c.OY + (size_t)m * D; f32x4 v[4]; float s = 0.f;
#pragma unroll
            for (int j = 0; j < 4; ++j) { v[j] = *(const f32x4*)(yr + 4 * lane + 256 * j); s += (v[j][0] * v[j][0] + v[j][1] * v[j][1]) + (v[j][2] * v[j][2] + v[j][3] * v[j][3]); }
            const float rs = 1.0f / sqrtf(wave_sum(s) * (1.0f / D) + EPS);
#pragma unroll
            for (int j = 0; j < 4; ++j) *(f32x4*)(yr + 4 * lane + 256 * j) = v[j] * rs * gn[j];
        }
    }
#undef IN
#undef SEAM
}

extern "C" void kernel_launch(void* const* d_in, const int* in_sizes, int n_in, void* d_out, int out_size, void* d_ws, size_t ws_size, hipStream_t stream) {
    static int grid = 0;
    if (grid == 0) {
        if (n_in != 17 || ws_size < WS_END) { fprintf(stderr, "kernel_launch: unexpected n_in %d / ws %zu\n", n_in, ws_size); grid = -1; return; }
        int dev = 0, cus = 0, per_cu = 0;
        (void)hipGetDevice(&dev); (void)hipDeviceGetAttribute(&cus, hipDeviceAttributeMultiprocessorCount, dev);
        if (hipFuncSetAttribute((const void*)hymba_fwd, hipFuncAttributeMaxDynamicSharedMemorySize, LDS_BYTES) != hipSuccess) { fprintf(stderr, "kernel_launch: hipFuncSetAttribute failed\n"); grid = -1; return; }
        if (hipOccupancyMaxActiveBlocksPerMultiprocessor(&per_cu, (const void*)hymba_fwd, NTHR, LDS_BYTES) != hipSuccess || per_cu < 1) { fprintf(stderr, "kernel_launch: occupancy query says %d\n", per_cu); per_cu = 1; }
        (void)hipGetLastError();
        grid = cus * per_cu;
        if (grid <= 0) grid = 256;
    }
    if (grid < 0) return;
    Args a{};
    for (int i = 0; i < 17; ++i) a.in[i] = (const float*)d_in[i];
    a.out = (float*)d_out; a.ws = (unsigned char*)d_ws;
    if (MK_N_LAUNCHES == 1) {
        a.ph_lo = 0; a.ph_hi = NPHASE;
        void* kargs[] = {&a};
        hipError_t e = hipLaunchCooperativeKernel((const void*)hymba_fwd, dim3(grid), dim3(NTHR), kargs, LDS_BYTES, stream);
        if (e != hipSuccess) fprintf(stderr, "kernel_launch: cooperative launch failed: %s (grid %d)\n", hipGetErrorString(e), grid);
    } else {
        for (int p = 0; p < NPHASE; ++p) { a.ph_lo = p; a.ph_hi = p + 1; hipLaunchKernelGGL(hymba_fwd, dim3(grid), dim3(NTHR), LDS_BYTES, stream, a); }
    }
}
```

```cpp
#include <hip/hip_runtime.h>
#include <hip/hip_cooperative_groups.h>
#include <cstdio>
#include <cstdint>
namespace cg = cooperative_groups;
namespace pg8 {
#define PG8_LAS __attribute__((address_space(3)))
typedef unsigned short bf16_t;
typedef short bf16x8 __attribute__((ext_vector_type(8)));
typedef float f32x4 __attribute__((ext_vector_type(4)));
typedef unsigned u32x4 __attribute__((ext_vector_type(4)));
constexpr int BM = 256, BK = 64, HALF = 128, HTB = HALF * BK * 2  , STAGE_BYTES = 8 * HTB, NXCD = 8, WGM = 8;

__host__ __device__ __forceinline__ int lds_byte(int r, int c) { const int st = (r >> 4) * 2 + (c >> 5), rr = r & 15, cc = c & 31, ob = rr * 64 + cc * 2; return st * 1024 + (ob ^ (((ob >> 9) & 1) << 5)); }
__host__ __device__ __forceinline__ void stage_rc(int b, int& R, int& C) { const int st = b / 1024, sb = b % 1024, swz = sb ^ (((sb >> 9) & 1) << 5); R = (st >> 1) * 16 + swz / 64; C = (st & 1) * 32 + (swz % 64) / 2; }
__host__ __device__ __forceinline__ int perm32(int rho) { const int n = rho >> 4, i = rho & 15; return 8 * (i >> 2) + 4 * n + (i & 3); }

struct Unit { int pm, pn; };
struct Gemm { const bf16_t* A; const bf16_t* Bt; int M, N, K; };

struct StaticOrder {
    int nM, nN, nwg, G, c;
    __host__ __device__ void init(int M, int N, int G_, int c_) { nM = M / BM; nN = N / BM; nwg = nM * nN; G = G_; c = c_; }
    __host__ __device__ bool next(int i, Unit& u) const {
        const long L = (long)i * G + c; if (L >= nwg) return false;
        int wgid = (int)L; { const int q = nwg / NXCD, r = nwg % NXCD, xcd = wgid % NXCD, off = wgid / NXCD; wgid = (xcd < r ? xcd * (q + 1) : r * (q + 1) + (xcd - r) * q) + off; }
        const int nig = WGM * nN, gid = wgid / nig, fm = gid * WGM, gsz = (nM - fm) < WGM ? (nM - fm) : WGM;
        u.pm = fm + ((wgid % nig) % gsz); u.pn = (wgid % nig) / gsz; return true;
    }
    __device__ __forceinline__ void a_ready(const Unit&) const {}
    __device__ __forceinline__ void done(const Unit&) const {}
};

__device__ __forceinline__ unsigned cvt_pk_bf16(float lo, float hi) { unsigned r; asm volatile("v_cvt_pk_bf16_f32 %0, %1, %2" : "=v"(r) : "v"(lo), "v"(hi)); return r; }
typedef float f32x2 __attribute__((ext_vector_type(2)));

template <class Epi, class Sched, bool ALIGN_EPI = false, bool SP2 = false>
__device__ __forceinline__ void gemm_phase(PG8_LAS unsigned char* lds, const Gemm g, const Sched& S, const Epi& E) {
    const int tid = threadIdx.x, wid = __builtin_amdgcn_readfirstlane(tid >> 6), lane = tid & 63, wr = wid >> 2, wc = wid & 3, fr = lane & 15, fq = lane >> 4;
    const int K = g.K, nt = K / BK;
    unsigned voffA[2], voffB[2];
#pragma unroll
    for (int i = 0; i < 2; ++i) { int R, C; stage_rc(tid * 16 + i * 8192, R, C); const int Rb = Epi::PERM ? ((R & ~31) + perm32(R & 31)) : R;
        voffA[i] = (unsigned)(R * K + C) * 2u; voffB[i] = (unsigned)(Rb * K + C) * 2u; }
    const size_t kstep = (size_t)(BK * 2);
    const size_t hstep = (size_t)HALF * K * 2;
    const size_t tstep = 2 * hstep;
    const unsigned ldsw = (unsigned)wid * 1024u;
    const int aoff = lds_byte(wr * 64 + fr, fq * 8), boff = lds_byte(wc * 32 + fr, fq * 8);
#define PG8_SA(b, h) (((b) * 2 + (h)) * HTB)
#define PG8_SB(b, h) ((4 + (b) * 2 + (h)) * HTB)
#define PG8_STAGE(bufoff, gbase, voff) do { _Pragma("unroll") for (int _i = 0; _i < 2; ++_i) \
        __builtin_amdgcn_global_load_lds((const unsigned*)((const char*)(gbase) + (voff)[_i]), (PG8_LAS unsigned*)(lds + (bufoff) + ldsw + _i * 8192), 16, 0, 0); } while (0)
#define PG8_LDA(dst, b, h) do { _Pragma("unroll") for (int m = 0; m < 4; ++m) _Pragma("unroll") for (int k = 0; k < 2; ++k) dst[m][k] = *(const PG8_LAS bf16x8*)(lds + PG8_SA(b, h) + aoff + m * 2048 + k * 1024); } while (0)
#define PG8_LDB(dst, b, h) do { _Pragma("unroll") for (int n = 0; n < 2; ++n) _Pragma("unroll") for (int k = 0; k < 2; ++k) dst[n][k] = *(const PG8_LAS bf16x8*)(lds + PG8_SB(b, h) + boff + n * 2048 + k * 1024); } while (0)
#define PG8_MMA(ai, bj, At, Bt) do { __builtin_amdgcn_s_setprio(1); _Pragma("unroll") for (int m = 0; m < 4; ++m) _Pragma("unroll") for (int n = 0; n < 2; ++n) _Pragma("unroll") for (int k = 0; k < 2; ++k) \
        acc[ai][bj][m][n] = __builtin_amdgcn_mfma_f32_16x16x32_bf16(Bt[n][k], At[m][k], acc[ai][bj][m][n], 0, 0, 0); __builtin_amdgcn_s_setprio(0); } while (0)
#define PG8_WAIT_V(n) asm volatile("s_waitcnt vmcnt(" #n ")" ::: "memory")
#define PG8_WAIT_L(n) asm volatile("s_waitcnt lgkmcnt(" #n ")" ::: "memory")
#define PG8_BAR __builtin_amdgcn_s_barrier()
#define PG8_SCHED __builtin_amdgcn_sched_barrier(0)
    Unit cur, nxt; int ui = 0;
    if (!S.next(0, cur)) return;
    f32x4 acc[2][2][4][2];
#pragma unroll
    for (int a = 0; a < 2; ++a)
#pragma unroll
        for (int b = 0; b < 2; ++b)
#pragma unroll
            for (int m = 0; m < 4; ++m)
#pragma unroll
                for (int n = 0; n < 2; ++n) acc[a][b][m][n] = (f32x4){0.f, 0.f, 0.f, 0.f};
    bf16x8 At[4][2], B0[2][2], B1[2][2];
    const char* cA = (const char*)g.A + (size_t)cur.pm * tstep; const char* cB = (const char*)g.Bt + (size_t)cur.pn * tstep;
    S.a_ready(cur);
    if constexpr (SP2) {
        PG8_STAGE(PG8_SB(0, 0), cB, voffB); PG8_STAGE(PG8_SB(0, 1), cB + hstep, voffB); PG8_STAGE(PG8_SA(0, 0), cA, voffA); PG8_STAGE(PG8_SA(0, 1), cA + hstep, voffA);
        if (wr == 1) PG8_BAR;
        PG8_WAIT_V(2); PG8_BAR;
        PG8_STAGE(PG8_SB(1, 0), cB + kstep, voffB); PG8_STAGE(PG8_SA(1, 0), cA + kstep, voffA); PG8_STAGE(PG8_SB(1, 1), cB + hstep + kstep, voffB);
        PG8_WAIT_V(6); PG8_BAR;
    } else {
        PG8_STAGE(PG8_SB(0, 0), cB, voffB); PG8_STAGE(PG8_SA(0, 0), cA, voffA); PG8_STAGE(PG8_SB(0, 1), cB + hstep, voffB); PG8_STAGE(PG8_SA(0, 1), cA + hstep, voffA);
        if (wr == 1) PG8_BAR;
        PG8_WAIT_V(4); PG8_BAR;
        PG8_STAGE(PG8_SB(1, 0), cB + kstep, voffB); PG8_STAGE(PG8_SA(1, 0), cA + kstep, voffA); PG8_STAGE(PG8_SB(1, 1), cB + hstep + kstep, voffB);
        PG8_WAIT_V(6); PG8_BAR;
    }
    for (;;) {
        const bool has_next = S.next(ui + 1, nxt);
        const char* nA = has_next ? (const char*)g.A + (size_t)nxt.pm * tstep : cA; const char* nB = has_next ? (const char*)g.Bt + (size_t)nxt.pn * tstep : cB;
        for (int t = 0; t < nt; t += 2) {
            const bool last = (t == nt - 2);
            const char* a1 = cA + (size_t)(t + 1) * kstep;
            const char* a2 = last ? nA : cA + (size_t)(t + 2) * kstep; const char* b2 = last ? nB : cB + (size_t)(t + 2) * kstep;
            const char* a3 = a2 + kstep; const char* b3 = b2 + kstep;
            if (last && has_next) S.a_ready(nxt);
            if constexpr (SP2) {
            PG8_LDB(B0, 0, 0); PG8_LDB(B1, 0, 1); PG8_SCHED; PG8_LDA(At, 0, 0); PG8_STAGE(PG8_SA(1, 1), a1 + hstep, voffA);
            PG8_WAIT_V(8); PG8_WAIT_L(0); PG8_BAR; PG8_MMA(0, 0, At, B0); PG8_MMA(0, 1, At, B1); PG8_BAR; PG8_SCHED;
            PG8_LDA(At, 0, 1); PG8_STAGE(PG8_SB(0, 0), b2, voffB); PG8_STAGE(PG8_SB(0, 1), b2 + hstep, voffB); PG8_STAGE(PG8_SA(0, 0), a2, voffA);
            PG8_WAIT_V(8); PG8_WAIT_L(0); PG8_BAR; PG8_MMA(1, 0, At, B0); PG8_MMA(1, 1, At, B1); PG8_BAR; PG8_SCHED;
            PG8_LDB(B0, 1, 0); PG8_LDB(B1, 1, 1); PG8_SCHED; PG8_LDA(At, 1, 0); PG8_STAGE(PG8_SA(0, 1), a2 + hstep, voffA);
            PG8_WAIT_V(8); PG8_WAIT_L(0); PG8_BAR; PG8_MMA(0, 0, At, B0); PG8_MMA(0, 1, At, B1); PG8_BAR; PG8_SCHED;
            PG8_LDA(At, 1, 1); PG8_STAGE(PG8_SB(1, 0), b3, voffB); PG8_STAGE(PG8_SB(1, 1), b3 + hstep, voffB); PG8_STAGE(PG8_SA(1, 0), a3, voffA);
            PG8_WAIT_V(8); PG8_WAIT_L(0); PG8_BAR; PG8_MMA(1, 0, At, B0); PG8_MMA(1, 1, At, B1); PG8_BAR; PG8_SCHED;
            } else {
            PG8_LDB(B0, 0, 0); PG8_SCHED; PG8_LDA(At, 0, 0); PG8_STAGE(PG8_SA(1, 1), a1 + hstep, voffA);
            PG8_WAIT_L(8); PG8_BAR; PG8_WAIT_L(0); PG8_MMA(0, 0, At, B0); PG8_BAR; PG8_SCHED;
            PG8_LDB(B1, 0, 1); PG8_STAGE(PG8_SB(0, 0), b2, voffB);
            PG8_BAR; PG8_WAIT_L(0); PG8_MMA(0, 1, At, B1); PG8_BAR;
            PG8_LDA(At, 0, 1); PG8_STAGE(PG8_SA(0, 0), a2, voffA);
            PG8_BAR; PG8_WAIT_L(0); PG8_MMA(1, 0, At, B0); PG8_BAR; PG8_SCHED;
            PG8_STAGE(PG8_SB(0, 1), b2 + hstep, voffB);
            PG8_WAIT_V(6); PG8_BAR; PG8_MMA(1, 1, At, B1); PG8_BAR;
            PG8_LDB(B0, 1, 0); PG8_SCHED; PG8_LDA(At, 1, 0); PG8_STAGE(PG8_SA(0, 1), a2 + hstep, voffA);
            PG8_WAIT_L(8); PG8_BAR; PG8_WAIT_L(0); PG8_MMA(0, 0, At, B0); PG8_BAR; PG8_SCHED;
            PG8_LDB(B1, 1, 1); PG8_STAGE(PG8_SB(1, 0), b3, voffB);
            PG8_BAR; PG8_WAIT_L(0); PG8_MMA(0, 1, At, B1); PG8_BAR;
            PG8_LDA(At, 1, 1); PG8_STAGE(PG8_SA(1, 0), a3, voffA);
            PG8_BAR; PG8_WAIT_L(0); PG8_MMA(1, 0, At, B0); PG8_BAR; PG8_SCHED;
            PG8_STAGE(PG8_SB(1, 1), b3 + hstep, voffB);
            PG8_WAIT_V(6); PG8_BAR; PG8_MMA(1, 1, At, B1); PG8_BAR;
            }
        }
        if constexpr (ALIGN_EPI) { if (wr == 0) PG8_BAR; }
        if constexpr (!Epi::AFTER_DRAIN) { E(acc, cur, wr, wc, fr, fq); S.done(cur); }
        if (!has_next) break;
#pragma unroll
        for (int a = 0; a < 2; ++a)
#pragma unroll
            for (int b = 0; b < 2; ++b)
#pragma unroll
                for (int m = 0; m < 4; ++m)
#pragma unroll
                    for (int n = 0; n < 2; ++n) acc[a][b][m][n] = (f32x4){0.f, 0.f, 0.f, 0.f};
        cur = nxt; cA = nA; cB = nB; ++ui;
        if constexpr (ALIGN_EPI) { if (wr == 1) PG8_BAR; }
    }
    PG8_WAIT_V(0);
    if constexpr (!ALIGN_EPI) { if (wr == 0) PG8_BAR; }
    PG8_BAR;
    if constexpr (Epi::AFTER_DRAIN) { E.fused(acc, cur, wr, wc, fr, fq, lds, wid, lane); S.done(cur); }
#undef PG8_SA
#undef PG8_SB
#undef PG8_STAGE
#undef PG8_LDA
#undef PG8_LDB
#undef PG8_MMA
#undef PG8_WAIT_V
#undef PG8_WAIT_L
#undef PG8_BAR
#undef PG8_SCHED
}
}

#ifndef MK_N_LAUNCHES
#define MK_N_LAUNCHES 1
#endif
#ifndef REP_MASK
#define REP_MASK 0
#endif
#define LAS __attribute__((address_space(3)))
using pg8::bf16_t; using pg8::bf16x8; using pg8::f32x4; using pg8::u32x4;
typedef float f32x16 __attribute__((ext_vector_type(16)));
typedef __bf16 bf16x2_t __attribute__((ext_vector_type(2)));
typedef float f32x2_t __attribute__((ext_vector_type(2)));
typedef unsigned u32x2 __attribute__((ext_vector_type(2)));

constexpr int NWAVES = 8, NTHR = 512;
constexpr int D = 1024, MP = 16384, MS = 1024, M = MP + MS, NIN = 3840, PLD = 3584, FF = 2816, NUP = 2 * FF;
constexpr float EPS = 1e-6f;
constexpr size_t MiB = 1u << 20;
constexpr size_t WS_BAR = 26 * MiB + 768 * 1024, WS_WIN = 0, WS_WO = 8 * MiB, WS_W13 = 10 * MiB, WS_W2 = 21 * MiB, WS_RSTD1 = 27 * MiB, WS_SSQ2 = 28 * MiB, WS_LRA = 32 * MiB, WS_DCH = 34 * MiB,
                 WS_KDTS = 37 * MiB, WS_XB = 45 * MiB, WS_FB = 79 * MiB, WS_P = 113 * MiB, WS_END = 233 * MiB;
static_assert(WS_P + (size_t)(M + 32) * PLD * 2 <= WS_END && WS_XB + (size_t)M * D * 2 <= WS_FB && WS_FB + (size_t)M * 512 * 4 <= WS_P, "ws map");
constexpr size_t OUT_Y = 0, OUT_SAP = 17825792, OUT_SBP = 18087936, OUT_SAS = 18612224, OUT_SBS = 22806528;
constexpr int LDS_BYTES = 152576;

__device__ __forceinline__ unsigned pk_bf16(float lo, float hi) { f32x2_t v = {lo, hi}; bf16x2_t b = __builtin_convertvector(v, bf16x2_t); return __builtin_bit_cast(unsigned, b); }
__device__ __forceinline__ float bf_lo(unsigned u) { return __uint_as_float(u << 16); }
__device__ __forceinline__ float bf_hi(unsigned u) { return __uint_as_float(u & 0xffff0000u); }
__device__ __forceinline__ float bf_f(unsigned short u) { return __uint_as_float(((unsigned)u) << 16); }
__device__ __forceinline__ float wave_sum(float v) {
#pragma unroll
    for (int o = 1; o < 64; o <<= 1) v += __shfl_xor(v, o);
    return v;
}

template <int CTRL, int ROWMASK> __device__ __forceinline__ float dpp_f(float v) { return __builtin_bit_cast(float, __builtin_amdgcn_update_dpp(0, __builtin_bit_cast(int, v), CTRL, ROWMASK, 0xF, true)); }
__device__ __forceinline__ float row16_sum(float v) { v += dpp_f<0xB1, 0xF>(v); v += dpp_f<0x4E, 0xF>(v); v += dpp_f<0x141, 0xF>(v); v += dpp_f<0x140, 0xF>(v); return v; }
__device__ __forceinline__ float scan32(float a) {
    a += dpp_f<0x111, 0xF>(a); a += dpp_f<0x112, 0xF>(a); a += dpp_f<0x114, 0xF>(a); a += dpp_f<0x118, 0xF>(a); a += dpp_f<0x142, 0xA>(a); return a; }
__device__ __forceinline__ float lane_bcast(float v, int l) { return __builtin_bit_cast(float, __builtin_amdgcn_readlane(__builtin_bit_cast(int, v), l)); }
#define LDS_WAIT() asm volatile("s_waitcnt lgkmcnt(0)" ::: "memory")
#define WG_BAR() do { asm volatile("s_waitcnt lgkmcnt(0)" ::: "memory"); __builtin_amdgcn_s_barrier(); asm volatile("" ::: "memory"); } while (0)
#define MFMA32(a, b, c) __builtin_amdgcn_mfma_f32_32x32x16_bf16((a), (b), (c), 0, 0, 0)
#define MFMA16(a, b, c) __builtin_amdgcn_mfma_f32_16x16x32_bf16((a), (b), (c), 0, 0, 0)

struct Ptrs {
    const float* in[17]; float* out;
    bf16_t *WinT, *WoT, *W13T, *W2T, *XB, *P, *KDTS, *OF, *X1B, *HID;
    float *RSTD1, *SSQ2, *LRA, *DCH, *FB, *OY; bf16_t *DUMP, *OX, *OI;
};

namespace pg8 {
struct EpiIn {
    static constexpr bool PERM = true, AFTER_DRAIN = false;
    bf16_t* P; float* FB; float* LRA; const float* rstd;
    __device__ __forceinline__ void operator()(const f32x4 (&acc)[2][2][4][2], const Unit& u, int wr, int wc, int fr, int fq) const {
        const int row0 = u.pm * BM + wr * 64 + fr, ct = wc * 32 + 8 * fq;
#pragma unroll
        for (int ai = 0; ai < 2; ++ai)
#pragma unroll
            for (int m = 0; m < 4; ++m) {
                const int row = row0 + ai * HALF + m * 16; const float rs = rstd[row];
#pragma unroll
                for (int bj = 0; bj < 2; ++bj) {
                    const f32x4 v0 = acc[ai][bj][m][0] * rs, v1 = acc[ai][bj][m][1] * rs; const int cl = bj * HALF + ct;
                    if (u.pn == 8 || u.pn == 9) { float* o = FB + (size_t)row * 512 + (u.pn - 8) * BM + cl; *(f32x4*)o = v0; *(f32x4*)(o + 4) = v1; }
                    else if (u.pn == 14) { if (cl < 16) { float* o = LRA + (size_t)row * 16 + cl; *(f32x4*)o = v0; *(f32x4*)(o + 4) = v1; } }
                    else { u32x4 w; w.x = cvt_pk_bf16(v0[0], v0[1]); w.y = cvt_pk_bf16(v0[2], v0[3]); w.z = cvt_pk_bf16(v1[0], v1[1]); w.w = cvt_pk_bf16(v1[2], v1[3]);
                           *(u32x4*)(P + (size_t)row * 3584 + u.pn * BM + cl) = w; }
                }
            }
    }
};
struct EpiRes1 {
    static constexpr bool PERM = true, AFTER_DRAIN = false;
    const float* xp; const float* xs; float* Y; bf16_t* X1B; float* SSQ;
    __device__ __forceinline__ void operator()(const f32x4 (&acc)[2][2][4][2], const Unit& u, int wr, int wc, int fr, int fq) const {
        const int row0 = u.pm * BM + wr * 64 + fr, ct = u.pn * BM + wc * 32 + 8 * fq;
#pragma unroll
        for (int ai = 0; ai < 2; ++ai)
#pragma unroll
            for (int m = 0; m < 4; ++m) {
                const int row = row0 + ai * HALF + m * 16;
                const float* xr = row < 16384 ? xp + (size_t)row * 1024 : xs + (size_t)(row - 16384) * 1024;
                float ss = 0.f;
#pragma unroll
                for (int bj = 0; bj < 2; ++bj) {
                    const int col = ct + bj * HALF;
                    const f32x4 v0 = acc[ai][bj][m][0] + *(const f32x4*)(xr + col), v1 = acc[ai][bj][m][1] + *(const f32x4*)(xr + col + 4);
                    *(f32x4*)(Y + (size_t)row * 1024 + col) = v0; *(f32x4*)(Y + (size_t)row * 1024 + col + 4) = v1;
                    u32x4 w; w.x = cvt_pk_bf16(v0[0], v0[1]); w.y = cvt_pk_bf16(v0[2], v0[3]); w.z = cvt_pk_bf16(v1[0], v1[1]); w.w = cvt_pk_bf16(v1[2], v1[3]);
                    *(u32x4*)(X1B + (size_t)row * 1024 + col) = w;
                    ss += (v0[0] * v0[0] + v0[1] * v0[1]) + (v0[2] * v0[2] + v0[3] * v0[3]) + (v1[0] * v1[0] + v1[1] * v1[1]) + (v1[2] * v1[2] + v1[3] * v1[3]);
                }
                ss += __shfl_xor(ss, 16); ss += __shfl_xor(ss, 32);
                if (fq == 0) SSQ[(size_t)row * 16 + u.pn * 4 + wc] = ss;
            }
    }
};
struct EpiSwiglu {
    static constexpr bool PERM = true, AFTER_DRAIN = false;
    bf16_t* H; const float* SSQ;
    __device__ __forceinline__ void operator()(const f32x4 (&acc)[2][2][4][2], const Unit& u, int wr, int wc, int fr, int fq) const {
        const int row0 = u.pm * BM + wr * 64 + fr, hc = u.pn * 128 + wc * 16 + fq * 4;
#pragma unroll
        for (int ai = 0; ai < 2; ++ai)
#pragma unroll
            for (int m = 0; m < 4; ++m) {
                const int row = row0 + ai * HALF + m * 16;
                const f32x4* sp = (const f32x4*)(SSQ + (size_t)row * 16);
                const f32x4 s0 = sp[0], s1 = sp[1], s2 = sp[2], s3 = sp[3];
                const float tot = ((s0[0] + s0[1]) + (s0[2] + s0[3])) + ((s1[0] + s1[1]) + (s1[2] + s1[3])) + ((s2[0] + s2[1]) + (s2[2] + s2[3])) + ((s3[0] + s3[1]) + (s3[2] + s3[3]));
                const float rs = 1.0f / sqrtf(tot * (1.0f / 1024.0f) + 1e-6f);
#pragma unroll
                for (int bj = 0; bj < 2; ++bj) {
                    const f32x4 a = acc[ai][bj][m][0] * rs, b = acc[ai][bj][m][1] * rs; float h[4];
#pragma unroll
                    for (int e = 0; e < 4; ++e) h[e] = a[e] / (1.0f + __expf(-a[e])) * b[e];
                    unsigned lo = cvt_pk_bf16(h[0], h[1]), hi = cvt_pk_bf16(h[2], h[3]);
                    *(unsigned long long*)(H + (size_t)row * 2816 + hc + bj * 64) = (unsigned long long)lo | ((unsigned long long)hi << 32);
                }
            }
    }
};
struct EpiRes2 {
    static constexpr bool PERM = true, AFTER_DRAIN = false;
    float* Y; float sc;
    __device__ __forceinline__ void operator()(const f32x4 (&acc)[2][2][4][2], const Unit& u, int wr, int wc, int fr, int fq) const {
        const int row0 = u.pm * BM + wr * 64 + fr, ct = u.pn * BM + wc * 32 + 8 * fq;
#pragma unroll
        for (int ai = 0; ai < 2; ++ai)
#pragma unroll
            for (int m = 0; m < 4; ++m) {
                float* yr = Y + (size_t)(row0 + ai * HALF + m * 16) * 1024;
#pragma unroll
                for (int bj = 0; bj < 2; ++bj) {
                    const int col = ct + bj * HALF;
                    const f32x4 v0 = acc[ai][bj][m][0] * sc + *(const f32x4*)(yr + col), v1 = acc[ai][bj][m][1] * sc + *(const f32x4*)(yr + col + 4);
                    *(f32x4*)(yr + col) = v0; *(f32x4*)(yr + col + 4) = v1;
                }
            }
    }
};
}

__device__ __forceinline__ void tr_item(const float* colp, int ldw, const float* gain, int k0, int dcol, bf16_t* WT, int K, int nrow0, LAS float* scr, int lane) {
#pragma unroll 8
    for (int i = 0; i < 32; ++i) {
        const int kk = 2 * i + (lane >> 5); float v = 0.f;
        if (colp) { v = colp[(size_t)(k0 + kk) * ldw]; if (gain) v *= gain[k0 + kk]; }
        scr[kk * 33 + dcol] = v;
    }
    LDS_WAIT();
    const int c = lane & 7;
#pragma unroll
    for (int j = 0; j < 4; ++j) {
        const int n = (lane >> 3) + 8 * j; const LAS float* s = scr + (8 * c) * 33 + n;
        u32x4 o; o.x = pk_bf16(s[0 * 33], s[1 * 33]); o.y = pk_bf16(s[2 * 33], s[3 * 33]); o.z = pk_bf16(s[4 * 33], s[5 * 33]); o.w = pk_bf16(s[6 * 33], s[7 * 33]);
        *(u32x4*)(WT + (size_t)(nrow0 + n) * K + k0 + 8 * c) = o;
    }
    LDS_WAIT();
}
__device__ __forceinline__ void p0_prologue(const Ptrs& c, LAS unsigned char* lds, int G, int wave, int lane) {
    LAS float* scr = (LAS float*)(lds + wave * 16384);
    const int gw = blockIdx.x * NWAVES + wave, NGW = G * NWAVES, l31 = lane & 31;
    constexpr int I_IN = 16 * 120, I_O = 16 * 32, I_13 = 16 * 176, I_2 = 44 * 32, NITEMS = I_IN + I_O + I_13 + I_2;
    for (int it = gw; it < NITEMS; it += NGW) {
        int r = it;
        if (r < I_IN) { const int kb = r / 120, nb = r % 120, n = nb * 32 + l31;
            const int oc = n < 1536 ? n : (n < 3584 ? n + 16 : (n < 3600 ? n - 3584 + 1536 : -1));
            tr_item(oc >= 0 ? c.in[5] + oc : nullptr, 3600, c.in[4], kb * 64, l31, c.WinT, 1024, nb * 32, scr, lane); continue; }
        r -= I_IN;
        if (r < I_O) { const int kb = r / 32, nb = r % 32; tr_item(c.in[11] + nb * 32 + l31, 1024, nullptr, kb * 64, l31, c.WoT, 1024, nb * 32, scr, lane); continue; }
        r -= I_O;
        if (r < I_13) { const int kb = r / 176, nb = r % 176; const bool is3 = l31 >= 16; const int hcol = nb * 16 + (l31 & 15);
            tr_item((is3 ? c.in[14] : c.in[13]) + hcol, 2816, c.in[12], kb * 64, ((l31 & 15) >> 2) * 8 + (is3 ? 4 : 0) + (l31 & 3), c.W13T, 1024, nb * 32, scr, lane); continue; }
        r -= I_13;
        { const int kb = r / 32, nb = r % 32; tr_item(c.in[15] + nb * 32 + l31, 1024, nullptr, kb * 64, l31, c.W2T, 2816, nb * 32, scr, lane); }
    }
    for (int m = gw; m < M; m += NGW) {
        const float* xr = m < MP ? c.in[0] + (size_t)m * D : c.in[1] + (size_t)(m - MP) * D;
        f32x4 v[4]; float s = 0.f;
#pragma unroll
        for (int j = 0; j < 4; ++j) { v[j] = *(const f32x4*)(xr + 4 * lane + 256 * j); s += (v[j][0] * v[j][0] + v[j][1] * v[j][1]) + (v[j][2] * v[j][2] + v[j][3] * v[j][3]); }
        s = wave_sum(s);
#pragma unroll
        for (int j = 0; j < 4; ++j) { u32x2 w; w.x = pk_bf16(v[j][0], v[j][1]); w.y = pk_bf16(v[j][2], v[j][3]); *(u32x2*)(c.XB + (size_t)m * D + 4 * lane + 256 * j) = w; }
        if (lane == 0) c.RSTD1[m] = 1.0f / sqrtf(s * (1.0f / D) + EPS);
    }
}

__device__ __forceinline__ int crow(int i, int h) { return (i & 3) + 8 * (i >> 2) + 4 * h; }
template <int K, bool GLA>
__device__ __forceinline__ void pre_item(const Ptrs& c, int row0, int ntok, int hh, int item, bf16_t* kdt_base, int kdt_stride,
                                         const LAS float* wa2_l, const LAS float* ba_l, const LAS float* lb_l, LAS unsigned char* vt, int lane, bool dry) {
    const int r = lane & 31, kg = lane >> 5;
    const bool valid = r < ntok;
    const int row = row0 + (valid ? r : 0), nt1 = ntok - 1;
    constexpr int NJ = K / 16;
    const int qcol0 = GLA ? hh * 64 : 1536 + hh * 128, kcol0 = 256 + hh * 64, vcol0 = GLA ? 512 + hh * 128 : 2560 + hh * 128, ocol0 = (GLA ? hh : 4 + hh) * 128;
    bf16_t* Prow = c.P + (size_t)row * PLD;
    LAS unsigned char* kt = vt + 8192;
    float lra[16];
    {
        u32x4 vreg[8];
#pragma unroll
        for (int i = 0; i < 8; ++i) { const int p = lane + 64 * i, vr = (p >> 4) < nt1 ? (p >> 4) : nt1; vreg[i] = *(const u32x4*)(c.P + (size_t)(row0 + vr) * PLD + vcol0 + (p & 15) * 8); }
        if constexpr (GLA) {
#pragma unroll
            for (int i = 0; i < 4; ++i) { const f32x4 t = *(const f32x4*)(c.LRA + (size_t)row * 16 + 4 * i); lra[4 * i] = t[0]; lra[4 * i + 1] = t[1]; lra[4 * i + 2] = t[2]; lra[4 * i + 3] = t[3]; }
        }
#pragma unroll
        for (int i = 0; i < 8; ++i) { const int p = lane + 64 * i; *(LAS u32x4*)(vt + (p >> 4) * 256 + (p & 15) * 16) = vreg[i]; }
    }
    const bf16_t* qptr = Prow + qcol0 + 8 * kg;
    const bf16_t* kptr = Prow + kcol0 + 8 * kg;
    const float* fptr = c.FB + (size_t)row * 512 + hh * 128 + 8 * kg;
    u32x4 qn = *(const u32x4*)qptr, kn = {0u, 0u, 0u, 0u}; f32x4 fn0 = {0.f, 0.f, 0.f, 0.f}, fn1 = fn0;
    if constexpr (GLA) kn = *(const u32x4*)kptr; else { fn0 = *(const f32x4*)fptr; fn1 = *(const f32x4*)(fptr + 4); }
    f32x16 att;
#pragma unroll
    for (int i = 0; i < 16; ++i) att[i] = 0.f;
    float* dch = c.DCH + (size_t)item * 128;
#pragma unroll 1
    for (int j = 0; j < NJ; ++j) {
        const int cl = 16 * j + 8 * kg;
        const u32x4 qr = qn, kr = kn; const f32x4 f0 = fn0, f1 = fn1;
        { const int jn = j + 1 < NJ ? j + 1 : j;
          qn = *(const u32x4*)(qptr + 16 * jn);
          if constexpr (GLA) kn = *(const u32x4*)(kptr + 16 * jn); else { fn0 = *(const f32x4*)(fptr + 16 * jn); fn1 = *(const f32x4*)(fptr + 16 * jn + 4); } }
        float la[8], kv[8], qv[8];
        if constexpr (GLA) {
            const LAS float* wl = wa2_l + hh * 64 + cl;
            f32x4 a0 = *(const LAS f32x4*)(ba_l + hh * 64 + cl), a1 = *(const LAS f32x4*)(ba_l + hh * 64 + cl + 4);
#pragma unroll
            for (int rr = 0; rr < 16; ++rr) { const f32x4 w0 = *(const LAS f32x4*)(wl + rr * 256), w1 = *(const LAS f32x4*)(wl + rr * 256 + 4); a0 += w0 * lra[rr]; a1 += w1 * lra[rr]; }
#pragma unroll
            for (int e = 0; e < 8; ++e) { const float x = e < 4 ? a0[e & 3] : a1[e & 3]; la[e] = (fminf(x, 0.f) - __logf(1.0f + __expf(-fabsf(x)))) * 0.0625f; }
            kv[0] = bf_lo(kr.x); kv[1] = bf_hi(kr.x); kv[2] = bf_lo(kr.y); kv[3] = bf_hi(kr.y); kv[4] = bf_lo(kr.z); kv[5] = bf_hi(kr.z); kv[6] = bf_lo(kr.w); kv[7] = bf_hi(kr.w);
        } else {
            const f32x4 l0 = *(const LAS f32x4*)(lb_l + hh * 128 + cl), l1 = *(const LAS f32x4*)(lb_l + hh * 128 + cl + 4);
#pragma unroll
            for (int e = 0; e < 8; ++e) {
                const float x = e < 4 ? f0[e & 3] : f1[e & 3], lb = e < 4 ? l0[e & 3] : l1[e & 3];
                const float ex = __expf(-fabsf(x)), inv = __builtin_amdgcn_rcpf(1.0f + ex);
                const float sg = x >= 0.f ? inv : ex * inv, ng = x >= 0.f ? ex * inv : inv;
                la[e] = __logf(lb + (1.0f - lb) * sg); kv[e] = (1.0f - lb) * ng;
            }
        }
        qv[0] = bf_lo(qr.x); qv[1] = bf_hi(qr.x); qv[2] = bf_lo(qr.y); qv[3] = bf_hi(qr.y); qv[4] = bf_lo(qr.z); qv[5] = bf_hi(qr.z); qv[6] = bf_lo(qr.w); qv[7] = bf_hi(qr.w);
        float qi[8], ki[8], kd[8], eb[8];
#pragma unroll
        for (int e = 0; e < 8; ++e) {
            float q = GLA ? qv[e] * 0.125f : qv[e] * __builtin_amdgcn_rcpf(1.0f + __expf(-qv[e]));
            float k = kv[e], a = la[e];
            if (!valid) { q = 0.f; k = 0.f; a = 0.f; }
            a = fmaxf(scan32(a), -80.f);
            const float ea = __expf(a), ia = __builtin_amdgcn_rcpf(ea);
            const float e31 = lane_bcast(ea, 31), e63 = lane_bcast(ea, 63);
            eb[e] = kg ? e63 : e31;
            qi[e] = q * ea; ki[e] = k * ia; kd[e] = ki[e] * eb[e];
        }
        u32x4 qp, kp;
        qp.x = pk_bf16(qi[0], qi[1]); qp.y = pk_bf16(qi[2], qi[3]); qp.z = pk_bf16(qi[4], qi[5]); qp.w = pk_bf16(qi[6], qi[7]);
        kp.x = pk_bf16(ki[0], ki[1]); kp.y = pk_bf16(ki[2], ki[3]); kp.z = pk_bf16(ki[4], ki[5]); kp.w = pk_bf16(ki[6], ki[7]);
        att = MFMA32(__builtin_bit_cast(bf16x8, kp), __builtin_bit_cast(bf16x8, qp), att);
        if (valid) *(u32x4*)(Prow + qcol0 + cl) = dry ? qr : qp;
#pragma unroll
        for (int e = 0; e < 8; e += 2) {
            const unsigned pkd = pk_bf16(kd[e], kd[e + 1]);
            *(LAS unsigned short*)(kt + (cl + e) * 64 + r * 2) = (unsigned short)(pkd & 0xffffu);
            *(LAS unsigned short*)(kt + (cl + e + 1) * 64 + r * 2) = (unsigned short)(pkd >> 16);
        }
        if (r == 0) { f32x4 d0 = {eb[0], eb[1], eb[2], eb[3]}, d1 = {eb[4], eb[5], eb[6], eb[7]}; *(f32x4*)(dch + cl) = d0; *(f32x4*)(dch + cl + 4) = d1; }
    }
#pragma unroll
    for (int i = 0; i < K / 16; ++i) {
        const int p = lane + 64 * i, L = p * 8;
        *(u32x4*)(kdt_base + (size_t)(L / K) * kdt_stride + (L % K)) = *(const LAS u32x4*)(kt + p * 16);
    }
#pragma unroll
    for (int i = 0; i < 16; ++i) if (crow(i, kg) > r) att[i] = 0.f;
    u32x4 pa0, pa1;
    pa0.x = pk_bf16(att[0], att[1]); pa0.y = pk_bf16(att[2], att[3]); pa0.z = pk_bf16(att[4], att[5]); pa0.w = pk_bf16(att[6], att[7]);
    pa1.x = pk_bf16(att[8], att[9]); pa1.y = pk_bf16(att[10], att[11]); pa1.z = pk_bf16(att[12], att[13]); pa1.w = pk_bf16(att[14], att[15]);
#pragma unroll 1
    for (int vb = 0; vb < 4; ++vb) {
        unsigned short vs[16];
#pragma unroll
        for (int i = 0; i < 16; ++i) vs[i] = *(const LAS unsigned short*)(vt + crow(i, kg) * 256 + (vb * 32 + r) * 2);
        u32x4 b0, b1;
        b0.x = vs[0] | ((unsigned)vs[1] << 16); b0.y = vs[2] | ((unsigned)vs[3] << 16); b0.z = vs[4] | ((unsigned)vs[5] << 16); b0.w = vs[6] | ((unsigned)vs[7] << 16);
        b1.x = vs[8] | ((unsigned)vs[9] << 16); b1.y = vs[10] | ((unsigned)vs[11] << 16); b1.z = vs[12] | ((unsigned)vs[13] << 16); b1.w = vs[14] | ((unsigned)vs[15] << 16);
        f32x16 o;
#pragma unroll
        for (int i = 0; i < 16; ++i) o[i] = 0.f;
        o = MFMA32(__builtin_bit_cast(bf16x8, pa0), __builtin_bit_cast(bf16x8, b0), o);
        o = MFMA32(__builtin_bit_cast(bf16x8, pa1), __builtin_bit_cast(bf16x8, b1), o);
#pragma unroll
        for (int i = 0; i < 16; ++i) *(LAS unsigned short*)(kt + crow(i, kg) * 256 + (vb * 32 + r) * 2) = (unsigned short)(pk_bf16(o[i], 0.f) & 0xffffu);
    }
#pragma unroll
    for (int i = 0; i < 8; ++i) {
        const int p = lane + 64 * i, t = p >> 4;
        if (t < ntok) *(u32x4*)(c.OI + (size_t)(row0 + t) * 1024 + ocol0 + (p & 15) * 8) = *(const LAS u32x4*)(kt + p * 16);
    }
}
__device__ __forceinline__ void p2_prepass(const Ptrs& c, LAS unsigned char* lds, int G, int tid, int wave, int lane, bool dry) {
    LAS float* wa2_l = (LAS float*)lds; LAS float* ba_l = wa2_l + 4096; LAS float* lb_l = ba_l + 256;
    for (int i = tid; i < 4096; i += NTHR) wa2_l[i] = c.in[6][i];
    if (tid < 256) ba_l[tid] = c.in[7][tid];
    { const float p0 = c.in[8][tid], p1 = c.in[8][512 + tid]; lb_l[tid] = 1.0f / (1.0f + __expf(p1 - p0)); }
    WG_BAR();
    const int gw = blockIdx.x * NWAVES + wave, NGW = G * NWAVES;
    for (int it = gw; it < 4096 + 1024; it += NGW) {
        int row0, ntok, h; bf16_t* kdt; int kst;
        if (it < 4096) { h = it & 7; const int ch = (it >> 3) & 63, b = it >> 9; row0 = b * 2048 + ch * 32; ntok = 32; kst = PLD;
                         kdt = c.P + (size_t)row0 * PLD + (h < 4 ? 256 + h * 64 : 2048 + (h - 4) * 128); }
        else { const int j = it - 4096; h = j & 7; row0 = MP + (j >> 3) * 8; ntok = 8; kst = h < 4 ? 64 : 128; kdt = c.KDTS + (size_t)j * 4096; }
        if (dry) { kst = h < 4 ? 64 : 128; kdt = (bf16_t*)((unsigned char*)c.DUMP + 203 * MiB) + (size_t)(it & 2047) * 4096; }
        if (h < 4) pre_item<64, true>(c, row0, ntok, h, it, kdt, kst, wa2_l, ba_l, lb_l, lds + 20480 + wave * 16384, lane, dry);
        else pre_item<128, false>(c, row0, ntok, h - 4, it, kdt, kst, wa2_l, ba_l, lb_l, lds + 20480 + wave * 16384, lane, dry);
    }
}

template <int K>
__device__ __forceinline__ void seq_item(const Ptrs& c, LAS unsigned char* lds, int row0, int nch, int ntok, int h8, int colbase, int ncw, const float* S0, float* Sout,
                                         const bf16_t* kdt0, int kdt_rstride, size_t kdt_cstep, const float* dch0, size_t dch_cstep, int tid, int wave, int lane) {
    constexpr int QROW = 2 * K + 16, VROW = 272;
    constexpr int KOFF = 8704, DOFF = 18944, VOFF = 19456, BUFB = 28160, NMB = K / 16, NPC = 4 * K;
    const int n = lane & 15, q = lane >> 4, col = colbase + 16 * (wave < ncw ? wave : 0) + n;
    const bool cw = wave < ncw;
    const bool gla = h8 < 4; const int hh = h8 & 3;
    const int qcol0 = gla ? hh * 64 : 1536 + hh * 128, vcol0 = gla ? 512 + hh * 128 : 2560 + hh * 128, ocol = h8 * 128 + col;
    f32x4 S[NMB];
#pragma unroll
    for (int mb = 0; mb < NMB; ++mb)
#pragma unroll
        for (int i = 0; i < 4; ++i) S[mb][i] = (S0 && cw) ? S0[(size_t)(16 * mb + 4 * q + i) * 128 + col] : 0.f;
    const int nt1 = ntok - 1;
    const int pq = tid % NPC, prow_q = pq / (K / 8), pc8 = pq % (K / 8), prq = prow_q < nt1 ? prow_q : nt1;
    const int vrow = tid >> 4, vc8 = tid & 15, vr = vrow < nt1 ? vrow : nt1;
    const int dpi = tid % (K / 4);
    const bf16_t* gq = c.P + (size_t)(row0 + prq) * PLD + qcol0 + pc8 * 8;
    const bf16_t* gk = kdt0 + (size_t)prow_q * kdt_rstride + pc8 * 8;
    const float* gd = dch0 + dpi * 4;
    const bf16_t* gvp = c.P + (size_t)(row0 + vr) * PLD + vcol0 + vc8 * 8;
    struct Stage { u32x4 q, k, v; f32x4 d; };
    const int nch1 = nch - 1;
#define SEQ_LOAD(R, cc) do { const int c_ = (cc) < nch1 ? (cc) : nch1; const size_t ro_ = (size_t)c_ * 32; \
        R.q = *(const u32x4*)(gq + ro_ * PLD); R.k = *(const u32x4*)(gk + (size_t)c_ * kdt_cstep); R.d = *(const f32x4*)(gd + (size_t)c_ * dch_cstep); \
        R.v = *(const u32x4*)(gvp + ro_ * PLD); } while (0)
#define SEQ_STORE(R, buf) do { LAS unsigned char* B_ = lds + (buf) * BUFB; \
        *(LAS u32x4*)(B_ + prow_q * QROW + pc8 * 16) = R.q; *(LAS u32x4*)(B_ + KOFF + (pq >> 2) * 80 + (pq & 3) * 16) = R.k; *(LAS f32x4*)(B_ + DOFF + dpi * 16) = R.d; \
        *(LAS u32x4*)(B_ + VOFF + vrow * VROW + vc8 * 16) = R.v; } while (0)
#define SEQ_ITER(ci, buf, RST) do { \
        const LAS unsigned char* B = lds + (buf) * BUFB; \
        if (cw) { \
        f32x4 o[2] = {{0.f, 0.f, 0.f, 0.f}, {0.f, 0.f, 0.f, 0.f}}; \
        _Pragma("unroll") for (int js = 0; js < K / 32; ++js) { \
            u32x4 sb; sb.x = pk_bf16(S[2 * js][0], S[2 * js][1]); sb.y = pk_bf16(S[2 * js][2], S[2 * js][3]); sb.z = pk_bf16(S[2 * js + 1][0], S[2 * js + 1][1]); sb.w = pk_bf16(S[2 * js + 1][2], S[2 * js + 1][3]); \
            _Pragma("unroll") for (int mb2 = 0; mb2 < 2; ++mb2) { \
                const LAS unsigned char* qp = B + (16 * mb2 + n) * QROW + (32 * js + 4 * q) * 2; \
                const u32x2 lo = *(const LAS u32x2*)qp, hi = *(const LAS u32x2*)(qp + 32); \
                u32x4 qa; qa.x = lo.x; qa.y = lo.y; qa.z = hi.x; qa.w = hi.y; \
                o[mb2] = MFMA16(__builtin_bit_cast(bf16x8, qa), __builtin_bit_cast(bf16x8, sb), o[mb2]); } } \
        { unsigned short vs[8]; \
            _Pragma("unroll") for (int j = 0; j < 8; ++j) vs[j] = *(const LAS unsigned short*)(B + VOFF + (8 * q + j) * VROW + col * 2); \
            u32x4 vb; vb.x = vs[0] | ((unsigned)vs[1] << 16); vb.y = vs[2] | ((unsigned)vs[3] << 16); vb.z = vs[4] | ((unsigned)vs[5] << 16); vb.w = vs[6] | ((unsigned)vs[7] << 16); \
            _Pragma("unroll") for (int mb = 0; mb < NMB; ++mb) { \
                const u32x4 ka = *(const LAS u32x4*)(B + KOFF + (16 * mb + n) * 80 + q * 16); \
                const f32x4 dv = *(const LAS f32x4*)(B + DOFF + (16 * mb + 4 * q) * 4); \
                S[mb] = S[mb] * dv; \
                S[mb] = MFMA16(__builtin_bit_cast(bf16x8, ka), __builtin_bit_cast(bf16x8, vb), S[mb]); } } \
        bf16_t* ob = c.OX + (size_t)(row0 + 32 * (ci)) * 1024 + ocol; \
        _Pragma("unroll") for (int x = 0; x < 8; x += 2) { \
            const int t = 16 * (x >> 2) + 4 * q + (x & 3); const unsigned pv = pk_bf16(o[x >> 2][x & 3], o[x >> 2][(x & 3) + 1]); \
            bf16_t* d0 = t < ntok ? ob + (size_t)t * 1024 : c.DUMP + tid; bf16_t* d1 = t + 1 < ntok ? ob + (size_t)(t + 1) * 1024 : c.DUMP + tid; \
            *d0 = (bf16_t)(pv & 0xffffu); *d1 = (bf16_t)(pv >> 16); } \
        } \
        WG_BAR(); \
        SEQ_STORE(RST, buf); \
    } while (0)
    Stage RA, RB;
    SEQ_LOAD(RA, 0); SEQ_STORE(RA, 0);
    SEQ_LOAD(RB, 1); SEQ_LOAD(RA, 2);
    SEQ_STORE(RB, 1);
    WG_BAR();
    for (int ci = 0; ci < nch; ci += 2) {
        SEQ_LOAD(RB, ci + 3);
        SEQ_ITER(ci, 0, RA);
        if (ci + 1 >= nch) break;
        SEQ_LOAD(RA, ci + 4);
        SEQ_ITER(ci + 1, 1, RB);
    }
    if (cw) {
#pragma unroll
    for (int mb = 0; mb < NMB; ++mb)
#pragma unroll
        for (int i = 0; i < 4; ++i) Sout[(size_t)(16 * mb + 4 * q + i) * 128 + col] = S[mb][i];
    }
    WG_BAR();
#undef SEQ_LOAD
#undef SEQ_STORE
#undef SEQ_ITER
}
__device__ __forceinline__ void seq_dispatch(const Ptrs& c, LAS unsigned char* lds, int item, int tid, int wave, int lane) {
    int row0, nch, ntok, h8, colbase, ncw; const float* S0; float* Sout; const bf16_t* kdt0; int kst; size_t kcs, dcs; const float* dch0;
    if (item < 128) {
        const int bh = item >> 1, b = bh >> 3; h8 = bh & 7; const int hh = h8 & 3; row0 = b * 2048; nch = 64; ntok = 32; S0 = nullptr; colbase = (item & 1) * 64; ncw = 4;
        Sout = h8 < 4 ? c.out + OUT_SAP + (size_t)(b * 4 + hh) * 64 * 128 : c.out + OUT_SBP + (size_t)(b * 4 + hh) * 128 * 128;
        kdt0 = c.P + (size_t)row0 * PLD + (h8 < 4 ? 256 + hh * 64 : 2048 + hh * 128); kst = PLD; kcs = (size_t)32 * PLD;
        dch0 = c.DCH + (size_t)(b * 64 * 8 + h8) * 128; dcs = 8 * 128;
    } else {
        const int j = item - 128, b = j >> 3; h8 = j & 7; const int hh = h8 & 3; row0 = MP + b * 8; nch = 1; ntok = 8; colbase = 0; ncw = 8;
        S0 = h8 < 4 ? c.in[2] + (size_t)(b * 4 + hh) * 64 * 128 : c.in[3] + (size_t)(b * 4 + hh) * 128 * 128;
        Sout = h8 < 4 ? c.out + OUT_SAS + (size_t)(b * 4 + hh) * 64 * 128 : c.out + OUT_SBS + (size_t)(b * 4 + hh) * 128 * 128;
        kdt0 = c.KDTS + (size_t)j * 4096; kst = h8 < 4 ? 64 : 128; kcs = 0; dch0 = c.DCH + (size_t)(4096 + j) * 128; dcs = 0;
    }
    if (h8 < 4) seq_item<64>(c, lds, row0, nch, ntok, h8, colbase, ncw, S0, Sout, kdt0, kst, kcs, dch0, dcs, tid, wave, lane);
    else seq_item<128>(c, lds, row0, nch, ntok, h8, colbase, ncw, S0, Sout, kdt0, kst, kcs, dch0, dcs, tid, wave, lane);
}
__device__ __forceinline__ void p3b_finalize(const Ptrs& c, int G, int wave, int lane) {
    const int gw = blockIdx.x * NWAVES + wave, NGW = G * NWAVES, h8 = lane >> 3, cw = (lane & 7) * 16;
    const float* gp = (h8 < 4 ? c.in[9] : c.in[10]) + cw;
    f32x4 gn[4];
#pragma unroll
    for (int j = 0; j < 4; ++j) gn[j] = *(const f32x4*)(gp + 4 * j);
    const int gcol = (h8 < 4 ? 1024 + h8 * 128 : 3072 + (h8 - 4) * 128) + cw;
    for (int m = gw; m < M; m += NGW) {
        f32x4 o[4]; u32x4 x[2], g[2], oi[2];
#pragma unroll
        for (int j = 0; j < 2; ++j) { oi[j] = *(const u32x4*)(c.OI + (size_t)m * 1024 + lane * 16 + 8 * j); x[j] = *(const u32x4*)(c.OX + (size_t)m * 1024 + lane * 16 + 8 * j); g[j] = *(const u32x4*)(c.P + (size_t)m * PLD + gcol + 8 * j); }
        o[0][0] = bf_lo(oi[0].x); o[0][1] = bf_hi(oi[0].x); o[0][2] = bf_lo(oi[0].y); o[0][3] = bf_hi(oi[0].y); o[1][0] = bf_lo(oi[0].z); o[1][1] = bf_hi(oi[0].z); o[1][2] = bf_lo(oi[0].w); o[1][3] = bf_hi(oi[0].w);
        o[2][0] = bf_lo(oi[1].x); o[2][1] = bf_hi(oi[1].x); o[2][2] = bf_lo(oi[1].y); o[2][3] = bf_hi(oi[1].y); o[3][0] = bf_lo(oi[1].z); o[3][1] = bf_hi(oi[1].z); o[3][2] = bf_lo(oi[1].w); o[3][3] = bf_hi(oi[1].w);
        float ss = 0.f;
#pragma unroll
        for (int j = 0; j < 4; ++j) {
            const unsigned w0 = j < 2 ? (j == 0 ? x[0].x : x[0].z) : (j == 2 ? x[1].x : x[1].z), w1 = j < 2 ? (j == 0 ? x[0].y : x[0].w) : (j == 2 ? x[1].y : x[1].w);
            o[j][0] += bf_lo(w0); o[j][1] += bf_hi(w0); o[j][2] += bf_lo(w1); o[j][3] += bf_hi(w1);
            ss += (o[j][0] * o[j][0] + o[j][1] * o[j][1]) + (o[j][2] * o[j][2] + o[j][3] * o[j][3]);
        }
        ss += dpp_f<0xB1, 0xF>(ss); ss += dpp_f<0x4E, 0xF>(ss); ss += dpp_f<0x141, 0xF>(ss);
        const float rs = __builtin_amdgcn_rsqf(ss * (1.0f / 128.0f) + EPS);
        u32x4 w[2];
#pragma unroll
        for (int j = 0; j < 4; ++j) {
            const unsigned g0 = j < 2 ? (j == 0 ? g[0].x : g[0].z) : (j == 2 ? g[1].x : g[1].z), g1 = j < 2 ? (j == 0 ? g[0].y : g[0].w) : (j == 2 ? g[1].y : g[1].w);
            float gg[4] = {bf_lo(g0), bf_hi(g0), bf_lo(g1), bf_hi(g1)}, v[4];
#pragma unroll
            for (int e = 0; e < 4; ++e) v[e] = o[j][e] * rs * gn[j][e] * (gg[e] * __builtin_amdgcn_rcpf(1.0f + __expf(-gg[e])));
            const unsigned p0 = pk_bf16(v[0], v[1]), p1 = pk_bf16(v[2], v[3]);
            if (j == 0) { w[0].x = p0; w[0].y = p1; } else if (j == 1) { w[0].z = p0; w[0].w = p1; } else if (j == 2) { w[1].x = p0; w[1].y = p1; } else { w[1].z = p0; w[1].w = p1; }
        }
        *(u32x4*)(c.OF + (size_t)m * 1024 + lane * 16) = w[0]; *(u32x4*)(c.OF + (size_t)m * 1024 + lane * 16 + 8) = w[1];
    }
}
#define XB_TMO      128
#define XB_XCNT(j)  (256  + 64 * (j))
#define XB_XSUB(j)  (1280 + 64 * (j))
#define XB_XGEN(j)  (2304 + 64 * (j))
#define XB_TOP      3328
#define XB_TOPGEN   3392
#define XCD_BAR_WORDS 3456
#define XB_SPIN_CAP (1u << 18)

__device__ __forceinline__ unsigned xb_ld(unsigned* p)              { return __hip_atomic_load(p, __ATOMIC_RELAXED, __HIP_MEMORY_SCOPE_AGENT); }
__device__ __forceinline__ unsigned xb_add(unsigned* p, unsigned v) { return __hip_atomic_fetch_add(p, v, __ATOMIC_RELAXED, __HIP_MEMORY_SCOPE_AGENT); }
__device__ __forceinline__ unsigned xb_xcc_id() { return (unsigned)__builtin_amdgcn_s_getreg((3 << 11) | 20) & 0xFu; }
#define XB_SPIN(cond, bar) do { unsigned _sp = 0; while (cond) { __builtin_amdgcn_s_sleep(1); \
    if ((++_sp & 255u) == 0u) { if (xb_ld(&(bar)[XB_TMO])) break; if (_sp > XB_SPIN_CAP) { atomicAdd(&(bar)[XB_TMO], 1u); break; } } } } while (0)

struct XcdBarrier {
    unsigned* bar; unsigned x;
    volatile LAS unsigned* st;
};

__device__ __forceinline__ XcdBarrier xcd_barrier_post(unsigned* bar, volatile LAS unsigned* st) {
    XcdBarrier b; b.bar = bar; b.x = xb_xcc_id(); b.st = st;
    if (threadIdx.x == 0) (void)xb_add(&bar[XB_XCNT(b.x)], 1u);
    return b;
}
__device__ __forceinline__ void xcd_barrier_complete(unsigned* bar, unsigned x, unsigned& nloc, unsigned& nx) {
    const unsigned G = gridDim.x * gridDim.y * gridDim.z;
    unsigned sum, cnt, mine, sp = 0u;
    for (;;) {
        sum = 0u; cnt = 0u; mine = 0u;
#pragma unroll
        for (unsigned j = 0; j < 16; ++j) { const unsigned c = xb_ld(&bar[XB_XCNT(j)]); sum += c; cnt += (c > 0u) ? 1u : 0u; mine = (j == x) ? c : mine; }
        if (sum == G) break;
        __builtin_amdgcn_s_sleep(1);
        if ((++sp & 255u) == 0u) { if (xb_ld(&bar[XB_TMO])) break; if (sp > XB_SPIN_CAP) { atomicAdd(&bar[XB_TMO], 1u); break; } }
    }
    nloc = mine > 0u ? mine : 1u; nx = cnt > 0u ? cnt : 1u;
}

__device__ __forceinline__ void xcd_barrier(const XcdBarrier& b) {
    asm volatile("s_waitcnt vmcnt(0)" ::: "memory");
    __syncthreads();
    if (threadIdx.x == 0) {
        unsigned* bar = b.bar;
        __builtin_amdgcn_s_waitcnt(0);
        unsigned nloc = b.st[0], nx = b.st[1];
        if (nloc == 0u) { xcd_barrier_complete(bar, b.x, nloc, nx); b.st[0] = nloc; b.st[1] = nx; }
        const unsigned old = xb_add(&bar[XB_XSUB(b.x)], 1u);
        const unsigned gen = old / nloc;
        if (old + 1u == (gen + 1u) * nloc) {
            __builtin_amdgcn_fence(__ATOMIC_RELEASE, "agent");
            asm volatile("s_waitcnt vmcnt(0)" ::: "memory");
            const unsigned og = xb_add(&bar[XB_TOP], 1u);
            const unsigned tg = og / nx;
            if (og + 1u == (tg + 1u) * nx) xb_add(&bar[XB_TOPGEN], 1u);
            else XB_SPIN(xb_ld(&bar[XB_TOPGEN]) == tg, bar);
            __builtin_amdgcn_fence(__ATOMIC_ACQUIRE, "agent");
            xb_add(&bar[XB_XGEN(b.x)], 1u);
            asm volatile("s_waitcnt vmcnt(0)" ::: "memory");
        } else {
            XB_SPIN(xb_ld(&bar[XB_XGEN(b.x)]) == gen, bar);
            __builtin_amdgcn_fence(__ATOMIC_ACQUIRE, "agent");
            asm volatile("s_waitcnt vmcnt(0)" ::: "memory");
        }
    }
    __syncthreads();
}

struct Args { const float* in[17]; float* out; unsigned char* ws; int ph_lo, ph_hi, aux, pad; };
constexpr int NPHASE = 9;
__global__ void __launch_bounds__(NTHR, 2) hymba_fwd(Args args) {
    extern __shared__ __attribute__((aligned(16))) unsigned char lds_raw[];
    LAS unsigned char* lds = (LAS unsigned char*)lds_raw;
    const int tid = threadIdx.x, lane = tid & 63, wave = __builtin_amdgcn_readfirstlane(tid >> 6), G = gridDim.x;
    Ptrs c;
#pragma unroll
    for (int i = 0; i < 17; ++i) c.in[i] = args.in[i];
    c.out = args.out;
    unsigned char* ws = args.ws;
    c.WinT = (bf16_t*)(ws + WS_WIN); c.WoT = (bf16_t*)(ws + WS_WO); c.W13T = (bf16_t*)(ws + WS_W13); c.W2T = (bf16_t*)(ws + WS_W2);
    c.XB = (bf16_t*)(ws + WS_XB); c.OF = (bf16_t*)(ws + WS_XB); c.P = (bf16_t*)(ws + WS_P); c.HID = (bf16_t*)(ws + WS_P); c.KDTS = (bf16_t*)(ws + WS_KDTS);
    c.X1B = (bf16_t*)(ws + WS_FB); c.FB = (float*)(ws + WS_FB);
    c.RSTD1 = (float*)(ws + WS_RSTD1); c.SSQ2 = (float*)(ws + WS_SSQ2); c.LRA = (float*)(ws + WS_LRA); c.DCH = (float*)(ws + WS_DCH); c.OY = args.out + OUT_Y; c.DUMP = (bf16_t*)(ws + 30 * MiB); c.OX = (bf16_t*)(ws + WS_FB); c.OI = (bf16_t*)(ws + WS_XB);
    const int lo = args.ph_lo, hi = args.ph_hi;
    volatile LAS unsigned* xst = (volatile LAS unsigned*)(lds + 152064);
    if (tid == 0) { xst[0] = 0u; xst[1] = 0u; }
    __syncthreads();
    XcdBarrier xbar; xbar.bar = (unsigned*)(ws + WS_BAR); xbar.x = 0; xbar.st = xst;
    if (hi - lo > 1) xbar = xcd_barrier_post((unsigned*)(ws + WS_BAR), xst);
#define IN(k) (lo <= (k) && (k) < hi)
#define SEAM(k) do { if (IN(k) && IN((k) + 1)) { if ((k) == 0) cg::this_grid().sync(); else xcd_barrier(xbar); } } while (0)
    if (IN(0)) { p0_prologue(c, lds, G, wave, lane); }
    SEAM(0);
    if (IN(1)) {
        pg8::Gemm g{c.XB, c.WinT, M, NIN, D}; pg8::StaticOrder S; S.init(M, NIN, G, (int)blockIdx.x);
        pg8::EpiIn E{c.P, c.FB, c.LRA, c.RSTD1};
        pg8::gemm_phase<pg8::EpiIn, pg8::StaticOrder, true, true>(lds, g, S, E);
    }
    SEAM(1);
    if (IN(2)) { p2_prepass(c, lds, G, tid, wave, lane, args.aux != 0); }
    SEAM(2);
    if (IN(3)) {
        const int wg = blockIdx.x;
        if (G >= 256) { if (wg < 128) seq_dispatch(c, lds, wg, tid, wave, lane); else for (int j = wg - 128; j < 1024; j += G - 128) seq_dispatch(c, lds, 128 + j, tid, wave, lane); }
        else for (int it = wg; it < 128 + 1024; it += G) seq_dispatch(c, lds, it, tid, wave, lane);
    }
    SEAM(3);
    if (IN(4)) { p3b_finalize(c, G, wave, lane); }
    SEAM(4);
    if (IN(5)) {
        pg8::Gemm g{c.OF, c.WoT, M, D, D}; pg8::StaticOrder S; S.init(M, D, G, (int)blockIdx.x);
        pg8::EpiRes1 E{c.in[0], c.in[1], c.OY, c.X1B, c.SSQ2};
        pg8::gemm_phase<pg8::EpiRes1, pg8::StaticOrder, true, true>(lds, g, S, E);
    }
    SEAM(5);
    if (IN(6)) {
        pg8::Gemm g{c.X1B, c.W13T, M, NUP, D}; pg8::StaticOrder S; S.init(M, NUP, G, (int)blockIdx.x);
        pg8::EpiSwiglu E{c.HID, c.SSQ2};
        pg8::gemm_phase<pg8::EpiSwiglu, pg8::StaticOrder, true, true>(lds, g, S, E);
    }
    SEAM(6);
    if (IN(7)) {
        pg8::Gemm g{c.HID, c.W2T, M, D, FF}; pg8::StaticOrder S; S.init(M, D, G, (int)blockIdx.x);
        pg8::EpiRes2 E{c.OY, args.aux ? 0.f : 1.f};
        pg8::gemm_phase<pg8::EpiRes2, pg8::StaticOrder, true, true>(lds, g, S, E);
    }
    SEAM(7);
    if (IN(8)) {
        const int gw = blockIdx.x * NWAVES + wave, NGW = G * NWAVES;
        f32x4 gn[4];
#pragma unroll
        for (int j = 0; j < 4; ++j) gn[j] = *(const f32x4*)(c.in[16] + 4 * lane + 256 * j);
        for (int m = gw; m < M; m += NGW) {
            float* yr = c.OY + (size_t)m * D; f32x4 v[4]; float s = 0.f;
#pragma unroll
            for (int j = 0; j < 4; ++j) { v[j] = *(const f32x4*)(yr + 4 * lane + 256 * j); s += (v[j][0] * v[j][0] + v[j][1] * v[j][1]) + (v[j][2] * v[j][2] + v[j][3] * v[j][3]); }
            const float rs = 1.0f / sqrtf(wave_sum(s) * (1.0f / D) + EPS);
#pragma unroll
            for (int j = 0; j < 4; ++j) *(f32x4*)(yr + 4 * lane + 256 * j) = args.aux ? v[j] : v[j] * rs * gn[j];
        }
    }
#undef IN
#undef SEAM
}

extern "C" void kernel_launch(void* const* d_in, const int* in_sizes, int n_in, void* d_out, int out_size, void* d_ws, size_t ws_size, hipStream_t stream) {
    static int grid = 0;
    if (grid == 0) {
        if (n_in != 17 || ws_size < WS_END) { fprintf(stderr, "kernel_launch: unexpected n_in %d / ws %zu\n", n_in, ws_size); grid = -1; return; }
        int dev = 0, cus = 0, per_cu = 0;
        (void)hipGetDevice(&dev); (void)hipDeviceGetAttribute(&cus, hipDeviceAttributeMultiprocessorCount, dev);
        if (hipFuncSetAttribute((const void*)hymba_fwd, hipFuncAttributeMaxDynamicSharedMemorySize, LDS_BYTES) != hipSuccess) { fprintf(stderr, "kernel_launch: hipFuncSetAttribute failed\n"); grid = -1; return; }
        if (hipOccupancyMaxActiveBlocksPerMultiprocessor(&per_cu, (const void*)hymba_fwd, NTHR, LDS_BYTES) != hipSuccess || per_cu < 1) { fprintf(stderr, "kernel_launch: occupancy query says %d\n", per_cu); per_cu = 1; }
        (void)hipGetLastError();
        grid = cus * per_cu;
        if (grid <= 0) grid = 256;
    }
    if (grid < 0) return;
    if (hipMemsetAsync((char*)d_ws + WS_BAR, 0, 16384, stream) != hipSuccess) { fprintf(stderr, "kernel_launch: memset failed\n"); return; }
    Args a{};
    for (int i = 0; i < 17; ++i) a.in[i] = (const float*)d_in[i];
    a.out = (float*)d_out; a.ws = (unsigned char*)d_ws;
    if (MK_N_LAUNCHES == 1) {
        a.ph_lo = 0; a.ph_hi = NPHASE;
        void* kargs[] = {&a};
        hipError_t e = hipLaunchCooperativeKernel((const void*)hymba_fwd, dim3(grid), dim3(NTHR), kargs, LDS_BYTES, stream);
        if (e != hipSuccess) fprintf(stderr, "kernel_launch: cooperative launch failed: %s (grid %d)\n", hipGetErrorString(e), grid);
    } else {
        for (int p = 0; p < NPHASE; ++p) { a.ph_lo = p; a.ph_hi = p + 1; const int nrep = ((REP_MASK >> p) & 1) ? 3 : 1;
            for (int rr = 0; rr < nrep; ++rr) { a.aux = ((p == 2 || p == 7 || p == 8) && rr + 1 < nrep) ? 1 : 0; hipLaunchKernelGGL(hymba_fwd, dim3(grid), dim3(NTHR), LDS_BYTES, stream, a); } }
    }
}
```

```cpp
#include <hip/hip_runtime.h>
#include <hip/hip_cooperative_groups.h>
#include <cstdio>
#include <cstdint>
namespace cg = cooperative_groups;
namespace pg8 {
#define PG8_LAS __attribute__((address_space(3)))
typedef unsigned short bf16_t;
typedef short bf16x8 __attribute__((ext_vector_type(8)));
typedef float f32x4 __attribute__((ext_vector_type(4)));
typedef unsigned u32x4 __attribute__((ext_vector_type(4)));
constexpr int BM = 256, BK = 64, HALF = 128, HTB = HALF * BK * 2  , STAGE_BYTES = 8 * HTB, NXCD = 8, WGM = 8;

__host__ __device__ __forceinline__ int lds_byte(int r, int c) { const int st = (r >> 4) * 2 + (c >> 5), rr = r & 15, cc = c & 31, ob = rr * 64 + cc * 2; return st * 1024 + (ob ^ (((ob >> 9) & 1) << 5)); }
__host__ __device__ __forceinline__ void stage_rc(int b, int& R, int& C) { const int st = b / 1024, sb = b % 1024, swz = sb ^ (((sb >> 9) & 1) << 5); R = (st >> 1) * 16 + swz / 64; C = (st & 1) * 32 + (swz % 64) / 2; }
__host__ __device__ __forceinline__ int perm32(int rho) { const int n = rho >> 4, i = rho & 15; return 8 * (i >> 2) + 4 * n + (i & 3); }

struct Unit { int pm, pn, k0, nk; };
struct Gemm { const bf16_t* A; const bf16_t* Bt; int M, N, K; };

struct StaticOrder {
    int nM, nN, nwg, G, c, nkt;
    __host__ __device__ void init(int M, int N, int G_, int c_, int K_) { nM = M / BM; nN = N / BM; nwg = nM * nN; G = G_; c = c_; nkt = K_ / BK; }
    __host__ __device__ bool next(int i, Unit& u) const { return at((long)i * G + c, u); }
    __host__ __device__ bool at(long L, Unit& u) const {
        if (L >= nwg) return false;
        int wgid = (int)L; { const int q = nwg / NXCD, r = nwg % NXCD, xcd = wgid % NXCD, off = wgid / NXCD; wgid = (xcd < r ? xcd * (q + 1) : r * (q + 1) + (xcd - r) * q) + off; }
        const int nig = WGM * nN, gid = wgid / nig, fm = gid * WGM, gsz = (nM - fm) < WGM ? (nM - fm) : WGM;
        u.pm = fm + ((wgid % nig) % gsz); u.pn = (wgid % nig) / gsz; u.k0 = 0; u.nk = nkt; return true;
    }
    __device__ __forceinline__ void a_ready(const Unit&) const {}
    __device__ __forceinline__ void done(const Unit&) const {}
};


struct TailOrder {
    int G, c, NS, nkt, pm0, nN, ntu;
    __host__ __device__ bool next(int i, Unit& u) const {
        const int id = i * G + c; if (id >= ntu * NS) return false;
        const int tu = id / NS, ks = id % NS; u.pm = pm0 + tu / nN; u.pn = tu % nN; u.nk = nkt / NS; u.k0 = ks * u.nk; return true;
    }
    __device__ __forceinline__ void a_ready(const Unit&) const {}
    __device__ __forceinline__ void done(const Unit&) const {}
};

__device__ __forceinline__ unsigned cvt_pk_bf16(float lo, float hi) { unsigned r; asm volatile("v_cvt_pk_bf16_f32 %0, %1, %2" : "=v"(r) : "v"(lo), "v"(hi)); return r; }
typedef float f32x2 __attribute__((ext_vector_type(2)));

template <class Epi, class Sched, bool ALIGN_EPI = false, bool SP2 = false>
__device__ __forceinline__ void gemm_phase(PG8_LAS unsigned char* lds, const Gemm g, const Sched& S, const Epi& E) {
    const int tid = threadIdx.x, wid = __builtin_amdgcn_readfirstlane(tid >> 6), lane = tid & 63, wr = wid >> 2, wc = wid & 3, fr = lane & 15, fq = lane >> 4;
    const int K = g.K, nt = K / BK;
    unsigned voffA[2], voffB[2];
#pragma unroll
    for (int i = 0; i < 2; ++i) { int R, C; stage_rc(tid * 16 + i * 8192, R, C); const int Rb = Epi::PERM ? ((R & ~31) + perm32(R & 31)) : R;
        voffA[i] = (unsigned)(R * K + C) * 2u; voffB[i] = (unsigned)(Rb * K + C) * 2u; }
    const size_t kstep = (size_t)(BK * 2);
    const size_t hstep = (size_t)HALF * K * 2;
    const size_t tstep = 2 * hstep;
    const unsigned ldsw = (unsigned)wid * 1024u;
    const int aoff = lds_byte(wr * 64 + fr, fq * 8), boff = lds_byte(wc * 32 + fr, fq * 8);
#define PG8_SA(b, h) (((b) * 2 + (h)) * HTB)
#define PG8_SB(b, h) ((4 + (b) * 2 + (h)) * HTB)
#define PG8_STAGE(bufoff, gbase, voff) do { _Pragma("unroll") for (int _i = 0; _i < 2; ++_i) \
        __builtin_amdgcn_global_load_lds((const unsigned*)((const char*)(gbase) + (voff)[_i]), (PG8_LAS unsigned*)(lds + (bufoff) + ldsw + _i * 8192), 16, 0, 0); } while (0)
#define PG8_LDA(dst, b, h) do { _Pragma("unroll") for (int m = 0; m < 4; ++m) _Pragma("unroll") for (int k = 0; k < 2; ++k) dst[m][k] = *(const PG8_LAS bf16x8*)(lds + PG8_SA(b, h) + aoff + m * 2048 + k * 1024); } while (0)
#define PG8_LDB(dst, b, h) do { _Pragma("unroll") for (int n = 0; n < 2; ++n) _Pragma("unroll") for (int k = 0; k < 2; ++k) dst[n][k] = *(const PG8_LAS bf16x8*)(lds + PG8_SB(b, h) + boff + n * 2048 + k * 1024); } while (0)
#define PG8_MMA(ai, bj, At, Bt) do { __builtin_amdgcn_s_setprio(1); _Pragma("unroll") for (int m = 0; m < 4; ++m) _Pragma("unroll") for (int n = 0; n < 2; ++n) _Pragma("unroll") for (int k = 0; k < 2; ++k) \
        acc[ai][bj][m][n] = __builtin_amdgcn_mfma_f32_16x16x32_bf16(Bt[n][k], At[m][k], acc[ai][bj][m][n], 0, 0, 0); __builtin_amdgcn_s_setprio(0); } while (0)
#define PG8_WAIT_V(n) asm volatile("s_waitcnt vmcnt(" #n ")" ::: "memory")
#define PG8_WAIT_L(n) asm volatile("s_waitcnt lgkmcnt(" #n ")" ::: "memory")
#define PG8_BAR __builtin_amdgcn_s_barrier()
#define PG8_SCHED __builtin_amdgcn_sched_barrier(0)
    Unit cur, nxt; int ui = 0;
    if (!S.next(0, cur)) return;
    f32x4 acc[2][2][4][2];
#pragma unroll
    for (int a = 0; a < 2; ++a)
#pragma unroll
        for (int b = 0; b < 2; ++b)
#pragma unroll
            for (int m = 0; m < 4; ++m)
#pragma unroll
                for (int n = 0; n < 2; ++n) acc[a][b][m][n] = (f32x4){0.f, 0.f, 0.f, 0.f};
    bf16x8 At[4][2], B0[2][2], B1[2][2];
    const char* cA = (const char*)g.A + (size_t)cur.pm * tstep + (size_t)cur.k0 * kstep; const char* cB = (const char*)g.Bt + (size_t)cur.pn * tstep + (size_t)cur.k0 * kstep;
    S.a_ready(cur);
    if constexpr (SP2) {
        PG8_STAGE(PG8_SB(0, 0), cB, voffB); PG8_STAGE(PG8_SB(0, 1), cB + hstep, voffB); PG8_STAGE(PG8_SA(0, 0), cA, voffA); PG8_STAGE(PG8_SA(0, 1), cA + hstep, voffA);
        if (wr == 1) PG8_BAR;
        PG8_WAIT_V(2); PG8_BAR;
        PG8_STAGE(PG8_SB(1, 0), cB + kstep, voffB); PG8_STAGE(PG8_SA(1, 0), cA + kstep, voffA); PG8_STAGE(PG8_SB(1, 1), cB + hstep + kstep, voffB);
        PG8_WAIT_V(6); PG8_BAR;
    } else {
        PG8_STAGE(PG8_SB(0, 0), cB, voffB); PG8_STAGE(PG8_SA(0, 0), cA, voffA); PG8_STAGE(PG8_SB(0, 1), cB + hstep, voffB); PG8_STAGE(PG8_SA(0, 1), cA + hstep, voffA);
        if (wr == 1) PG8_BAR;
        PG8_WAIT_V(4); PG8_BAR;
        PG8_STAGE(PG8_SB(1, 0), cB + kstep, voffB); PG8_STAGE(PG8_SA(1, 0), cA + kstep, voffA); PG8_STAGE(PG8_SB(1, 1), cB + hstep + kstep, voffB);
        PG8_WAIT_V(6); PG8_BAR;
    }
    for (;;) {
        const bool has_next = S.next(ui + 1, nxt);
        const char* nA = has_next ? (const char*)g.A + (size_t)nxt.pm * tstep + (size_t)nxt.k0 * kstep : cA; const char* nB = has_next ? (const char*)g.Bt + (size_t)nxt.pn * tstep + (size_t)nxt.k0 * kstep : cB;
        const int ntc = cur.nk;
        for (int t = 0; t < ntc; t += 2) {
            const bool last = (t == ntc - 2);
            const char* a1 = cA + (size_t)(t + 1) * kstep;
            const char* a2 = last ? nA : cA + (size_t)(t + 2) * kstep; const char* b2 = last ? nB : cB + (size_t)(t + 2) * kstep;
            const char* a3 = a2 + kstep; const char* b3 = b2 + kstep;
            if (last && has_next) S.a_ready(nxt);
            if constexpr (SP2) {
            PG8_LDB(B0, 0, 0); PG8_LDB(B1, 0, 1); PG8_SCHED; PG8_LDA(At, 0, 0); PG8_STAGE(PG8_SA(1, 1), a1 + hstep, voffA);
            PG8_WAIT_V(8); PG8_WAIT_L(0); PG8_BAR; PG8_MMA(0, 0, At, B0); PG8_MMA(0, 1, At, B1); PG8_BAR; PG8_SCHED;
            PG8_LDA(At, 0, 1); PG8_STAGE(PG8_SB(0, 0), b2, voffB); PG8_STAGE(PG8_SB(0, 1), b2 + hstep, voffB); PG8_STAGE(PG8_SA(0, 0), a2, voffA);
            PG8_WAIT_V(8); PG8_WAIT_L(0); PG8_BAR; PG8_MMA(1, 0, At, B0); PG8_MMA(1, 1, At, B1); PG8_BAR; PG8_SCHED;
            PG8_LDB(B0, 1, 0); PG8_LDB(B1, 1, 1); PG8_SCHED; PG8_LDA(At, 1, 0); PG8_STAGE(PG8_SA(0, 1), a2 + hstep, voffA);
            PG8_WAIT_V(8); PG8_WAIT_L(0); PG8_BAR; PG8_MMA(0, 0, At, B0); PG8_MMA(0, 1, At, B1); PG8_BAR; PG8_SCHED;
            PG8_LDA(At, 1, 1); PG8_STAGE(PG8_SB(1, 0), b3, voffB); PG8_STAGE(PG8_SB(1, 1), b3 + hstep, voffB); PG8_STAGE(PG8_SA(1, 0), a3, voffA);
            PG8_WAIT_V(8); PG8_WAIT_L(0); PG8_BAR; PG8_MMA(1, 0, At, B0); PG8_MMA(1, 1, At, B1); PG8_BAR; PG8_SCHED;
            } else {
            PG8_LDB(B0, 0, 0); PG8_SCHED; PG8_LDA(At, 0, 0); PG8_STAGE(PG8_SA(1, 1), a1 + hstep, voffA);
            PG8_WAIT_L(8); PG8_BAR; PG8_WAIT_L(0); PG8_MMA(0, 0, At, B0); PG8_BAR; PG8_SCHED;
            PG8_LDB(B1, 0, 1); PG8_STAGE(PG8_SB(0, 0), b2, voffB);
            PG8_BAR; PG8_WAIT_L(0); PG8_MMA(0, 1, At, B1); PG8_BAR;
            PG8_LDA(At, 0, 1); PG8_STAGE(PG8_SA(0, 0), a2, voffA);
            PG8_BAR; PG8_WAIT_L(0); PG8_MMA(1, 0, At, B0); PG8_BAR; PG8_SCHED;
            PG8_STAGE(PG8_SB(0, 1), b2 + hstep, voffB);
            PG8_WAIT_V(6); PG8_BAR; PG8_MMA(1, 1, At, B1); PG8_BAR;
            PG8_LDB(B0, 1, 0); PG8_SCHED; PG8_LDA(At, 1, 0); PG8_STAGE(PG8_SA(0, 1), a2 + hstep, voffA);
            PG8_WAIT_L(8); PG8_BAR; PG8_WAIT_L(0); PG8_MMA(0, 0, At, B0); PG8_BAR; PG8_SCHED;
            PG8_LDB(B1, 1, 1); PG8_STAGE(PG8_SB(1, 0), b3, voffB);
            PG8_BAR; PG8_WAIT_L(0); PG8_MMA(0, 1, At, B1); PG8_BAR;
            PG8_LDA(At, 1, 1); PG8_STAGE(PG8_SA(1, 0), a3, voffA);
            PG8_BAR; PG8_WAIT_L(0); PG8_MMA(1, 0, At, B0); PG8_BAR; PG8_SCHED;
            PG8_STAGE(PG8_SB(1, 1), b3 + hstep, voffB);
            PG8_WAIT_V(6); PG8_BAR; PG8_MMA(1, 1, At, B1); PG8_BAR;
            }
        }
        if constexpr (ALIGN_EPI) { if (wr == 0) PG8_BAR; }
        if constexpr (!Epi::AFTER_DRAIN) { E(acc, cur, wr, wc, fr, fq); S.done(cur); }
        if (!has_next) break;
#pragma unroll
        for (int a = 0; a < 2; ++a)
#pragma unroll
            for (int b = 0; b < 2; ++b)
#pragma unroll
                for (int m = 0; m < 4; ++m)
#pragma unroll
                    for (int n = 0; n < 2; ++n) acc[a][b][m][n] = (f32x4){0.f, 0.f, 0.f, 0.f};
        cur = nxt; cA = nA; cB = nB; ++ui;
        if constexpr (ALIGN_EPI) { if (wr == 1) PG8_BAR; }
    }
    PG8_WAIT_V(0);
    if constexpr (!ALIGN_EPI) { if (wr == 0) PG8_BAR; }
    PG8_BAR;
    if constexpr (Epi::AFTER_DRAIN) { E.fused(acc, cur, wr, wc, fr, fq, lds, wid, lane); S.done(cur); }
#undef PG8_SA
#undef PG8_SB
#undef PG8_STAGE
#undef PG8_LDA
#undef PG8_LDB
#undef PG8_MMA
#undef PG8_WAIT_V
#undef PG8_WAIT_L
#undef PG8_BAR
#undef PG8_SCHED
}
}

#ifndef MK_N_LAUNCHES
#define MK_N_LAUNCHES 1
#endif
#ifndef REP_MASK
#define REP_MASK 0
#endif
#define LAS __attribute__((address_space(3)))
using pg8::bf16_t; using pg8::bf16x8; using pg8::f32x4; using pg8::u32x4;
typedef float f32x16 __attribute__((ext_vector_type(16)));
typedef __bf16 bf16x2_t __attribute__((ext_vector_type(2)));
typedef float f32x2_t __attribute__((ext_vector_type(2)));
typedef unsigned u32x2 __attribute__((ext_vector_type(2)));

constexpr int NWAVES = 8, NTHR = 512;
constexpr int D = 1024, MP = 16384, MS = 1024, M = MP + MS, NIN = 3840, PLD = 3584, FF = 2816, NUP = 2 * FF;
constexpr float EPS = 1e-6f;
constexpr size_t MiB = 1u << 20;
constexpr size_t WS_BAR = 26 * MiB + 768 * 1024, WS_WIN = 0, WS_WO = 8 * MiB, WS_W13 = 10 * MiB, WS_W2 = 21 * MiB, WS_RSTD1 = 27 * MiB, WS_SSQ2 = 28 * MiB, WS_LRA = 32 * MiB, WS_DCH = 34 * MiB,
                 WS_KDTS = 37 * MiB, WS_XB = 45 * MiB, WS_FB = 79 * MiB, WS_P = 113 * MiB, WS_END = 233 * MiB;
static_assert(WS_P + (size_t)(M + 32) * PLD * 2 <= WS_END && WS_XB + (size_t)M * D * 2 <= WS_FB && WS_FB + (size_t)M * 512 * 4 <= WS_P, "ws map");
constexpr size_t OUT_Y = 0, OUT_SAP = 17825792, OUT_SBP = 18087936, OUT_SAS = 18612224, OUT_SBS = 22806528;
constexpr int LDS_BYTES = 152576;

__device__ __forceinline__ unsigned pk_bf16(float lo, float hi) { f32x2_t v = {lo, hi}; bf16x2_t b = __builtin_convertvector(v, bf16x2_t); return __builtin_bit_cast(unsigned, b); }
__device__ __forceinline__ float bf_lo(unsigned u) { return __uint_as_float(u << 16); }
__device__ __forceinline__ float bf_hi(unsigned u) { return __uint_as_float(u & 0xffff0000u); }
__device__ __forceinline__ float bf_f(unsigned short u) { return __uint_as_float(((unsigned)u) << 16); }


template <int CTRL, int ROWMASK> __device__ __forceinline__ float dpp_f(float v) { return __builtin_bit_cast(float, __builtin_amdgcn_update_dpp(0, __builtin_bit_cast(int, v), CTRL, ROWMASK, 0xF, true)); }
__device__ __forceinline__ float row16_sum(float v) { v += dpp_f<0xB1, 0xF>(v); v += dpp_f<0x4E, 0xF>(v); v += dpp_f<0x141, 0xF>(v); v += dpp_f<0x140, 0xF>(v); return v; }
__device__ __forceinline__ float scan32(float a) {
    a += dpp_f<0x111, 0xF>(a); a += dpp_f<0x112, 0xF>(a); a += dpp_f<0x114, 0xF>(a); a += dpp_f<0x118, 0xF>(a); a += dpp_f<0x142, 0xA>(a); return a; }
__device__ __forceinline__ float lane_bcast(float v, int l);
__device__ __forceinline__ float wave_sum(float v) { v = row16_sum(v); return (lane_bcast(v, 0) + lane_bcast(v, 16)) + (lane_bcast(v, 32) + lane_bcast(v, 48)); }
__device__ __forceinline__ float lane_bcast(float v, int l) { return __builtin_bit_cast(float, __builtin_amdgcn_readlane(__builtin_bit_cast(int, v), l)); }
#define LDS_WAIT() asm volatile("s_waitcnt lgkmcnt(0)" ::: "memory")
#define WG_BAR() do { asm volatile("s_waitcnt lgkmcnt(0)" ::: "memory"); __builtin_amdgcn_s_barrier(); asm volatile("" ::: "memory"); } while (0)
#define MFMA32(a, b, c) __builtin_amdgcn_mfma_f32_32x32x16_bf16((a), (b), (c), 0, 0, 0)
#define MFMA16(a, b, c) __builtin_amdgcn_mfma_f32_16x16x32_bf16((a), (b), (c), 0, 0, 0)

struct Ptrs {
    const float* in[17]; float* out;
    bf16_t *WinT, *WoT, *W13T, *W2T, *XB, *P, *KDTS, *OF, *X1B, *HID;
    float *RSTD1, *SSQ2, *LRA, *DCH, *FB, *OY; bf16_t *DUMP, *OX, *OI; float *PART, *PART4;
};

namespace pg8 {
struct EpiIn {
    static constexpr bool PERM = true, AFTER_DRAIN = false;
    bf16_t* P; float* FB; float* LRA; const float* rstd;
    __device__ __forceinline__ void operator()(const f32x4 (&acc)[2][2][4][2], const Unit& u, int wr, int wc, int fr, int fq) const {
        const int row0 = u.pm * BM + wr * 64 + fr, ct = wc * 32 + 8 * fq;
#pragma unroll
        for (int ai = 0; ai < 2; ++ai)
#pragma unroll
            for (int m = 0; m < 4; ++m) {
                const int row = row0 + ai * HALF + m * 16; const float rs = rstd[row];
#pragma unroll
                for (int bj = 0; bj < 2; ++bj) {
                    const f32x4 v0 = acc[ai][bj][m][0] * rs, v1 = acc[ai][bj][m][1] * rs; const int cl = bj * HALF + ct;
                    if (u.pn == 8 || u.pn == 9) { float* o = FB + (size_t)row * 512 + (u.pn - 8) * BM + cl; *(f32x4*)o = v0; *(f32x4*)(o + 4) = v1; }
                    else if (u.pn == 14) { if (cl < 16) { float* o = LRA + (size_t)row * 16 + cl; *(f32x4*)o = v0; *(f32x4*)(o + 4) = v1; } }
                    else { u32x4 w; w.x = cvt_pk_bf16(v0[0], v0[1]); w.y = cvt_pk_bf16(v0[2], v0[3]); w.z = cvt_pk_bf16(v1[0], v1[1]); w.w = cvt_pk_bf16(v1[2], v1[3]);
                           *(u32x4*)(P + (size_t)row * 3584 + u.pn * BM + cl) = w; }
                }
            }
    }
};
struct EpiRes1 {
    static constexpr bool PERM = true, AFTER_DRAIN = false;
    const float* xp; const float* xs; float* Y; bf16_t* X1B; float* SSQ;
    __device__ __forceinline__ void operator()(const f32x4 (&acc)[2][2][4][2], const Unit& u, int wr, int wc, int fr, int fq) const {
        const int row0 = u.pm * BM + wr * 64 + fr, ct = u.pn * BM + wc * 32 + 8 * fq;
#pragma unroll
        for (int ai = 0; ai < 2; ++ai)
#pragma unroll
            for (int m = 0; m < 4; ++m) {
                const int row = row0 + ai * HALF + m * 16;
                const float* xr = row < 16384 ? xp + (size_t)row * 1024 : xs + (size_t)(row - 16384) * 1024;
                float ss = 0.f;
#pragma unroll
                for (int bj = 0; bj < 2; ++bj) {
                    const int col = ct + bj * HALF;
                    const f32x4 v0 = acc[ai][bj][m][0] + *(const f32x4*)(xr + col), v1 = acc[ai][bj][m][1] + *(const f32x4*)(xr + col + 4);
                    *(f32x4*)(Y + (size_t)row * 1024 + col) = v0; *(f32x4*)(Y + (size_t)row * 1024 + col + 4) = v1;
                    u32x4 w; w.x = cvt_pk_bf16(v0[0], v0[1]); w.y = cvt_pk_bf16(v0[2], v0[3]); w.z = cvt_pk_bf16(v1[0], v1[1]); w.w = cvt_pk_bf16(v1[2], v1[3]);
                    *(u32x4*)(X1B + (size_t)row * 1024 + col) = w;
                    ss += (v0[0] * v0[0] + v0[1] * v0[1]) + (v0[2] * v0[2] + v0[3] * v0[3]) + (v1[0] * v1[0] + v1[1] * v1[1]) + (v1[2] * v1[2] + v1[3] * v1[3]);
                }
                ss += __shfl_xor(ss, 16); ss += __shfl_xor(ss, 32);
                if (fq == 0) SSQ[(size_t)row * 16 + u.pn * 4 + wc] = ss;
            }
    }
};
struct EpiSwiglu {
    static constexpr bool PERM = true, AFTER_DRAIN = false;
    bf16_t* H; const float* SSQ;
    __device__ __forceinline__ void operator()(const f32x4 (&acc)[2][2][4][2], const Unit& u, int wr, int wc, int fr, int fq) const {
        const int row0 = u.pm * BM + wr * 64 + fr, hc = u.pn * 128 + wc * 16 + fq * 4;
#pragma unroll
        for (int ai = 0; ai < 2; ++ai)
#pragma unroll
            for (int m = 0; m < 4; ++m) {
                const int row = row0 + ai * HALF + m * 16;
                const f32x4* sp = (const f32x4*)(SSQ + (size_t)row * 16);
                const f32x4 s0 = sp[0], s1 = sp[1], s2 = sp[2], s3 = sp[3];
                const float tot = ((s0[0] + s0[1]) + (s0[2] + s0[3])) + ((s1[0] + s1[1]) + (s1[2] + s1[3])) + ((s2[0] + s2[1]) + (s2[2] + s2[3])) + ((s3[0] + s3[1]) + (s3[2] + s3[3]));
                const float rs = __builtin_amdgcn_rsqf(tot * (1.0f / 1024.0f) + 1e-6f);
#pragma unroll
                for (int bj = 0; bj < 2; ++bj) {
                    const f32x4 a = acc[ai][bj][m][0] * rs, b = acc[ai][bj][m][1] * rs; float h[4];
#pragma unroll
                    for (int e = 0; e < 4; ++e) h[e] = a[e] * __builtin_amdgcn_rcpf(1.0f + __expf(-a[e])) * b[e];
                    unsigned lo = cvt_pk_bf16(h[0], h[1]), hi = cvt_pk_bf16(h[2], h[3]);
                    *(unsigned long long*)(H + (size_t)row * 2816 + hc + bj * 64) = (unsigned long long)lo | ((unsigned long long)hi << 32);
                }
            }
    }
};
struct EpiRes2 {
    static constexpr bool PERM = true, AFTER_DRAIN = false;
    float* Y; float sc;
    __device__ __forceinline__ void operator()(const f32x4 (&acc)[2][2][4][2], const Unit& u, int wr, int wc, int fr, int fq) const {
        const int row0 = u.pm * BM + wr * 64 + fr, ct = u.pn * BM + wc * 32 + 8 * fq;
#pragma unroll
        for (int ai = 0; ai < 2; ++ai)
#pragma unroll
            for (int m = 0; m < 4; ++m) {
                float* yr = Y + (size_t)(row0 + ai * HALF + m * 16) * 1024;
#pragma unroll
                for (int bj = 0; bj < 2; ++bj) {
                    const int col = ct + bj * HALF;
                    const f32x4 v0 = acc[ai][bj][m][0] * sc + *(const f32x4*)(yr + col), v1 = acc[ai][bj][m][1] * sc + *(const f32x4*)(yr + col + 4);
                    *(f32x4*)(yr + col) = v0; *(f32x4*)(yr + col + 4) = v1;
                }
            }
    }
};
struct EpiPart {
    static constexpr bool PERM = true, AFTER_DRAIN = false;
    float* PART; int rowbase; float sc;
    __device__ __forceinline__ void operator()(const f32x4 (&acc)[2][2][4][2], const Unit& u, int wr, int wc, int fr, int fq) const {
        const int row0 = u.pm * BM + wr * 64 + fr - rowbase, ct = u.pn * BM + wc * 32 + 8 * fq;
        float* base = PART + (size_t)(u.k0 / u.nk) * 1024 * 1024;
#pragma unroll
        for (int ai = 0; ai < 2; ++ai)
#pragma unroll
            for (int m = 0; m < 4; ++m) {
                float* yr = base + (size_t)(row0 + ai * HALF + m * 16) * 1024;
#pragma unroll
                for (int bj = 0; bj < 2; ++bj) { const int col = ct + bj * HALF; *(f32x4*)(yr + col) = acc[ai][bj][m][0] * sc; *(f32x4*)(yr + col + 4) = acc[ai][bj][m][1] * sc; }
            }
    }
};
}

__device__ __forceinline__ void tr_item(const float* colp, int ldw, const float* gain, int k0, int dcol, bf16_t* WT, int K, int nrow0, LAS float* scr, int lane) {
#pragma unroll 8
    for (int i = 0; i < 32; ++i) {
        const int kk = 2 * i + (lane >> 5); float v = 0.f;
        if (colp) { v = colp[(size_t)(k0 + kk) * ldw]; if (gain) v *= gain[k0 + kk]; }
        scr[kk * 33 + dcol] = v;
    }
    LDS_WAIT();
    const int c = lane & 7;
#pragma unroll
    for (int j = 0; j < 4; ++j) {
        const int n = (lane >> 3) + 8 * j; const LAS float* s = scr + (8 * c) * 33 + n;
        u32x4 o; o.x = pk_bf16(s[0 * 33], s[1 * 33]); o.y = pk_bf16(s[2 * 33], s[3 * 33]); o.z = pk_bf16(s[4 * 33], s[5 * 33]); o.w = pk_bf16(s[6 * 33], s[7 * 33]);
        *(u32x4*)(WT + (size_t)(nrow0 + n) * K + k0 + 8 * c) = o;
    }
    LDS_WAIT();
}
__device__ __forceinline__ void weight_items(const Ptrs& c, LAS float* scr, int part, int gw, int NGW, int lane) {
    const int l31 = lane & 31;
    constexpr int I_IN = 16 * 120, I_O = 16 * 32, I_13 = 16 * 176, I_2 = 44 * 32;
    if (part == 0) {
        for (int r = gw; r < I_IN; r += NGW) { const int kb = r / 120, nb = r % 120, n = nb * 32 + l31;
            const int oc = n < 1536 ? n : (n < 3584 ? n + 16 : (n < 3600 ? n - 3584 + 1536 : -1));
            tr_item(oc >= 0 ? c.in[5] + oc : nullptr, 3600, c.in[4], kb * 64, l31, c.WinT, 1024, nb * 32, scr, lane); }
        return;
    }
    for (int it = gw; it < I_O + I_13 + I_2; it += NGW) {
        int r = it;
        if (r < I_O) { const int kb = r / 32, nb = r % 32; tr_item(c.in[11] + nb * 32 + l31, 1024, nullptr, kb * 64, l31, c.WoT, 1024, nb * 32, scr, lane); continue; }
        r -= I_O;
        if (r < I_13) { const int kb = r / 176, nb = r % 176; const bool is3 = l31 >= 16; const int hcol = nb * 16 + (l31 & 15);
            tr_item((is3 ? c.in[14] : c.in[13]) + hcol, 2816, c.in[12], kb * 64, ((l31 & 15) >> 2) * 8 + (is3 ? 4 : 0) + (l31 & 3), c.W13T, 1024, nb * 32, scr, lane); continue; }
        r -= I_13;
        { const int kb = r / 32, nb = r % 32; tr_item(c.in[15] + nb * 32 + l31, 1024, nullptr, kb * 64, l31, c.W2T, 2816, nb * 32, scr, lane); }
    }
}
__device__ __forceinline__ void p0_prologue(const Ptrs& c, LAS unsigned char* lds, int G, int wave, int lane, bool all_weights) {
    LAS float* scr = (LAS float*)(lds + wave * 16384);
    const int gw = blockIdx.x * NWAVES + wave, NGW = G * NWAVES;
    weight_items(c, scr, 0, gw, NGW, lane);
    if (all_weights) weight_items(c, scr, 1, gw, NGW, lane);
    {
        f32x4 v[4], nv[4];
        { const int m0 = gw < M ? gw : M - 1; const float* xr = m0 < MP ? c.in[0] + (size_t)m0 * D : c.in[1] + (size_t)(m0 - MP) * D;
#pragma unroll
          for (int j = 0; j < 4; ++j) v[j] = *(const f32x4*)(xr + 4 * lane + 256 * j); }
        for (int m = gw; m < M; m += NGW) {
            { const int mn = m + NGW < M ? m + NGW : m; const float* xr = mn < MP ? c.in[0] + (size_t)mn * D : c.in[1] + (size_t)(mn - MP) * D;
#pragma unroll
              for (int j = 0; j < 4; ++j) nv[j] = *(const f32x4*)(xr + 4 * lane + 256 * j); }
            float s = 0.f;
#pragma unroll
            for (int j = 0; j < 4; ++j) s += (v[j][0] * v[j][0] + v[j][1] * v[j][1]) + (v[j][2] * v[j][2] + v[j][3] * v[j][3]);
            s = wave_sum(s);
#pragma unroll
            for (int j = 0; j < 4; ++j) { u32x2 w; w.x = pk_bf16(v[j][0], v[j][1]); w.y = pk_bf16(v[j][2], v[j][3]); *(u32x2*)(c.XB + (size_t)m * D + 4 * lane + 256 * j) = w; }
            if (lane == 0) c.RSTD1[m] = 1.0f / sqrtf(s * (1.0f / D) + EPS);
#pragma unroll
            for (int j = 0; j < 4; ++j) v[j] = nv[j];
        }
    }
}

__device__ __forceinline__ int crow(int i, int h) { return (i & 3) + 8 * (i >> 2) + 4 * h; }
template <int K, bool GLA>
__device__ __forceinline__ void pre_item(const Ptrs& c, int row0, int ntok, int hh, int item, bf16_t* kdt_base, int kdt_stride,
                                         const LAS float* wa2_l, const LAS float* ba_l, const LAS float* lb_l, LAS unsigned char* vt, int lane, bool dry) {
    const int r = lane & 31, kg = lane >> 5;
    const bool valid = r < ntok;
    const int row = row0 + (valid ? r : 0), nt1 = ntok - 1;
    constexpr int NJ = K / 16;
    const int qcol0 = GLA ? hh * 64 : 1536 + hh * 128, kcol0 = 256 + hh * 64, vcol0 = GLA ? 512 + hh * 128 : 2560 + hh * 128, ocol0 = (GLA ? hh : 4 + hh) * 128;
    bf16_t* Prow = c.P + (size_t)row * PLD;
    LAS unsigned char* kt = vt + 8192;
    float lra[16];
    {
        u32x4 vreg[8];
#pragma unroll
        for (int i = 0; i < 8; ++i) { const int p = lane + 64 * i, vr = (p >> 4) < nt1 ? (p >> 4) : nt1; vreg[i] = *(const u32x4*)(c.P + (size_t)(row0 + vr) * PLD + vcol0 + (p & 15) * 8); }
        if constexpr (GLA) {
#pragma unroll
            for (int i = 0; i < 4; ++i) { const f32x4 t = *(const f32x4*)(c.LRA + (size_t)row * 16 + 4 * i); lra[4 * i] = t[0]; lra[4 * i + 1] = t[1]; lra[4 * i + 2] = t[2]; lra[4 * i + 3] = t[3]; }
        }
#pragma unroll
        for (int i = 0; i < 8; ++i) { const int p = lane + 64 * i; *(LAS u32x4*)(vt + (p >> 4) * 256 + (p & 15) * 16) = vreg[i]; }
    }
    const bf16_t* qptr = Prow + qcol0 + 8 * kg;
    const bf16_t* kptr = Prow + kcol0 + 8 * kg;
    const float* fptr = c.FB + (size_t)row * 512 + hh * 128 + 8 * kg;
    u32x4 qn = *(const u32x4*)qptr, kn = {0u, 0u, 0u, 0u}; f32x4 fn0 = {0.f, 0.f, 0.f, 0.f}, fn1 = fn0;
    if constexpr (GLA) kn = *(const u32x4*)kptr; else { fn0 = *(const f32x4*)fptr; fn1 = *(const f32x4*)(fptr + 4); }
    f32x16 att;
#pragma unroll
    for (int i = 0; i < 16; ++i) att[i] = 0.f;
    float* dch = c.DCH + (size_t)item * 128;
#pragma unroll 1
    for (int j = 0; j < NJ; ++j) {
        const int cl = 16 * j + 8 * kg;
        const u32x4 qr = qn, kr = kn; const f32x4 f0 = fn0, f1 = fn1;
        { const int jn = j + 1 < NJ ? j + 1 : j;
          qn = *(const u32x4*)(qptr + 16 * jn);
          if constexpr (GLA) kn = *(const u32x4*)(kptr + 16 * jn); else { fn0 = *(const f32x4*)(fptr + 16 * jn); fn1 = *(const f32x4*)(fptr + 16 * jn + 4); } }
        float la[8], kv[8], qv[8];
        if constexpr (GLA) {
            const LAS float* wl = wa2_l + hh * 64 + cl;
            f32x4 a0 = *(const LAS f32x4*)(ba_l + hh * 64 + cl), a1 = *(const LAS f32x4*)(ba_l + hh * 64 + cl + 4);
#pragma unroll
            for (int rr = 0; rr < 16; ++rr) { const f32x4 w0 = *(const LAS f32x4*)(wl + rr * 256), w1 = *(const LAS f32x4*)(wl + rr * 256 + 4); a0 += w0 * lra[rr]; a1 += w1 * lra[rr]; }
#pragma unroll
            for (int e = 0; e < 8; ++e) { const float x = e < 4 ? a0[e & 3] : a1[e & 3]; la[e] = (fminf(x, 0.f) - __logf(1.0f + __expf(-fabsf(x)))) * 0.0625f; }
            kv[0] = bf_lo(kr.x); kv[1] = bf_hi(kr.x); kv[2] = bf_lo(kr.y); kv[3] = bf_hi(kr.y); kv[4] = bf_lo(kr.z); kv[5] = bf_hi(kr.z); kv[6] = bf_lo(kr.w); kv[7] = bf_hi(kr.w);
        } else {
            const f32x4 l0 = *(const LAS f32x4*)(lb_l + hh * 128 + cl), l1 = *(const LAS f32x4*)(lb_l + hh * 128 + cl + 4);
#pragma unroll
            for (int e = 0; e < 8; ++e) {
                const float x = e < 4 ? f0[e & 3] : f1[e & 3], lb = e < 4 ? l0[e & 3] : l1[e & 3];
                const float ex = __expf(-fabsf(x)), inv = __builtin_amdgcn_rcpf(1.0f + ex);
                const float sg = x >= 0.f ? inv : ex * inv, ng = x >= 0.f ? ex * inv : inv;
                la[e] = __logf(lb + (1.0f - lb) * sg); kv[e] = (1.0f - lb) * ng;
            }
        }
        qv[0] = bf_lo(qr.x); qv[1] = bf_hi(qr.x); qv[2] = bf_lo(qr.y); qv[3] = bf_hi(qr.y); qv[4] = bf_lo(qr.z); qv[5] = bf_hi(qr.z); qv[6] = bf_lo(qr.w); qv[7] = bf_hi(qr.w);
        float qi[8], ki[8], kd[8], eb[8];
#pragma unroll
        for (int e = 0; e < 8; ++e) {
            float q = GLA ? qv[e] * 0.125f : qv[e] * __builtin_amdgcn_rcpf(1.0f + __expf(-qv[e]));
            float k = kv[e], a = la[e];
            if (!valid) { q = 0.f; k = 0.f; a = 0.f; }
            a = fmaxf(scan32(a), -80.f);
            const float ea = __expf(a), ia = __builtin_amdgcn_rcpf(ea);
            const float e31 = lane_bcast(ea, 31), e63 = lane_bcast(ea, 63);
            eb[e] = kg ? e63 : e31;
            qi[e] = q * ea; ki[e] = k * ia; kd[e] = ki[e] * eb[e];
        }
        u32x4 qp, kp;
        qp.x = pk_bf16(qi[0], qi[1]); qp.y = pk_bf16(qi[2], qi[3]); qp.z = pk_bf16(qi[4], qi[5]); qp.w = pk_bf16(qi[6], qi[7]);
        kp.x = pk_bf16(ki[0], ki[1]); kp.y = pk_bf16(ki[2], ki[3]); kp.z = pk_bf16(ki[4], ki[5]); kp.w = pk_bf16(ki[6], ki[7]);
        att = MFMA32(__builtin_bit_cast(bf16x8, kp), __builtin_bit_cast(bf16x8, qp), att);
        if (valid) *(u32x4*)(Prow + qcol0 + cl) = dry ? qr : qp;
#pragma unroll
        for (int e = 0; e < 8; e += 2) {
            const unsigned pkd = pk_bf16(kd[e], kd[e + 1]);
            *(LAS unsigned short*)(kt + (cl + e) * 64 + r * 2) = (unsigned short)(pkd & 0xffffu);
            *(LAS unsigned short*)(kt + (cl + e + 1) * 64 + r * 2) = (unsigned short)(pkd >> 16);
        }
        if (r == 0) { f32x4 d0 = {eb[0], eb[1], eb[2], eb[3]}, d1 = {eb[4], eb[5], eb[6], eb[7]}; *(f32x4*)(dch + cl) = d0; *(f32x4*)(dch + cl + 4) = d1; }
    }
#pragma unroll
    for (int i = 0; i < K / 16; ++i) {
        const int p = lane + 64 * i, L = p * 8;
        *(u32x4*)(kdt_base + (size_t)(L / K) * kdt_stride + (L % K)) = *(const LAS u32x4*)(kt + p * 16);
    }
#pragma unroll
    for (int i = 0; i < 16; ++i) if (crow(i, kg) > r) att[i] = 0.f;
    u32x4 pa0, pa1;
    pa0.x = pk_bf16(att[0], att[1]); pa0.y = pk_bf16(att[2], att[3]); pa0.z = pk_bf16(att[4], att[5]); pa0.w = pk_bf16(att[6], att[7]);
    pa1.x = pk_bf16(att[8], att[9]); pa1.y = pk_bf16(att[10], att[11]); pa1.z = pk_bf16(att[12], att[13]); pa1.w = pk_bf16(att[14], att[15]);
#pragma unroll 1
    for (int vb = 0; vb < 4; ++vb) {
        unsigned short vs[16];
#pragma unroll
        for (int i = 0; i < 16; ++i) vs[i] = *(const LAS unsigned short*)(vt + crow(i, kg) * 256 + (vb * 32 + r) * 2);
        u32x4 b0, b1;
        b0.x = vs[0] | ((unsigned)vs[1] << 16); b0.y = vs[2] | ((unsigned)vs[3] << 16); b0.z = vs[4] | ((unsigned)vs[5] << 16); b0.w = vs[6] | ((unsigned)vs[7] << 16);
        b1.x = vs[8] | ((unsigned)vs[9] << 16); b1.y = vs[10] | ((unsigned)vs[11] << 16); b1.z = vs[12] | ((unsigned)vs[13] << 16); b1.w = vs[14] | ((unsigned)vs[15] << 16);
        f32x16 o;
#pragma unroll
        for (int i = 0; i < 16; ++i) o[i] = 0.f;
        o = MFMA32(__builtin_bit_cast(bf16x8, pa0), __builtin_bit_cast(bf16x8, b0), o);
        o = MFMA32(__builtin_bit_cast(bf16x8, pa1), __builtin_bit_cast(bf16x8, b1), o);
#pragma unroll
        for (int i = 0; i < 16; ++i) *(LAS unsigned short*)(kt + crow(i, kg) * 256 + (vb * 32 + r) * 2) = (unsigned short)(pk_bf16(o[i], 0.f) & 0xffffu);
    }
#pragma unroll
    for (int i = 0; i < 8; ++i) {
        const int p = lane + 64 * i, t = p >> 4;
        if (t < ntok) *(u32x4*)(c.OI + (size_t)(row0 + t) * 1024 + ocol0 + (p & 15) * 8) = *(const LAS u32x4*)(kt + p * 16);
    }
}
__device__ __forceinline__ void p2_prepass(const Ptrs& c, LAS unsigned char* lds, int G, int tid, int wave, int lane, bool dry) {
    LAS float* wa2_l = (LAS float*)lds; LAS float* ba_l = wa2_l + 4096; LAS float* lb_l = ba_l + 256;
    for (int i = tid; i < 4096; i += NTHR) wa2_l[i] = c.in[6][i];
    if (tid < 256) ba_l[tid] = c.in[7][tid];
    { const float p0 = c.in[8][tid], p1 = c.in[8][512 + tid]; lb_l[tid] = 1.0f / (1.0f + __expf(p1 - p0)); }
    WG_BAR();
    const int gw = blockIdx.x * NWAVES + wave, NGW = G * NWAVES;
    for (int it = gw; it < 4096 + 1024; it += NGW) {
        int row0, ntok, h; bf16_t* kdt; int kst;
        if (it < 4096) { h = it & 7; const int ch = (it >> 3) & 63, b = it >> 9; row0 = b * 2048 + ch * 32; ntok = 32; kst = PLD;
                         kdt = c.P + (size_t)row0 * PLD + (h < 4 ? 256 + h * 64 : 2048 + (h - 4) * 128); }
        else { const int j = it - 4096; h = j & 7; row0 = MP + (j >> 3) * 8; ntok = 8; kst = h < 4 ? 64 : 128; kdt = c.KDTS + (size_t)j * 4096; }
        if (dry) { kst = h < 4 ? 64 : 128; kdt = (bf16_t*)((unsigned char*)c.DUMP + 203 * MiB) + (size_t)(it & 2047) * 4096; }
        if (h < 4) pre_item<64, true>(c, row0, ntok, h, it, kdt, kst, wa2_l, ba_l, lb_l, lds + 20480 + wave * 16384, lane, dry);
        else pre_item<128, false>(c, row0, ntok, h - 4, it, kdt, kst, wa2_l, ba_l, lb_l, lds + 20480 + wave * 16384, lane, dry);
    }
    if (G >= 256 && blockIdx.x >= 128) weight_items(c, (LAS float*)(lds + 20480 + wave * 16384), 1, (blockIdx.x - 128) * NWAVES + wave, (G - 128) * NWAVES, lane);
}

template <int K>
__device__ __forceinline__ void seq_item(const Ptrs& c, LAS unsigned char* lds, int row0, int nch, int ntok, int h8, int colbase, int ncw, const float* S0, float* Sout,
                                         const bf16_t* kdt0, int kdt_rstride, size_t kdt_cstep, const float* dch0, size_t dch_cstep, int tid, int wave, int lane) {
    constexpr int QROW = 2 * K + 16, VROW = 272;
    constexpr int KOFF = 8704, DOFF = 18944, VOFF = 19456, BUFB = 28160, NMB = K / 16, NPC = 4 * K;
    const int n = lane & 15, q = lane >> 4, col = colbase + 16 * (wave < ncw ? wave : 0) + n;
    const bool cw = wave < ncw;
    const bool gla = h8 < 4; const int hh = h8 & 3;
    const int qcol0 = gla ? hh * 64 : 1536 + hh * 128, vcol0 = gla ? 512 + hh * 128 : 2560 + hh * 128, ocol = h8 * 128 + col;
    f32x4 S[NMB];
#pragma unroll
    for (int mb = 0; mb < NMB; ++mb)
#pragma unroll
        for (int i = 0; i < 4; ++i) S[mb][i] = (S0 && cw) ? S0[(size_t)(16 * mb + 4 * q + i) * 128 + col] : 0.f;
    const int nt1 = ntok - 1;
    const int pq = tid % NPC, prow_q = pq / (K / 8), pc8 = pq % (K / 8), prq = prow_q < nt1 ? prow_q : nt1;
    const int vrow = tid >> 4, vc8 = tid & 15, vr = vrow < nt1 ? vrow : nt1;
    const int dpi = tid % (K / 4);
    const bf16_t* gq = c.P + (size_t)(row0 + prq) * PLD + qcol0 + pc8 * 8;
    const bf16_t* gk = kdt0 + (size_t)prow_q * kdt_rstride + pc8 * 8;
    const float* gd = dch0 + dpi * 4;
    const bf16_t* gvp = c.P + (size_t)(row0 + vr) * PLD + vcol0 + vc8 * 8;
    struct Stage { u32x4 q, k, v; f32x4 d; };
    const int nch1 = nch - 1;
#define SEQ_LOAD(R, cc) do { const int c_ = (cc) < nch1 ? (cc) : nch1; const size_t ro_ = (size_t)c_ * 32; \
        R.q = *(const u32x4*)(gq + ro_ * PLD); R.k = *(const u32x4*)(gk + (size_t)c_ * kdt_cstep); R.d = *(const f32x4*)(gd + (size_t)c_ * dch_cstep); \
        R.v = *(const u32x4*)(gvp + ro_ * PLD); } while (0)
#define SEQ_STORE(R, buf) do { LAS unsigned char* B_ = lds + (buf) * BUFB; \
        *(LAS u32x4*)(B_ + prow_q * QROW + pc8 * 16) = R.q; *(LAS u32x4*)(B_ + KOFF + (pq >> 2) * 80 + (pq & 3) * 16) = R.k; *(LAS f32x4*)(B_ + DOFF + dpi * 16) = R.d; \
        *(LAS u32x4*)(B_ + VOFF + vrow * VROW + vc8 * 16) = R.v; } while (0)
#define SEQ_ITER(ci, buf, RST) do { \
        const LAS unsigned char* B = lds + (buf) * BUFB; \
        if (cw) { \
        f32x4 o[2] = {{0.f, 0.f, 0.f, 0.f}, {0.f, 0.f, 0.f, 0.f}}; \
        _Pragma("unroll") for (int js = 0; js < K / 32; ++js) { \
            u32x4 sb; sb.x = pk_bf16(S[2 * js][0], S[2 * js][1]); sb.y = pk_bf16(S[2 * js][2], S[2 * js][3]); sb.z = pk_bf16(S[2 * js + 1][0], S[2 * js + 1][1]); sb.w = pk_bf16(S[2 * js + 1][2], S[2 * js + 1][3]); \
            _Pragma("unroll") for (int mb2 = 0; mb2 < 2; ++mb2) { \
                const LAS unsigned char* qp = B + (16 * mb2 + n) * QROW + (32 * js + 4 * q) * 2; \
                const u32x2 lo = *(const LAS u32x2*)qp, hi = *(const LAS u32x2*)(qp + 32); \
                u32x4 qa; qa.x = lo.x; qa.y = lo.y; qa.z = hi.x; qa.w = hi.y; \
                o[mb2] = MFMA16(__builtin_bit_cast(bf16x8, qa), __builtin_bit_cast(bf16x8, sb), o[mb2]); } } \
        { unsigned short vs[8]; \
            _Pragma("unroll") for (int j = 0; j < 8; ++j) vs[j] = *(const LAS unsigned short*)(B + VOFF + (8 * q + j) * VROW + col * 2); \
            u32x4 vb; vb.x = vs[0] | ((unsigned)vs[1] << 16); vb.y = vs[2] | ((unsigned)vs[3] << 16); vb.z = vs[4] | ((unsigned)vs[5] << 16); vb.w = vs[6] | ((unsigned)vs[7] << 16); \
            _Pragma("unroll") for (int mb = 0; mb < NMB; ++mb) { \
                const u32x4 ka = *(const LAS u32x4*)(B + KOFF + (16 * mb + n) * 80 + q * 16); \
                const f32x4 dv = *(const LAS f32x4*)(B + DOFF + (16 * mb + 4 * q) * 4); \
                S[mb] = S[mb] * dv; \
                S[mb] = MFMA16(__builtin_bit_cast(bf16x8, ka), __builtin_bit_cast(bf16x8, vb), S[mb]); } } \
        bf16_t* ob = c.OX + (size_t)(row0 + 32 * (ci)) * 1024 + ocol; \
        _Pragma("unroll") for (int x = 0; x < 8; x += 2) { \
            const int t = 16 * (x >> 2) + 4 * q + (x & 3); const unsigned pv = pk_bf16(o[x >> 2][x & 3], o[x >> 2][(x & 3) + 1]); \
            bf16_t* d0 = t < ntok ? ob + (size_t)t * 1024 : c.DUMP + tid; bf16_t* d1 = t + 1 < ntok ? ob + (size_t)(t + 1) * 1024 : c.DUMP + tid; \
            *d0 = (bf16_t)(pv & 0xffffu); *d1 = (bf16_t)(pv >> 16); } \
        } \
        WG_BAR(); \
        SEQ_STORE(RST, buf); \
    } while (0)
    Stage R0, R1, R2, R3;
    SEQ_LOAD(R0, 0); SEQ_STORE(R0, 0);
    SEQ_LOAD(R1, 1); SEQ_LOAD(R2, 2); SEQ_LOAD(R3, 3); SEQ_LOAD(R0, 4);
    SEQ_STORE(R1, 1);
    WG_BAR();
    for (int ci = 0; ci < nch; ci += 4) {
        SEQ_LOAD(R1, ci + 5); SEQ_ITER(ci, 0, R2);
        if (ci + 1 >= nch) break;
        SEQ_LOAD(R2, ci + 6); SEQ_ITER(ci + 1, 1, R3);
        if (ci + 2 >= nch) break;
        SEQ_LOAD(R3, ci + 7); SEQ_ITER(ci + 2, 0, R0);
        if (ci + 3 >= nch) break;
        SEQ_LOAD(R0, ci + 8); SEQ_ITER(ci + 3, 1, R1);
    }
    if (cw) {
#pragma unroll
    for (int mb = 0; mb < NMB; ++mb)
#pragma unroll
        for (int i = 0; i < 4; ++i) Sout[(size_t)(16 * mb + 4 * q + i) * 128 + col] = S[mb][i];
    }
    WG_BAR();
#undef SEQ_LOAD
#undef SEQ_STORE
#undef SEQ_ITER
}
__device__ __forceinline__ void seq_dispatch(const Ptrs& c, LAS unsigned char* lds, int item, int tid, int wave, int lane) {
    int row0, nch, ntok, h8, colbase, ncw; const float* S0; float* Sout; const bf16_t* kdt0; int kst; size_t kcs, dcs; const float* dch0;
    if (item < 128) {
        const int bh = item >> 1, b = bh >> 3; h8 = bh & 7; const int hh = h8 & 3; row0 = b * 2048; nch = 64; ntok = 32; S0 = nullptr; colbase = (item & 1) * 64; ncw = 4;
        Sout = h8 < 4 ? c.out + OUT_SAP + (size_t)(b * 4 + hh) * 64 * 128 : c.out + OUT_SBP + (size_t)(b * 4 + hh) * 128 * 128;
        kdt0 = c.P + (size_t)row0 * PLD + (h8 < 4 ? 256 + hh * 64 : 2048 + hh * 128); kst = PLD; kcs = (size_t)32 * PLD;
        dch0 = c.DCH + (size_t)(b * 64 * 8 + h8) * 128; dcs = 8 * 128;
    } else {
        const int j = item - 128, b = j >> 3; h8 = j & 7; const int hh = h8 & 3; row0 = MP + b * 8; nch = 1; ntok = 8; colbase = 0; ncw = 8;
        S0 = h8 < 4 ? c.in[2] + (size_t)(b * 4 + hh) * 64 * 128 : c.in[3] + (size_t)(b * 4 + hh) * 128 * 128;
        Sout = h8 < 4 ? c.out + OUT_SAS + (size_t)(b * 4 + hh) * 64 * 128 : c.out + OUT_SBS + (size_t)(b * 4 + hh) * 128 * 128;
        kdt0 = c.KDTS + (size_t)j * 4096; kst = h8 < 4 ? 64 : 128; kcs = 0; dch0 = c.DCH + (size_t)(4096 + j) * 128; dcs = 0;
    }
    if (h8 < 4) seq_item<64>(c, lds, row0, nch, ntok, h8, colbase, ncw, S0, Sout, kdt0, kst, kcs, dch0, dcs, tid, wave, lane);
    else seq_item<128>(c, lds, row0, nch, ntok, h8, colbase, ncw, S0, Sout, kdt0, kst, kcs, dch0, dcs, tid, wave, lane);
}
__device__ __forceinline__ void p3b_finalize(const Ptrs& c, int G, int wave, int lane) {
    const int gw = blockIdx.x * NWAVES + wave, NGW = G * NWAVES, h8 = lane >> 3, cw = (lane & 7) * 16;
    const float* gp = (h8 < 4 ? c.in[9] : c.in[10]) + cw;
    f32x4 gn[4];
#pragma unroll
    for (int j = 0; j < 4; ++j) gn[j] = *(const f32x4*)(gp + 4 * j);
    const int gcol = (h8 < 4 ? 1024 + h8 * 128 : 3072 + (h8 - 4) * 128) + cw;
    for (int m = gw; m < M; m += NGW) {
        f32x4 o[4]; u32x4 x[2], g[2], oi[2];
#pragma unroll
        for (int j = 0; j < 2; ++j) { oi[j] = *(const u32x4*)(c.OI + (size_t)m * 1024 + lane * 16 + 8 * j); x[j] = *(const u32x4*)(c.OX + (size_t)m * 1024 + lane * 16 + 8 * j); g[j] = *(const u32x4*)(c.P + (size_t)m * PLD + gcol + 8 * j); }
        o[0][0] = bf_lo(oi[0].x); o[0][1] = bf_hi(oi[0].x); o[0][2] = bf_lo(oi[0].y); o[0][3] = bf_hi(oi[0].y); o[1][0] = bf_lo(oi[0].z); o[1][1] = bf_hi(oi[0].z); o[1][2] = bf_lo(oi[0].w); o[1][3] = bf_hi(oi[0].w);
        o[2][0] = bf_lo(oi[1].x); o[2][1] = bf_hi(oi[1].x); o[2][2] = bf_lo(oi[1].y); o[2][3] = bf_hi(oi[1].y); o[3][0] = bf_lo(oi[1].z); o[3][1] = bf_hi(oi[1].z); o[3][2] = bf_lo(oi[1].w); o[3][3] = bf_hi(oi[1].w);
        float ss = 0.f;
#pragma unroll
        for (int j = 0; j < 4; ++j) {
            const unsigned w0 = j < 2 ? (j == 0 ? x[0].x : x[0].z) : (j == 2 ? x[1].x : x[1].z), w1 = j < 2 ? (j == 0 ? x[0].y : x[0].w) : (j == 2 ? x[1].y : x[1].w);
            o[j][0] += bf_lo(w0); o[j][1] += bf_hi(w0); o[j][2] += bf_lo(w1); o[j][3] += bf_hi(w1);
            ss += (o[j][0] * o[j][0] + o[j][1] * o[j][1]) + (o[j][2] * o[j][2] + o[j][3] * o[j][3]);
        }
        ss += dpp_f<0xB1, 0xF>(ss); ss += dpp_f<0x4E, 0xF>(ss); ss += dpp_f<0x141, 0xF>(ss);
        const float rs = __builtin_amdgcn_rsqf(ss * (1.0f / 128.0f) + EPS);
        u32x4 w[2];
#pragma unroll
        for (int j = 0; j < 4; ++j) {
            const unsigned g0 = j < 2 ? (j == 0 ? g[0].x : g[0].z) : (j == 2 ? g[1].x : g[1].z), g1 = j < 2 ? (j == 0 ? g[0].y : g[0].w) : (j == 2 ? g[1].y : g[1].w);
            float gg[4] = {bf_lo(g0), bf_hi(g0), bf_lo(g1), bf_hi(g1)}, v[4];
#pragma unroll
            for (int e = 0; e < 4; ++e) v[e] = o[j][e] * rs * gn[j][e] * (gg[e] * __builtin_amdgcn_rcpf(1.0f + __expf(-gg[e])));
            const unsigned p0 = pk_bf16(v[0], v[1]), p1 = pk_bf16(v[2], v[3]);
            if (j == 0) { w[0].x = p0; w[0].y = p1; } else if (j == 1) { w[0].z = p0; w[0].w = p1; } else if (j == 2) { w[1].x = p0; w[1].y = p1; } else { w[1].z = p0; w[1].w = p1; }
        }
        *(u32x4*)(c.OF + (size_t)m * 1024 + lane * 16) = w[0]; *(u32x4*)(c.OF + (size_t)m * 1024 + lane * 16 + 8) = w[1];
    }
}
#define XB_TMO      128
#define XB_XCNT(j)  (256  + 64 * (j))
#define XB_XSUB(j)  (1280 + 64 * (j))
#define XB_XGEN(j)  (2304 + 64 * (j))
#define XB_TOP      3328
#define XB_TOPGEN   3392
#define XCD_BAR_WORDS 3456
#define XB_SPIN_CAP (1u << 18)

__device__ __forceinline__ unsigned xb_ld(unsigned* p)              { return __hip_atomic_load(p, __ATOMIC_RELAXED, __HIP_MEMORY_SCOPE_AGENT); }
__device__ __forceinline__ unsigned xb_add(unsigned* p, unsigned v) { return __hip_atomic_fetch_add(p, v, __ATOMIC_RELAXED, __HIP_MEMORY_SCOPE_AGENT); }
__device__ __forceinline__ unsigned xb_xcc_id() { return (unsigned)__builtin_amdgcn_s_getreg((3 << 11) | 20) & 0xFu; }
#define XB_SPIN(cond, bar) do { unsigned _sp = 0; while (cond) { __builtin_amdgcn_s_sleep(1); \
    if ((++_sp & 255u) == 0u) { if (xb_ld(&(bar)[XB_TMO])) break; if (_sp > XB_SPIN_CAP) { atomicAdd(&(bar)[XB_TMO], 1u); break; } } } } while (0)

struct XcdBarrier {
    unsigned* bar; unsigned x;
    volatile LAS unsigned* st;
};

__device__ __forceinline__ XcdBarrier xcd_barrier_post(unsigned* bar, volatile LAS unsigned* st) {
    XcdBarrier b; b.bar = bar; b.x = xb_xcc_id(); b.st = st;
    if (threadIdx.x == 0) (void)xb_add(&bar[XB_XCNT(b.x)], 1u);
    return b;
}
__device__ __forceinline__ void xcd_barrier_complete(unsigned* bar, unsigned x, unsigned& nloc, unsigned& nx) {
    const unsigned G = gridDim.x * gridDim.y * gridDim.z;
    unsigned sum, cnt, mine, sp = 0u;
    for (;;) {
        sum = 0u; cnt = 0u; mine = 0u;
#pragma unroll
        for (unsigned j = 0; j < 16; ++j) { const unsigned c = xb_ld(&bar[XB_XCNT(j)]); sum += c; cnt += (c > 0u) ? 1u : 0u; mine = (j == x) ? c : mine; }
        if (sum == G) break;
        __builtin_amdgcn_s_sleep(1);
        if ((++sp & 255u) == 0u) { if (xb_ld(&bar[XB_TMO])) break; if (sp > XB_SPIN_CAP) { atomicAdd(&bar[XB_TMO], 1u); break; } }
    }
    nloc = mine > 0u ? mine : 1u; nx = cnt > 0u ? cnt : 1u;
}

__device__ __forceinline__ void xcd_barrier(const XcdBarrier& b) {
    asm volatile("s_waitcnt vmcnt(0)" ::: "memory");
    __syncthreads();
    if (threadIdx.x == 0) {
        unsigned* bar = b.bar;
        __builtin_amdgcn_s_waitcnt(0);
        unsigned nloc = b.st[0], nx = b.st[1];
        if (nloc == 0u) { xcd_barrier_complete(bar, b.x, nloc, nx); b.st[0] = nloc; b.st[1] = nx; }
        const unsigned old = xb_add(&bar[XB_XSUB(b.x)], 1u);
        const unsigned gen = old / nloc;
        if (old + 1u == (gen + 1u) * nloc) {
            __builtin_amdgcn_fence(__ATOMIC_RELEASE, "agent");
            asm volatile("s_waitcnt vmcnt(0)" ::: "memory");
            const unsigned og = xb_add(&bar[XB_TOP], 1u);
            const unsigned tg = og / nx;
            if (og + 1u == (tg + 1u) * nx) xb_add(&bar[XB_TOPGEN], 1u);
            else XB_SPIN(xb_ld(&bar[XB_TOPGEN]) == tg, bar);
            __builtin_amdgcn_fence(__ATOMIC_ACQUIRE, "agent");
            xb_add(&bar[XB_XGEN(b.x)], 1u);
            asm volatile("s_waitcnt vmcnt(0)" ::: "memory");
        } else {
            XB_SPIN(xb_ld(&bar[XB_XGEN(b.x)]) == gen, bar);
            __builtin_amdgcn_fence(__ATOMIC_ACQUIRE, "agent");
            asm volatile("s_waitcnt vmcnt(0)" ::: "memory");
        }
    }
    __syncthreads();
}

struct Args { const float* in[17]; float* out; unsigned char* ws; int ph_lo, ph_hi, aux, pad; };
constexpr int NPHASE = 9;
__device__ __forceinline__ void fill_ptrs(Ptrs& c, const Args& args) {
#pragma unroll
    for (int i = 0; i < 17; ++i) c.in[i] = args.in[i];
    c.out = args.out;
    unsigned char* ws = args.ws;
    c.WinT = (bf16_t*)(ws + WS_WIN); c.WoT = (bf16_t*)(ws + WS_WO); c.W13T = (bf16_t*)(ws + WS_W13); c.W2T = (bf16_t*)(ws + WS_W2);
    c.XB = (bf16_t*)(ws + WS_XB); c.OF = (bf16_t*)(ws + WS_XB); c.P = (bf16_t*)(ws + WS_P); c.HID = (bf16_t*)(ws + WS_P); c.KDTS = (bf16_t*)(ws + WS_KDTS);
    c.X1B = (bf16_t*)(ws + WS_FB); c.FB = (float*)(ws + WS_FB);
    c.RSTD1 = (float*)(ws + WS_RSTD1); c.SSQ2 = (float*)(ws + WS_SSQ2); c.LRA = (float*)(ws + WS_LRA); c.DCH = (float*)(ws + WS_DCH); c.OY = args.out + OUT_Y; c.DUMP = (bf16_t*)(ws + 30 * MiB); c.OX = (bf16_t*)(ws + WS_FB); c.OI = (bf16_t*)(ws + WS_XB); c.PART = (float*)(ws + 208 * MiB); c.PART4 = (float*)(ws + WS_P);
}

__global__ void __launch_bounds__(NTHR, 2) hymba_fwd(Args args) {
    extern __shared__ __attribute__((aligned(16))) unsigned char lds_raw[];
    LAS unsigned char* lds = (LAS unsigned char*)lds_raw;
    const int tid = threadIdx.x, lane = tid & 63, wave = __builtin_amdgcn_readfirstlane(tid >> 6), G = gridDim.x;
    unsigned char* ws = args.ws;
    const int lo = args.ph_lo, hi = args.ph_hi;
    volatile LAS unsigned* xst = (volatile LAS unsigned*)(lds + 152064);
    if (tid == 0) { xst[0] = 0u; xst[1] = 0u; }
    __syncthreads();
    XcdBarrier xbar; xbar.bar = (unsigned*)(ws + WS_BAR); xbar.x = 0; xbar.st = xst;
    if (hi - lo > 1) xbar = xcd_barrier_post((unsigned*)(ws + WS_BAR), xst);
#define IN(k) (lo <= (k) && (k) < hi)
#define SEAM(k) do { if (IN(k) && IN((k) + 1)) { if (args.pad != 0) cg::this_grid().sync(); else xcd_barrier(xbar); } } while (0)
    if (IN(0)) { Ptrs c; fill_ptrs(c, args); p0_prologue(c, lds, G, wave, lane, G < 256); }
    SEAM(0);
    if (IN(1)) { Ptrs c; fill_ptrs(c, args);
        pg8::Gemm g{c.XB, c.WinT, M, NIN, D}; pg8::StaticOrder S; S.init(M, NIN, G, (int)blockIdx.x, D);
        pg8::EpiIn E{c.P, c.FB, c.LRA, c.RSTD1};
        pg8::gemm_phase<pg8::EpiIn, pg8::StaticOrder, true, true>(lds, g, S, E);
    }
    SEAM(1);
    if (IN(2)) { Ptrs c; fill_ptrs(c, args); p2_prepass(c, lds, G, tid, wave, lane, args.aux != 0); }
    SEAM(2);
    if (IN(3)) { Ptrs c; fill_ptrs(c, args);
        const int wg = blockIdx.x;
        if (G >= 256) {
            if (wg < 128) seq_dispatch(c, lds, wg, tid, wave, lane);
            else for (int j = wg - 128; j < 1024; j += G - 128) seq_dispatch(c, lds, 128 + j, tid, wave, lane);
        }
        else for (int it = wg; it < 128 + 1024; it += G) seq_dispatch(c, lds, it, tid, wave, lane);
    }
    SEAM(3);
    if (IN(4)) { Ptrs c; fill_ptrs(c, args); p3b_finalize(c, G, wave, lane); }
    SEAM(4);
    if (IN(5)) { Ptrs c; fill_ptrs(c, args);
        pg8::Gemm g{c.OF, c.WoT, M, D, D};
        { pg8::StaticOrder S; S.init(MP, D, G, (int)blockIdx.x, D); pg8::EpiRes1 E{c.in[0], c.in[1], c.OY, c.X1B, c.SSQ2};
          pg8::gemm_phase<pg8::EpiRes1, pg8::StaticOrder, true, true>(lds, g, S, E); }
        { pg8::TailOrder S{G, (int)blockIdx.x, 8, D / 64, MP / 256, 4, 16}; pg8::EpiPart E{c.PART4, MP, 1.f};
          pg8::gemm_phase<pg8::EpiPart, pg8::TailOrder, true, true>(lds, g, S, E); }
        if (hi - lo > 1) xcd_barrier(xbar);
        {
            const int gw = blockIdx.x * NWAVES + wave, NGW = G * NWAVES;
            for (int r = gw; r < MS; r += NGW) {
                const int m = MP + r; f32x4 v[4]; float ss = 0.f;
#pragma unroll
                for (int j = 0; j < 4; ++j) v[j] = *(const f32x4*)(c.in[1] + (size_t)r * D + 4 * lane + 256 * j);
#pragma unroll 1
                for (int ks = 0; ks < 8; ++ks)
#pragma unroll
                    for (int j = 0; j < 4; ++j) v[j] += *(const f32x4*)(c.PART4 + ((size_t)ks * 1024 + r) * 1024 + 4 * lane + 256 * j);
#pragma unroll
                for (int j = 0; j < 4; ++j) {
                    *(f32x4*)(c.OY + (size_t)m * D + 4 * lane + 256 * j) = v[j];
                    u32x2 w; w.x = pk_bf16(v[j][0], v[j][1]); w.y = pk_bf16(v[j][2], v[j][3]); *(u32x2*)(c.X1B + (size_t)m * D + 4 * lane + 256 * j) = w;
                    ss += (v[j][0] * v[j][0] + v[j][1] * v[j][1]) + (v[j][2] * v[j][2] + v[j][3] * v[j][3]);
                }
                ss = wave_sum(ss);
                if (lane < 16) c.SSQ2[(size_t)m * 16 + lane] = lane == 0 ? ss : 0.f;
            }
        }
    }
    SEAM(5);
    if (IN(6)) { Ptrs c; fill_ptrs(c, args);
        pg8::Gemm g{c.X1B, c.W13T, M, NUP, D}; pg8::StaticOrder S; S.init(M, NUP, G, (int)blockIdx.x, D);
        pg8::EpiSwiglu E{c.HID, c.SSQ2};
        pg8::gemm_phase<pg8::EpiSwiglu, pg8::StaticOrder, true, true>(lds, g, S, E);
    }
    SEAM(6);
    if (IN(7)) { Ptrs c; fill_ptrs(c, args);
        pg8::Gemm g{c.HID, c.W2T, M, D, FF};
        { pg8::StaticOrder S; S.init(MP, D, G, (int)blockIdx.x, FF); pg8::EpiRes2 E{c.OY, args.aux ? 0.f : 1.f};
          pg8::gemm_phase<pg8::EpiRes2, pg8::StaticOrder, true, true>(lds, g, S, E); }
        { pg8::TailOrder S{G, (int)blockIdx.x, 11, FF / 64, MP / 256, 4, 16}; pg8::EpiPart E{c.PART, MP, args.aux ? 0.f : 1.f};
          pg8::gemm_phase<pg8::EpiPart, pg8::TailOrder, true, true>(lds, g, S, E); }
    }
    SEAM(7);
    if (IN(8)) { Ptrs c; fill_ptrs(c, args);
        const int gw = blockIdx.x * NWAVES + wave, NGW = G * NWAVES;
        f32x4 gn[4];
#pragma unroll
        for (int j = 0; j < 4; ++j) gn[j] = *(const f32x4*)(c.in[16] + 4 * lane + 256 * j);
        f32x4 v[4], nv[4];
        { const int m0 = gw < M ? gw : M - 1;
#pragma unroll
          for (int j = 0; j < 4; ++j) v[j] = *(const f32x4*)(c.OY + (size_t)m0 * D + 4 * lane + 256 * j); }
#define ADD_PARTS(vv, mm) do { if ((mm) >= MP) { _Pragma("unroll 1") for (int ks = 0; ks < 11; ++ks) { _Pragma("unroll") for (int j = 0; j < 4; ++j) \
            vv[j] += *(const f32x4*)(c.PART + ((size_t)ks * 1024 + ((mm) - MP)) * 1024 + 4 * lane + 256 * j); } } } while (0)
        { const int m0 = gw < M ? gw : M - 1; ADD_PARTS(v, m0); }
        for (int m = gw; m < M; m += NGW) {
            float* yr = c.OY + (size_t)m * D; float s = 0.f;
            { const int mn = m + NGW < M ? m + NGW : m;
#pragma unroll
              for (int j = 0; j < 4; ++j) nv[j] = *(const f32x4*)(c.OY + (size_t)mn * D + 4 * lane + 256 * j);
              ADD_PARTS(nv, mn); }
#pragma unroll
            for (int j = 0; j < 4; ++j) s += (v[j][0] * v[j][0] + v[j][1] * v[j][1]) + (v[j][2] * v[j][2] + v[j][3] * v[j][3]);
            const float rs = __builtin_amdgcn_rsqf(wave_sum(s) * (1.0f / D) + EPS);
#pragma unroll
            for (int j = 0; j < 4; ++j) *(f32x4*)(yr + 4 * lane + 256 * j) = args.aux ? v[j] : v[j] * rs * gn[j];
#pragma unroll
            for (int j = 0; j < 4; ++j) v[j] = nv[j];
        }
    }
#undef IN
#undef SEAM
}

extern "C" void kernel_launch(void* const* d_in, const int* in_sizes, int n_in, void* d_out, int out_size, void* d_ws, size_t ws_size, hipStream_t stream) {
    static int grid = 0;
    if (grid == 0) {
        if (n_in != 17 || ws_size < WS_END) { fprintf(stderr, "kernel_launch: unexpected n_in %d / ws %zu\n", n_in, ws_size); grid = -1; return; }
        int dev = 0, cus = 0, per_cu = 0;
        (void)hipGetDevice(&dev); (void)hipDeviceGetAttribute(&cus, hipDeviceAttributeMultiprocessorCount, dev);
        if (hipFuncSetAttribute((const void*)hymba_fwd, hipFuncAttributeMaxDynamicSharedMemorySize, LDS_BYTES) != hipSuccess) { fprintf(stderr, "kernel_launch: hipFuncSetAttribute failed\n"); grid = -1; return; }
        if (hipOccupancyMaxActiveBlocksPerMultiprocessor(&per_cu, (const void*)hymba_fwd, NTHR, LDS_BYTES) != hipSuccess || per_cu < 1) { fprintf(stderr, "kernel_launch: occupancy query says %d\n", per_cu); per_cu = 1; }
        (void)hipGetLastError();
        grid = cus * per_cu;
        if (grid <= 0) grid = 256;
    }
    if (grid < 0) return;
    if (hipMemsetAsync((char*)d_ws + WS_BAR, 0, 16384, stream) != hipSuccess) { fprintf(stderr, "kernel_launch: memset failed\n"); return; }
    Args a{};
    for (int i = 0; i < 17; ++i) a.in[i] = (const float*)d_in[i];
    a.out = (float*)d_out; a.ws = (unsigned char*)d_ws;
    if (MK_N_LAUNCHES == 1) {
        a.ph_lo = 0; a.ph_hi = NPHASE;
        void* kargs[] = {&a};
        hipError_t e = hipLaunchCooperativeKernel((const void*)hymba_fwd, dim3(grid), dim3(NTHR), kargs, LDS_BYTES, stream);
        if (e != hipSuccess) fprintf(stderr, "kernel_launch: cooperative launch failed: %s (grid %d)\n", hipGetErrorString(e), grid);
    } else {
        for (int p = 0; p < NPHASE; ++p) { a.ph_lo = p; a.ph_hi = p + 1; const int nrep = ((REP_MASK >> p) & 1) ? 3 : 1;
            for (int rr = 0; rr < nrep; ++rr) { a.aux = ((p == 2 || p == 7 || p == 8) && rr + 1 < nrep) ? 1 : 0; hipLaunchKernelGGL(hymba_fwd, dim3(grid), dim3(NTHR), LDS_BYTES, stream, a); } }
    }
}
```

```cpp
#include <hip/hip_runtime.h>
#include <hip/hip_cooperative_groups.h>
#include <cstdio>
#include <cstdint>
namespace cg = cooperative_groups;
namespace pg8 {
#define PG8_LAS __attribute__((address_space(3)))
typedef unsigned short bf16_t;
typedef short bf16x8 __attribute__((ext_vector_type(8)));
typedef float f32x4 __attribute__((ext_vector_type(4)));
typedef unsigned u32x4 __attribute__((ext_vector_type(4)));
constexpr int BM = 256, BK = 64, HALF = 128, HTB = HALF * BK * 2  , STAGE_BYTES = 8 * HTB, NXCD = 8, WGM = 8;

__host__ __device__ __forceinline__ int lds_byte(int r, int c) { const int st = (r >> 4) * 2 + (c >> 5), rr = r & 15, cc = c & 31, ob = rr * 64 + cc * 2; return st * 1024 + (ob ^ (((ob >> 9) & 1) << 5)); }
__host__ __device__ __forceinline__ void stage_rc(int b, int& R, int& C) { const int st = b / 1024, sb = b % 1024, swz = sb ^ (((sb >> 9) & 1) << 5); R = (st >> 1) * 16 + swz / 64; C = (st & 1) * 32 + (swz % 64) / 2; }
__host__ __device__ __forceinline__ int perm32(int rho) { const int n = rho >> 4, i = rho & 15; return 8 * (i >> 2) + 4 * n + (i & 3); }

struct Unit { int pm, pn, k0, nk; };
struct Gemm { const bf16_t* A; const bf16_t* Bt; int M, N, K; };

struct StaticOrder {
    int nM, nN, nwg, G, c, nkt;
    __host__ __device__ void init(int M, int N, int G_, int c_, int K_) { nM = M / BM; nN = N / BM; nwg = nM * nN; G = G_; c = c_; nkt = K_ / BK; }
    __host__ __device__ bool next(int i, Unit& u) const { return at((long)i * G + c, u); }
    __host__ __device__ bool at(long L, Unit& u) const {
        if (L >= nwg) return false;
        int wgid = (int)L; { const int q = nwg / NXCD, r = nwg % NXCD, xcd = wgid % NXCD, off = wgid / NXCD; wgid = (xcd < r ? xcd * (q + 1) : r * (q + 1) + (xcd - r) * q) + off; }
        const int nig = WGM * nN, gid = wgid / nig, fm = gid * WGM, gsz = (nM - fm) < WGM ? (nM - fm) : WGM;
        u.pm = fm + ((wgid % nig) % gsz); u.pn = (wgid % nig) / gsz; u.k0 = 0; u.nk = nkt; return true;
    }
    __device__ __forceinline__ void a_ready(const Unit&) const {}
    __device__ __forceinline__ void done(const Unit&) const {}
};


struct TailOrder {
    int G, c, NS, nkt, pm0, nN, ntu;
    __host__ __device__ bool next(int i, Unit& u) const {
        const int id = i * G + c; if (id >= ntu * NS) return false;
        const int tu = id / NS, ks = id % NS; u.pm = pm0 + tu / nN; u.pn = tu % nN; u.nk = nkt / NS; u.k0 = ks * u.nk; return true;
    }
    __device__ __forceinline__ void a_ready(const Unit&) const {}
    __device__ __forceinline__ void done(const Unit&) const {}
};

__device__ __forceinline__ unsigned cvt_pk_bf16(float lo, float hi) { unsigned r; asm volatile("v_cvt_pk_bf16_f32 %0, %1, %2" : "=v"(r) : "v"(lo), "v"(hi)); return r; }
typedef float f32x2 __attribute__((ext_vector_type(2)));

template <class Epi, class Sched, bool ALIGN_EPI = false, bool SP2 = false>
__device__ __forceinline__ void gemm_phase(PG8_LAS unsigned char* lds, const Gemm g, const Sched& S, const Epi& E) {
    const int tid = threadIdx.x, wid = __builtin_amdgcn_readfirstlane(tid >> 6), lane = tid & 63, wr = wid >> 2, wc = wid & 3, fr = lane & 15, fq = lane >> 4;
    const int K = g.K, nt = K / BK;
    unsigned voffA[2], voffB[2];
#pragma unroll
    for (int i = 0; i < 2; ++i) { int R, C; stage_rc(tid * 16 + i * 8192, R, C); const int Rb = Epi::PERM ? ((R & ~31) + perm32(R & 31)) : R;
        voffA[i] = (unsigned)(R * K + C) * 2u; voffB[i] = (unsigned)(Rb * K + C) * 2u; }
    const size_t kstep = (size_t)(BK * 2);
    const size_t hstep = (size_t)HALF * K * 2;
    const size_t tstep = 2 * hstep;
    const unsigned ldsw = (unsigned)wid * 1024u;
    const int aoff = lds_byte(wr * 64 + fr, fq * 8), boff = lds_byte(wc * 32 + fr, fq * 8);
#define PG8_SA(b, h) (((b) * 2 + (h)) * HTB)
#define PG8_SB(b, h) ((4 + (b) * 2 + (h)) * HTB)
#define PG8_STAGE(bufoff, gbase, voff) do { _Pragma("unroll") for (int _i = 0; _i < 2; ++_i) \
        __builtin_amdgcn_global_load_lds((const unsigned*)((const char*)(gbase) + (voff)[_i]), (PG8_LAS unsigned*)(lds + (bufoff) + ldsw + _i * 8192), 16, 0, 0); } while (0)
#define PG8_LDA(dst, b, h) do { _Pragma("unroll") for (int m = 0; m < 4; ++m) _Pragma("unroll") for (int k = 0; k < 2; ++k) dst[m][k] = *(const PG8_LAS bf16x8*)(lds + PG8_SA(b, h) + aoff + m * 2048 + k * 1024); } while (0)
#define PG8_LDB(dst, b, h) do { _Pragma("unroll") for (int n = 0; n < 2; ++n) _Pragma("unroll") for (int k = 0; k < 2; ++k) dst[n][k] = *(const PG8_LAS bf16x8*)(lds + PG8_SB(b, h) + boff + n * 2048 + k * 1024); } while (0)
#define PG8_MMA(ai, bj, At, Bt) do { __builtin_amdgcn_s_setprio(1); _Pragma("unroll") for (int m = 0; m < 4; ++m) _Pragma("unroll") for (int n = 0; n < 2; ++n) _Pragma("unroll") for (int k = 0; k < 2; ++k) \
        acc[ai][bj][m][n] = __builtin_amdgcn_mfma_f32_16x16x32_bf16(Bt[n][k], At[m][k], acc[ai][bj][m][n], 0, 0, 0); __builtin_amdgcn_s_setprio(0); } while (0)
#define PG8_WAIT_V(n) asm volatile("s_waitcnt vmcnt(" #n ")" ::: "memory")
#define PG8_WAIT_L(n) asm volatile("s_waitcnt lgkmcnt(" #n ")" ::: "memory")
#define PG8_BAR __builtin_amdgcn_s_barrier()
#define PG8_SCHED __builtin_amdgcn_sched_barrier(0)
    Unit cur, nxt; int ui = 0;
    if (!S.next(0, cur)) return;
    f32x4 acc[2][2][4][2];
#pragma unroll
    for (int a = 0; a < 2; ++a)
#pragma unroll
        for (int b = 0; b < 2; ++b)
#pragma unroll
            for (int m = 0; m < 4; ++m)
#pragma unroll
                for (int n = 0; n < 2; ++n) acc[a][b][m][n] = (f32x4){0.f, 0.f, 0.f, 0.f};
    bf16x8 At[4][2], B0[2][2], B1[2][2];
    const char* cA = (const char*)g.A + (size_t)cur.pm * tstep + (size_t)cur.k0 * kstep; const char* cB = (const char*)g.Bt + (size_t)cur.pn * tstep + (size_t)cur.k0 * kstep;
    S.a_ready(cur);
    if constexpr (SP2) {
        PG8_STAGE(PG8_SB(0, 0), cB, voffB); PG8_STAGE(PG8_SB(0, 1), cB + hstep, voffB); PG8_STAGE(PG8_SA(0, 0), cA, voffA); PG8_STAGE(PG8_SA(0, 1), cA + hstep, voffA);
        if (wr == 1) PG8_BAR;
        PG8_WAIT_V(2); PG8_BAR;
        PG8_STAGE(PG8_SB(1, 0), cB + kstep, voffB); PG8_STAGE(PG8_SA(1, 0), cA + kstep, voffA); PG8_STAGE(PG8_SB(1, 1), cB + hstep + kstep, voffB);
        PG8_WAIT_V(6); PG8_BAR;
    } else {
        PG8_STAGE(PG8_SB(0, 0), cB, voffB); PG8_STAGE(PG8_SA(0, 0), cA, voffA); PG8_STAGE(PG8_SB(0, 1), cB + hstep, voffB); PG8_STAGE(PG8_SA(0, 1), cA + hstep, voffA);
        if (wr == 1) PG8_BAR;
        PG8_WAIT_V(4); PG8_BAR;
        PG8_STAGE(PG8_SB(1, 0), cB + kstep, voffB); PG8_STAGE(PG8_SA(1, 0), cA + kstep, voffA); PG8_STAGE(PG8_SB(1, 1), cB + hstep + kstep, voffB);
        PG8_WAIT_V(6); PG8_BAR;
    }
    for (;;) {
        const bool has_next = S.next(ui + 1, nxt);
        const char* nA = has_next ? (const char*)g.A + (size_t)nxt.pm * tstep + (size_t)nxt.k0 * kstep : cA; const char* nB = has_next ? (const char*)g.Bt + (size_t)nxt.pn * tstep + (size_t)nxt.k0 * kstep : cB;
        const int ntc = cur.nk;
        for (int t = 0; t < ntc; t += 2) {
            const bool last = (t == ntc - 2);
            const char* a1 = cA + (size_t)(t + 1) * kstep;
            const char* a2 = last ? nA : cA + (size_t)(t + 2) * kstep; const char* b2 = last ? nB : cB + (size_t)(t + 2) * kstep;
            const char* a3 = a2 + kstep; const char* b3 = b2 + kstep;
            if (last && has_next) S.a_ready(nxt);
            if constexpr (SP2) {
            PG8_LDB(B0, 0, 0); PG8_LDB(B1, 0, 1); PG8_SCHED; PG8_LDA(At, 0, 0); PG8_STAGE(PG8_SA(1, 1), a1 + hstep, voffA);
            PG8_WAIT_V(8); PG8_WAIT_L(0); PG8_BAR; PG8_MMA(0, 0, At, B0); PG8_MMA(0, 1, At, B1); PG8_BAR; PG8_SCHED;
            PG8_LDA(At, 0, 1); PG8_STAGE(PG8_SB(0, 0), b2, voffB); PG8_STAGE(PG8_SB(0, 1), b2 + hstep, voffB); PG8_STAGE(PG8_SA(0, 0), a2, voffA);
            PG8_WAIT_V(8); PG8_WAIT_L(0); PG8_BAR; PG8_MMA(1, 0, At, B0); PG8_MMA(1, 1, At, B1); PG8_BAR; PG8_SCHED;
            PG8_LDB(B0, 1, 0); PG8_LDB(B1, 1, 1); PG8_SCHED; PG8_LDA(At, 1, 0); PG8_STAGE(PG8_SA(0, 1), a2 + hstep, voffA);
            PG8_WAIT_V(8); PG8_WAIT_L(0); PG8_BAR; PG8_MMA(0, 0, At, B0); PG8_MMA(0, 1, At, B1); PG8_BAR; PG8_SCHED;
            PG8_LDA(At, 1, 1); PG8_STAGE(PG8_SB(1, 0), b3, voffB); PG8_STAGE(PG8_SB(1, 1), b3 + hstep, voffB); PG8_STAGE(PG8_SA(1, 0), a3, voffA);
            PG8_WAIT_V(8); PG8_WAIT_L(0); PG8_BAR; PG8_MMA(1, 0, At, B0); PG8_MMA(1, 1, At, B1); PG8_BAR; PG8_SCHED;
            } else {
            PG8_LDB(B0, 0, 0); PG8_SCHED; PG8_LDA(At, 0, 0); PG8_STAGE(PG8_SA(1, 1), a1 + hstep, voffA);
            PG8_WAIT_L(8); PG8_BAR; PG8_WAIT_L(0); PG8_MMA(0, 0, At, B0); PG8_BAR; PG8_SCHED;
            PG8_LDB(B1, 0, 1); PG8_STAGE(PG8_SB(0, 0), b2, voffB);
            PG8_BAR; PG8_WAIT_L(0); PG8_MMA(0, 1, At, B1); PG8_BAR;
            PG8_LDA(At, 0, 1); PG8_STAGE(PG8_SA(0, 0), a2, voffA);
            PG8_BAR; PG8_WAIT_L(0); PG8_MMA(1, 0, At, B0); PG8_BAR; PG8_SCHED;
            PG8_STAGE(PG8_SB(0, 1), b2 + hstep, voffB);
            PG8_WAIT_V(6); PG8_BAR; PG8_MMA(1, 1, At, B1); PG8_BAR;
            PG8_LDB(B0, 1, 0); PG8_SCHED; PG8_LDA(At, 1, 0); PG8_STAGE(PG8_SA(0, 1), a2 + hstep, voffA);
            PG8_WAIT_L(8); PG8_BAR; PG8_WAIT_L(0); PG8_MMA(0, 0, At, B0); PG8_BAR; PG8_SCHED;
            PG8_LDB(B1, 1, 1); PG8_STAGE(PG8_SB(1, 0), b3, voffB);
            PG8_BAR; PG8_WAIT_L(0); PG8_MMA(0, 1, At, B1); PG8_BAR;
            PG8_LDA(At, 1, 1); PG8_STAGE(PG8_SA(1, 0), a3, voffA);
            PG8_BAR; PG8_WAIT_L(0); PG8_MMA(1, 0, At, B0); PG8_BAR; PG8_SCHED;
            PG8_STAGE(PG8_SB(1, 1), b3 + hstep, voffB);
            PG8_WAIT_V(6); PG8_BAR; PG8_MMA(1, 1, At, B1); PG8_BAR;
            }
        }
        if constexpr (ALIGN_EPI) { if (wr == 0) PG8_BAR; }
        if constexpr (!Epi::AFTER_DRAIN) { E(acc, cur, wr, wc, fr, fq); S.done(cur); }
        if (!has_next) break;
#pragma unroll
        for (int a = 0; a < 2; ++a)
#pragma unroll
            for (int b = 0; b < 2; ++b)
#pragma unroll
                for (int m = 0; m < 4; ++m)
#pragma unroll
                    for (int n = 0; n < 2; ++n) acc[a][b][m][n] = (f32x4){0.f, 0.f, 0.f, 0.f};
        cur = nxt; cA = nA; cB = nB; ++ui;
        if constexpr (ALIGN_EPI) { if (wr == 1) PG8_BAR; }
    }
    PG8_WAIT_V(0);
    if constexpr (!ALIGN_EPI) { if (wr == 0) PG8_BAR; }
    PG8_BAR;
    if constexpr (Epi::AFTER_DRAIN) { E.fused(acc, cur, wr, wc, fr, fq, lds, wid, lane); S.done(cur); }
#undef PG8_SA
#undef PG8_SB
#undef PG8_STAGE
#undef PG8_LDA
#undef PG8_LDB
#undef PG8_MMA
#undef PG8_WAIT_V
#undef PG8_WAIT_L
#undef PG8_BAR
#undef PG8_SCHED
}
}

#ifndef MK_N_LAUNCHES
#define MK_N_LAUNCHES 1
#endif
#ifndef REP_MASK
#define REP_MASK 0
#endif
#define LAS __attribute__((address_space(3)))
using pg8::bf16_t; using pg8::bf16x8; using pg8::f32x4; using pg8::u32x4;
typedef float f32x16 __attribute__((ext_vector_type(16)));
typedef __bf16 bf16x2_t __attribute__((ext_vector_type(2)));
typedef float f32x2_t __attribute__((ext_vector_type(2)));
typedef unsigned u32x2 __attribute__((ext_vector_type(2)));

constexpr int NWAVES = 8, NTHR = 512;
constexpr int D = 1024, MP = 16384, MS = 1024, M = MP + MS, NIN = 3840, PLD = 3584, FF = 2816, NUP = 2 * FF;
constexpr float EPS = 1e-6f;
constexpr size_t MiB = 1u << 20;
constexpr size_t WS_BAR = 26 * MiB + 768 * 1024, WS_WIN = 0, WS_WO = 8 * MiB, WS_W13 = 10 * MiB, WS_W2 = 21 * MiB, WS_RSTD1 = 27 * MiB, WS_SSQ2 = 28 * MiB, WS_LRA = 32 * MiB, WS_DCH = 34 * MiB,
                 WS_KDTS = 37 * MiB, WS_XB = 45 * MiB, WS_FB = 79 * MiB, WS_P = 113 * MiB, WS_END = 233 * MiB;
static_assert(WS_P + (size_t)(M + 32) * PLD * 2 <= WS_END && WS_XB + (size_t)M * D * 2 <= WS_FB && WS_FB + (size_t)M * 512 * 4 <= WS_P, "ws map");
constexpr size_t OUT_Y = 0, OUT_SAP = 17825792, OUT_SBP = 18087936, OUT_SAS = 18612224, OUT_SBS = 22806528;
constexpr int LDS_BYTES = 152576;

__device__ __forceinline__ unsigned pk_bf16(float lo, float hi) { f32x2_t v = {lo, hi}; bf16x2_t b = __builtin_convertvector(v, bf16x2_t); return __builtin_bit_cast(unsigned, b); }
__device__ __forceinline__ float bf_lo(unsigned u) { return __uint_as_float(u << 16); }
__device__ __forceinline__ float bf_hi(unsigned u) { return __uint_as_float(u & 0xffff0000u); }
__device__ __forceinline__ float bf_f(unsigned short u) { return __uint_as_float(((unsigned)u) << 16); }


template <int CTRL, int ROWMASK> __device__ __forceinline__ float dpp_f(float v) { return __builtin_bit_cast(float, __builtin_amdgcn_update_dpp(0, __builtin_bit_cast(int, v), CTRL, ROWMASK, 0xF, true)); }
__device__ __forceinline__ float row16_sum(float v) { v += dpp_f<0xB1, 0xF>(v); v += dpp_f<0x4E, 0xF>(v); v += dpp_f<0x141, 0xF>(v); v += dpp_f<0x140, 0xF>(v); return v; }
__device__ __forceinline__ float scan32(float a) {
    a += dpp_f<0x111, 0xF>(a); a += dpp_f<0x112, 0xF>(a); a += dpp_f<0x114, 0xF>(a); a += dpp_f<0x118, 0xF>(a); a += dpp_f<0x142, 0xA>(a); return a; }
template <int CTRL, int ROWMASK> __device__ __forceinline__ float dpp_f1(float v) { return __builtin_bit_cast(float, __builtin_amdgcn_update_dpp(0x3f800000, __builtin_bit_cast(int, v), CTRL, ROWMASK, 0xF, false)); }
__device__ __forceinline__ float scanmul32(float a) {
    a *= dpp_f1<0x111, 0xF>(a); a *= dpp_f1<0x112, 0xF>(a); a *= dpp_f1<0x114, 0xF>(a); a *= dpp_f1<0x118, 0xF>(a); a *= dpp_f1<0x142, 0xA>(a); return a; }
__device__ __forceinline__ float lane_bcast(float v, int l);
__device__ __forceinline__ float wave_sum(float v) { v = row16_sum(v); return (lane_bcast(v, 0) + lane_bcast(v, 16)) + (lane_bcast(v, 32) + lane_bcast(v, 48)); }
__device__ __forceinline__ float lane_bcast(float v, int l) { return __builtin_bit_cast(float, __builtin_amdgcn_readlane(__builtin_bit_cast(int, v), l)); }
#define LDS_WAIT() asm volatile("s_waitcnt lgkmcnt(0)" ::: "memory")
#define WG_BAR() do { asm volatile("s_waitcnt lgkmcnt(0)" ::: "memory"); __builtin_amdgcn_s_barrier(); asm volatile("" ::: "memory"); } while (0)
#define MFMA32(a, b, c) __builtin_amdgcn_mfma_f32_32x32x16_bf16((a), (b), (c), 0, 0, 0)
#define MFMA16(a, b, c) __builtin_amdgcn_mfma_f32_16x16x32_bf16((a), (b), (c), 0, 0, 0)

struct Ptrs {
    const float* in[17]; float* out;
    bf16_t *WinT, *WoT, *W13T, *W2T, *XB, *P, *KDTS, *OF, *X1B, *HID;
    float *RSTD1, *SSQ2, *LRA, *DCH, *FB, *OY; bf16_t *DUMP, *OX, *OI; float *PART, *PART4, *SSQ3;
};

namespace pg8 {
struct EpiIn {
    static constexpr bool PERM = true, AFTER_DRAIN = false;
    bf16_t* P; float* FB; float* LRA; const float* rstd;
    __device__ __forceinline__ void operator()(const f32x4 (&acc)[2][2][4][2], const Unit& u, int wr, int wc, int fr, int fq) const {
        const int row0 = u.pm * BM + wr * 64 + fr, ct = wc * 32 + 8 * fq;
#pragma unroll
        for (int ai = 0; ai < 2; ++ai)
#pragma unroll
            for (int m = 0; m < 4; ++m) {
                const int row = row0 + ai * HALF + m * 16; const float rs = rstd[row];
#pragma unroll
                for (int bj = 0; bj < 2; ++bj) {
                    const f32x4 v0 = acc[ai][bj][m][0] * rs, v1 = acc[ai][bj][m][1] * rs; const int cl = bj * HALF + ct;
                    if (u.pn == 8 || u.pn == 9) { float* o = FB + (size_t)row * 512 + (u.pn - 8) * BM + cl; *(f32x4*)o = v0; *(f32x4*)(o + 4) = v1; }
                    else if (u.pn == 14) { if (cl < 16) { float* o = LRA + (size_t)row * 16 + cl; *(f32x4*)o = v0; *(f32x4*)(o + 4) = v1; } }
                    else { u32x4 w; w.x = cvt_pk_bf16(v0[0], v0[1]); w.y = cvt_pk_bf16(v0[2], v0[3]); w.z = cvt_pk_bf16(v1[0], v1[1]); w.w = cvt_pk_bf16(v1[2], v1[3]);
                           *(u32x4*)(P + (size_t)row * 3584 + u.pn * BM + cl) = w; }
                }
            }
    }
};
struct EpiRes1 {
    static constexpr bool PERM = true, AFTER_DRAIN = false;
    const float* xp; const float* xs; float* Y; bf16_t* X1B; float* SSQ;
    __device__ __forceinline__ void operator()(const f32x4 (&acc)[2][2][4][2], const Unit& u, int wr, int wc, int fr, int fq) const {
        const int row0 = u.pm * BM + wr * 64 + fr, ct = u.pn * BM + wc * 32 + 8 * fq;
#pragma unroll
        for (int ai = 0; ai < 2; ++ai)
#pragma unroll
            for (int m = 0; m < 4; ++m) {
                const int row = row0 + ai * HALF + m * 16;
                const float* xr = row < 16384 ? xp + (size_t)row * 1024 : xs + (size_t)(row - 16384) * 1024;
                float ss = 0.f;
#pragma unroll
                for (int bj = 0; bj < 2; ++bj) {
                    const int col = ct + bj * HALF;
                    const f32x4 v0 = acc[ai][bj][m][0] + *(const f32x4*)(xr + col), v1 = acc[ai][bj][m][1] + *(const f32x4*)(xr + col + 4);
                    *(f32x4*)(Y + (size_t)row * 1024 + col) = v0; *(f32x4*)(Y + (size_t)row * 1024 + col + 4) = v1;
                    u32x4 w; w.x = cvt_pk_bf16(v0[0], v0[1]); w.y = cvt_pk_bf16(v0[2], v0[3]); w.z = cvt_pk_bf16(v1[0], v1[1]); w.w = cvt_pk_bf16(v1[2], v1[3]);
                    *(u32x4*)(X1B + (size_t)row * 1024 + col) = w;
                    ss += (v0[0] * v0[0] + v0[1] * v0[1]) + (v0[2] * v0[2] + v0[3] * v0[3]) + (v1[0] * v1[0] + v1[1] * v1[1]) + (v1[2] * v1[2] + v1[3] * v1[3]);
                }
                ss += __shfl_xor(ss, 16); ss += __shfl_xor(ss, 32);
                if (fq == 0) SSQ[(size_t)row * 16 + u.pn * 4 + wc] = ss;
            }
    }
};
struct EpiSwiglu {
    static constexpr bool PERM = true, AFTER_DRAIN = false;
    bf16_t* H; const float* SSQ;
    __device__ __forceinline__ void operator()(const f32x4 (&acc)[2][2][4][2], const Unit& u, int wr, int wc, int fr, int fq) const {
        const int row0 = u.pm * BM + wr * 64 + fr, hc = u.pn * 128 + wc * 16 + fq * 4;
#pragma unroll
        for (int ai = 0; ai < 2; ++ai)
#pragma unroll
            for (int m = 0; m < 4; ++m) {
                const int row = row0 + ai * HALF + m * 16;
                const f32x4* sp = (const f32x4*)(SSQ + (size_t)row * 16);
                const f32x4 s0 = sp[0], s1 = sp[1], s2 = sp[2], s3 = sp[3];
                const float tot = ((s0[0] + s0[1]) + (s0[2] + s0[3])) + ((s1[0] + s1[1]) + (s1[2] + s1[3])) + ((s2[0] + s2[1]) + (s2[2] + s2[3])) + ((s3[0] + s3[1]) + (s3[2] + s3[3]));
                const float rs = __builtin_amdgcn_rsqf(tot * (1.0f / 1024.0f) + 1e-6f);
#pragma unroll
                for (int bj = 0; bj < 2; ++bj) {
                    const f32x4 a = acc[ai][bj][m][0] * rs, b = acc[ai][bj][m][1] * rs; float h[4];
#pragma unroll
                    for (int e = 0; e < 4; ++e) h[e] = a[e] * __builtin_amdgcn_rcpf(1.0f + __expf(-a[e])) * b[e];
                    unsigned lo = cvt_pk_bf16(h[0], h[1]), hi = cvt_pk_bf16(h[2], h[3]);
                    *(unsigned long long*)(H + (size_t)row * 2816 + hc + bj * 64) = (unsigned long long)lo | ((unsigned long long)hi << 32);
                }
            }
    }
};
struct EpiRes2 {
    static constexpr bool PERM = true, AFTER_DRAIN = false;
    float* Y; float sc;
    __device__ __forceinline__ void operator()(const f32x4 (&acc)[2][2][4][2], const Unit& u, int wr, int wc, int fr, int fq) const {
        const int row0 = u.pm * BM + wr * 64 + fr, ct = u.pn * BM + wc * 32 + 8 * fq;
#pragma unroll
        for (int ai = 0; ai < 2; ++ai)
#pragma unroll
            for (int m = 0; m < 4; ++m) {
                float* yr = Y + (size_t)(row0 + ai * HALF + m * 16) * 1024;
#pragma unroll
                for (int bj = 0; bj < 2; ++bj) {
                    const int col = ct + bj * HALF;
                    const f32x4 v0 = acc[ai][bj][m][0] * sc + *(const f32x4*)(yr + col), v1 = acc[ai][bj][m][1] * sc + *(const f32x4*)(yr + col + 4);
                    *(f32x4*)(yr + col) = v0; *(f32x4*)(yr + col + 4) = v1;
                }
            }
    }
};
struct EpiPart {
    static constexpr bool PERM = true, AFTER_DRAIN = false;
    float* PART; int rowbase; float sc;
    __device__ __forceinline__ void operator()(const f32x4 (&acc)[2][2][4][2], const Unit& u, int wr, int wc, int fr, int fq) const {
        const int row0 = u.pm * BM + wr * 64 + fr - rowbase, ct = u.pn * BM + wc * 32 + 8 * fq;
        float* base = PART + (size_t)(u.k0 / u.nk) * 1024 * 1024;
#pragma unroll
        for (int ai = 0; ai < 2; ++ai)
#pragma unroll
            for (int m = 0; m < 4; ++m) {
                float* yr = base + (size_t)(row0 + ai * HALF + m * 16) * 1024;
#pragma unroll
                for (int bj = 0; bj < 2; ++bj) { const int col = ct + bj * HALF; *(f32x4*)(yr + col) = acc[ai][bj][m][0] * sc; *(f32x4*)(yr + col + 4) = acc[ai][bj][m][1] * sc; }
            }
    }
};
}

__device__ __forceinline__ void tr_item(const float* colp, int ldw, const float* gain, int k0, int dcol, bf16_t* WT, int K, int nrow0, LAS float* scr, int lane) {
#pragma unroll 8
    for (int i = 0; i < 32; ++i) {
        const int kk = 2 * i + (lane >> 5); float v = 0.f;
        if (colp) { v = colp[(size_t)(k0 + kk) * ldw]; if (gain) v *= gain[k0 + kk]; }
        scr[kk * 33 + dcol] = v;
    }
    LDS_WAIT();
    const int c = lane & 7;
#pragma unroll
    for (int j = 0; j < 4; ++j) {
        const int n = (lane >> 3) + 8 * j; const LAS float* s = scr + (8 * c) * 33 + n;
        u32x4 o; o.x = pk_bf16(s[0 * 33], s[1 * 33]); o.y = pk_bf16(s[2 * 33], s[3 * 33]); o.z = pk_bf16(s[4 * 33], s[5 * 33]); o.w = pk_bf16(s[6 * 33], s[7 * 33]);
        *(u32x4*)(WT + (size_t)(nrow0 + n) * K + k0 + 8 * c) = o;
    }
    LDS_WAIT();
}
__device__ __forceinline__ void weight_items(const Ptrs& c, LAS float* scr, int part, int gw, int NGW, int lane) {
    const int l31 = lane & 31;
    constexpr int I_IN = 16 * 120, I_O = 16 * 32, I_13 = 16 * 176, I_2 = 44 * 32;
    if (part == 0) {
        for (int r = gw; r < I_IN; r += NGW) { const int kb = r / 120, nb = r % 120, n = nb * 32 + l31;
            const int oc = n < 1536 ? n : (n < 3584 ? n + 16 : (n < 3600 ? n - 3584 + 1536 : -1));
            tr_item(oc >= 0 ? c.in[5] + oc : nullptr, 3600, c.in[4], kb * 64, l31, c.WinT, 1024, nb * 32, scr, lane); }
        return;
    }
    for (int it = gw; it < I_O + I_13 + I_2; it += NGW) {
        int r = it;
        if (r < I_O) { const int kb = r / 32, nb = r % 32; tr_item(c.in[11] + nb * 32 + l31, 1024, nullptr, kb * 64, l31, c.WoT, 1024, nb * 32, scr, lane); continue; }
        r -= I_O;
        if (r < I_13) { const int kb = r / 176, nb = r % 176; const bool is3 = l31 >= 16; const int hcol = nb * 16 + (l31 & 15);
            tr_item((is3 ? c.in[14] : c.in[13]) + hcol, 2816, c.in[12], kb * 64, ((l31 & 15) >> 2) * 8 + (is3 ? 4 : 0) + (l31 & 3), c.W13T, 1024, nb * 32, scr, lane); continue; }
        r -= I_13;
        { const int kb = r / 32, nb = r % 32; tr_item(c.in[15] + nb * 32 + l31, 1024, nullptr, kb * 64, l31, c.W2T, 2816, nb * 32, scr, lane); }
    }
}
__device__ __forceinline__ void p0_prologue(const Ptrs& c, LAS unsigned char* lds, int G, int wave, int lane, bool all_weights) {
    LAS float* scr = (LAS float*)(lds + wave * 16384);
    const int gw = blockIdx.x * NWAVES + wave, NGW = G * NWAVES;
    weight_items(c, scr, 0, gw, NGW, lane);
    if (all_weights) weight_items(c, scr, 1, gw, NGW, lane);
    {
        f32x4 v[4], nv[4];
        { const int m0 = gw < M ? gw : M - 1; const float* xr = m0 < MP ? c.in[0] + (size_t)m0 * D : c.in[1] + (size_t)(m0 - MP) * D;
#pragma unroll
          for (int j = 0; j < 4; ++j) v[j] = *(const f32x4*)(xr + 4 * lane + 256 * j); }
        for (int m = gw; m < M; m += NGW) {
            { const int mn = m + NGW < M ? m + NGW : m; const float* xr = mn < MP ? c.in[0] + (size_t)mn * D : c.in[1] + (size_t)(mn - MP) * D;
#pragma unroll
              for (int j = 0; j < 4; ++j) nv[j] = *(const f32x4*)(xr + 4 * lane + 256 * j); }
            float s = 0.f;
#pragma unroll
            for (int j = 0; j < 4; ++j) s += (v[j][0] * v[j][0] + v[j][1] * v[j][1]) + (v[j][2] * v[j][2] + v[j][3] * v[j][3]);
            s = wave_sum(s);
#pragma unroll
            for (int j = 0; j < 4; ++j) { u32x2 w; w.x = pk_bf16(v[j][0], v[j][1]); w.y = pk_bf16(v[j][2], v[j][3]); *(u32x2*)(c.XB + (size_t)m * D + 4 * lane + 256 * j) = w; }
            if (lane == 0) c.RSTD1[m] = 1.0f / sqrtf(s * (1.0f / D) + EPS);
#pragma unroll
            for (int j = 0; j < 4; ++j) v[j] = nv[j];
        }
    }
}

__device__ __forceinline__ int crow(int i, int h) { return (i & 3) + 8 * (i >> 2) + 4 * h; }
template <int K, bool GLA, bool ALLV>
__device__ __forceinline__ void pre_item(const Ptrs& c, int row0, int ntok, int hh, int item, bf16_t* kdt_base, int kdt_stride,
                                         const LAS float* wa2_l, const LAS float* ba_l, const LAS float* lb_l, LAS unsigned char* vt, int lane, bool dry) {
    const int r = lane & 31, kg = lane >> 5;
    const bool valid = ALLV || r < ntok;
    const int row = row0 + (valid ? r : 0), nt1 = ntok - 1;
    constexpr int NJ = K / 16;
    const int qcol0 = GLA ? hh * 64 : 1536 + hh * 128, kcol0 = 256 + hh * 64, vcol0 = GLA ? 512 + hh * 128 : 2560 + hh * 128, ocol0 = (GLA ? hh : 4 + hh) * 128;
    bf16_t* Prow = c.P + (size_t)row * PLD;
    LAS unsigned char* kt = vt + 8192;
    float lra[16];
    {
        u32x4 vreg[8];
#pragma unroll
        for (int i = 0; i < 8; ++i) { const int p = lane + 64 * i, vr = (p >> 4) < nt1 ? (p >> 4) : nt1; vreg[i] = *(const u32x4*)(c.P + (size_t)(row0 + vr) * PLD + vcol0 + (p & 15) * 8); }
        if constexpr (GLA) {
#pragma unroll
            for (int i = 0; i < 4; ++i) { const f32x4 t = *(const f32x4*)(c.LRA + (size_t)row * 16 + 4 * i); lra[4 * i] = t[0]; lra[4 * i + 1] = t[1]; lra[4 * i + 2] = t[2]; lra[4 * i + 3] = t[3]; }
        }
#pragma unroll
        for (int i = 0; i < 8; ++i) { const int p = lane + 64 * i; *(LAS u32x4*)(vt + (p >> 4) * 256 + (p & 15) * 16) = vreg[i]; }
    }
    const bf16_t* qptr = Prow + qcol0 + 8 * kg;
    const bf16_t* kptr = Prow + kcol0 + 8 * kg;
    const float* fptr = c.FB + (size_t)row * 512 + hh * 128 + 8 * kg;
    u32x4 qn = *(const u32x4*)qptr, kn = {0u, 0u, 0u, 0u}; f32x4 fn0 = {0.f, 0.f, 0.f, 0.f}, fn1 = fn0;
    if constexpr (GLA) kn = *(const u32x4*)kptr; else { fn0 = *(const f32x4*)fptr; fn1 = *(const f32x4*)(fptr + 4); }
    f32x16 att;
#pragma unroll
    for (int i = 0; i < 16; ++i) att[i] = 0.f;
    float* dch = c.DCH + (size_t)item * 128;
#pragma unroll 1
    for (int j = 0; j < NJ; ++j) {
        const int cl = 16 * j + 8 * kg;
        const u32x4 qr = qn, kr = kn; const f32x4 f0 = fn0, f1 = fn1;
        { const int jn = j + 1 < NJ ? j + 1 : j;
          qn = *(const u32x4*)(qptr + 16 * jn);
          if constexpr (GLA) kn = *(const u32x4*)(kptr + 16 * jn); else { fn0 = *(const f32x4*)(fptr + 16 * jn); fn1 = *(const f32x4*)(fptr + 16 * jn + 4); } }
        float la[8], kv[8], qv[8];
        if constexpr (GLA) {
            const LAS float* wl = wa2_l + hh * 64 + cl;
            f32x4 a0 = *(const LAS f32x4*)(ba_l + hh * 64 + cl), a1 = *(const LAS f32x4*)(ba_l + hh * 64 + cl + 4);
#pragma unroll
            for (int rr = 0; rr < 16; ++rr) { const f32x4 w0 = *(const LAS f32x4*)(wl + rr * 256), w1 = *(const LAS f32x4*)(wl + rr * 256 + 4); a0 += w0 * lra[rr]; a1 += w1 * lra[rr]; }
#pragma unroll
            for (int e = 0; e < 8; ++e) { const float x = e < 4 ? a0[e & 3] : a1[e & 3]; la[e] = (fminf(x, 0.f) - __logf(1.0f + __expf(-fabsf(x)))) * 0.0625f; }
            kv[0] = bf_lo(kr.x); kv[1] = bf_hi(kr.x); kv[2] = bf_lo(kr.y); kv[3] = bf_hi(kr.y); kv[4] = bf_lo(kr.z); kv[5] = bf_hi(kr.z); kv[6] = bf_lo(kr.w); kv[7] = bf_hi(kr.w);
        } else {
            const f32x4 l0 = *(const LAS f32x4*)(lb_l + hh * 128 + cl), l1 = *(const LAS f32x4*)(lb_l + hh * 128 + cl + 4);
#pragma unroll
            for (int e = 0; e < 8; ++e) {
                const float x = e < 4 ? f0[e & 3] : f1[e & 3], lb = e < 4 ? l0[e & 3] : l1[e & 3];
                const float ex = __expf(-fabsf(x)), inv = __builtin_amdgcn_rcpf(1.0f + ex);
                const float sg = x >= 0.f ? inv : ex * inv, ng = x >= 0.f ? ex * inv : inv;
                la[e] = lb + (1.0f - lb) * sg; kv[e] = (1.0f - lb) * ng;
            }
        }
        qv[0] = bf_lo(qr.x); qv[1] = bf_hi(qr.x); qv[2] = bf_lo(qr.y); qv[3] = bf_hi(qr.y); qv[4] = bf_lo(qr.z); qv[5] = bf_hi(qr.z); qv[6] = bf_lo(qr.w); qv[7] = bf_hi(qr.w);
        float qi[8], ki[8], kd[8], eb[8];
#pragma unroll
        for (int e = 0; e < 8; ++e) {
            float q = GLA ? qv[e] * 0.125f : qv[e] * __builtin_amdgcn_rcpf(1.0f + __expf(-qv[e]));
            float k = kv[e], a = la[e];
            if (!ALLV) { if (!valid) { q = 0.f; k = 0.f; a = GLA ? 0.f : 1.f; } }
            float ea;
            if constexpr (GLA) { a = fmaxf(scan32(a), -80.f); ea = __expf(a); } else ea = fmaxf(scanmul32(a), 1e-35f);
            const float ia = __builtin_amdgcn_rcpf(ea);
            const float e31 = lane_bcast(ea, 31), e63 = lane_bcast(ea, 63);
            eb[e] = kg ? e63 : e31;
            qi[e] = q * ea; ki[e] = k * ia; kd[e] = ki[e] * eb[e];
        }
        u32x4 qp, kp;
        qp.x = pk_bf16(qi[0], qi[1]); qp.y = pk_bf16(qi[2], qi[3]); qp.z = pk_bf16(qi[4], qi[5]); qp.w = pk_bf16(qi[6], qi[7]);
        kp.x = pk_bf16(ki[0], ki[1]); kp.y = pk_bf16(ki[2], ki[3]); kp.z = pk_bf16(ki[4], ki[5]); kp.w = pk_bf16(ki[6], ki[7]);
        att = MFMA32(__builtin_bit_cast(bf16x8, kp), __builtin_bit_cast(bf16x8, qp), att);
        if (valid) *(u32x4*)(Prow + qcol0 + cl) = dry ? qr : qp;
#pragma unroll
        for (int e = 0; e < 8; e += 2) {
            const unsigned pkd = pk_bf16(kd[e], kd[e + 1]);
            *(LAS unsigned short*)(kt + (cl + e) * 64 + r * 2) = (unsigned short)(pkd & 0xffffu);
            *(LAS unsigned short*)(kt + (cl + e + 1) * 64 + r * 2) = (unsigned short)(pkd >> 16);
        }
        if (r == 0) { f32x4 d0 = {eb[0], eb[1], eb[2], eb[3]}, d1 = {eb[4], eb[5], eb[6], eb[7]}; *(f32x4*)(dch + cl) = d0; *(f32x4*)(dch + cl + 4) = d1; }
    }
#pragma unroll
    for (int i = 0; i < K / 16; ++i) {
        const int p = lane + 64 * i, L = p * 8;
        *(u32x4*)(kdt_base + (size_t)(L / K) * kdt_stride + (L % K)) = *(const LAS u32x4*)(kt + p * 16);
    }
#pragma unroll
    for (int i = 0; i < 16; ++i) if (crow(i, kg) > r) att[i] = 0.f;
    u32x4 pa0, pa1;
    pa0.x = pk_bf16(att[0], att[1]); pa0.y = pk_bf16(att[2], att[3]); pa0.z = pk_bf16(att[4], att[5]); pa0.w = pk_bf16(att[6], att[7]);
    pa1.x = pk_bf16(att[8], att[9]); pa1.y = pk_bf16(att[10], att[11]); pa1.z = pk_bf16(att[12], att[13]); pa1.w = pk_bf16(att[14], att[15]);
#pragma unroll 1
    for (int vb = 0; vb < 4; ++vb) {
        unsigned short vs[16];
#pragma unroll
        for (int i = 0; i < 16; ++i) vs[i] = *(const LAS unsigned short*)(vt + crow(i, kg) * 256 + (vb * 32 + r) * 2);
        u32x4 b0, b1;
        b0.x = vs[0] | ((unsigned)vs[1] << 16); b0.y = vs[2] | ((unsigned)vs[3] << 16); b0.z = vs[4] | ((unsigned)vs[5] << 16); b0.w = vs[6] | ((unsigned)vs[7] << 16);
        b1.x = vs[8] | ((unsigned)vs[9] << 16); b1.y = vs[10] | ((unsigned)vs[11] << 16); b1.z = vs[12] | ((unsigned)vs[13] << 16); b1.w = vs[14] | ((unsigned)vs[15] << 16);
        f32x16 o;
#pragma unroll
        for (int i = 0; i < 16; ++i) o[i] = 0.f;
        o = MFMA32(__builtin_bit_cast(bf16x8, pa0), __builtin_bit_cast(bf16x8, b0), o);
        o = MFMA32(__builtin_bit_cast(bf16x8, pa1), __builtin_bit_cast(bf16x8, b1), o);
#pragma unroll
        for (int i = 0; i < 16; ++i) *(LAS unsigned short*)(kt + crow(i, kg) * 256 + (vb * 32 + r) * 2) = (unsigned short)(pk_bf16(o[i], 0.f) & 0xffffu);
    }
#pragma unroll
    for (int i = 0; i < 8; ++i) {
        const int p = lane + 64 * i, t = p >> 4;
        if (t < ntok) *(u32x4*)(c.OI + (size_t)(row0 + t) * 1024 + ocol0 + (p & 15) * 8) = *(const LAS u32x4*)(kt + p * 16);
    }
}
__device__ __forceinline__ void p2_prepass(const Ptrs& c, LAS unsigned char* lds, int G, int tid, int wave, int lane, bool dry) {
    LAS float* wa2_l = (LAS float*)lds; LAS float* ba_l = wa2_l + 4096; LAS float* lb_l = ba_l + 256;
    for (int i = tid; i < 4096; i += NTHR) wa2_l[i] = c.in[6][i];
    if (tid < 256) ba_l[tid] = c.in[7][tid];
    { const float p0 = c.in[8][tid], p1 = c.in[8][512 + tid]; lb_l[tid] = 1.0f / (1.0f + __expf(p1 - p0)); }
    WG_BAR();
    const int gw = blockIdx.x * NWAVES + wave, NGW = G * NWAVES;
    for (int it = gw; it < 4096 + 1024; it += NGW) {
        int row0, ntok, h; bf16_t* kdt; int kst;
        if (it < 4096) { h = it & 7; const int ch = (it >> 3) & 63, b = it >> 9; row0 = b * 2048 + ch * 32; ntok = 32; kst = PLD;
                         kdt = c.P + (size_t)row0 * PLD + (h < 4 ? 256 + h * 64 : 2048 + (h - 4) * 128); }
        else { const int j = it - 4096; h = j & 7; row0 = MP + (j >> 3) * 8; ntok = 8; kst = h < 4 ? 64 : 128; kdt = c.KDTS + (size_t)j * 4096; }
        if (dry) { kst = h < 4 ? 64 : 128; kdt = (bf16_t*)((unsigned char*)c.DUMP + 203 * MiB) + (size_t)(it & 2047) * 4096; }
        if (it < 4096) { if (h < 4) pre_item<64, true, true>(c, row0, ntok, h, it, kdt, kst, wa2_l, ba_l, lb_l, lds + 20480 + wave * 16384, lane, dry);
                         else pre_item<128, false, true>(c, row0, ntok, h - 4, it, kdt, kst, wa2_l, ba_l, lb_l, lds + 20480 + wave * 16384, lane, dry); }
        else { if (h < 4) pre_item<64, true, false>(c, row0, ntok, h, it, kdt, kst, wa2_l, ba_l, lb_l, lds + 20480 + wave * 16384, lane, dry);
               else pre_item<128, false, false>(c, row0, ntok, h - 4, it, kdt, kst, wa2_l, ba_l, lb_l, lds + 20480 + wave * 16384, lane, dry); }
    }
    if (G >= 256 && blockIdx.x >= 128) weight_items(c, (LAS float*)(lds + 20480 + wave * 16384), 1, (blockIdx.x - 128) * NWAVES + wave, (G - 128) * NWAVES, lane);
}

template <int K>
__device__ __forceinline__ void seq_item(const Ptrs& c, LAS unsigned char* lds, int row0, int nch, int ntok, int h8, int colbase, int ncw, const float* S0, float* Sout,
                                         const bf16_t* kdt0, int kdt_rstride, size_t kdt_cstep, const float* dch0, size_t dch_cstep, int tid, int wave, int lane) {
    constexpr int QROW = 2 * K + 16, VROW = 272;
    constexpr int KOFF = 8704, DOFF = 18944, VOFF = 19456, BUFB = 28160, NMB = K / 16, NPC = 4 * K;
    const int n = lane & 15, q = lane >> 4, col = colbase + 16 * (wave < ncw ? wave : 0) + n;
    const bool cw = wave < ncw;
    const bool gla = h8 < 4; const int hh = h8 & 3;
    const int qcol0 = gla ? hh * 64 : 1536 + hh * 128, vcol0 = gla ? 512 + hh * 128 : 2560 + hh * 128, ocol = h8 * 128 + col;
    f32x4 S[NMB];
#pragma unroll
    for (int mb = 0; mb < NMB; ++mb)
#pragma unroll
        for (int i = 0; i < 4; ++i) S[mb][i] = (S0 && cw) ? S0[(size_t)(16 * mb + 4 * q + i) * 128 + col] : 0.f;
    const int nt1 = ntok - 1;
    const int pq = tid % NPC, prow_q = pq / (K / 8), pc8 = pq % (K / 8), prq = prow_q < nt1 ? prow_q : nt1;
    const int vrow = tid >> 4, vc8 = tid & 15, vr = vrow < nt1 ? vrow : nt1;
    const int dpi = tid % (K / 4);
    const bf16_t* gq = c.P + (size_t)(row0 + prq) * PLD + qcol0 + pc8 * 8;
    const bf16_t* gk = kdt0 + (size_t)prow_q * kdt_rstride + pc8 * 8;
    const float* gd = dch0 + dpi * 4;
    const bf16_t* gvp = c.P + (size_t)(row0 + vr) * PLD + vcol0 + vc8 * 8;
    struct Stage { u32x4 q, k, v; f32x4 d; };
    const int nch1 = nch - 1;
#define SEQ_LOAD(R, cc) do { const int c_ = (cc) < nch1 ? (cc) : nch1; const size_t ro_ = (size_t)c_ * 32; \
        R.q = *(const u32x4*)(gq + ro_ * PLD); R.k = *(const u32x4*)(gk + (size_t)c_ * kdt_cstep); R.d = *(const f32x4*)(gd + (size_t)c_ * dch_cstep); \
        R.v = *(const u32x4*)(gvp + ro_ * PLD); } while (0)
#define SEQ_STORE(R, buf) do { LAS unsigned char* B_ = lds + (buf) * BUFB; \
        *(LAS u32x4*)(B_ + prow_q * QROW + pc8 * 16) = R.q; *(LAS u32x4*)(B_ + KOFF + (pq >> 2) * 80 + (pq & 3) * 16) = R.k; *(LAS f32x4*)(B_ + DOFF + dpi * 16) = R.d; \
        *(LAS u32x4*)(B_ + VOFF + vrow * VROW + vc8 * 16) = R.v; } while (0)
#define SEQ_ITER(ci, buf, RST) do { \
        const LAS unsigned char* B = lds + (buf) * BUFB; \
        if (cw) { \
        f32x4 o[2] = {{0.f, 0.f, 0.f, 0.f}, {0.f, 0.f, 0.f, 0.f}}; \
        _Pragma("unroll") for (int js = 0; js < K / 32; ++js) { \
            u32x4 sb; sb.x = pk_bf16(S[2 * js][0], S[2 * js][1]); sb.y = pk_bf16(S[2 * js][2], S[2 * js][3]); sb.z = pk_bf16(S[2 * js + 1][0], S[2 * js + 1][1]); sb.w = pk_bf16(S[2 * js + 1][2], S[2 * js + 1][3]); \
            _Pragma("unroll") for (int mb2 = 0; mb2 < 2; ++mb2) { \
                const LAS unsigned char* qp = B + (16 * mb2 + n) * QROW + (32 * js + 4 * q) * 2; \
                const u32x2 lo = *(const LAS u32x2*)qp, hi = *(const LAS u32x2*)(qp + 32); \
                u32x4 qa; qa.x = lo.x; qa.y = lo.y; qa.z = hi.x; qa.w = hi.y; \
                o[mb2] = MFMA16(__builtin_bit_cast(bf16x8, qa), __builtin_bit_cast(bf16x8, sb), o[mb2]); } } \
        { unsigned short vs[8]; \
            _Pragma("unroll") for (int j = 0; j < 8; ++j) vs[j] = *(const LAS unsigned short*)(B + VOFF + (8 * q + j) * VROW + col * 2); \
            u32x4 vb; vb.x = vs[0] | ((unsigned)vs[1] << 16); vb.y = vs[2] | ((unsigned)vs[3] << 16); vb.z = vs[4] | ((unsigned)vs[5] << 16); vb.w = vs[6] | ((unsigned)vs[7] << 16); \
            _Pragma("unroll") for (int mb = 0; mb < NMB; ++mb) { \
                const u32x4 ka = *(const LAS u32x4*)(B + KOFF + (16 * mb + n) * 80 + q * 16); \
                const f32x4 dv = *(const LAS f32x4*)(B + DOFF + (16 * mb + 4 * q) * 4); \
                S[mb] = S[mb] * dv; \
                S[mb] = MFMA16(__builtin_bit_cast(bf16x8, ka), __builtin_bit_cast(bf16x8, vb), S[mb]); } } \
        bf16_t* ob = c.OX + (size_t)(row0 + 32 * (ci)) * 1024 + ocol; \
        _Pragma("unroll") for (int x = 0; x < 8; x += 2) { \
            const int t = 16 * (x >> 2) + 4 * q + (x & 3); const unsigned pv = pk_bf16(o[x >> 2][x & 3], o[x >> 2][(x & 3) + 1]); \
            bf16_t* d0 = t < ntok ? ob + (size_t)t * 1024 : c.DUMP + tid; bf16_t* d1 = t + 1 < ntok ? ob + (size_t)(t + 1) * 1024 : c.DUMP + tid; \
            *d0 = (bf16_t)(pv & 0xffffu); *d1 = (bf16_t)(pv >> 16); } \
        } \
        WG_BAR(); \
        SEQ_STORE(RST, buf); \
    } while (0)
    Stage R0, R1, R2, R3;
    SEQ_LOAD(R0, 0); SEQ_STORE(R0, 0);
    SEQ_LOAD(R1, 1); SEQ_LOAD(R2, 2); SEQ_LOAD(R3, 3); SEQ_LOAD(R0, 4);
    SEQ_STORE(R1, 1);
    WG_BAR();
    for (int ci = 0; ci < nch; ci += 4) {
        SEQ_LOAD(R1, ci + 5); SEQ_ITER(ci, 0, R2);
        if (ci + 1 >= nch) break;
        SEQ_LOAD(R2, ci + 6); SEQ_ITER(ci + 1, 1, R3);
        if (ci + 2 >= nch) break;
        SEQ_LOAD(R3, ci + 7); SEQ_ITER(ci + 2, 0, R0);
        if (ci + 3 >= nch) break;
        SEQ_LOAD(R0, ci + 8); SEQ_ITER(ci + 3, 1, R1);
    }
    if (cw) {
#pragma unroll
    for (int mb = 0; mb < NMB; ++mb)
#pragma unroll
        for (int i = 0; i < 4; ++i) Sout[(size_t)(16 * mb + 4 * q + i) * 128 + col] = S[mb][i];
    }
    WG_BAR();
#undef SEQ_LOAD
#undef SEQ_STORE
#undef SEQ_ITER
}
__device__ __forceinline__ void seq_dispatch(const Ptrs& c, LAS unsigned char* lds, int item, int tid, int wave, int lane) {
    int row0, nch, ntok, h8, colbase, ncw; const float* S0; float* Sout; const bf16_t* kdt0; int kst; size_t kcs, dcs; const float* dch0;
    if (item < 128) {
        const int bh = item >> 1, b = bh >> 3; h8 = bh & 7; const int hh = h8 & 3; row0 = b * 2048; nch = 64; ntok = 32; S0 = nullptr; colbase = (item & 1) * 64; ncw = 4;
        Sout = h8 < 4 ? c.out + OUT_SAP + (size_t)(b * 4 + hh) * 64 * 128 : c.out + OUT_SBP + (size_t)(b * 4 + hh) * 128 * 128;
        kdt0 = c.P + (size_t)row0 * PLD + (h8 < 4 ? 256 + hh * 64 : 2048 + hh * 128); kst = PLD; kcs = (size_t)32 * PLD;
        dch0 = c.DCH + (size_t)(b * 64 * 8 + h8) * 128; dcs = 8 * 128;
    } else {
        const int j = item - 128, b = j >> 3; h8 = j & 7; const int hh = h8 & 3; row0 = MP + b * 8; nch = 1; ntok = 8; colbase = 0; ncw = 8;
        S0 = h8 < 4 ? c.in[2] + (size_t)(b * 4 + hh) * 64 * 128 : c.in[3] + (size_t)(b * 4 + hh) * 128 * 128;
        Sout = h8 < 4 ? c.out + OUT_SAS + (size_t)(b * 4 + hh) * 64 * 128 : c.out + OUT_SBS + (size_t)(b * 4 + hh) * 128 * 128;
        kdt0 = c.KDTS + (size_t)j * 4096; kst = h8 < 4 ? 64 : 128; kcs = 0; dch0 = c.DCH + (size_t)(4096 + j) * 128; dcs = 0;
    }
    if (h8 < 4) seq_item<64>(c, lds, row0, nch, ntok, h8, colbase, ncw, S0, Sout, kdt0, kst, kcs, dch0, dcs, tid, wave, lane);
    else seq_item<128>(c, lds, row0, nch, ntok, h8, colbase, ncw, S0, Sout, kdt0, kst, kcs, dch0, dcs, tid, wave, lane);
}
__device__ __forceinline__ void p3b_finalize(const Ptrs& c, int G, int wave, int lane) {
    const int gw = blockIdx.x * NWAVES + wave, NGW = G * NWAVES, h8 = lane >> 3, cw = (lane & 7) * 16;
    const float* gp = (h8 < 4 ? c.in[9] : c.in[10]) + cw;
    f32x4 gn[4];
#pragma unroll
    for (int j = 0; j < 4; ++j) gn[j] = *(const f32x4*)(gp + 4 * j);
    const int gcol = (h8 < 4 ? 1024 + h8 * 128 : 3072 + (h8 - 4) * 128) + cw;
    for (int m = gw; m < M; m += NGW) {
        f32x4 o[4]; u32x4 x[2], g[2], oi[2];
#pragma unroll
        for (int j = 0; j < 2; ++j) { oi[j] = *(const u32x4*)(c.OI + (size_t)m * 1024 + lane * 16 + 8 * j); x[j] = *(const u32x4*)(c.OX + (size_t)m * 1024 + lane * 16 + 8 * j); g[j] = *(const u32x4*)(c.P + (size_t)m * PLD + gcol + 8 * j); }
        o[0][0] = bf_lo(oi[0].x); o[0][1] = bf_hi(oi[0].x); o[0][2] = bf_lo(oi[0].y); o[0][3] = bf_hi(oi[0].y); o[1][0] = bf_lo(oi[0].z); o[1][1] = bf_hi(oi[0].z); o[1][2] = bf_lo(oi[0].w); o[1][3] = bf_hi(oi[0].w);
        o[2][0] = bf_lo(oi[1].x); o[2][1] = bf_hi(oi[1].x); o[2][2] = bf_lo(oi[1].y); o[2][3] = bf_hi(oi[1].y); o[3][0] = bf_lo(oi[1].z); o[3][1] = bf_hi(oi[1].z); o[3][2] = bf_lo(oi[1].w); o[3][3] = bf_hi(oi[1].w);
        float ss = 0.f;
#pragma unroll
        for (int j = 0; j < 4; ++j) {
            const unsigned w0 = j < 2 ? (j == 0 ? x[0].x : x[0].z) : (j == 2 ? x[1].x : x[1].z), w1 = j < 2 ? (j == 0 ? x[0].y : x[0].w) : (j == 2 ? x[1].y : x[1].w);
            o[j][0] += bf_lo(w0); o[j][1] += bf_hi(w0); o[j][2] += bf_lo(w1); o[j][3] += bf_hi(w1);
            ss += (o[j][0] * o[j][0] + o[j][1] * o[j][1]) + (o[j][2] * o[j][2] + o[j][3] * o[j][3]);
        }
        ss += dpp_f<0xB1, 0xF>(ss); ss += dpp_f<0x4E, 0xF>(ss); ss += dpp_f<0x141, 0xF>(ss);
        const float rs = __builtin_amdgcn_rsqf(ss * (1.0f / 128.0f) + EPS);
        u32x4 w[2];
#pragma unroll
        for (int j = 0; j < 4; ++j) {
            const unsigned g0 = j < 2 ? (j == 0 ? g[0].x : g[0].z) : (j == 2 ? g[1].x : g[1].z), g1 = j < 2 ? (j == 0 ? g[0].y : g[0].w) : (j == 2 ? g[1].y : g[1].w);
            float gg[4] = {bf_lo(g0), bf_hi(g0), bf_lo(g1), bf_hi(g1)}, v[4];
#pragma unroll
            for (int e = 0; e < 4; ++e) v[e] = o[j][e] * rs * gn[j][e] * (gg[e] * __builtin_amdgcn_rcpf(1.0f + __expf(-gg[e])));
            const unsigned p0 = pk_bf16(v[0], v[1]), p1 = pk_bf16(v[2], v[3]);
            if (j == 0) { w[0].x = p0; w[0].y = p1; } else if (j == 1) { w[0].z = p0; w[0].w = p1; } else if (j == 2) { w[1].x = p0; w[1].y = p1; } else { w[1].z = p0; w[1].w = p1; }
        }
        *(u32x4*)(c.OF + (size_t)m * 1024 + lane * 16) = w[0]; *(u32x4*)(c.OF + (size_t)m * 1024 + lane * 16 + 8) = w[1];
    }
}
#define XB_TMO      128
#define XB_XCNT(j)  (256  + 64 * (j))
#define XB_XSUB(j)  (1280 + 64 * (j))
#define XB_XGEN(j)  (2304 + 64 * (j))
#define XB_TOP      3328
#define XB_TOPGEN   3392
#define XCD_BAR_WORDS 3456
#define XB_SPIN_CAP (1u << 18)

__device__ __forceinline__ unsigned xb_ld(unsigned* p)              { return __hip_atomic_load(p, __ATOMIC_RELAXED, __HIP_MEMORY_SCOPE_AGENT); }
__device__ __forceinline__ unsigned xb_add(unsigned* p, unsigned v) { return __hip_atomic_fetch_add(p, v, __ATOMIC_RELAXED, __HIP_MEMORY_SCOPE_AGENT); }
__device__ __forceinline__ unsigned xb_xcc_id() { return (unsigned)__builtin_amdgcn_s_getreg((3 << 11) | 20) & 0xFu; }
#define XB_SPIN(cond, bar) do { unsigned _sp = 0; while (cond) { __builtin_amdgcn_s_sleep(1); \
    if ((++_sp & 255u) == 0u) { if (xb_ld(&(bar)[XB_TMO])) break; if (_sp > XB_SPIN_CAP) { atomicAdd(&(bar)[XB_TMO], 1u); break; } } } } while (0)

struct XcdBarrier {
    unsigned* bar; unsigned x;
    volatile LAS unsigned* st;
};

__device__ __forceinline__ XcdBarrier xcd_barrier_post(unsigned* bar, volatile LAS unsigned* st) {
    XcdBarrier b; b.bar = bar; b.x = xb_xcc_id(); b.st = st;
    if (threadIdx.x == 0) (void)xb_add(&bar[XB_XCNT(b.x)], 1u);
    return b;
}
__device__ __forceinline__ void xcd_barrier_complete(unsigned* bar, unsigned x, unsigned& nloc, unsigned& nx) {
    const unsigned G = gridDim.x * gridDim.y * gridDim.z;
    unsigned sum, cnt, mine, sp = 0u;
    for (;;) {
        sum = 0u; cnt = 0u; mine = 0u;
#pragma unroll
        for (unsigned j = 0; j < 16; ++j) { const unsigned c = xb_ld(&bar[XB_XCNT(j)]); sum += c; cnt += (c > 0u) ? 1u : 0u; mine = (j == x) ? c : mine; }
        if (sum == G) break;
        __builtin_amdgcn_s_sleep(1);
        if ((++sp & 255u) == 0u) { if (xb_ld(&bar[XB_TMO])) break; if (sp > XB_SPIN_CAP) { atomicAdd(&bar[XB_TMO], 1u); break; } }
    }
    nloc = mine > 0u ? mine : 1u; nx = cnt > 0u ? cnt : 1u;
}

__device__ __forceinline__ void xcd_barrier(const XcdBarrier& b) {
    asm volatile("s_waitcnt vmcnt(0)" ::: "memory");
    __syncthreads();
    if (threadIdx.x == 0) {
        unsigned* bar = b.bar;
        __builtin_amdgcn_s_waitcnt(0);
        unsigned nloc = b.st[0], nx = b.st[1];
        if (nloc == 0u) { xcd_barrier_complete(bar, b.x, nloc, nx); b.st[0] = nloc; b.st[1] = nx; }
        const unsigned old = xb_add(&bar[XB_XSUB(b.x)], 1u);
        const unsigned gen = old / nloc;
        if (old + 1u == (gen + 1u) * nloc) {
            __builtin_amdgcn_fence(__ATOMIC_RELEASE, "agent");
            asm volatile("s_waitcnt vmcnt(0)" ::: "memory");
            const unsigned og = xb_add(&bar[XB_TOP], 1u);
            const unsigned tg = og / nx;
            if (og + 1u == (tg + 1u) * nx) xb_add(&bar[XB_TOPGEN], 1u);
            else XB_SPIN(xb_ld(&bar[XB_TOPGEN]) == tg, bar);
            __builtin_amdgcn_fence(__ATOMIC_ACQUIRE, "agent");
            xb_add(&bar[XB_XGEN(b.x)], 1u);
            asm volatile("s_waitcnt vmcnt(0)" ::: "memory");
        } else {
            XB_SPIN(xb_ld(&bar[XB_XGEN(b.x)]) == gen, bar);
            __builtin_amdgcn_fence(__ATOMIC_ACQUIRE, "agent");
            asm volatile("s_waitcnt vmcnt(0)" ::: "memory");
        }
    }
    __syncthreads();
}


struct EpiRes2Norm {
    static constexpr bool PERM = true, AFTER_DRAIN = true;
    float* Y; float* SSQ; const float* gfin; XcdBarrier xb;
    __device__ __forceinline__ void fused(pg8::f32x4 (&acc)[2][2][4][2], const pg8::Unit& u, int wr, int wc, int fr, int fq, LAS unsigned char* lds, int wid, int lane) const {
        using pg8::BM; using pg8::HALF;
        const int row0 = u.pm * BM + wr * 64 + fr, ct = u.pn * BM + wc * 32 + 8 * fq;
#pragma unroll
        for (int ai = 0; ai < 2; ++ai)
#pragma unroll
            for (int m = 0; m < 4; ++m) {
                const int row = row0 + ai * HALF + m * 16; const float* yr = Y + (size_t)row * 1024; float ss = 0.f;
#pragma unroll
                for (int bj = 0; bj < 2; ++bj) {
                    const int col = ct + bj * HALF;
                    acc[ai][bj][m][0] += *(const f32x4*)(yr + col); acc[ai][bj][m][1] += *(const f32x4*)(yr + col + 4);
                    const f32x4 v0 = acc[ai][bj][m][0], v1 = acc[ai][bj][m][1];
                    ss += (v0[0] * v0[0] + v0[1] * v0[1]) + (v0[2] * v0[2] + v0[3] * v0[3]) + (v1[0] * v1[0] + v1[1] * v1[1]) + (v1[2] * v1[2] + v1[3] * v1[3]);
                }
                ss += __shfl_xor(ss, 16); ss += __shfl_xor(ss, 32);
                if (fq == 0) SSQ[(size_t)row * 16 + u.pn * 4 + wc] = ss;
            }
        xcd_barrier(xb);
#pragma unroll
        for (int ai = 0; ai < 2; ++ai)
#pragma unroll
            for (int m = 0; m < 4; ++m) {
                const int row = row0 + ai * HALF + m * 16; float* yr = Y + (size_t)row * 1024;
                const f32x4* sp = (const f32x4*)(SSQ + (size_t)row * 16);
                const f32x4 s0 = sp[0], s1 = sp[1], s2 = sp[2], s3 = sp[3];
                const float tot = ((s0[0] + s0[1]) + (s0[2] + s0[3])) + ((s1[0] + s1[1]) + (s1[2] + s1[3])) + ((s2[0] + s2[1]) + (s2[2] + s2[3])) + ((s3[0] + s3[1]) + (s3[2] + s3[3]));
                const float rs = __builtin_amdgcn_rsqf(tot * (1.0f / 1024.0f) + EPS);
#pragma unroll
                for (int bj = 0; bj < 2; ++bj) {
                    const int col = ct + bj * HALF;
                    *(f32x4*)(yr + col) = acc[ai][bj][m][0] * rs * *(const f32x4*)(gfin + col); *(f32x4*)(yr + col + 4) = acc[ai][bj][m][1] * rs * *(const f32x4*)(gfin + col + 4);
                }
            }
    }
};

struct Args { const float* in[17]; float* out; unsigned char* ws; int ph_lo, ph_hi, aux, pad; };
constexpr int NPHASE = 9;
__device__ __forceinline__ void fill_ptrs(Ptrs& c, const Args& args) {
#pragma unroll
    for (int i = 0; i < 17; ++i) c.in[i] = args.in[i];
    c.out = args.out;
    unsigned char* ws = args.ws;
    c.WinT = (bf16_t*)(ws + WS_WIN); c.WoT = (bf16_t*)(ws + WS_WO); c.W13T = (bf16_t*)(ws + WS_W13); c.W2T = (bf16_t*)(ws + WS_W2);
    c.XB = (bf16_t*)(ws + WS_XB); c.OF = (bf16_t*)(ws + WS_XB); c.P = (bf16_t*)(ws + WS_P); c.HID = (bf16_t*)(ws + WS_P); c.KDTS = (bf16_t*)(ws + WS_KDTS);
    c.X1B = (bf16_t*)(ws + WS_FB); c.FB = (float*)(ws + WS_FB);
    c.RSTD1 = (float*)(ws + WS_RSTD1); c.SSQ2 = (float*)(ws + WS_SSQ2); c.LRA = (float*)(ws + WS_LRA); c.DCH = (float*)(ws + WS_DCH); c.OY = args.out + OUT_Y; c.DUMP = (bf16_t*)(ws + 30 * MiB); c.OX = (bf16_t*)(ws + WS_FB); c.OI = (bf16_t*)(ws + WS_XB); c.PART = (float*)(ws + 208 * MiB); c.PART4 = (float*)(ws + WS_P); c.SSQ3 = (float*)(ws + 30 * MiB + 65536);
}

__global__ void __launch_bounds__(NTHR, 2) hymba_fwd(Args args) {
    extern __shared__ __attribute__((aligned(16))) unsigned char lds_raw[];
    LAS unsigned char* lds = (LAS unsigned char*)lds_raw;
    const int tid = threadIdx.x, lane = tid & 63, wave = __builtin_amdgcn_readfirstlane(tid >> 6), G = gridDim.x;
    unsigned char* ws = args.ws;
    const int lo = args.ph_lo, hi = args.ph_hi;
    volatile LAS unsigned* xst = (volatile LAS unsigned*)(lds + 152064);
    if (tid == 0) { xst[0] = 0u; xst[1] = 0u; }
    __syncthreads();
    XcdBarrier xbar; xbar.bar = (unsigned*)(ws + WS_BAR); xbar.x = 0; xbar.st = xst;
    if (hi - lo > 1) xbar = xcd_barrier_post((unsigned*)(ws + WS_BAR), xst);
#define IN(k) (lo <= (k) && (k) < hi)
#define SEAM(k) do { if (IN(k) && IN((k) + 1)) { if (args.pad != 0) cg::this_grid().sync(); else xcd_barrier(xbar); } } while (0)
    if (IN(0)) { Ptrs c; fill_ptrs(c, args); p0_prologue(c, lds, G, wave, lane, G < 256); }
    SEAM(0);
    if (IN(1)) { Ptrs c; fill_ptrs(c, args);
        pg8::Gemm g{c.XB, c.WinT, M, NIN, D}; pg8::StaticOrder S; S.init(M, NIN, G, (int)blockIdx.x, D);
        pg8::EpiIn E{c.P, c.FB, c.LRA, c.RSTD1};
        pg8::gemm_phase<pg8::EpiIn, pg8::StaticOrder, true, true>(lds, g, S, E);
    }
    SEAM(1);
    if (IN(2)) { Ptrs c; fill_ptrs(c, args); p2_prepass(c, lds, G, tid, wave, lane, args.aux != 0); }
    SEAM(2);
    if (IN(3)) { Ptrs c; fill_ptrs(c, args);
        const int wg = blockIdx.x;
        if (G >= 256) {
            if (wg < 128) seq_dispatch(c, lds, wg, tid, wave, lane);
            else for (int j = wg - 128; j < 1024; j += G - 128) seq_dispatch(c, lds, 128 + j, tid, wave, lane);
        }
        else for (int it = wg; it < 128 + 1024; it += G) seq_dispatch(c, lds, it, tid, wave, lane);
    }
    SEAM(3);
    if (IN(4)) { Ptrs c; fill_ptrs(c, args); p3b_finalize(c, G, wave, lane); }
    SEAM(4);
    if (IN(5)) { Ptrs c; fill_ptrs(c, args);
        pg8::Gemm g{c.OF, c.WoT, M, D, D};
        { pg8::StaticOrder S; S.init(MP, D, G, (int)blockIdx.x, D); pg8::EpiRes1 E{c.in[0], c.in[1], c.OY, c.X1B, c.SSQ2};
          pg8::gemm_phase<pg8::EpiRes1, pg8::StaticOrder, true, true>(lds, g, S, E); }
        { pg8::TailOrder S{G, (int)blockIdx.x, 8, D / 64, MP / 256, 4, 16}; pg8::EpiPart E{c.PART4, MP, 1.f};
          pg8::gemm_phase<pg8::EpiPart, pg8::TailOrder, true, true>(lds, g, S, E); }
        if (hi - lo > 1) xcd_barrier(xbar);
        {
            const int gw = blockIdx.x * NWAVES + wave, NGW = G * NWAVES;
            for (int r = gw; r < MS; r += NGW) {
                const int m = MP + r; f32x4 v[4]; float ss = 0.f;
#pragma unroll
                for (int j = 0; j < 4; ++j) v[j] = *(const f32x4*)(c.in[1] + (size_t)r * D + 4 * lane + 256 * j);
#pragma unroll 1
                for (int ks = 0; ks < 8; ++ks)
#pragma unroll
                    for (int j = 0; j < 4; ++j) v[j] += *(const f32x4*)(c.PART4 + ((size_t)ks * 1024 + r) * 1024 + 4 * lane + 256 * j);
#pragma unroll
                for (int j = 0; j < 4; ++j) {
                    *(f32x4*)(c.OY + (size_t)m * D + 4 * lane + 256 * j) = v[j];
                    u32x2 w; w.x = pk_bf16(v[j][0], v[j][1]); w.y = pk_bf16(v[j][2], v[j][3]); *(u32x2*)(c.X1B + (size_t)m * D + 4 * lane + 256 * j) = w;
                    ss += (v[j][0] * v[j][0] + v[j][1] * v[j][1]) + (v[j][2] * v[j][2] + v[j][3] * v[j][3]);
                }
                ss = wave_sum(ss);
                if (lane < 16) c.SSQ2[(size_t)m * 16 + lane] = lane == 0 ? ss : 0.f;
            }
        }
    }
    SEAM(5);
    if (IN(6)) { Ptrs c; fill_ptrs(c, args);
        pg8::Gemm g{c.X1B, c.W13T, M, NUP, D}; pg8::StaticOrder S; S.init(M, NUP, G, (int)blockIdx.x, D);
        pg8::EpiSwiglu E{c.HID, c.SSQ2};
        pg8::gemm_phase<pg8::EpiSwiglu, pg8::StaticOrder, true, true>(lds, g, S, E);
    }
    SEAM(6);
    if (IN(7)) { Ptrs c; fill_ptrs(c, args);
        pg8::Gemm g{c.HID, c.W2T, M, D, FF};
        if (G == 256 && hi - lo > 1) {
            pg8::StaticOrder S; S.init(MP, D, G, (int)blockIdx.x, FF); EpiRes2Norm E{c.OY, c.SSQ3, c.in[16], xbar};
            pg8::gemm_phase<EpiRes2Norm, pg8::StaticOrder, true, true>(lds, g, S, E);
        } else {
            pg8::StaticOrder S; S.init(MP, D, G, (int)blockIdx.x, FF); pg8::EpiRes2 E{c.OY, args.aux ? 0.f : 1.f};
            pg8::gemm_phase<pg8::EpiRes2, pg8::StaticOrder, true, true>(lds, g, S, E);
        }
        { pg8::TailOrder S{G, (int)blockIdx.x, 11, FF / 64, MP / 256, 4, 16}; pg8::EpiPart E{c.PART, MP, args.aux ? 0.f : 1.f};
          pg8::gemm_phase<pg8::EpiPart, pg8::TailOrder, true, true>(lds, g, S, E); }
    }
    SEAM(7);
    if (IN(8)) { Ptrs c; fill_ptrs(c, args);
        const int NGW = G * NWAVES, gw = blockIdx.x * NWAVES + wave + ((G == 256 && hi - lo > 1) ? MP : 0);
        f32x4 gn[4];
#pragma unroll
        for (int j = 0; j < 4; ++j) gn[j] = *(const f32x4*)(c.in[16] + 4 * lane + 256 * j);
        f32x4 v[4], nv[4];
        { const int m0 = gw < M ? gw : M - 1;
#pragma unroll
          for (int j = 0; j < 4; ++j) v[j] = *(const f32x4*)(c.OY + (size_t)m0 * D + 4 * lane + 256 * j); }
#define ADD_PARTS(vv, mm) do { if ((mm) >= MP) { _Pragma("unroll 1") for (int ks = 0; ks < 11; ++ks) { _Pragma("unroll") for (int j = 0; j < 4; ++j) \
            vv[j] += *(const f32x4*)(c.PART + ((size_t)ks * 1024 + ((mm) - MP)) * 1024 + 4 * lane + 256 * j); } } } while (0)
        { const int m0 = gw < M ? gw : M - 1; ADD_PARTS(v, m0); }
        for (int m = gw; m < M; m += NGW) {
            float* yr = c.OY + (size_t)m * D; float s = 0.f;
            { const int mn = m + NGW < M ? m + NGW : m;
#pragma unroll
              for (int j = 0; j < 4; ++j) nv[j] = *(const f32x4*)(c.OY + (size_t)mn * D + 4 * lane + 256 * j);
              ADD_PARTS(nv, mn); }
#pragma unroll
            for (int j = 0; j < 4; ++j) s += (v[j][0] * v[j][0] + v[j][1] * v[j][1]) + (v[j][2] * v[j][2] + v[j][3] * v[j][3]);
            const float rs = __builtin_amdgcn_rsqf(wave_sum(s) * (1.0f / D) + EPS);
#pragma unroll
            for (int j = 0; j < 4; ++j) *(f32x4*)(yr + 4 * lane + 256 * j) = args.aux ? v[j] : v[j] * rs * gn[j];
#pragma unroll
            for (int j = 0; j < 4; ++j) v[j] = nv[j];
        }
    }
#undef IN
#undef SEAM
}

extern "C" void kernel_launch(void* const* d_in, const int* in_sizes, int n_in, void* d_out, int out_size, void* d_ws, size_t ws_size, hipStream_t stream) {
    static int grid = 0;
    if (grid == 0) {
        if (n_in != 17 || ws_size < WS_END) { fprintf(stderr, "kernel_launch: unexpected n_in %d / ws %zu\n", n_in, ws_size); grid = -1; return; }
        int dev = 0, cus = 0, per_cu = 0;
        (void)hipGetDevice(&dev); (void)hipDeviceGetAttribute(&cus, hipDeviceAttributeMultiprocessorCount, dev);
        if (hipFuncSetAttribute((const void*)hymba_fwd, hipFuncAttributeMaxDynamicSharedMemorySize, LDS_BYTES) != hipSuccess) { fprintf(stderr, "kernel_launch: hipFuncSetAttribute failed\n"); grid = -1; return; }
        if (hipOccupancyMaxActiveBlocksPerMultiprocessor(&per_cu, (const void*)hymba_fwd, NTHR, LDS_BYTES) != hipSuccess || per_cu < 1) { fprintf(stderr, "kernel_launch: occupancy query says %d\n", per_cu); per_cu = 1; }
        (void)hipGetLastError();
        grid = cus * per_cu;
        if (grid <= 0) grid = 256;
    }
    if (grid < 0) return;
    if (hipMemsetAsync((char*)d_ws + WS_BAR, 0, 16384, stream) != hipSuccess) { fprintf(stderr, "kernel_launch: memset failed\n"); return; }
    Args a{};
    for (int i = 0; i < 17; ++i) a.in[i] = (const float*)d_in[i];
    a.out = (float*)d_out; a.ws = (unsigned char*)d_ws;
    if (MK_N_LAUNCHES == 1) {
        a.ph_lo = 0; a.ph_hi = NPHASE;
        void* kargs[] = {&a};
        hipError_t e = hipLaunchCooperativeKernel((const void*)hymba_fwd, dim3(grid), dim3(NTHR), kargs, LDS_BYTES, stream);
        if (e != hipSuccess) fprintf(stderr, "kernel_launch: cooperative launch failed: %s (grid %d)\n", hipGetErrorString(e), grid);
    } else {
        for (int p = 0; p < NPHASE; ++p) { a.ph_lo = p; a.ph_hi = p + 1; const int nrep = ((REP_MASK >> p) & 1) ? 3 : 1;
            for (int rr = 0; rr < nrep; ++rr) { a.aux = ((p == 2 || p == 7 || p == 8) && rr + 1 < nrep) ? 1 : 0; hipLaunchKernelGGL(hymba_fwd, dim3(grid), dim3(NTHR), LDS_BYTES, stream, a); } }
    }
}
```

```cpp
#include <hip/hip_runtime.h>
#include <hip/hip_cooperative_groups.h>
#include <cstdio>
#include <cstdint>
namespace cg = cooperative_groups;
namespace pg8 {
#define PG8_LAS __attribute__((address_space(3)))
typedef unsigned short bf16_t;
typedef short bf16x8 __attribute__((ext_vector_type(8)));
typedef float f32x4 __attribute__((ext_vector_type(4)));
typedef unsigned u32x4 __attribute__((ext_vector_type(4)));
constexpr int BM = 256, BK = 64, HALF = 128, HTB = HALF * BK * 2  , STAGE_BYTES = 8 * HTB, NXCD = 8, WGM = 8;

__host__ __device__ __forceinline__ int lds_byte(int r, int c) { const int st = (r >> 4) * 2 + (c >> 5), rr = r & 15, cc = c & 31, ob = rr * 64 + cc * 2; return st * 1024 + (ob ^ (((ob >> 9) & 1) << 5)); }
__host__ __device__ __forceinline__ void stage_rc(int b, int& R, int& C) { const int st = b / 1024, sb = b % 1024, swz = sb ^ (((sb >> 9) & 1) << 5); R = (st >> 1) * 16 + swz / 64; C = (st & 1) * 32 + (swz % 64) / 2; }
__host__ __device__ __forceinline__ int perm32(int rho) { const int n = rho >> 4, i = rho & 15; return 8 * (i >> 2) + 4 * n + (i & 3); }

struct Unit { int pm, pn, k0, nk; };
struct Gemm { const bf16_t* A; const bf16_t* Bt; int M, N, K; };

struct StaticOrder {
    int nM, nN, nwg, G, c, nkt;
    __host__ __device__ void init(int M, int N, int G_, int c_, int K_) { nM = M / BM; nN = N / BM; nwg = nM * nN; G = G_; c = c_; nkt = K_ / BK; }
    __host__ __device__ bool next(int i, Unit& u) const { return at((long)i * G + c, u); }
    __host__ __device__ bool at(long L, Unit& u) const {
        if (L >= nwg) return false;
        int wgid = (int)L; { const int q = nwg / NXCD, r = nwg % NXCD, xcd = wgid % NXCD, off = wgid / NXCD; wgid = (xcd < r ? xcd * (q + 1) : r * (q + 1) + (xcd - r) * q) + off; }
        const int nig = WGM * nN, gid = wgid / nig, fm = gid * WGM, gsz = (nM - fm) < WGM ? (nM - fm) : WGM;
        u.pm = fm + ((wgid % nig) % gsz); u.pn = (wgid % nig) / gsz; u.k0 = 0; u.nk = nkt; return true;
    }
    __device__ __forceinline__ void a_ready(const Unit&) const {}
    __device__ __forceinline__ void done(const Unit&) const {}
};


struct TailOrder {
    int G, c, NS, nkt, pm0, nN, ntu;
    __host__ __device__ bool next(int i, Unit& u) const {
        const int id = i * G + c; if (id >= ntu * NS) return false;
        const int tu = id / NS, ks = id % NS; u.pm = pm0 + tu / nN; u.pn = tu % nN; u.nk = nkt / NS; u.k0 = ks * u.nk; return true;
    }
    __device__ __forceinline__ void a_ready(const Unit&) const {}
    __device__ __forceinline__ void done(const Unit&) const {}
};

__device__ __forceinline__ unsigned cvt_pk_bf16(float lo, float hi) { unsigned r; asm volatile("v_cvt_pk_bf16_f32 %0, %1, %2" : "=v"(r) : "v"(lo), "v"(hi)); return r; }
typedef float f32x2 __attribute__((ext_vector_type(2)));

template <class Epi, class Sched, bool ALIGN_EPI = false, bool SP2 = false>
__device__ __forceinline__ void gemm_phase(PG8_LAS unsigned char* lds, const Gemm g, const Sched& S, const Epi& E) {
    const int tid = threadIdx.x, wid = __builtin_amdgcn_readfirstlane(tid >> 6), lane = tid & 63, wr = wid >> 2, wc = wid & 3, fr = lane & 15, fq = lane >> 4;
    const int K = g.K, nt = K / BK;
    unsigned voffA[2], voffB[2];
#pragma unroll
    for (int i = 0; i < 2; ++i) { int R, C; stage_rc(tid * 16 + i * 8192, R, C); const int Rb = Epi::PERM ? ((R & ~31) + perm32(R & 31)) : R;
        voffA[i] = (unsigned)(R * K + C) * 2u; voffB[i] = (unsigned)(Rb * K + C) * 2u; }
    const size_t kstep = (size_t)(BK * 2);
    const size_t hstep = (size_t)HALF * K * 2;
    const size_t tstep = 2 * hstep;
    const unsigned ldsw = (unsigned)wid * 1024u;
    const int aoff = lds_byte(wr * 64 + fr, fq * 8), boff = lds_byte(wc * 32 + fr, fq * 8);
#define PG8_SA(b, h) (((b) * 2 + (h)) * HTB)
#define PG8_SB(b, h) ((4 + (b) * 2 + (h)) * HTB)
#define PG8_STAGE(bufoff, gbase, voff) do { _Pragma("unroll") for (int _i = 0; _i < 2; ++_i) \
        __builtin_amdgcn_global_load_lds((const unsigned*)((const char*)(gbase) + (voff)[_i]), (PG8_LAS unsigned*)(lds + (bufoff) + ldsw + _i * 8192), 16, 0, 0); } while (0)
#define PG8_LDA(dst, b, h) do { _Pragma("unroll") for (int m = 0; m < 4; ++m) _Pragma("unroll") for (int k = 0; k < 2; ++k) dst[m][k] = *(const PG8_LAS bf16x8*)(lds + PG8_SA(b, h) + aoff + m * 2048 + k * 1024); } while (0)
#define PG8_LDB(dst, b, h) do { _Pragma("unroll") for (int n = 0; n < 2; ++n) _Pragma("unroll") for (int k = 0; k < 2; ++k) dst[n][k] = *(const PG8_LAS bf16x8*)(lds + PG8_SB(b, h) + boff + n * 2048 + k * 1024); } while (0)
#define PG8_MMA(ai, bj, At, Bt) do { __builtin_amdgcn_s_setprio(1); _Pragma("unroll") for (int m = 0; m < 4; ++m) _Pragma("unroll") for (int n = 0; n < 2; ++n) _Pragma("unroll") for (int k = 0; k < 2; ++k) \
        acc[ai][bj][m][n] = __builtin_amdgcn_mfma_f32_16x16x32_bf16(Bt[n][k], At[m][k], acc[ai][bj][m][n], 0, 0, 0); __builtin_amdgcn_s_setprio(0); } while (0)
#define PG8_WAIT_V(n) asm volatile("s_waitcnt vmcnt(" #n ")" ::: "memory")
#define PG8_WAIT_L(n) asm volatile("s_waitcnt lgkmcnt(" #n ")" ::: "memory")
#define PG8_BAR __builtin_amdgcn_s_barrier()
#define PG8_SCHED __builtin_amdgcn_sched_barrier(0)
    Unit cur, nxt; int ui = 0;
    if (!S.next(0, cur)) return;
    f32x4 acc[2][2][4][2];
#pragma unroll
    for (int a = 0; a < 2; ++a)
#pragma unroll
        for (int b = 0; b < 2; ++b)
#pragma unroll
            for (int m = 0; m < 4; ++m)
#pragma unroll
                for (int n = 0; n < 2; ++n) acc[a][b][m][n] = (f32x4){0.f, 0.f, 0.f, 0.f};
    bf16x8 At[4][2], B0[2][2], B1[2][2];
    const char* cA = (const char*)g.A + (size_t)cur.pm * tstep + (size_t)cur.k0 * kstep; const char* cB = (const char*)g.Bt + (size_t)cur.pn * tstep + (size_t)cur.k0 * kstep;
    S.a_ready(cur);
    if constexpr (SP2) {
        PG8_STAGE(PG8_SB(0, 0), cB, voffB); PG8_STAGE(PG8_SB(0, 1), cB + hstep, voffB); PG8_STAGE(PG8_SA(0, 0), cA, voffA); PG8_STAGE(PG8_SA(0, 1), cA + hstep, voffA);
        if (wr == 1) PG8_BAR;
        PG8_WAIT_V(2); PG8_BAR;
        PG8_STAGE(PG8_SB(1, 0), cB + kstep, voffB); PG8_STAGE(PG8_SA(1, 0), cA + kstep, voffA); PG8_STAGE(PG8_SB(1, 1), cB + hstep + kstep, voffB);
        PG8_WAIT_V(6); PG8_BAR;
    } else {
        PG8_STAGE(PG8_SB(0, 0), cB, voffB); PG8_STAGE(PG8_SA(0, 0), cA, voffA); PG8_STAGE(PG8_SB(0, 1), cB + hstep, voffB); PG8_STAGE(PG8_SA(0, 1), cA + hstep, voffA);
        if (wr == 1) PG8_BAR;
        PG8_WAIT_V(4); PG8_BAR;
        PG8_STAGE(PG8_SB(1, 0), cB + kstep, voffB); PG8_STAGE(PG8_SA(1, 0), cA + kstep, voffA); PG8_STAGE(PG8_SB(1, 1), cB + hstep + kstep, voffB);
        PG8_WAIT_V(6); PG8_BAR;
    }
    for (;;) {
        const bool has_next = S.next(ui + 1, nxt);
        const char* nA = has_next ? (const char*)g.A + (size_t)nxt.pm * tstep + (size_t)nxt.k0 * kstep : cA; const char* nB = has_next ? (const char*)g.Bt + (size_t)nxt.pn * tstep + (size_t)nxt.k0 * kstep : cB;
        const int ntc = cur.nk;
        for (int t = 0; t < ntc; t += 2) {
            const bool last = (t == ntc - 2);
            const char* a1 = cA + (size_t)(t + 1) * kstep;
            const char* a2 = last ? nA : cA + (size_t)(t + 2) * kstep; const char* b2 = last ? nB : cB + (size_t)(t + 2) * kstep;
            const char* a3 = a2 + kstep; const char* b3 = b2 + kstep;
            if (last && has_next) S.a_ready(nxt);
            if constexpr (SP2) {
            PG8_LDB(B0, 0, 0); PG8_LDB(B1, 0, 1); PG8_SCHED; PG8_LDA(At, 0, 0); PG8_STAGE(PG8_SA(1, 1), a1 + hstep, voffA);
            PG8_WAIT_V(8); PG8_WAIT_L(0); PG8_BAR; PG8_MMA(0, 0, At, B0); PG8_MMA(0, 1, At, B1); PG8_BAR; PG8_SCHED;
            PG8_LDA(At, 0, 1); PG8_STAGE(PG8_SB(0, 0), b2, voffB); PG8_STAGE(PG8_SB(0, 1), b2 + hstep, voffB); PG8_STAGE(PG8_SA(0, 0), a2, voffA);
            PG8_WAIT_V(8); PG8_WAIT_L(0); PG8_BAR; PG8_MMA(1, 0, At, B0); PG8_MMA(1, 1, At, B1); PG8_BAR; PG8_SCHED;
            PG8_LDB(B0, 1, 0); PG8_LDB(B1, 1, 1); PG8_SCHED; PG8_LDA(At, 1, 0); PG8_STAGE(PG8_SA(0, 1), a2 + hstep, voffA);
            PG8_WAIT_V(8); PG8_WAIT_L(0); PG8_BAR; PG8_MMA(0, 0, At, B0); PG8_MMA(0, 1, At, B1); PG8_BAR; PG8_SCHED;
            PG8_LDA(At, 1, 1); PG8_STAGE(PG8_SB(1, 0), b3, voffB); PG8_STAGE(PG8_SB(1, 1), b3 + hstep, voffB); PG8_STAGE(PG8_SA(1, 0), a3, voffA);
            PG8_WAIT_V(8); PG8_WAIT_L(0); PG8_BAR; PG8_MMA(1, 0, At, B0); PG8_MMA(1, 1, At, B1); PG8_BAR; PG8_SCHED;
            } else {
            PG8_LDB(B0, 0, 0); PG8_SCHED; PG8_LDA(At, 0, 0); PG8_STAGE(PG8_SA(1, 1), a1 + hstep, voffA);
            PG8_WAIT_L(8); PG8_BAR; PG8_WAIT_L(0); PG8_MMA(0, 0, At, B0); PG8_BAR; PG8_SCHED;
            PG8_LDB(B1, 0, 1); PG8_STAGE(PG8_SB(0, 0), b2, voffB);
            PG8_BAR; PG8_WAIT_L(0); PG8_MMA(0, 1, At, B1); PG8_BAR;
            PG8_LDA(At, 0, 1); PG8_STAGE(PG8_SA(0, 0), a2, voffA);
            PG8_BAR; PG8_WAIT_L(0); PG8_MMA(1, 0, At, B0); PG8_BAR; PG8_SCHED;
            PG8_STAGE(PG8_SB(0, 1), b2 + hstep, voffB);
            PG8_WAIT_V(6); PG8_BAR; PG8_MMA(1, 1, At, B1); PG8_BAR;
            PG8_LDB(B0, 1, 0); PG8_SCHED; PG8_LDA(At, 1, 0); PG8_STAGE(PG8_SA(0, 1), a2 + hstep, voffA);
            PG8_WAIT_L(8); PG8_BAR; PG8_WAIT_L(0); PG8_MMA(0, 0, At, B0); PG8_BAR; PG8_SCHED;
            PG8_LDB(B1, 1, 1); PG8_STAGE(PG8_SB(1, 0), b3, voffB);
            PG8_BAR; PG8_WAIT_L(0); PG8_MMA(0, 1, At, B1); PG8_BAR;
            PG8_LDA(At, 1, 1); PG8_STAGE(PG8_SA(1, 0), a3, voffA);
            PG8_BAR; PG8_WAIT_L(0); PG8_MMA(1, 0, At, B0); PG8_BAR; PG8_SCHED;
            PG8_STAGE(PG8_SB(1, 1), b3 + hstep, voffB);
            PG8_WAIT_V(6); PG8_BAR; PG8_MMA(1, 1, At, B1); PG8_BAR;
            }
        }
        if constexpr (ALIGN_EPI) { if (wr == 0) PG8_BAR; }
        if constexpr (!Epi::AFTER_DRAIN) { E(acc, cur, wr, wc, fr, fq); S.done(cur); }
        if (!has_next) break;
#pragma unroll
        for (int a = 0; a < 2; ++a)
#pragma unroll
            for (int b = 0; b < 2; ++b)
#pragma unroll
                for (int m = 0; m < 4; ++m)
#pragma unroll
                    for (int n = 0; n < 2; ++n) acc[a][b][m][n] = (f32x4){0.f, 0.f, 0.f, 0.f};
        cur = nxt; cA = nA; cB = nB; ++ui;
        if constexpr (ALIGN_EPI) { if (wr == 1) PG8_BAR; }
    }
    PG8_WAIT_V(0);
    if constexpr (!ALIGN_EPI) { if (wr == 0) PG8_BAR; }
    PG8_BAR;
    if constexpr (Epi::AFTER_DRAIN) { E.fused(acc, cur, wr, wc, fr, fq, lds, wid, lane); S.done(cur); }
#undef PG8_SA
#undef PG8_SB
#undef PG8_STAGE
#undef PG8_LDA
#undef PG8_LDB
#undef PG8_MMA
#undef PG8_WAIT_V
#undef PG8_WAIT_L
#undef PG8_BAR
#undef PG8_SCHED
}
}

#ifndef MK_N_LAUNCHES
#define MK_N_LAUNCHES 1
#endif
#ifndef REP_MASK
#define REP_MASK 0
#endif
#define LAS __attribute__((address_space(3)))
using pg8::bf16_t; using pg8::bf16x8; using pg8::f32x4; using pg8::u32x4;
typedef float f32x16 __attribute__((ext_vector_type(16)));
typedef __bf16 bf16x2_t __attribute__((ext_vector_type(2)));
typedef float f32x2_t __attribute__((ext_vector_type(2)));
typedef unsigned u32x2 __attribute__((ext_vector_type(2)));

constexpr int NWAVES = 8, NTHR = 512;
constexpr int D = 1024, MP = 16384, MS = 1024, M = MP + MS, NIN = 3840, PLD = 3584, FF = 2816, NUP = 2 * FF;
constexpr float EPS = 1e-6f;
constexpr size_t MiB = 1u << 20;
constexpr size_t WS_BAR = 26 * MiB + 768 * 1024, WS_WIN = 0, WS_WO = 8 * MiB, WS_W13 = 10 * MiB, WS_W2 = 21 * MiB, WS_RSTD1 = 27 * MiB, WS_SSQ2 = 28 * MiB, WS_LRA = 32 * MiB, WS_DCH = 34 * MiB,
                 WS_KDTS = 37 * MiB, WS_XB = 45 * MiB, WS_FB = 79 * MiB, WS_P = 113 * MiB, WS_END = 233 * MiB;
static_assert(WS_P + (size_t)(M + 32) * PLD * 2 <= WS_END && WS_XB + (size_t)M * D * 2 <= WS_FB && WS_FB + (size_t)M * 512 * 4 <= WS_P, "ws map");
constexpr size_t OUT_Y = 0, OUT_SAP = 17825792, OUT_SBP = 18087936, OUT_SAS = 18612224, OUT_SBS = 22806528;
constexpr int LDS_BYTES = 160768;

__device__ __forceinline__ unsigned pk_bf16(float lo, float hi) { f32x2_t v = {lo, hi}; bf16x2_t b = __builtin_convertvector(v, bf16x2_t); return __builtin_bit_cast(unsigned, b); }
__device__ __forceinline__ float bf_lo(unsigned u) { return __uint_as_float(u << 16); }
__device__ __forceinline__ float bf_hi(unsigned u) { return __uint_as_float(u & 0xffff0000u); }
__device__ __forceinline__ float bf_f(unsigned short u) { return __uint_as_float(((unsigned)u) << 16); }


template <int CTRL, int ROWMASK> __device__ __forceinline__ float dpp_f(float v) { return __builtin_bit_cast(float, __builtin_amdgcn_update_dpp(0, __builtin_bit_cast(int, v), CTRL, ROWMASK, 0xF, true)); }
__device__ __forceinline__ float row16_sum(float v) { v += dpp_f<0xB1, 0xF>(v); v += dpp_f<0x4E, 0xF>(v); v += dpp_f<0x141, 0xF>(v); v += dpp_f<0x140, 0xF>(v); return v; }
__device__ __forceinline__ float scan32(float a) {
    a += dpp_f<0x111, 0xF>(a); a += dpp_f<0x112, 0xF>(a); a += dpp_f<0x114, 0xF>(a); a += dpp_f<0x118, 0xF>(a); a += dpp_f<0x142, 0xA>(a); return a; }
template <int CTRL, int ROWMASK> __device__ __forceinline__ float dpp_f1(float v) { return __builtin_bit_cast(float, __builtin_amdgcn_update_dpp(0x3f800000, __builtin_bit_cast(int, v), CTRL, ROWMASK, 0xF, false)); }
__device__ __forceinline__ float scanmul32(float a) {
    a *= dpp_f1<0x111, 0xF>(a); a *= dpp_f1<0x112, 0xF>(a); a *= dpp_f1<0x114, 0xF>(a); a *= dpp_f1<0x118, 0xF>(a); a *= dpp_f1<0x142, 0xA>(a); return a; }
__device__ __forceinline__ float lane_bcast(float v, int l);
__device__ __forceinline__ float wave_sum(float v) { v = row16_sum(v); return (lane_bcast(v, 0) + lane_bcast(v, 16)) + (lane_bcast(v, 32) + lane_bcast(v, 48)); }
__device__ __forceinline__ float lane_bcast(float v, int l) { return __builtin_bit_cast(float, __builtin_amdgcn_readlane(__builtin_bit_cast(int, v), l)); }
#define LDS_WAIT() asm volatile("s_waitcnt lgkmcnt(0)" ::: "memory")
#define WG_BAR() do { asm volatile("s_waitcnt lgkmcnt(0)" ::: "memory"); __builtin_amdgcn_s_barrier(); asm volatile("" ::: "memory"); } while (0)
#define MFMA32(a, b, c) __builtin_amdgcn_mfma_f32_32x32x16_bf16((a), (b), (c), 0, 0, 0)
#define MFMA16(a, b, c) __builtin_amdgcn_mfma_f32_16x16x32_bf16((a), (b), (c), 0, 0, 0)

struct Ptrs {
    const float* in[17]; float* out;
    bf16_t *WinT, *WoT, *W13T, *W2T, *XB, *P, *KDTS, *OF, *X1B, *HID;
    float *RSTD1, *SSQ2, *LRA, *DCH, *FB, *OY; bf16_t *DUMP, *OX, *OI; float *PART, *PART4, *SSQ3;
};

namespace pg8 {
struct EpiIn {
    static constexpr bool PERM = true, AFTER_DRAIN = false;
    bf16_t* P; float* FB; float* LRA; const float* rstd;
    __device__ __forceinline__ void operator()(const f32x4 (&acc)[2][2][4][2], const Unit& u, int wr, int wc, int fr, int fq) const {
        const int row0 = u.pm * BM + wr * 64 + fr, ct = wc * 32 + 8 * fq;
#pragma unroll
        for (int ai = 0; ai < 2; ++ai)
#pragma unroll
            for (int m = 0; m < 4; ++m) {
                const int row = row0 + ai * HALF + m * 16; const float rs = rstd[row];
#pragma unroll
                for (int bj = 0; bj < 2; ++bj) {
                    const f32x4 v0 = acc[ai][bj][m][0] * rs, v1 = acc[ai][bj][m][1] * rs; const int cl = bj * HALF + ct;
                    if (u.pn == 8 || u.pn == 9) { float* o = FB + (size_t)row * 512 + (u.pn - 8) * BM + cl; *(f32x4*)o = v0; *(f32x4*)(o + 4) = v1; }
                    else if (u.pn == 14) { if (cl < 16) { float* o = LRA + (size_t)row * 16 + cl; *(f32x4*)o = v0; *(f32x4*)(o + 4) = v1; } }
                    else { u32x4 w; w.x = cvt_pk_bf16(v0[0], v0[1]); w.y = cvt_pk_bf16(v0[2], v0[3]); w.z = cvt_pk_bf16(v1[0], v1[1]); w.w = cvt_pk_bf16(v1[2], v1[3]);
                           *(u32x4*)(P + (size_t)row * 3584 + u.pn * BM + cl) = w; }
                }
            }
    }
};
struct EpiRes1 {
    static constexpr bool PERM = true, AFTER_DRAIN = false;
    const float* xp; const float* xs; float* Y; bf16_t* X1B; float* SSQ;
    __device__ __forceinline__ void operator()(const f32x4 (&acc)[2][2][4][2], const Unit& u, int wr, int wc, int fr, int fq) const {
        const int row0 = u.pm * BM + wr * 64 + fr, ct = u.pn * BM + wc * 32 + 8 * fq;
#pragma unroll
        for (int ai = 0; ai < 2; ++ai)
#pragma unroll
            for (int m = 0; m < 4; ++m) {
                const int row = row0 + ai * HALF + m * 16;
                const float* xr = row < 16384 ? xp + (size_t)row * 1024 : xs + (size_t)(row - 16384) * 1024;
                float ss = 0.f;
#pragma unroll
                for (int bj = 0; bj < 2; ++bj) {
                    const int col = ct + bj * HALF;
                    const f32x4 v0 = acc[ai][bj][m][0] + *(const f32x4*)(xr + col), v1 = acc[ai][bj][m][1] + *(const f32x4*)(xr + col + 4);
                    *(f32x4*)(Y + (size_t)row * 1024 + col) = v0; *(f32x4*)(Y + (size_t)row * 1024 + col + 4) = v1;
                    u32x4 w; w.x = cvt_pk_bf16(v0[0], v0[1]); w.y = cvt_pk_bf16(v0[2], v0[3]); w.z = cvt_pk_bf16(v1[0], v1[1]); w.w = cvt_pk_bf16(v1[2], v1[3]);
                    *(u32x4*)(X1B + (size_t)row * 1024 + col) = w;
                    ss += (v0[0] * v0[0] + v0[1] * v0[1]) + (v0[2] * v0[2] + v0[3] * v0[3]) + (v1[0] * v1[0] + v1[1] * v1[1]) + (v1[2] * v1[2] + v1[3] * v1[3]);
                }
                ss += __shfl_xor(ss, 16); ss += __shfl_xor(ss, 32);
                if (fq == 0) SSQ[(size_t)row * 16 + u.pn * 4 + wc] = ss;
            }
    }
};
struct EpiSwiglu {
    static constexpr bool PERM = true, AFTER_DRAIN = false;
    bf16_t* H; const float* SSQ;
    __device__ __forceinline__ void operator()(const f32x4 (&acc)[2][2][4][2], const Unit& u, int wr, int wc, int fr, int fq) const {
        const int row0 = u.pm * BM + wr * 64 + fr, hc = u.pn * 128 + wc * 16 + fq * 4;
#pragma unroll
        for (int ai = 0; ai < 2; ++ai)
#pragma unroll
            for (int m = 0; m < 4; ++m) {
                const int row = row0 + ai * HALF + m * 16;
                const f32x4* sp = (const f32x4*)(SSQ + (size_t)row * 16);
                const f32x4 s0 = sp[0], s1 = sp[1], s2 = sp[2], s3 = sp[3];
                const float tot = ((s0[0] + s0[1]) + (s0[2] + s0[3])) + ((s1[0] + s1[1]) + (s1[2] + s1[3])) + ((s2[0] + s2[1]) + (s2[2] + s2[3])) + ((s3[0] + s3[1]) + (s3[2] + s3[3]));
                const float rs = __builtin_amdgcn_rsqf(tot * (1.0f / 1024.0f) + 1e-6f);
#pragma unroll
                for (int bj = 0; bj < 2; ++bj) {
                    const f32x4 a = acc[ai][bj][m][0] * rs, b = acc[ai][bj][m][1] * rs; float h[4];
#pragma unroll
                    for (int e = 0; e < 4; ++e) h[e] = a[e] * __builtin_amdgcn_rcpf(1.0f + __expf(-a[e])) * b[e];
                    unsigned lo = cvt_pk_bf16(h[0], h[1]), hi = cvt_pk_bf16(h[2], h[3]);
                    *(unsigned long long*)(H + (size_t)row * 2816 + hc + bj * 64) = (unsigned long long)lo | ((unsigned long long)hi << 32);
                }
            }
    }
};
struct EpiRes2 {
    static constexpr bool PERM = true, AFTER_DRAIN = false;
    float* Y; float sc;
    __device__ __forceinline__ void operator()(const f32x4 (&acc)[2][2][4][2], const Unit& u, int wr, int wc, int fr, int fq) const {
        const int row0 = u.pm * BM + wr * 64 + fr, ct = u.pn * BM + wc * 32 + 8 * fq;
#pragma unroll
        for (int ai = 0; ai < 2; ++ai)
#pragma unroll
            for (int m = 0; m < 4; ++m) {
                float* yr = Y + (size_t)(row0 + ai * HALF + m * 16) * 1024;
#pragma unroll
                for (int bj = 0; bj < 2; ++bj) {
                    const int col = ct + bj * HALF;
                    const f32x4 v0 = acc[ai][bj][m][0] * sc + *(const f32x4*)(yr + col), v1 = acc[ai][bj][m][1] * sc + *(const f32x4*)(yr + col + 4);
                    *(f32x4*)(yr + col) = v0; *(f32x4*)(yr + col + 4) = v1;
                }
            }
    }
};
struct EpiPart {
    static constexpr bool PERM = true, AFTER_DRAIN = false;
    float* PART; int rowbase; float sc;
    __device__ __forceinline__ void operator()(const f32x4 (&acc)[2][2][4][2], const Unit& u, int wr, int wc, int fr, int fq) const {
        const int row0 = u.pm * BM + wr * 64 + fr - rowbase, ct = u.pn * BM + wc * 32 + 8 * fq;
        float* base = PART + (size_t)(u.k0 / u.nk) * 1024 * 1024;
#pragma unroll
        for (int ai = 0; ai < 2; ++ai)
#pragma unroll
            for (int m = 0; m < 4; ++m) {
                float* yr = base + (size_t)(row0 + ai * HALF + m * 16) * 1024;
#pragma unroll
                for (int bj = 0; bj < 2; ++bj) { const int col = ct + bj * HALF; *(f32x4*)(yr + col) = acc[ai][bj][m][0] * sc; *(f32x4*)(yr + col + 4) = acc[ai][bj][m][1] * sc; }
            }
    }
};
}

__device__ __forceinline__ void tr_item(const float* colp, int ldw, const float* gain, int k0, int dcol, bf16_t* WT, int K, int nrow0, LAS float* scr, int lane) {
#pragma unroll 8
    for (int i = 0; i < 32; ++i) {
        const int kk = 2 * i + (lane >> 5); float v = 0.f;
        if (colp) { v = colp[(size_t)(k0 + kk) * ldw]; if (gain) v *= gain[k0 + kk]; }
        scr[kk * 33 + dcol] = v;
    }
    LDS_WAIT();
    const int c = lane & 7;
#pragma unroll
    for (int j = 0; j < 4; ++j) {
        const int n = (lane >> 3) + 8 * j; const LAS float* s = scr + (8 * c) * 33 + n;
        u32x4 o; o.x = pk_bf16(s[0 * 33], s[1 * 33]); o.y = pk_bf16(s[2 * 33], s[3 * 33]); o.z = pk_bf16(s[4 * 33], s[5 * 33]); o.w = pk_bf16(s[6 * 33], s[7 * 33]);
        *(u32x4*)(WT + (size_t)(nrow0 + n) * K + k0 + 8 * c) = o;
    }
    LDS_WAIT();
}
__device__ __forceinline__ void weight_items(const Ptrs& c, LAS float* scr, int part, int gw, int NGW, int lane) {
    const int l31 = lane & 31;
    constexpr int I_IN = 16 * 120, I_O = 16 * 32, I_13 = 16 * 176, I_2 = 44 * 32;
    if (part == 0) {
        for (int r = gw; r < I_IN; r += NGW) { const int kb = r / 120, nb = r % 120, n = nb * 32 + l31;
            const int oc = n < 1536 ? n : (n < 3584 ? n + 16 : (n < 3600 ? n - 3584 + 1536 : -1));
            tr_item(oc >= 0 ? c.in[5] + oc : nullptr, 3600, c.in[4], kb * 64, l31, c.WinT, 1024, nb * 32, scr, lane); }
        return;
    }
    for (int it = gw; it < I_O + I_13 + I_2; it += NGW) {
        int r = it;
        if (r < I_O) { const int kb = r / 32, nb = r % 32; tr_item(c.in[11] + nb * 32 + l31, 1024, nullptr, kb * 64, l31, c.WoT, 1024, nb * 32, scr, lane); continue; }
        r -= I_O;
        if (r < I_13) { const int kb = r / 176, nb = r % 176; const bool is3 = l31 >= 16; const int hcol = nb * 16 + (l31 & 15);
            tr_item((is3 ? c.in[14] : c.in[13]) + hcol, 2816, c.in[12], kb * 64, ((l31 & 15) >> 2) * 8 + (is3 ? 4 : 0) + (l31 & 3), c.W13T, 1024, nb * 32, scr, lane); continue; }
        r -= I_13;
        { const int kb = r / 32, nb = r % 32; tr_item(c.in[15] + nb * 32 + l31, 1024, nullptr, kb * 64, l31, c.W2T, 2816, nb * 32, scr, lane); }
    }
}
__device__ __forceinline__ void p0_prologue(const Ptrs& c, LAS unsigned char* lds, int G, int wave, int lane, bool all_weights) {
    LAS float* scr = (LAS float*)(lds + wave * 16384);
    const int gw = blockIdx.x * NWAVES + wave, NGW = G * NWAVES;
    weight_items(c, scr, 0, gw, NGW, lane);
    if (all_weights) weight_items(c, scr, 1, gw, NGW, lane);
    {
        f32x4 v[4], nv[4];
        { const int m0 = gw < M ? gw : M - 1; const float* xr = m0 < MP ? c.in[0] + (size_t)m0 * D : c.in[1] + (size_t)(m0 - MP) * D;
#pragma unroll
          for (int j = 0; j < 4; ++j) v[j] = *(const f32x4*)(xr + 4 * lane + 256 * j); }
        for (int m = gw; m < M; m += NGW) {
            { const int mn = m + NGW < M ? m + NGW : m; const float* xr = mn < MP ? c.in[0] + (size_t)mn * D : c.in[1] + (size_t)(mn - MP) * D;
#pragma unroll
              for (int j = 0; j < 4; ++j) nv[j] = *(const f32x4*)(xr + 4 * lane + 256 * j); }
            float s = 0.f;
#pragma unroll
            for (int j = 0; j < 4; ++j) s += (v[j][0] * v[j][0] + v[j][1] * v[j][1]) + (v[j][2] * v[j][2] + v[j][3] * v[j][3]);
            s = wave_sum(s);
#pragma unroll
            for (int j = 0; j < 4; ++j) { u32x2 w; w.x = pk_bf16(v[j][0], v[j][1]); w.y = pk_bf16(v[j][2], v[j][3]); *(u32x2*)(c.XB + (size_t)m * D + 4 * lane + 256 * j) = w; }
            if (lane == 0) c.RSTD1[m] = 1.0f / sqrtf(s * (1.0f / D) + EPS);
#pragma unroll
            for (int j = 0; j < 4; ++j) v[j] = nv[j];
        }
    }
}

__device__ __forceinline__ int crow(int i, int h) { return (i & 3) + 8 * (i >> 2) + 4 * h; }
template <int K, bool GLA, bool ALLV>
__device__ __forceinline__ void pre_item(const Ptrs& c, int row0, int ntok, int hh, int item, bf16_t* kdt_base, int kdt_stride,
                                         const LAS float* wa2_l, const LAS float* ba_l, const LAS float* lb_l, LAS unsigned char* vt, int lane, bool dry) {
    const int r = lane & 31, kg = lane >> 5;
    const bool valid = ALLV || r < ntok;
    const int row = row0 + (valid ? r : 0), nt1 = ntok - 1;
    constexpr int NJ = K / 16;
    const int qcol0 = GLA ? hh * 64 : 1536 + hh * 128, kcol0 = 256 + hh * 64, vcol0 = GLA ? 512 + hh * 128 : 2560 + hh * 128, ocol0 = (GLA ? hh : 4 + hh) * 128;
    bf16_t* Prow = c.P + (size_t)row * PLD;
    LAS unsigned char* kt = vt + 8192;
    LAS unsigned char* dl = vt + 16384;
    float lra[16];
    if constexpr (GLA) {
#pragma unroll
        for (int i = 0; i < 4; ++i) { const f32x4 t = *(const f32x4*)(c.LRA + (size_t)row * 16 + 4 * i); lra[4 * i] = t[0]; lra[4 * i + 1] = t[1]; lra[4 * i + 2] = t[2]; lra[4 * i + 3] = t[3]; }
    }
    const bf16_t* qptr = Prow + qcol0 + 8 * kg;
    const bf16_t* kptr = Prow + kcol0 + 8 * kg;
    const float* fptr = c.FB + (size_t)row * 512 + hh * 128 + 8 * kg;
    u32x4 qn = *(const u32x4*)qptr, kn = {0u, 0u, 0u, 0u}; f32x4 fn0 = {0.f, 0.f, 0.f, 0.f}, fn1 = fn0;
    if constexpr (GLA) kn = *(const u32x4*)kptr; else { fn0 = *(const f32x4*)fptr; fn1 = *(const f32x4*)(fptr + 4); }
    f32x16 att;
#pragma unroll
    for (int i = 0; i < 16; ++i) att[i] = 0.f;
    float* dch = c.DCH + (size_t)item * 128;
#pragma unroll 1
    for (int j = 0; j < NJ; ++j) {
        const int cl = 16 * j + 8 * kg;
        const u32x4 qr = qn, kr = kn; const f32x4 f0 = fn0, f1 = fn1;
        { const int jn = j + 1 < NJ ? j + 1 : j;
          qn = *(const u32x4*)(qptr + 16 * jn);
          if constexpr (GLA) kn = *(const u32x4*)(kptr + 16 * jn); else { fn0 = *(const f32x4*)(fptr + 16 * jn); fn1 = *(const f32x4*)(fptr + 16 * jn + 4); } }
        float la[8], kv[8], qv[8];
        if constexpr (GLA) {
            const LAS float* wl = wa2_l + hh * 64 + cl;
            f32x4 a0 = *(const LAS f32x4*)(ba_l + hh * 64 + cl), a1 = *(const LAS f32x4*)(ba_l + hh * 64 + cl + 4);
#pragma unroll
            for (int rb = 0; rb < 16; rb += 4) {
                f32x4 w[8];
#pragma unroll
                for (int rr = 0; rr < 4; ++rr) { w[2 * rr] = *(const LAS f32x4*)(wl + (rb + rr) * 256); w[2 * rr + 1] = *(const LAS f32x4*)(wl + (rb + rr) * 256 + 4); }
#pragma unroll
                for (int rr = 0; rr < 4; ++rr) { a0 += w[2 * rr] * lra[rb + rr]; a1 += w[2 * rr + 1] * lra[rb + rr]; }
            }
            float x[8], t[8];
#pragma unroll
            for (int e = 0; e < 8; ++e) x[e] = e < 4 ? a0[e & 3] : a1[e & 3];
#pragma unroll
            for (int e = 0; e < 8; ++e) t[e] = __expf(-fabsf(x[e]));
#pragma unroll
            for (int e = 0; e < 8; ++e) t[e] = __logf(1.0f + t[e]);
#pragma unroll
            for (int e = 0; e < 8; ++e) la[e] = (fminf(x[e], 0.f) - t[e]) * 0.0625f;
            kv[0] = bf_lo(kr.x); kv[1] = bf_hi(kr.x); kv[2] = bf_lo(kr.y); kv[3] = bf_hi(kr.y); kv[4] = bf_lo(kr.z); kv[5] = bf_hi(kr.z); kv[6] = bf_lo(kr.w); kv[7] = bf_hi(kr.w);
        } else {
            const f32x4 l0 = *(const LAS f32x4*)(lb_l + hh * 128 + cl), l1 = *(const LAS f32x4*)(lb_l + hh * 128 + cl + 4);
            float x[8], lbv[8], ex[8], inv[8];
#pragma unroll
            for (int e = 0; e < 8; ++e) { x[e] = e < 4 ? f0[e & 3] : f1[e & 3]; lbv[e] = e < 4 ? l0[e & 3] : l1[e & 3]; }
#pragma unroll
            for (int e = 0; e < 8; ++e) ex[e] = __expf(-fabsf(x[e]));
#pragma unroll
            for (int e = 0; e < 8; ++e) inv[e] = __builtin_amdgcn_rcpf(1.0f + ex[e]);
#pragma unroll
            for (int e = 0; e < 8; ++e) { const float ei = ex[e] * inv[e]; const float sg = x[e] >= 0.f ? inv[e] : ei, ng = x[e] >= 0.f ? ei : inv[e];
                la[e] = lbv[e] + (1.0f - lbv[e]) * sg; kv[e] = (1.0f - lbv[e]) * ng; }
        }
        qv[0] = bf_lo(qr.x); qv[1] = bf_hi(qr.x); qv[2] = bf_lo(qr.y); qv[3] = bf_hi(qr.y); qv[4] = bf_lo(qr.z); qv[5] = bf_hi(qr.z); qv[6] = bf_lo(qr.w); qv[7] = bf_hi(qr.w);
        float qi[8], ki[8], kd[8], eb[8], q[8], ea[8], ia[8];
        if constexpr (GLA) {
#pragma unroll
            for (int e = 0; e < 8; ++e) q[e] = qv[e] * 0.125f;
        } else {
#pragma unroll
            for (int e = 0; e < 8; ++e) q[e] = __expf(-qv[e]);
#pragma unroll
            for (int e = 0; e < 8; ++e) q[e] = __builtin_amdgcn_rcpf(1.0f + q[e]);
#pragma unroll
            for (int e = 0; e < 8; ++e) q[e] *= qv[e];
        }
        if (!ALLV) {
#pragma unroll
            for (int e = 0; e < 8; ++e) if (!valid) { q[e] = 0.f; kv[e] = 0.f; la[e] = GLA ? 0.f : 1.f; }
        }
        if constexpr (GLA) {
#pragma unroll
            for (int e = 0; e < 8; ++e) la[e] += dpp_f<0x111, 0xF>(la[e]);
#pragma unroll
            for (int e = 0; e < 8; ++e) la[e] += dpp_f<0x112, 0xF>(la[e]);
#pragma unroll
            for (int e = 0; e < 8; ++e) la[e] += dpp_f<0x114, 0xF>(la[e]);
#pragma unroll
            for (int e = 0; e < 8; ++e) la[e] += dpp_f<0x118, 0xF>(la[e]);
#pragma unroll
            for (int e = 0; e < 8; ++e) la[e] += dpp_f<0x142, 0xA>(la[e]);
#pragma unroll
            for (int e = 0; e < 8; ++e) ea[e] = __expf(fmaxf(la[e], -80.f));
        } else {
#pragma unroll
            for (int e = 0; e < 8; ++e) la[e] *= dpp_f1<0x111, 0xF>(la[e]);
#pragma unroll
            for (int e = 0; e < 8; ++e) la[e] *= dpp_f1<0x112, 0xF>(la[e]);
#pragma unroll
            for (int e = 0; e < 8; ++e) la[e] *= dpp_f1<0x114, 0xF>(la[e]);
#pragma unroll
            for (int e = 0; e < 8; ++e) la[e] *= dpp_f1<0x118, 0xF>(la[e]);
#pragma unroll
            for (int e = 0; e < 8; ++e) la[e] *= dpp_f1<0x142, 0xA>(la[e]);
#pragma unroll
            for (int e = 0; e < 8; ++e) ea[e] = fmaxf(la[e], 1e-35f);
        }
#pragma unroll
        for (int e = 0; e < 8; ++e) ia[e] = __builtin_amdgcn_rcpf(ea[e]);
#pragma unroll
        for (int e = 0; e < 8; ++e) { const float e31 = lane_bcast(ea[e], 31), e63 = lane_bcast(ea[e], 63); eb[e] = kg ? e63 : e31; }
#pragma unroll
        for (int e = 0; e < 8; ++e) { qi[e] = q[e] * ea[e]; ki[e] = kv[e] * ia[e]; kd[e] = ki[e] * eb[e]; }
        u32x4 qp, kp;
        qp.x = pk_bf16(qi[0], qi[1]); qp.y = pk_bf16(qi[2], qi[3]); qp.z = pk_bf16(qi[4], qi[5]); qp.w = pk_bf16(qi[6], qi[7]);
        kp.x = pk_bf16(ki[0], ki[1]); kp.y = pk_bf16(ki[2], ki[3]); kp.z = pk_bf16(ki[4], ki[5]); kp.w = pk_bf16(ki[6], ki[7]);
        att = MFMA32(__builtin_bit_cast(bf16x8, kp), __builtin_bit_cast(bf16x8, qp), att);
        *(LAS u32x4*)(vt + r * (K * 2) + ((((cl >> 3) ^ r) & (K / 8 - 1)) << 4)) = qp;
#pragma unroll
        for (int e = 0; e < 8; e += 2) {
            const unsigned pkd = pk_bf16(kd[e], kd[e + 1]);
            *(LAS unsigned short*)(kt + (cl + e) * 64 + r * 2) = (unsigned short)(pkd & 0xffffu);
            *(LAS unsigned short*)(kt + (cl + e + 1) * 64 + r * 2) = (unsigned short)(pkd >> 16);
        }
        if (r == 0) { f32x4 d0 = {eb[0], eb[1], eb[2], eb[3]}, d1 = {eb[4], eb[5], eb[6], eb[7]}; *(LAS f32x4*)(dl + cl * 4) = d0; *(LAS f32x4*)(dl + cl * 4 + 16) = d1; }
    }
    u32x4 vreg[8];
#pragma unroll
    for (int i = 0; i < 8; ++i) { const int p = lane + 64 * i, vr = (p >> 4) < nt1 ? (p >> 4) : nt1; vreg[i] = *(const u32x4*)(c.P + (size_t)(row0 + vr) * PLD + vcol0 + (p & 15) * 8); }
#pragma unroll
    for (int i = 0; i < K / 16; ++i) {
        const int p = lane + 64 * i, L = p * 8, qr_ = p / (K / 8), qc_ = p % (K / 8);
        if ((ALLV || qr_ < ntok) && !dry) *(u32x4*)(c.P + (size_t)(row0 + qr_) * PLD + qcol0 + qc_ * 8) = *(const LAS u32x4*)(vt + qr_ * (K * 2) + (((qc_ ^ qr_) & (K / 8 - 1)) << 4));
        *(u32x4*)(kdt_base + (size_t)(L / K) * kdt_stride + (L % K)) = *(const LAS u32x4*)(kt + p * 16);
    }
    if (lane < K / 4) *(f32x4*)(dch + lane * 4) = *(const LAS f32x4*)(dl + lane * 16);
#pragma unroll
    for (int i = 0; i < 8; ++i) { const int p = lane + 64 * i; *(LAS u32x4*)(vt + (p >> 4) * 256 + (p & 15) * 16) = vreg[i]; }
#pragma unroll
    for (int i = 0; i < 16; ++i) if (crow(i, kg) > r) att[i] = 0.f;
    u32x4 pa0, pa1;
    pa0.x = pk_bf16(att[0], att[1]); pa0.y = pk_bf16(att[2], att[3]); pa0.z = pk_bf16(att[4], att[5]); pa0.w = pk_bf16(att[6], att[7]);
    pa1.x = pk_bf16(att[8], att[9]); pa1.y = pk_bf16(att[10], att[11]); pa1.z = pk_bf16(att[12], att[13]); pa1.w = pk_bf16(att[14], att[15]);
#pragma unroll 1
    for (int vb = 0; vb < 4; ++vb) {
        unsigned short vs[16];
#pragma unroll
        for (int i = 0; i < 16; ++i) vs[i] = *(const LAS unsigned short*)(vt + crow(i, kg) * 256 + (vb * 32 + r) * 2);
        u32x4 b0, b1;
        b0.x = vs[0] | ((unsigned)vs[1] << 16); b0.y = vs[2] | ((unsigned)vs[3] << 16); b0.z = vs[4] | ((unsigned)vs[5] << 16); b0.w = vs[6] | ((unsigned)vs[7] << 16);
        b1.x = vs[8] | ((unsigned)vs[9] << 16); b1.y = vs[10] | ((unsigned)vs[11] << 16); b1.z = vs[12] | ((unsigned)vs[13] << 16); b1.w = vs[14] | ((unsigned)vs[15] << 16);
        f32x16 o;
#pragma unroll
        for (int i = 0; i < 16; ++i) o[i] = 0.f;
        o = MFMA32(__builtin_bit_cast(bf16x8, pa0), __builtin_bit_cast(bf16x8, b0), o);
        o = MFMA32(__builtin_bit_cast(bf16x8, pa1), __builtin_bit_cast(bf16x8, b1), o);
#pragma unroll
        for (int i = 0; i < 16; ++i) *(LAS unsigned short*)(kt + crow(i, kg) * 256 + (vb * 32 + r) * 2) = (unsigned short)(pk_bf16(o[i], 0.f) & 0xffffu);
    }
#pragma unroll
    for (int i = 0; i < 8; ++i) {
        const int p = lane + 64 * i, t = p >> 4;
        if (t < ntok) *(u32x4*)(c.OI + (size_t)(row0 + t) * 1024 + ocol0 + (p & 15) * 8) = *(const LAS u32x4*)(kt + p * 16);
    }
}
__device__ __forceinline__ void p2_prepass(const Ptrs& c, LAS unsigned char* lds, int G, int tid, int wave, int lane, bool dry) {
    LAS float* wa2_l = (LAS float*)lds; LAS float* ba_l = wa2_l + 4096; LAS float* lb_l = ba_l + 256;
    for (int i = tid; i < 4096; i += NTHR) wa2_l[i] = c.in[6][i];
    if (tid < 256) ba_l[tid] = c.in[7][tid];
    { const float p0 = c.in[8][tid], p1 = c.in[8][512 + tid]; lb_l[tid] = 1.0f / (1.0f + __expf(p1 - p0)); }
    WG_BAR();
    const int gw = blockIdx.x * NWAVES + wave, NGW = G * NWAVES;
    const bool bal = (G == 256);
    const int n_it = bal ? 4096 : 4096 + 1024;
    for (int it0 = gw; ; it0 += NGW) {
        int it = it0;
        if (it0 >= n_it) { if (!bal || wave >= 4 || it0 >= n_it + NGW) break; it = 4096 + blockIdx.x * 4 + wave; }
        int row0, ntok, h; bf16_t* kdt; int kst;
        if (it < 4096) { h = it & 7; const int ch = (it >> 3) & 63, b = it >> 9; row0 = b * 2048 + ch * 32; ntok = 32; kst = PLD;
                         kdt = c.P + (size_t)row0 * PLD + (h < 4 ? 256 + h * 64 : 2048 + (h - 4) * 128); }
        else { const int j = it - 4096; h = j & 7; row0 = MP + (j >> 3) * 8; ntok = 8; kst = h < 4 ? 64 : 128; kdt = c.KDTS + (size_t)j * 4096; }
        if (dry) { kst = h < 4 ? 64 : 128; kdt = (bf16_t*)((unsigned char*)c.DUMP + 203 * MiB) + (size_t)(it & 2047) * 4096; }
        if (it < 4096) { if (h < 4) pre_item<64, true, true>(c, row0, ntok, h, it, kdt, kst, wa2_l, ba_l, lb_l, lds + 20480 + wave * 16896, lane, dry);
                         else pre_item<128, false, true>(c, row0, ntok, h - 4, it, kdt, kst, wa2_l, ba_l, lb_l, lds + 20480 + wave * 16896, lane, dry); }
        else { if (h < 4) pre_item<64, true, false>(c, row0, ntok, h, it, kdt, kst, wa2_l, ba_l, lb_l, lds + 20480 + wave * 16896, lane, dry);
               else pre_item<128, false, false>(c, row0, ntok, h - 4, it, kdt, kst, wa2_l, ba_l, lb_l, lds + 20480 + wave * 16896, lane, dry); }
    }
    if (bal && wave >= 4) weight_items(c, (LAS float*)(lds + 20480 + wave * 16896), 1, blockIdx.x * 4 + wave - 4, G * 4, lane);
}

template <int K>
__device__ __forceinline__ void seq_item(const Ptrs& c, LAS unsigned char* lds, int row0, int nch, int ntok, int h8, int colbase, int ncw, const float* S0, float* Sout,
                                         const bf16_t* kdt0, int kdt_rstride, size_t kdt_cstep, const float* dch0, size_t dch_cstep, int tid, int wave, int lane) {
    constexpr int QROW = 2 * K + 16, VROW = 272;
    constexpr int KOFF = 8704, DOFF = 18944, VOFF = 19456, BUFB = 28160, NMB = K / 16, NPC = 4 * K;
    const int n = lane & 15, q = lane >> 4, col = colbase + 16 * (wave < ncw ? wave : 0) + n;
    const bool cw = wave < ncw;
    const bool gla = h8 < 4; const int hh = h8 & 3;
    const int qcol0 = gla ? hh * 64 : 1536 + hh * 128, vcol0 = gla ? 512 + hh * 128 : 2560 + hh * 128, ocol = h8 * 128 + col;
    f32x4 S[NMB];
#pragma unroll
    for (int mb = 0; mb < NMB; ++mb)
#pragma unroll
        for (int i = 0; i < 4; ++i) S[mb][i] = (S0 && cw) ? S0[(size_t)(16 * mb + 4 * q + i) * 128 + col] : 0.f;
    const int nt1 = ntok - 1;
    const int pq = tid % NPC, prow_q = pq / (K / 8), pc8 = pq % (K / 8), prq = prow_q < nt1 ? prow_q : nt1;
    const int vrow = tid >> 4, vc8 = tid & 15, vr = vrow < nt1 ? vrow : nt1;
    const int dpi = tid % (K / 4);
    const bf16_t* gq = c.P + (size_t)(row0 + prq) * PLD + qcol0 + pc8 * 8;
    const bf16_t* gk = kdt0 + (size_t)prow_q * kdt_rstride + pc8 * 8;
    const float* gd = dch0 + dpi * 4;
    const bf16_t* gvp = c.P + (size_t)(row0 + vr) * PLD + vcol0 + vc8 * 8;
    struct Stage { u32x4 q, k, v; f32x4 d; };
    const int nch1 = nch - 1;
#define SEQ_LOAD(R, cc) do { const int c_ = (cc) < nch1 ? (cc) : nch1; const size_t ro_ = (size_t)c_ * 32; \
        R.q = *(const u32x4*)(gq + ro_ * PLD); R.k = *(const u32x4*)(gk + (size_t)c_ * kdt_cstep); R.d = *(const f32x4*)(gd + (size_t)c_ * dch_cstep); \
        R.v = *(const u32x4*)(gvp + ro_ * PLD); } while (0)
#define SEQ_STORE(R, buf) do { LAS unsigned char* B_ = lds + (buf) * BUFB; \
        *(LAS u32x4*)(B_ + prow_q * QROW + pc8 * 16) = R.q; *(LAS u32x4*)(B_ + KOFF + (pq >> 2) * 80 + (pq & 3) * 16) = R.k; *(LAS f32x4*)(B_ + DOFF + dpi * 16) = R.d; \
        *(LAS u32x4*)(B_ + VOFF + vrow * VROW + vc8 * 16) = R.v; } while (0)
#define SEQ_ITER(ci, buf, RST) do { \
        const LAS unsigned char* B = lds + (buf) * BUFB; \
        if (cw) { \
        f32x4 o[2] = {{0.f, 0.f, 0.f, 0.f}, {0.f, 0.f, 0.f, 0.f}}; \
        _Pragma("unroll") for (int js = 0; js < K / 32; ++js) { \
            u32x4 sb; sb.x = pk_bf16(S[2 * js][0], S[2 * js][1]); sb.y = pk_bf16(S[2 * js][2], S[2 * js][3]); sb.z = pk_bf16(S[2 * js + 1][0], S[2 * js + 1][1]); sb.w = pk_bf16(S[2 * js + 1][2], S[2 * js + 1][3]); \
            _Pragma("unroll") for (int mb2 = 0; mb2 < 2; ++mb2) { \
                const LAS unsigned char* qp = B + (16 * mb2 + n) * QROW + (32 * js + 4 * q) * 2; \
                const u32x2 lo = *(const LAS u32x2*)qp, hi = *(const LAS u32x2*)(qp + 32); \
                u32x4 qa; qa.x = lo.x; qa.y = lo.y; qa.z = hi.x; qa.w = hi.y; \
                o[mb2] = MFMA16(__builtin_bit_cast(bf16x8, qa), __builtin_bit_cast(bf16x8, sb), o[mb2]); } } \
        { unsigned short vs[8]; \
            _Pragma("unroll") for (int j = 0; j < 8; ++j) vs[j] = *(const LAS unsigned short*)(B + VOFF + (8 * q + j) * VROW + col * 2); \
            u32x4 vb; vb.x = vs[0] | ((unsigned)vs[1] << 16); vb.y = vs[2] | ((unsigned)vs[3] << 16); vb.z = vs[4] | ((unsigned)vs[5] << 16); vb.w = vs[6] | ((unsigned)vs[7] << 16); \
            _Pragma("unroll") for (int mb = 0; mb < NMB; ++mb) { \
                const u32x4 ka = *(const LAS u32x4*)(B + KOFF + (16 * mb + n) * 80 + q * 16); \
                const f32x4 dv = *(const LAS f32x4*)(B + DOFF + (16 * mb + 4 * q) * 4); \
                S[mb] = S[mb] * dv; \
                S[mb] = MFMA16(__builtin_bit_cast(bf16x8, ka), __builtin_bit_cast(bf16x8, vb), S[mb]); } } \
        bf16_t* ob = c.OX + (size_t)(row0 + 32 * (ci)) * 1024 + ocol; \
        _Pragma("unroll") for (int x = 0; x < 8; x += 2) { \
            const int t = 16 * (x >> 2) + 4 * q + (x & 3); const unsigned pv = pk_bf16(o[x >> 2][x & 3], o[x >> 2][(x & 3) + 1]); \
            bf16_t* d0 = t < ntok ? ob + (size_t)t * 1024 : c.DUMP + tid; bf16_t* d1 = t + 1 < ntok ? ob + (size_t)(t + 1) * 1024 : c.DUMP + tid; \
            *d0 = (bf16_t)(pv & 0xffffu); *d1 = (bf16_t)(pv >> 16); } \
        } \
        WG_BAR(); \
        SEQ_STORE(RST, buf); \
    } while (0)
    Stage R0, R1, R2, R3;
    SEQ_LOAD(R0, 0); SEQ_STORE(R0, 0);
    SEQ_LOAD(R1, 1); SEQ_LOAD(R2, 2); SEQ_LOAD(R3, 3); SEQ_LOAD(R0, 4);
    SEQ_STORE(R1, 1);
    WG_BAR();
    for (int ci = 0; ci < nch; ci += 4) {
        SEQ_LOAD(R1, ci + 5); SEQ_ITER(ci, 0, R2);
        if (ci + 1 >= nch) break;
        SEQ_LOAD(R2, ci + 6); SEQ_ITER(ci + 1, 1, R3);
        if (ci + 2 >= nch) break;
        SEQ_LOAD(R3, ci + 7); SEQ_ITER(ci + 2, 0, R0);
        if (ci + 3 >= nch) break;
        SEQ_LOAD(R0, ci + 8); SEQ_ITER(ci + 3, 1, R1);
    }
    if (cw) {
#pragma unroll
    for (int mb = 0; mb < NMB; ++mb)
#pragma unroll
        for (int i = 0; i < 4; ++i) Sout[(size_t)(16 * mb + 4 * q + i) * 128 + col] = S[mb][i];
    }
    WG_BAR();
#undef SEQ_LOAD
#undef SEQ_STORE
#undef SEQ_ITER
}
__device__ __forceinline__ void seq_dispatch(const Ptrs& c, LAS unsigned char* lds, int item, int tid, int wave, int lane) {
    int row0, nch, ntok, h8, colbase, ncw; const float* S0; float* Sout; const bf16_t* kdt0; int kst; size_t kcs, dcs; const float* dch0;
    if (item < 128) {
        const int bh = item >> 1, b = bh >> 3; h8 = bh & 7; const int hh = h8 & 3; row0 = b * 2048; nch = 64; ntok = 32; S0 = nullptr; colbase = (item & 1) * 64; ncw = 4;
        Sout = h8 < 4 ? c.out + OUT_SAP + (size_t)(b * 4 + hh) * 64 * 128 : c.out + OUT_SBP + (size_t)(b * 4 + hh) * 128 * 128;
        kdt0 = c.P + (size_t)row0 * PLD + (h8 < 4 ? 256 + hh * 64 : 2048 + hh * 128); kst = PLD; kcs = (size_t)32 * PLD;
        dch0 = c.DCH + (size_t)(b * 64 * 8 + h8) * 128; dcs = 8 * 128;
    } else {
        const int j = item - 128, b = j >> 3; h8 = j & 7; const int hh = h8 & 3; row0 = MP + b * 8; nch = 1; ntok = 8; colbase = 0; ncw = 8;
        S0 = h8 < 4 ? c.in[2] + (size_t)(b * 4 + hh) * 64 * 128 : c.in[3] + (size_t)(b * 4 + hh) * 128 * 128;
        Sout = h8 < 4 ? c.out + OUT_SAS + (size_t)(b * 4 + hh) * 64 * 128 : c.out + OUT_SBS + (size_t)(b * 4 + hh) * 128 * 128;
        kdt0 = c.KDTS + (size_t)j * 4096; kst = h8 < 4 ? 64 : 128; kcs = 0; dch0 = c.DCH + (size_t)(4096 + j) * 128; dcs = 0;
    }
    if (h8 < 4) seq_item<64>(c, lds, row0, nch, ntok, h8, colbase, ncw, S0, Sout, kdt0, kst, kcs, dch0, dcs, tid, wave, lane);
    else seq_item<128>(c, lds, row0, nch, ntok, h8, colbase, ncw, S0, Sout, kdt0, kst, kcs, dch0, dcs, tid, wave, lane);
}
__device__ __forceinline__ void p3b_finalize(const Ptrs& c, int G, int wave, int lane) {
    const int gw = blockIdx.x * NWAVES + wave, NGW = G * NWAVES, h8 = lane >> 3, cw = (lane & 7) * 16;
    const float* gp = (h8 < 4 ? c.in[9] : c.in[10]) + cw;
    f32x4 gn[4];
#pragma unroll
    for (int j = 0; j < 4; ++j) gn[j] = *(const f32x4*)(gp + 4 * j);
    const int gcol = (h8 < 4 ? 1024 + h8 * 128 : 3072 + (h8 - 4) * 128) + cw;
    for (int m = gw; m < M; m += NGW) {
        f32x4 o[4]; u32x4 x[2], g[2], oi[2];
#pragma unroll
        for (int j = 0; j < 2; ++j) { oi[j] = *(const u32x4*)(c.OI + (size_t)m * 1024 + lane * 16 + 8 * j); x[j] = *(const u32x4*)(c.OX + (size_t)m * 1024 + lane * 16 + 8 * j); g[j] = *(const u32x4*)(c.P + (size_t)m * PLD + gcol + 8 * j); }
        o[0][0] = bf_lo(oi[0].x); o[0][1] = bf_hi(oi[0].x); o[0][2] = bf_lo(oi[0].y); o[0][3] = bf_hi(oi[0].y); o[1][0] = bf_lo(oi[0].z); o[1][1] = bf_hi(oi[0].z); o[1][2] = bf_lo(oi[0].w); o[1][3] = bf_hi(oi[0].w);
        o[2][0] = bf_lo(oi[1].x); o[2][1] = bf_hi(oi[1].x); o[2][2] = bf_lo(oi[1].y); o[2][3] = bf_hi(oi[1].y); o[3][0] = bf_lo(oi[1].z); o[3][1] = bf_hi(oi[1].z); o[3][2] = bf_lo(oi[1].w); o[3][3] = bf_hi(oi[1].w);
        float ss = 0.f;
#pragma unroll
        for (int j = 0; j < 4; ++j) {
            const unsigned w0 = j < 2 ? (j == 0 ? x[0].x : x[0].z) : (j == 2 ? x[1].x : x[1].z), w1 = j < 2 ? (j == 0 ? x[0].y : x[0].w) : (j == 2 ? x[1].y : x[1].w);
            o[j][0] += bf_lo(w0); o[j][1] += bf_hi(w0); o[j][2] += bf_lo(w1); o[j][3] += bf_hi(w1);
            ss += (o[j][0] * o[j][0] + o[j][1] * o[j][1]) + (o[j][2] * o[j][2] + o[j][3] * o[j][3]);
        }
        ss += dpp_f<0xB1, 0xF>(ss); ss += dpp_f<0x4E, 0xF>(ss); ss += dpp_f<0x141, 0xF>(ss);
        const float rs = __builtin_amdgcn_rsqf(ss * (1.0f / 128.0f) + EPS);
        u32x4 w[2];
#pragma unroll
        for (int j = 0; j < 4; ++j) {
            const unsigned g0 = j < 2 ? (j == 0 ? g[0].x : g[0].z) : (j == 2 ? g[1].x : g[1].z), g1 = j < 2 ? (j == 0 ? g[0].y : g[0].w) : (j == 2 ? g[1].y : g[1].w);
            float gg[4] = {bf_lo(g0), bf_hi(g0), bf_lo(g1), bf_hi(g1)}, v[4];
#pragma unroll
            for (int e = 0; e < 4; ++e) v[e] = o[j][e] * rs * gn[j][e] * (gg[e] * __builtin_amdgcn_rcpf(1.0f + __expf(-gg[e])));
            const unsigned p0 = pk_bf16(v[0], v[1]), p1 = pk_bf16(v[2], v[3]);
            if (j == 0) { w[0].x = p0; w[0].y = p1; } else if (j == 1) { w[0].z = p0; w[0].w = p1; } else if (j == 2) { w[1].x = p0; w[1].y = p1; } else { w[1].z = p0; w[1].w = p1; }
        }
        *(u32x4*)(c.OF + (size_t)m * 1024 + lane * 16) = w[0]; *(u32x4*)(c.OF + (size_t)m * 1024 + lane * 16 + 8) = w[1];
    }
}
#define XB_TMO      128
#define XB_XCNT(j)  (256  + 64 * (j))
#define XB_XSUB(j)  (1280 + 64 * (j))
#define XB_XGEN(j)  (2304 + 64 * (j))
#define XB_TOP      3328
#define XB_TOPGEN   3392
#define XCD_BAR_WORDS 3456
#define XB_SPIN_CAP (1u << 18)

__device__ __forceinline__ unsigned xb_ld(unsigned* p)              { return __hip_atomic_load(p, __ATOMIC_RELAXED, __HIP_MEMORY_SCOPE_AGENT); }
__device__ __forceinline__ unsigned xb_add(unsigned* p, unsigned v) { return __hip_atomic_fetch_add(p, v, __ATOMIC_RELAXED, __HIP_MEMORY_SCOPE_AGENT); }
__device__ __forceinline__ unsigned xb_xcc_id() { return (unsigned)__builtin_amdgcn_s_getreg((3 << 11) | 20) & 0xFu; }
#define XB_SPIN(cond, bar) do { unsigned _sp = 0; while (cond) { __builtin_amdgcn_s_sleep(1); \
    if ((++_sp & 255u) == 0u) { if (xb_ld(&(bar)[XB_TMO])) break; if (_sp > XB_SPIN_CAP) { atomicAdd(&(bar)[XB_TMO], 1u); break; } } } } while (0)

struct XcdBarrier {
    unsigned* bar; unsigned x;
    volatile LAS unsigned* st;
};

__device__ __forceinline__ XcdBarrier xcd_barrier_post(unsigned* bar, volatile LAS unsigned* st) {
    XcdBarrier b; b.bar = bar; b.x = xb_xcc_id(); b.st = st;
    if (threadIdx.x == 0) (void)xb_add(&bar[XB_XCNT(b.x)], 1u);
    return b;
}
__device__ __forceinline__ void xcd_barrier_complete(unsigned* bar, unsigned x, unsigned& nloc, unsigned& nx) {
    const unsigned G = gridDim.x * gridDim.y * gridDim.z;
    unsigned sum, cnt, mine, sp = 0u;
    for (;;) {
        sum = 0u; cnt = 0u; mine = 0u;
#pragma unroll
        for (unsigned j = 0; j < 16; ++j) { const unsigned c = xb_ld(&bar[XB_XCNT(j)]); sum += c; cnt += (c > 0u) ? 1u : 0u; mine = (j == x) ? c : mine; }
        if (sum == G) break;
        __builtin_amdgcn_s_sleep(1);
        if ((++sp & 255u) == 0u) { if (xb_ld(&bar[XB_TMO])) break; if (sp > XB_SPIN_CAP) { atomicAdd(&bar[XB_TMO], 1u); break; } }
    }
    nloc = mine > 0u ? mine : 1u; nx = cnt > 0u ? cnt : 1u;
}

__device__ __forceinline__ void xcd_barrier(const XcdBarrier& b) {
    asm volatile("s_waitcnt vmcnt(0)" ::: "memory");
    __syncthreads();
    if (threadIdx.x == 0) {
        unsigned* bar = b.bar;
        __builtin_amdgcn_s_waitcnt(0);
        unsigned nloc = b.st[0], nx = b.st[1];
        if (nloc == 0u) { xcd_barrier_complete(bar, b.x, nloc, nx); b.st[0] = nloc; b.st[1] = nx; }
        const unsigned old = xb_add(&bar[XB_XSUB(b.x)], 1u);
        const unsigned gen = old / nloc;
        if (old + 1u == (gen + 1u) * nloc) {
            __builtin_amdgcn_fence(__ATOMIC_RELEASE, "agent");
            asm volatile("s_waitcnt vmcnt(0)" ::: "memory");
            const unsigned og = xb_add(&bar[XB_TOP], 1u);
            const unsigned tg = og / nx;
            if (og + 1u == (tg + 1u) * nx) xb_add(&bar[XB_TOPGEN], 1u);
            else XB_SPIN(xb_ld(&bar[XB_TOPGEN]) == tg, bar);
            __builtin_amdgcn_fence(__ATOMIC_ACQUIRE, "agent");
            xb_add(&bar[XB_XGEN(b.x)], 1u);
            asm volatile("s_waitcnt vmcnt(0)" ::: "memory");
        } else {
            XB_SPIN(xb_ld(&bar[XB_XGEN(b.x)]) == gen, bar);
            __builtin_amdgcn_fence(__ATOMIC_ACQUIRE, "agent");
            asm volatile("s_waitcnt vmcnt(0)" ::: "memory");
        }
    }
    __syncthreads();
}


struct EpiRes2Norm {
    static constexpr bool PERM = true, AFTER_DRAIN = true;
    float* Y; float* SSQ; const float* gfin; XcdBarrier xb;
    __device__ __forceinline__ void fused(pg8::f32x4 (&acc)[2][2][4][2], const pg8::Unit& u, int wr, int wc, int fr, int fq, LAS unsigned char* lds, int wid, int lane) const {
        using pg8::BM; using pg8::HALF;
        const int row0 = u.pm * BM + wr * 64 + fr, ct = u.pn * BM + wc * 32 + 8 * fq;
#pragma unroll
        for (int ai = 0; ai < 2; ++ai)
#pragma unroll
            for (int m = 0; m < 4; ++m) {
                const int row = row0 + ai * HALF + m * 16; const float* yr = Y + (size_t)row * 1024; float ss = 0.f;
#pragma unroll
                for (int bj = 0; bj < 2; ++bj) {
                    const int col = ct + bj * HALF;
                    acc[ai][bj][m][0] += *(const f32x4*)(yr + col); acc[ai][bj][m][1] += *(const f32x4*)(yr + col + 4);
                    const f32x4 v0 = acc[ai][bj][m][0], v1 = acc[ai][bj][m][1];
                    ss += (v0[0] * v0[0] + v0[1] * v0[1]) + (v0[2] * v0[2] + v0[3] * v0[3]) + (v1[0] * v1[0] + v1[1] * v1[1]) + (v1[2] * v1[2] + v1[3] * v1[3]);
                }
                ss += __shfl_xor(ss, 16); ss += __shfl_xor(ss, 32);
                if (fq == 0) SSQ[(size_t)row * 16 + u.pn * 4 + wc] = ss;
            }
        xcd_barrier(xb);
#pragma unroll
        for (int ai = 0; ai < 2; ++ai)
#pragma unroll
            for (int m = 0; m < 4; ++m) {
                const int row = row0 + ai * HALF + m * 16; float* yr = Y + (size_t)row * 1024;
                const f32x4* sp = (const f32x4*)(SSQ + (size_t)row * 16);
                const f32x4 s0 = sp[0], s1 = sp[1], s2 = sp[2], s3 = sp[3];
                const float tot = ((s0[0] + s0[1]) + (s0[2] + s0[3])) + ((s1[0] + s1[1]) + (s1[2] + s1[3])) + ((s2[0] + s2[1]) + (s2[2] + s2[3])) + ((s3[0] + s3[1]) + (s3[2] + s3[3]));
                const float rs = __builtin_amdgcn_rsqf(tot * (1.0f / 1024.0f) + EPS);
#pragma unroll
                for (int bj = 0; bj < 2; ++bj) {
                    const int col = ct + bj * HALF;
                    *(f32x4*)(yr + col) = acc[ai][bj][m][0] * rs * *(const f32x4*)(gfin + col); *(f32x4*)(yr + col + 4) = acc[ai][bj][m][1] * rs * *(const f32x4*)(gfin + col + 4);
                }
            }
    }
};

struct Args { const float* in[17]; float* out; unsigned char* ws; int ph_lo, ph_hi, aux, pad; };
constexpr int NPHASE = 9;
__device__ __forceinline__ void fill_ptrs(Ptrs& c, const Args& args) {
#pragma unroll
    for (int i = 0; i < 17; ++i) c.in[i] = args.in[i];
    c.out = args.out;
    unsigned char* ws = args.ws;
    c.WinT = (bf16_t*)(ws + WS_WIN); c.WoT = (bf16_t*)(ws + WS_WO); c.W13T = (bf16_t*)(ws + WS_W13); c.W2T = (bf16_t*)(ws + WS_W2);
    c.XB = (bf16_t*)(ws + WS_XB); c.OF = (bf16_t*)(ws + WS_XB); c.P = (bf16_t*)(ws + WS_P); c.HID = (bf16_t*)(ws + WS_P); c.KDTS = (bf16_t*)(ws + WS_KDTS);
    c.X1B = (bf16_t*)(ws + WS_FB); c.FB = (float*)(ws + WS_FB);
    c.RSTD1 = (float*)(ws + WS_RSTD1); c.SSQ2 = (float*)(ws + WS_SSQ2); c.LRA = (float*)(ws + WS_LRA); c.DCH = (float*)(ws + WS_DCH); c.OY = args.out + OUT_Y; c.DUMP = (bf16_t*)(ws + 30 * MiB); c.OX = (bf16_t*)(ws + WS_FB); c.OI = (bf16_t*)(ws + WS_XB); c.PART = (float*)(ws + 208 * MiB); c.PART4 = (float*)(ws + WS_P); c.SSQ3 = (float*)(ws + 30 * MiB + 65536);
}

__global__ void __launch_bounds__(NTHR, 2) hymba_fwd(Args args) {
    extern __shared__ __attribute__((aligned(16))) unsigned char lds_raw[];
    LAS unsigned char* lds = (LAS unsigned char*)lds_raw;
    const int tid = threadIdx.x, lane = tid & 63, wave = __builtin_amdgcn_readfirstlane(tid >> 6), G = gridDim.x;
    unsigned char* ws = args.ws;
    const int lo = args.ph_lo, hi = args.ph_hi;
    volatile LAS unsigned* xst = (volatile LAS unsigned*)(lds + 160256);
    if (tid == 0) { xst[0] = 0u; xst[1] = 0u; }
    __syncthreads();
    XcdBarrier xbar; xbar.bar = (unsigned*)(ws + WS_BAR); xbar.x = 0; xbar.st = xst;
    if (hi - lo > 1) xbar = xcd_barrier_post((unsigned*)(ws + WS_BAR), xst);
#define IN(k) (lo <= (k) && (k) < hi)
#define SEAM(k) do { if (IN(k) && IN((k) + 1)) { if (args.pad != 0) cg::this_grid().sync(); else xcd_barrier(xbar); } } while (0)
    if (IN(0)) { Ptrs c; fill_ptrs(c, args); p0_prologue(c, lds, G, wave, lane, G != 256); }
    SEAM(0);
    if (IN(1)) { Ptrs c; fill_ptrs(c, args);
        pg8::Gemm g{c.XB, c.WinT, M, NIN, D}; pg8::StaticOrder S; S.init(M, NIN, G, (int)blockIdx.x, D);
        pg8::EpiIn E{c.P, c.FB, c.LRA, c.RSTD1};
        pg8::gemm_phase<pg8::EpiIn, pg8::StaticOrder, true, true>(lds, g, S, E);
    }
    SEAM(1);
    if (IN(2)) { Ptrs c; fill_ptrs(c, args); p2_prepass(c, lds, G, tid, wave, lane, args.aux != 0); }
    SEAM(2);
    if (IN(3)) { Ptrs c; fill_ptrs(c, args);
        const int wg = blockIdx.x;
        if (G >= 256) {
            if (wg < 128) seq_dispatch(c, lds, wg, tid, wave, lane);
            else for (int j = wg - 128; j < 1024; j += G - 128) seq_dispatch(c, lds, 128 + j, tid, wave, lane);
        }
        else for (int it = wg; it < 128 + 1024; it += G) seq_dispatch(c, lds, it, tid, wave, lane);
    }
    SEAM(3);
    if (IN(4)) { Ptrs c; fill_ptrs(c, args); p3b_finalize(c, G, wave, lane); }
    SEAM(4);
    if (IN(5)) { Ptrs c; fill_ptrs(c, args);
        pg8::Gemm g{c.OF, c.WoT, M, D, D};
        { pg8::StaticOrder S; S.init(MP, D, G, (int)blockIdx.x, D); pg8::EpiRes1 E{c.in[0], c.in[1], c.OY, c.X1B, c.SSQ2};
          pg8::gemm_phase<pg8::EpiRes1, pg8::StaticOrder, true, true>(lds, g, S, E); }
        { pg8::TailOrder S{G, (int)blockIdx.x, 8, D / 64, MP / 256, 4, 16}; pg8::EpiPart E{c.PART4, MP, 1.f};
          pg8::gemm_phase<pg8::EpiPart, pg8::TailOrder, true, true>(lds, g, S, E); }
        if (hi - lo > 1) xcd_barrier(xbar);
        {
            const int gw = blockIdx.x * NWAVES + wave, NGW = G * NWAVES;
            for (int r = gw; r < MS; r += NGW) {
                const int m = MP + r; f32x4 v[4]; float ss = 0.f;
#pragma unroll
                for (int j = 0; j < 4; ++j) v[j] = *(const f32x4*)(c.in[1] + (size_t)r * D + 4 * lane + 256 * j);
#pragma unroll 1
                for (int ks = 0; ks < 8; ++ks)
#pragma unroll
                    for (int j = 0; j < 4; ++j) v[j] += *(const f32x4*)(c.PART4 + ((size_t)ks * 1024 + r) * 1024 + 4 * lane + 256 * j);
#pragma unroll
                for (int j = 0; j < 4; ++j) {
                    *(f32x4*)(c.OY + (size_t)m * D + 4 * lane + 256 * j) = v[j];
                    u32x2 w; w.x = pk_bf16(v[j][0], v[j][1]); w.y = pk_bf16(v[j][2], v[j][3]); *(u32x2*)(c.X1B + (size_t)m * D + 4 * lane + 256 * j) = w;
                    ss += (v[j][0] * v[j][0] + v[j][1] * v[j][1]) + (v[j][2] * v[j][2] + v[j][3] * v[j][3]);
                }
                ss = wave_sum(ss);
                if (lane < 16) c.SSQ2[(size_t)m * 16 + lane] = lane == 0 ? ss : 0.f;
            }
        }
    }
    SEAM(5);
    if (IN(6)) { Ptrs c; fill_ptrs(c, args);
        pg8::Gemm g{c.X1B, c.W13T, M, NUP, D}; pg8::StaticOrder S; S.init(M, NUP, G, (int)blockIdx.x, D);
        pg8::EpiSwiglu E{c.HID, c.SSQ2};
        pg8::gemm_phase<pg8::EpiSwiglu, pg8::StaticOrder, true, true>(lds, g, S, E);
    }
    SEAM(6);
    if (IN(7)) { Ptrs c; fill_ptrs(c, args);
        pg8::Gemm g{c.HID, c.W2T, M, D, FF};
        if (G == 256 && hi - lo > 1) {
            pg8::StaticOrder S; S.init(MP, D, G, (int)blockIdx.x, FF); EpiRes2Norm E{c.OY, c.SSQ3, c.in[16], xbar};
            pg8::gemm_phase<EpiRes2Norm, pg8::StaticOrder, true, true>(lds, g, S, E);
        } else {
            pg8::StaticOrder S; S.init(MP, D, G, (int)blockIdx.x, FF); pg8::EpiRes2 E{c.OY, args.aux ? 0.f : 1.f};
            pg8::gemm_phase<pg8::EpiRes2, pg8::StaticOrder, true, true>(lds, g, S, E);
        }
        { pg8::TailOrder S{G, (int)blockIdx.x, 11, FF / 64, MP / 256, 4, 16}; pg8::EpiPart E{c.PART, MP, args.aux ? 0.f : 1.f};
          pg8::gemm_phase<pg8::EpiPart, pg8::TailOrder, true, true>(lds, g, S, E); }
    }
    SEAM(7);
    if (IN(8)) { Ptrs c; fill_ptrs(c, args);
        const int NGW = G * NWAVES, gw = blockIdx.x * NWAVES + wave + ((G == 256 && hi - lo > 1) ? MP : 0);
        f32x4 gn[4];
#pragma unroll
        for (int j = 0; j < 4; ++j) gn[j] = *(const f32x4*)(c.in[16] + 4 * lane + 256 * j);
        f32x4 v[4], nv[4];
        { const int m0 = gw < M ? gw : M - 1;
#pragma unroll
          for (int j = 0; j < 4; ++j) v[j] = *(const f32x4*)(c.OY + (size_t)m0 * D + 4 * lane + 256 * j); }
#define ADD_PARTS(vv, mm) do { if ((mm) >= MP) { _Pragma("unroll 1") for (int ks = 0; ks < 11; ++ks) { _Pragma("unroll") for (int j = 0; j < 4; ++j) \
            vv[j] += *(const f32x4*)(c.PART + ((size_t)ks * 1024 + ((mm) - MP)) * 1024 + 4 * lane + 256 * j); } } } while (0)
        { const int m0 = gw < M ? gw : M - 1; ADD_PARTS(v, m0); }
        for (int m = gw; m < M; m += NGW) {
            float* yr = c.OY + (size_t)m * D; float s = 0.f;
            { const int mn = m + NGW < M ? m + NGW : m;
#pragma unroll
              for (int j = 0; j < 4; ++j) nv[j] = *(const f32x4*)(c.OY + (size_t)mn * D + 4 * lane + 256 * j);
              ADD_PARTS(nv, mn); }
#pragma unroll
            for (int j = 0; j < 4; ++j) s += (v[j][0] * v[j][0] + v[j][1] * v[j][1]) + (v[j][2] * v[j][2] + v[j][3] * v[j][3]);
            const float rs = __builtin_amdgcn_rsqf(wave_sum(s) * (1.0f / D) + EPS);
#pragma unroll
            for (int j = 0; j < 4; ++j) *(f32x4*)(yr + 4 * lane + 256 * j) = args.aux ? v[j] : v[j] * rs * gn[j];
#pragma unroll
            for (int j = 0; j < 4; ++j) v[j] = nv[j];
        }
    }
#undef IN
#undef SEAM
}

extern "C" void kernel_launch(void* const* d_in, const int* in_sizes, int n_in, void* d_out, int out_size, void* d_ws, size_t ws_size, hipStream_t stream) {
    static int grid = 0;
    if (grid == 0) {
        if (n_in != 17 || ws_size < WS_END) { fprintf(stderr, "kernel_launch: unexpected n_in %d / ws %zu\n", n_in, ws_size); grid = -1; return; }
        int dev = 0, cus = 0, per_cu = 0;
        (void)hipGetDevice(&dev); (void)hipDeviceGetAttribute(&cus, hipDeviceAttributeMultiprocessorCount, dev);
        if (hipFuncSetAttribute((const void*)hymba_fwd, hipFuncAttributeMaxDynamicSharedMemorySize, LDS_BYTES) != hipSuccess) { fprintf(stderr, "kernel_launch: hipFuncSetAttribute failed\n"); grid = -1; return; }
        if (hipOccupancyMaxActiveBlocksPerMultiprocessor(&per_cu, (const void*)hymba_fwd, NTHR, LDS_BYTES) != hipSuccess || per_cu < 1) { fprintf(stderr, "kernel_launch: occupancy query says %d\n", per_cu); per_cu = 1; }
        (void)hipGetLastError();
        grid = cus * per_cu;
        if (grid <= 0) grid = 256;
    }
    if (grid < 0) return;
    if (hipMemsetAsync((char*)d_ws + WS_BAR, 0, 16384, stream) != hipSuccess) { fprintf(stderr, "kernel_launch: memset failed\n"); return; }
    Args a{};
    for (int i = 0; i < 17; ++i) a.in[i] = (const float*)d_in[i];
    a.out = (float*)d_out; a.ws = (unsigned char*)d_ws;
    if (MK_N_LAUNCHES == 1) {
        a.ph_lo = 0; a.ph_hi = NPHASE;
        void* kargs[] = {&a};
        hipError_t e = hipLaunchCooperativeKernel((const void*)hymba_fwd, dim3(grid), dim3(NTHR), kargs, LDS_BYTES, stream);
        if (e != hipSuccess) fprintf(stderr, "kernel_launch: cooperative launch failed: %s (grid %d)\n", hipGetErrorString(e), grid);
    } else {
        for (int p = 0; p < NPHASE; ++p) { a.ph_lo = p; a.ph_hi = p + 1; const int nrep = ((REP_MASK >> p) & 1) ? 3 : 1;
            for (int rr = 0; rr < nrep; ++rr) { a.aux = ((p == 2 || p == 7 || p == 8) && rr + 1 < nrep) ? 1 : 0; hipLaunchKernelGGL(hymba_fwd, dim3(grid), dim3(NTHR), LDS_BYTES, stream, a); } }
    }
}
```

```cpp
#include <hip/hip_runtime.h>
#include <hip/hip_cooperative_groups.h>
#include <cstdio>
#include <cstdint>
namespace cg = cooperative_groups;
namespace pg8 {
#define PG8_LAS __attribute__((address_space(3)))
typedef unsigned short bf16_t;
typedef short bf16x8 __attribute__((ext_vector_type(8)));
typedef float f32x4 __attribute__((ext_vector_type(4)));
typedef unsigned u32x4 __attribute__((ext_vector_type(4)));
constexpr int BM = 256, BK = 64, HALF = 128, HTB = HALF * BK * 2  , STAGE_BYTES = 8 * HTB, NXCD = 8, WGM = 8;

__host__ __device__ __forceinline__ int lds_byte(int r, int c) { const int st = (r >> 4) * 2 + (c >> 5), rr = r & 15, cc = c & 31, ob = rr * 64 + cc * 2; return st * 1024 + (ob ^ (((ob >> 9) & 1) << 5)); }
__host__ __device__ __forceinline__ void stage_rc(int b, int& R, int& C) { const int st = b / 1024, sb = b % 1024, swz = sb ^ (((sb >> 9) & 1) << 5); R = (st >> 1) * 16 + swz / 64; C = (st & 1) * 32 + (swz % 64) / 2; }
__host__ __device__ __forceinline__ int perm32(int rho) { const int n = rho >> 4, i = rho & 15; return 8 * (i >> 2) + 4 * n + (i & 3); }

struct Unit { int pm, pn, k0, nk; };
struct Gemm { const bf16_t* A; const bf16_t* Bt; int M, N, K; };

struct StaticOrder {
    int nM, nN, nwg, G, c, nkt;
    __host__ __device__ void init(int M, int N, int G_, int c_, int K_) { nM = M / BM; nN = N / BM; nwg = nM * nN; G = G_; c = c_; nkt = K_ / BK; }
    __host__ __device__ bool next(int i, Unit& u) const { return at((long)i * G + c, u); }
    __host__ __device__ bool at(long L, Unit& u) const {
        if (L >= nwg) return false;
        int wgid = (int)L; { const int q = nwg / NXCD, r = nwg % NXCD, xcd = wgid % NXCD, off = wgid / NXCD; wgid = (xcd < r ? xcd * (q + 1) : r * (q + 1) + (xcd - r) * q) + off; }
        const int nig = WGM * nN, gid = wgid / nig, fm = gid * WGM, gsz = (nM - fm) < WGM ? (nM - fm) : WGM;
        u.pm = fm + ((wgid % nig) % gsz); u.pn = (wgid % nig) / gsz; u.k0 = 0; u.nk = nkt; return true;
    }
    __device__ __forceinline__ void a_ready(const Unit&) const {}
    __device__ __forceinline__ void done(const Unit&) const {}
};


struct TailOrder {
    int G, c, NS, nkt, pm0, nN, ntu;
    __host__ __device__ bool next(int i, Unit& u) const {
        const int id = i * G + c; if (id >= ntu * NS) return false;
        const int tu = id / NS, ks = id % NS; u.pm = pm0 + tu / nN; u.pn = tu % nN; u.nk = nkt / NS; u.k0 = ks * u.nk; return true;
    }
    __device__ __forceinline__ void a_ready(const Unit&) const {}
    __device__ __forceinline__ void done(const Unit&) const {}
};

__device__ __forceinline__ unsigned cvt_pk_bf16(float lo, float hi) { unsigned r; asm volatile("v_cvt_pk_bf16_f32 %0, %1, %2" : "=v"(r) : "v"(lo), "v"(hi)); return r; }
typedef float f32x2 __attribute__((ext_vector_type(2)));

template <class Epi, class Sched, bool ALIGN_EPI = false, bool SP2 = false>
__device__ __forceinline__ void gemm_phase(PG8_LAS unsigned char* lds, const Gemm g, const Sched& S, const Epi& E) {
    const int tid = threadIdx.x, wid = __builtin_amdgcn_readfirstlane(tid >> 6), lane = tid & 63, wr = wid >> 2, wc = wid & 3, fr = lane & 15, fq = lane >> 4;
    const int K = g.K, nt = K / BK;
    unsigned voffA[2], voffB[2];
#pragma unroll
    for (int i = 0; i < 2; ++i) { int R, C; stage_rc(tid * 16 + i * 8192, R, C); const int Rb = Epi::PERM ? ((R & ~31) + perm32(R & 31)) : R;
        voffA[i] = (unsigned)(R * K + C) * 2u; voffB[i] = (unsigned)(Rb * K + C) * 2u; }
    const size_t kstep = (size_t)(BK * 2);
    const size_t hstep = (size_t)HALF * K * 2;
    const size_t tstep = 2 * hstep;
    const unsigned ldsw = (unsigned)wid * 1024u;
    const int aoff = lds_byte(wr * 64 + fr, fq * 8), boff = lds_byte(wc * 32 + fr, fq * 8);
#define PG8_SA(b, h) (((b) * 2 + (h)) * HTB)
#define PG8_SB(b, h) ((4 + (b) * 2 + (h)) * HTB)
#define PG8_STAGE(bufoff, gbase, voff) do { _Pragma("unroll") for (int _i = 0; _i < 2; ++_i) \
        __builtin_amdgcn_global_load_lds((const unsigned*)((const char*)(gbase) + (voff)[_i]), (PG8_LAS unsigned*)(lds + (bufoff) + ldsw + _i * 8192), 16, 0, 0); } while (0)
#define PG8_LDA(dst, b, h) do { _Pragma("unroll") for (int m = 0; m < 4; ++m) _Pragma("unroll") for (int k = 0; k < 2; ++k) dst[m][k] = *(const PG8_LAS bf16x8*)(lds + PG8_SA(b, h) + aoff + m * 2048 + k * 1024); } while (0)
#define PG8_LDB(dst, b, h) do { _Pragma("unroll") for (int n = 0; n < 2; ++n) _Pragma("unroll") for (int k = 0; k < 2; ++k) dst[n][k] = *(const PG8_LAS bf16x8*)(lds + PG8_SB(b, h) + boff + n * 2048 + k * 1024); } while (0)
#define PG8_MMA(ai, bj, At, Bt) do { __builtin_amdgcn_s_setprio(1); _Pragma("unroll") for (int m = 0; m < 4; ++m) _Pragma("unroll") for (int n = 0; n < 2; ++n) _Pragma("unroll") for (int k = 0; k < 2; ++k) \
        acc[ai][bj][m][n] = __builtin_amdgcn_mfma_f32_16x16x32_bf16(Bt[n][k], At[m][k], acc[ai][bj][m][n], 0, 0, 0); __builtin_amdgcn_s_setprio(0); } while (0)
#define PG8_WAIT_V(n) asm volatile("s_waitcnt vmcnt(" #n ")" ::: "memory")
#define PG8_WAIT_L(n) asm volatile("s_waitcnt lgkmcnt(" #n ")" ::: "memory")
#define PG8_BAR __builtin_amdgcn_s_barrier()
#define PG8_SCHED __builtin_amdgcn_sched_barrier(0)
    Unit cur, nxt; int ui = 0;
    if (!S.next(0, cur)) return;
    f32x4 acc[2][2][4][2];
#pragma unroll
    for (int a = 0; a < 2; ++a)
#pragma unroll
        for (int b = 0; b < 2; ++b)
#pragma unroll
            for (int m = 0; m < 4; ++m)
#pragma unroll
                for (int n = 0; n < 2; ++n) acc[a][b][m][n] = (f32x4){0.f, 0.f, 0.f, 0.f};
    bf16x8 At[4][2], B0[2][2], B1[2][2];
    const char* cA = (const char*)g.A + (size_t)cur.pm * tstep + (size_t)cur.k0 * kstep; const char* cB = (const char*)g.Bt + (size_t)cur.pn * tstep + (size_t)cur.k0 * kstep;
    S.a_ready(cur);
    if constexpr (SP2) {
        PG8_STAGE(PG8_SB(0, 0), cB, voffB); PG8_STAGE(PG8_SB(0, 1), cB + hstep, voffB); PG8_STAGE(PG8_SA(0, 0), cA, voffA); PG8_STAGE(PG8_SA(0, 1), cA + hstep, voffA);
        if (wr == 1) PG8_BAR;
        PG8_WAIT_V(2); PG8_BAR;
        PG8_STAGE(PG8_SB(1, 0), cB + kstep, voffB); PG8_STAGE(PG8_SA(1, 0), cA + kstep, voffA); PG8_STAGE(PG8_SB(1, 1), cB + hstep + kstep, voffB);
        PG8_WAIT_V(6); PG8_BAR;
    } else {
        PG8_STAGE(PG8_SB(0, 0), cB, voffB); PG8_STAGE(PG8_SA(0, 0), cA, voffA); PG8_STAGE(PG8_SB(0, 1), cB + hstep, voffB); PG8_STAGE(PG8_SA(0, 1), cA + hstep, voffA);
        if (wr == 1) PG8_BAR;
        PG8_WAIT_V(4); PG8_BAR;
        PG8_STAGE(PG8_SB(1, 0), cB + kstep, voffB); PG8_STAGE(PG8_SA(1, 0), cA + kstep, voffA); PG8_STAGE(PG8_SB(1, 1), cB + hstep + kstep, voffB);
        PG8_WAIT_V(6); PG8_BAR;
    }
    for (;;) {
        const bool has_next = S.next(ui + 1, nxt);
        const char* nA = has_next ? (const char*)g.A + (size_t)nxt.pm * tstep + (size_t)nxt.k0 * kstep : cA; const char* nB = has_next ? (const char*)g.Bt + (size_t)nxt.pn * tstep + (size_t)nxt.k0 * kstep : cB;
        const int ntc = cur.nk;
        for (int t = 0; t < ntc; t += 2) {
            const bool last = (t == ntc - 2);
            const char* a1 = cA + (size_t)(t + 1) * kstep;
            const char* a2 = last ? nA : cA + (size_t)(t + 2) * kstep; const char* b2 = last ? nB : cB + (size_t)(t + 2) * kstep;
            const char* a3 = a2 + kstep; const char* b3 = b2 + kstep;
            if (last && has_next) S.a_ready(nxt);
            if constexpr (SP2) {
            PG8_LDB(B0, 0, 0); PG8_LDB(B1, 0, 1); PG8_SCHED; PG8_LDA(At, 0, 0); PG8_STAGE(PG8_SA(1, 1), a1 + hstep, voffA);
            PG8_WAIT_V(8); PG8_WAIT_L(0); PG8_BAR; PG8_MMA(0, 0, At, B0); PG8_MMA(0, 1, At, B1); PG8_BAR; PG8_SCHED;
            PG8_LDA(At, 0, 1); PG8_STAGE(PG8_SB(0, 0), b2, voffB); PG8_STAGE(PG8_SB(0, 1), b2 + hstep, voffB); PG8_STAGE(PG8_SA(0, 0), a2, voffA);
            PG8_WAIT_V(8); PG8_WAIT_L(0); PG8_BAR; PG8_MMA(1, 0, At, B0); PG8_MMA(1, 1, At, B1); PG8_BAR; PG8_SCHED;
            PG8_LDB(B0, 1, 0); PG8_LDB(B1, 1, 1); PG8_SCHED; PG8_LDA(At, 1, 0); PG8_STAGE(PG8_SA(0, 1), a2 + hstep, voffA);
            PG8_WAIT_V(8); PG8_WAIT_L(0); PG8_BAR; PG8_MMA(0, 0, At, B0); PG8_MMA(0, 1, At, B1); PG8_BAR; PG8_SCHED;
            PG8_LDA(At, 1, 1); PG8_STAGE(PG8_SB(1, 0), b3, voffB); PG8_STAGE(PG8_SB(1, 1), b3 + hstep, voffB); PG8_STAGE(PG8_SA(1, 0), a3, voffA);
            PG8_WAIT_V(8); PG8_WAIT_L(0); PG8_BAR; PG8_MMA(1, 0, At, B0); PG8_MMA(1, 1, At, B1); PG8_BAR; PG8_SCHED;
            } else {
            PG8_LDB(B0, 0, 0); PG8_SCHED; PG8_LDA(At, 0, 0); PG8_STAGE(PG8_SA(1, 1), a1 + hstep, voffA);
            PG8_WAIT_L(8); PG8_BAR; PG8_WAIT_L(0); PG8_MMA(0, 0, At, B0); PG8_BAR; PG8_SCHED;
            PG8_LDB(B1, 0, 1); PG8_STAGE(PG8_SB(0, 0), b2, voffB);
            PG8_BAR; PG8_WAIT_L(0); PG8_MMA(0, 1, At, B1); PG8_BAR;
            PG8_LDA(At, 0, 1); PG8_STAGE(PG8_SA(0, 0), a2, voffA);
            PG8_BAR; PG8_WAIT_L(0); PG8_MMA(1, 0, At, B0); PG8_BAR; PG8_SCHED;
            PG8_STAGE(PG8_SB(0, 1), b2 + hstep, voffB);
            PG8_WAIT_V(6); PG8_BAR; PG8_MMA(1, 1, At, B1); PG8_BAR;
            PG8_LDB(B0, 1, 0); PG8_SCHED; PG8_LDA(At, 1, 0); PG8_STAGE(PG8_SA(0, 1), a2 + hstep, voffA);
            PG8_WAIT_L(8); PG8_BAR; PG8_WAIT_L(0); PG8_MMA(0, 0, At, B0); PG8_BAR; PG8_SCHED;
            PG8_LDB(B1, 1, 1); PG8_STAGE(PG8_SB(1, 0), b3, voffB);
            PG8_BAR; PG8_WAIT_L(0); PG8_MMA(0, 1, At, B1); PG8_BAR;
            PG8_LDA(At, 1, 1); PG8_STAGE(PG8_SA(1, 0), a3, voffA);
            PG8_BAR; PG8_WAIT_L(0); PG8_MMA(1, 0, At, B0); PG8_BAR; PG8_SCHED;
            PG8_STAGE(PG8_SB(1, 1), b3 + hstep, voffB);
            PG8_WAIT_V(6); PG8_BAR; PG8_MMA(1, 1, At, B1); PG8_BAR;
            }
        }
        if constexpr (ALIGN_EPI) { if (wr == 0) PG8_BAR; }
        if constexpr (!Epi::AFTER_DRAIN) { E(acc, cur, wr, wc, fr, fq); S.done(cur); }
        if (!has_next) break;
#pragma unroll
        for (int a = 0; a < 2; ++a)
#pragma unroll
            for (int b = 0; b < 2; ++b)
#pragma unroll
                for (int m = 0; m < 4; ++m)
#pragma unroll
                    for (int n = 0; n < 2; ++n) acc[a][b][m][n] = (f32x4){0.f, 0.f, 0.f, 0.f};
        cur = nxt; cA = nA; cB = nB; ++ui;
        if constexpr (ALIGN_EPI) { if (wr == 1) PG8_BAR; }
    }
    PG8_WAIT_V(0);
    if constexpr (!ALIGN_EPI) { if (wr == 0) PG8_BAR; }
    PG8_BAR;
    if constexpr (Epi::AFTER_DRAIN) { E.fused(acc, cur, wr, wc, fr, fq, lds, wid, lane); S.done(cur); }
#undef PG8_SA
#undef PG8_SB
#undef PG8_STAGE
#undef PG8_LDA
#undef PG8_LDB
#undef PG8_MMA
#undef PG8_WAIT_V
#undef PG8_WAIT_L
#undef PG8_BAR
#undef PG8_SCHED
}
}

#ifndef MK_N_LAUNCHES
#define MK_N_LAUNCHES 1
#endif
#ifndef REP_MASK
#define REP_MASK 0
#endif
#define LAS __attribute__((address_space(3)))
using pg8::bf16_t; using pg8::bf16x8; using pg8::f32x4; using pg8::u32x4;
typedef float f32x16 __attribute__((ext_vector_type(16)));
typedef __bf16 bf16x2_t __attribute__((ext_vector_type(2)));
typedef float f32x2_t __attribute__((ext_vector_type(2)));
typedef unsigned u32x2 __attribute__((ext_vector_type(2)));

constexpr int NWAVES = 8, NTHR = 512;
constexpr int D = 1024, MP = 16384, MS = 1024, M = MP + MS, NIN = 3840, PLD = 3584, FF = 2816, NUP = 2 * FF;
constexpr float EPS = 1e-6f;
constexpr size_t MiB = 1u << 20;
constexpr size_t WS_BAR = 26 * MiB + 768 * 1024, WS_WIN = 0, WS_WO = 8 * MiB, WS_W13 = 10 * MiB, WS_W2 = 21 * MiB, WS_RSTD1 = 27 * MiB, WS_SSQ2 = 28 * MiB, WS_LRA = 32 * MiB, WS_DCH = 34 * MiB,
                 WS_KDTS = 37 * MiB, WS_XB = 45 * MiB, WS_FB = 79 * MiB, WS_P = 113 * MiB, WS_END = 233 * MiB;
static_assert(WS_P + (size_t)(M + 32) * PLD * 2 <= WS_END && WS_XB + (size_t)M * D * 2 <= WS_FB && WS_FB + (size_t)M * 512 * 4 <= WS_P, "ws map");
constexpr size_t OUT_Y = 0, OUT_SAP = 17825792, OUT_SBP = 18087936, OUT_SAS = 18612224, OUT_SBS = 22806528;
constexpr int LDS_BYTES = 160768;

__device__ __forceinline__ unsigned pk_bf16(float lo, float hi) { f32x2_t v = {lo, hi}; bf16x2_t b = __builtin_convertvector(v, bf16x2_t); return __builtin_bit_cast(unsigned, b); }
__device__ __forceinline__ float bf_lo(unsigned u) { return __uint_as_float(u << 16); }
__device__ __forceinline__ float bf_hi(unsigned u) { return __uint_as_float(u & 0xffff0000u); }
__device__ __forceinline__ float bf_f(unsigned short u) { return __uint_as_float(((unsigned)u) << 16); }


template <int CTRL, int ROWMASK> __device__ __forceinline__ float dpp_f(float v) { return __builtin_bit_cast(float, __builtin_amdgcn_update_dpp(0, __builtin_bit_cast(int, v), CTRL, ROWMASK, 0xF, true)); }
__device__ __forceinline__ float row16_sum(float v) { v += dpp_f<0xB1, 0xF>(v); v += dpp_f<0x4E, 0xF>(v); v += dpp_f<0x141, 0xF>(v); v += dpp_f<0x140, 0xF>(v); return v; }
__device__ __forceinline__ float scan32(float a) {
    a += dpp_f<0x111, 0xF>(a); a += dpp_f<0x112, 0xF>(a); a += dpp_f<0x114, 0xF>(a); a += dpp_f<0x118, 0xF>(a); a += dpp_f<0x142, 0xA>(a); return a; }
template <int CTRL, int ROWMASK> __device__ __forceinline__ float dpp_f1(float v) { return __builtin_bit_cast(float, __builtin_amdgcn_update_dpp(0x3f800000, __builtin_bit_cast(int, v), CTRL, ROWMASK, 0xF, false)); }
__device__ __forceinline__ float scanmul32(float a) {
    a *= dpp_f1<0x111, 0xF>(a); a *= dpp_f1<0x112, 0xF>(a); a *= dpp_f1<0x114, 0xF>(a); a *= dpp_f1<0x118, 0xF>(a); a *= dpp_f1<0x142, 0xA>(a); return a; }
__device__ __forceinline__ float lane_bcast(float v, int l);
__device__ __forceinline__ float wave_sum(float v) { v = row16_sum(v); return (lane_bcast(v, 0) + lane_bcast(v, 16)) + (lane_bcast(v, 32) + lane_bcast(v, 48)); }
__device__ __forceinline__ float lane_bcast(float v, int l) { return __builtin_bit_cast(float, __builtin_amdgcn_readlane(__builtin_bit_cast(int, v), l)); }
#define LDS_WAIT() asm volatile("s_waitcnt lgkmcnt(0)" ::: "memory")
#define WG_BAR() do { asm volatile("s_waitcnt lgkmcnt(0)" ::: "memory"); __builtin_amdgcn_s_barrier(); asm volatile("" ::: "memory"); } while (0)
#define MFMA32(a, b, c) __builtin_amdgcn_mfma_f32_32x32x16_bf16((a), (b), (c), 0, 0, 0)
#define MFMA16(a, b, c) __builtin_amdgcn_mfma_f32_16x16x32_bf16((a), (b), (c), 0, 0, 0)

struct Ptrs {
    const float* in[17]; float* out;
    bf16_t *WinT, *WoT, *W13T, *W2T, *XB, *P, *KDTS, *OF, *X1B, *HID;
    float *RSTD1, *SSQ2, *LRA, *DCH, *FB, *OY; bf16_t *DUMP, *OX, *OI; float *PART, *PART4, *SSQ3;
};

namespace pg8 {
struct EpiIn {
    static constexpr bool PERM = true, AFTER_DRAIN = false;
    bf16_t* P; float* FB; float* LRA; const float* rstd;
    __device__ __forceinline__ void operator()(const f32x4 (&acc)[2][2][4][2], const Unit& u, int wr, int wc, int fr, int fq) const {
        const int row0 = u.pm * BM + wr * 64 + fr, ct = wc * 32 + 8 * fq;
#pragma unroll
        for (int ai = 0; ai < 2; ++ai)
#pragma unroll
            for (int m = 0; m < 4; ++m) {
                const int row = row0 + ai * HALF + m * 16; const float rs = rstd[row];
#pragma unroll
                for (int bj = 0; bj < 2; ++bj) {
                    const f32x4 v0 = acc[ai][bj][m][0] * rs, v1 = acc[ai][bj][m][1] * rs; const int cl = bj * HALF + ct;
                    if (u.pn == 8 || u.pn == 9) { float* o = FB + (size_t)row * 512 + (u.pn - 8) * BM + cl; *(f32x4*)o = v0; *(f32x4*)(o + 4) = v1; }
                    else if (u.pn == 14) { if (cl < 16) { float* o = LRA + (size_t)row * 16 + cl; *(f32x4*)o = v0; *(f32x4*)(o + 4) = v1; } }
                    else { u32x4 w; w.x = cvt_pk_bf16(v0[0], v0[1]); w.y = cvt_pk_bf16(v0[2], v0[3]); w.z = cvt_pk_bf16(v1[0], v1[1]); w.w = cvt_pk_bf16(v1[2], v1[3]);
                           *(u32x4*)(P + (size_t)row * 3584 + u.pn * BM + cl) = w; }
                }
            }
    }
};
struct EpiRes1 {
    static constexpr bool PERM = true, AFTER_DRAIN = false;
    const float* xp; const float* xs; float* Y; bf16_t* X1B; float* SSQ;
    __device__ __forceinline__ void operator()(const f32x4 (&acc)[2][2][4][2], const Unit& u, int wr, int wc, int fr, int fq) const {
        const int row0 = u.pm * BM + wr * 64 + fr, ct = u.pn * BM + wc * 32 + 8 * fq;
#pragma unroll
        for (int ai = 0; ai < 2; ++ai)
#pragma unroll
            for (int m = 0; m < 4; ++m) {
                const int row = row0 + ai * HALF + m * 16;
                const float* xr = row < 16384 ? xp + (size_t)row * 1024 : xs + (size_t)(row - 16384) * 1024;
                float ss = 0.f;
#pragma unroll
                for (int bj = 0; bj < 2; ++bj) {
                    const int col = ct + bj * HALF;
                    const f32x4 v0 = acc[ai][bj][m][0] + *(const f32x4*)(xr + col), v1 = acc[ai][bj][m][1] + *(const f32x4*)(xr + col + 4);
                    *(f32x4*)(Y + (size_t)row * 1024 + col) = v0; *(f32x4*)(Y + (size_t)row * 1024 + col + 4) = v1;
                    u32x4 w; w.x = cvt_pk_bf16(v0[0], v0[1]); w.y = cvt_pk_bf16(v0[2], v0[3]); w.z = cvt_pk_bf16(v1[0], v1[1]); w.w = cvt_pk_bf16(v1[2], v1[3]);
                    *(u32x4*)(X1B + (size_t)row * 1024 + col) = w;
                    ss += (v0[0] * v0[0] + v0[1] * v0[1]) + (v0[2] * v0[2] + v0[3] * v0[3]) + (v1[0] * v1[0] + v1[1] * v1[1]) + (v1[2] * v1[2] + v1[3] * v1[3]);
                }
                ss += __shfl_xor(ss, 16); ss += __shfl_xor(ss, 32);
                if (fq == 0) SSQ[(size_t)row * 16 + u.pn * 4 + wc] = ss;
            }
    }
};
struct EpiSwiglu {
    static constexpr bool PERM = true, AFTER_DRAIN = false;
    bf16_t* H; const float* SSQ;
    __device__ __forceinline__ void operator()(const f32x4 (&acc)[2][2][4][2], const Unit& u, int wr, int wc, int fr, int fq) const {
        const int row0 = u.pm * BM + wr * 64 + fr, hc = u.pn * 128 + wc * 16 + fq * 4;
#pragma unroll
        for (int ai = 0; ai < 2; ++ai)
#pragma unroll
            for (int m = 0; m < 4; ++m) {
                const int row = row0 + ai * HALF + m * 16;
                const f32x4* sp = (const f32x4*)(SSQ + (size_t)row * 16);
                const f32x4 s0 = sp[0], s1 = sp[1], s2 = sp[2], s3 = sp[3];
                const float tot = ((s0[0] + s0[1]) + (s0[2] + s0[3])) + ((s1[0] + s1[1]) + (s1[2] + s1[3])) + ((s2[0] + s2[1]) + (s2[2] + s2[3])) + ((s3[0] + s3[1]) + (s3[2] + s3[3]));
                const float rs = __builtin_amdgcn_rsqf(tot * (1.0f / 1024.0f) + 1e-6f);
#pragma unroll
                for (int bj = 0; bj < 2; ++bj) {
                    const f32x4 a = acc[ai][bj][m][0] * rs, b = acc[ai][bj][m][1] * rs; float h[4];
#pragma unroll
                    for (int e = 0; e < 4; ++e) h[e] = a[e] * __builtin_amdgcn_rcpf(1.0f + __expf(-a[e])) * b[e];
                    unsigned lo = cvt_pk_bf16(h[0], h[1]), hi = cvt_pk_bf16(h[2], h[3]);
                    *(unsigned long long*)(H + (size_t)row * 2816 + hc + bj * 64) = (unsigned long long)lo | ((unsigned long long)hi << 32);
                }
            }
    }
};
struct EpiRes2 {
    static constexpr bool PERM = true, AFTER_DRAIN = false;
    float* Y; float sc;
    __device__ __forceinline__ void operator()(const f32x4 (&acc)[2][2][4][2], const Unit& u, int wr, int wc, int fr, int fq) const {
        const int row0 = u.pm * BM + wr * 64 + fr, ct = u.pn * BM + wc * 32 + 8 * fq;
#pragma unroll
        for (int ai = 0; ai < 2; ++ai)
#pragma unroll
            for (int m = 0; m < 4; ++m) {
                float* yr = Y + (size_t)(row0 + ai * HALF + m * 16) * 1024;
#pragma unroll
                for (int bj = 0; bj < 2; ++bj) {
                    const int col = ct + bj * HALF;
                    const f32x4 v0 = acc[ai][bj][m][0] * sc + *(const f32x4*)(yr + col), v1 = acc[ai][bj][m][1] * sc + *(const f32x4*)(yr + col + 4);
                    *(f32x4*)(yr + col) = v0; *(f32x4*)(yr + col + 4) = v1;
                }
            }
    }
};
struct EpiPart {
    static constexpr bool PERM = true, AFTER_DRAIN = false;
    float* PART; int rowbase; float sc;
    __device__ __forceinline__ void operator()(const f32x4 (&acc)[2][2][4][2], const Unit& u, int wr, int wc, int fr, int fq) const {
        const int row0 = u.pm * BM + wr * 64 + fr - rowbase, ct = u.pn * BM + wc * 32 + 8 * fq;
        float* base = PART + (size_t)(u.k0 / u.nk) * 1024 * 1024;
#pragma unroll
        for (int ai = 0; ai < 2; ++ai)
#pragma unroll
            for (int m = 0; m < 4; ++m) {
                float* yr = base + (size_t)(row0 + ai * HALF + m * 16) * 1024;
#pragma unroll
                for (int bj = 0; bj < 2; ++bj) { const int col = ct + bj * HALF; *(f32x4*)(yr + col) = acc[ai][bj][m][0] * sc; *(f32x4*)(yr + col + 4) = acc[ai][bj][m][1] * sc; }
            }
    }
};
}

__device__ __forceinline__ void tr_item(const float* colp, int ldw, const float* gain, int k0, int dcol, bf16_t* WT, int K, int nrow0, LAS float* scr, int lane) {
    float tv[32];
#pragma unroll
    for (int i = 0; i < 32; ++i) { const int kk = 2 * i + (lane >> 5); tv[i] = colp ? colp[(size_t)(k0 + kk) * ldw] : 0.f; }
    if (gain) {
        float gv[32];
#pragma unroll
        for (int i = 0; i < 32; ++i) gv[i] = gain[k0 + 2 * i + (lane >> 5)];
#pragma unroll
        for (int i = 0; i < 32; ++i) tv[i] *= gv[i];
    }
#pragma unroll
    for (int i = 0; i < 32; ++i) scr[(2 * i + (lane >> 5)) * 33 + dcol] = tv[i];
    LDS_WAIT();
    const int c = lane & 7;
#pragma unroll
    for (int j = 0; j < 4; ++j) {
        const int n = (lane >> 3) + 8 * j; const LAS float* s = scr + (8 * c) * 33 + n;
        u32x4 o; o.x = pk_bf16(s[0 * 33], s[1 * 33]); o.y = pk_bf16(s[2 * 33], s[3 * 33]); o.z = pk_bf16(s[4 * 33], s[5 * 33]); o.w = pk_bf16(s[6 * 33], s[7 * 33]);
        *(u32x4*)(WT + (size_t)(nrow0 + n) * K + k0 + 8 * c) = o;
    }
    LDS_WAIT();
}
__device__ __forceinline__ void weight_items(const Ptrs& c, LAS float* scr, int part, int gw, int NGW, int lane) {
    const int l31 = lane & 31;
    constexpr int I_IN = 16 * 120, I_O = 16 * 32, I_13 = 16 * 176, I_2 = 44 * 32;
    if (part == 0) {
        for (int r = gw; r < I_IN; r += NGW) { const int kb = r / 120, nb = r % 120, n = nb * 32 + l31;
            const int oc = n < 1536 ? n : (n < 3584 ? n + 16 : (n < 3600 ? n - 3584 + 1536 : -1));
            tr_item(oc >= 0 ? c.in[5] + oc : nullptr, 3600, c.in[4], kb * 64, l31, c.WinT, 1024, nb * 32, scr, lane); }
        return;
    }
    for (int it = gw; it < I_O + I_13 + I_2; it += NGW) {
        int r = it;
        if (r < I_O) { const int kb = r / 32, nb = r % 32; tr_item(c.in[11] + nb * 32 + l31, 1024, nullptr, kb * 64, l31, c.WoT, 1024, nb * 32, scr, lane); continue; }
        r -= I_O;
        if (r < I_13) { const int kb = r / 176, nb = r % 176; const bool is3 = l31 >= 16; const int hcol = nb * 16 + (l31 & 15);
            tr_item((is3 ? c.in[14] : c.in[13]) + hcol, 2816, c.in[12], kb * 64, ((l31 & 15) >> 2) * 8 + (is3 ? 4 : 0) + (l31 & 3), c.W13T, 1024, nb * 32, scr, lane); continue; }
        r -= I_13;
        { const int kb = r / 32, nb = r % 32; tr_item(c.in[15] + nb * 32 + l31, 1024, nullptr, kb * 64, l31, c.W2T, 2816, nb * 32, scr, lane); }
    }
}
__device__ __forceinline__ void p0_prologue(const Ptrs& c, LAS unsigned char* lds, int G, int wave, int lane, bool all_weights) {
    LAS float* scr = (LAS float*)(lds + wave * 16384);
    const int gw = blockIdx.x * NWAVES + wave, NGW = G * NWAVES;
    weight_items(c, scr, 0, gw, NGW, lane);
    if (all_weights) weight_items(c, scr, 1, gw, NGW, lane);
    {
        f32x4 v[4], nv[4];
        { const int m0 = gw < M ? gw : M - 1; const float* xr = m0 < MP ? c.in[0] + (size_t)m0 * D : c.in[1] + (size_t)(m0 - MP) * D;
#pragma unroll
          for (int j = 0; j < 4; ++j) v[j] = *(const f32x4*)(xr + 4 * lane + 256 * j); }
        for (int m = gw; m < M; m += NGW) {
            { const int mn = m + NGW < M ? m + NGW : m; const float* xr = mn < MP ? c.in[0] + (size_t)mn * D : c.in[1] + (size_t)(mn - MP) * D;
#pragma unroll
              for (int j = 0; j < 4; ++j) nv[j] = *(const f32x4*)(xr + 4 * lane + 256 * j); }
            float s = 0.f;
#pragma unroll
            for (int j = 0; j < 4; ++j) s += (v[j][0] * v[j][0] + v[j][1] * v[j][1]) + (v[j][2] * v[j][2] + v[j][3] * v[j][3]);
            s = wave_sum(s);
#pragma unroll
            for (int j = 0; j < 4; ++j) { u32x2 w; w.x = pk_bf16(v[j][0], v[j][1]); w.y = pk_bf16(v[j][2], v[j][3]); *(u32x2*)(c.XB + (size_t)m * D + 4 * lane + 256 * j) = w; }
            if (lane == 0) c.RSTD1[m] = 1.0f / sqrtf(s * (1.0f / D) + EPS);
#pragma unroll
            for (int j = 0; j < 4; ++j) v[j] = nv[j];
        }
    }
}

__device__ __forceinline__ int crow(int i, int h) { return (i & 3) + 8 * (i >> 2) + 4 * h; }
template <int K, bool GLA, bool ALLV>
__device__ __forceinline__ void pre_item(const Ptrs& c, int row0, int ntok, int hh, int item, bf16_t* kdt_base, int kdt_stride,
                                         const LAS float* wa2_l, const LAS float* ba_l, const LAS float* lb_l, LAS unsigned char* vt, int lane, bool dry) {
    const int r = lane & 31, kg = lane >> 5;
    const bool valid = ALLV || r < ntok;
    const int row = row0 + (valid ? r : 0), nt1 = ntok - 1;
    constexpr int NJ = K / 16;
    const int qcol0 = GLA ? hh * 64 : 1536 + hh * 128, kcol0 = 256 + hh * 64, vcol0 = GLA ? 512 + hh * 128 : 2560 + hh * 128, ocol0 = (GLA ? hh : 4 + hh) * 128;
    bf16_t* Prow = c.P + (size_t)row * PLD;
    LAS unsigned char* kt = vt + 8192;
    LAS unsigned char* dl = vt + 16384;
    float lra[16];
    if constexpr (GLA) {
#pragma unroll
        for (int i = 0; i < 4; ++i) { const f32x4 t = *(const f32x4*)(c.LRA + (size_t)row * 16 + 4 * i); lra[4 * i] = t[0]; lra[4 * i + 1] = t[1]; lra[4 * i + 2] = t[2]; lra[4 * i + 3] = t[3]; }
    }
    const bf16_t* qptr = Prow + qcol0 + 8 * kg;
    const bf16_t* kptr = Prow + kcol0 + 8 * kg;
    const float* fptr = c.FB + (size_t)row * 512 + hh * 128 + 8 * kg;
    u32x4 qn = *(const u32x4*)qptr, kn = {0u, 0u, 0u, 0u}; f32x4 fn0 = {0.f, 0.f, 0.f, 0.f}, fn1 = fn0;
    if constexpr (GLA) kn = *(const u32x4*)kptr; else { fn0 = *(const f32x4*)fptr; fn1 = *(const f32x4*)(fptr + 4); }
    f32x16 att;
#pragma unroll
    for (int i = 0; i < 16; ++i) att[i] = 0.f;
    float* dch = c.DCH + (size_t)item * 128;
#pragma unroll 1
    for (int j = 0; j < NJ; ++j) {
        const int cl = 16 * j + 8 * kg;
        const u32x4 qr = qn, kr = kn; const f32x4 f0 = fn0, f1 = fn1;
        { const int jn = j + 1 < NJ ? j + 1 : j;
          qn = *(const u32x4*)(qptr + 16 * jn);
          if constexpr (GLA) kn = *(const u32x4*)(kptr + 16 * jn); else { fn0 = *(const f32x4*)(fptr + 16 * jn); fn1 = *(const f32x4*)(fptr + 16 * jn + 4); } }
        float la[8], kv[8], qv[8];
        if constexpr (GLA) {
            const LAS float* wl = wa2_l + hh * 64 + cl;
            f32x4 a0 = *(const LAS f32x4*)(ba_l + hh * 64 + cl), a1 = *(const LAS f32x4*)(ba_l + hh * 64 + cl + 4);
#pragma unroll
            for (int rb = 0; rb < 16; rb += 4) {
                f32x4 w[8];
#pragma unroll
                for (int rr = 0; rr < 4; ++rr) { w[2 * rr] = *(const LAS f32x4*)(wl + (rb + rr) * 256); w[2 * rr + 1] = *(const LAS f32x4*)(wl + (rb + rr) * 256 + 4); }
#pragma unroll
                for (int rr = 0; rr < 4; ++rr) { a0 += w[2 * rr] * lra[rb + rr]; a1 += w[2 * rr + 1] * lra[rb + rr]; }
            }
            float x[8], t[8];
#pragma unroll
            for (int e = 0; e < 8; ++e) x[e] = e < 4 ? a0[e & 3] : a1[e & 3];
#pragma unroll
            for (int e = 0; e < 8; ++e) t[e] = __expf(-fabsf(x[e]));
#pragma unroll
            for (int e = 0; e < 8; ++e) t[e] = __logf(1.0f + t[e]);
#pragma unroll
            for (int e = 0; e < 8; ++e) la[e] = (fminf(x[e], 0.f) - t[e]) * 0.0625f;
            kv[0] = bf_lo(kr.x); kv[1] = bf_hi(kr.x); kv[2] = bf_lo(kr.y); kv[3] = bf_hi(kr.y); kv[4] = bf_lo(kr.z); kv[5] = bf_hi(kr.z); kv[6] = bf_lo(kr.w); kv[7] = bf_hi(kr.w);
        } else {
            const f32x4 l0 = *(const LAS f32x4*)(lb_l + hh * 128 + cl), l1 = *(const LAS f32x4*)(lb_l + hh * 128 + cl + 4);
            float x[8], lbv[8], ex[8], inv[8];
#pragma unroll
            for (int e = 0; e < 8; ++e) { x[e] = e < 4 ? f0[e & 3] : f1[e & 3]; lbv[e] = e < 4 ? l0[e & 3] : l1[e & 3]; }
#pragma unroll
            for (int e = 0; e < 8; ++e) ex[e] = __expf(-fabsf(x[e]));
#pragma unroll
            for (int e = 0; e < 8; ++e) inv[e] = __builtin_amdgcn_rcpf(1.0f + ex[e]);
#pragma unroll
            for (int e = 0; e < 8; ++e) { const float ei = ex[e] * inv[e]; const float sg = x[e] >= 0.f ? inv[e] : ei, ng = x[e] >= 0.f ? ei : inv[e];
                la[e] = lbv[e] + (1.0f - lbv[e]) * sg; kv[e] = (1.0f - lbv[e]) * ng; }
        }
        qv[0] = bf_lo(qr.x); qv[1] = bf_hi(qr.x); qv[2] = bf_lo(qr.y); qv[3] = bf_hi(qr.y); qv[4] = bf_lo(qr.z); qv[5] = bf_hi(qr.z); qv[6] = bf_lo(qr.w); qv[7] = bf_hi(qr.w);
        float qi[8], ki[8], kd[8], eb[8], q[8], ea[8], ia[8];
        if constexpr (GLA) {
#pragma unroll
            for (int e = 0; e < 8; ++e) q[e] = qv[e] * 0.125f;
        } else {
#pragma unroll
            for (int e = 0; e < 8; ++e) q[e] = __expf(-qv[e]);
#pragma unroll
            for (int e = 0; e < 8; ++e) q[e] = __builtin_amdgcn_rcpf(1.0f + q[e]);
#pragma unroll
            for (int e = 0; e < 8; ++e) q[e] *= qv[e];
        }
        if (!ALLV) {
#pragma unroll
            for (int e = 0; e < 8; ++e) if (!valid) { q[e] = 0.f; kv[e] = 0.f; la[e] = GLA ? 0.f : 1.f; }
        }
        if constexpr (GLA) {
#pragma unroll
            for (int e = 0; e < 8; ++e) la[e] += dpp_f<0x111, 0xF>(la[e]);
#pragma unroll
            for (int e = 0; e < 8; ++e) la[e] += dpp_f<0x112, 0xF>(la[e]);
#pragma unroll
            for (int e = 0; e < 8; ++e) la[e] += dpp_f<0x114, 0xF>(la[e]);
#pragma unroll
            for (int e = 0; e < 8; ++e) la[e] += dpp_f<0x118, 0xF>(la[e]);
#pragma unroll
            for (int e = 0; e < 8; ++e) la[e] += dpp_f<0x142, 0xA>(la[e]);
#pragma unroll
            for (int e = 0; e < 8; ++e) ea[e] = __expf(fmaxf(la[e], -80.f));
        } else {
#pragma unroll
            for (int e = 0; e < 8; ++e) la[e] *= dpp_f1<0x111, 0xF>(la[e]);
#pragma unroll
            for (int e = 0; e < 8; ++e) la[e] *= dpp_f1<0x112, 0xF>(la[e]);
#pragma unroll
            for (int e = 0; e < 8; ++e) la[e] *= dpp_f1<0x114, 0xF>(la[e]);
#pragma unroll
            for (int e = 0; e < 8; ++e) la[e] *= dpp_f1<0x118, 0xF>(la[e]);
#pragma unroll
            for (int e = 0; e < 8; ++e) la[e] *= dpp_f1<0x142, 0xA>(la[e]);
#pragma unroll
            for (int e = 0; e < 8; ++e) ea[e] = fmaxf(la[e], 1e-35f);
        }
#pragma unroll
        for (int e = 0; e < 8; ++e) ia[e] = __builtin_amdgcn_rcpf(ea[e]);
#pragma unroll
        for (int e = 0; e < 8; ++e) { const float e31 = lane_bcast(ea[e], 31), e63 = lane_bcast(ea[e], 63); eb[e] = kg ? e63 : e31; }
#pragma unroll
        for (int e = 0; e < 8; ++e) { qi[e] = q[e] * ea[e]; ki[e] = kv[e] * ia[e]; kd[e] = ki[e] * eb[e]; }
        u32x4 qp, kp;
        qp.x = pk_bf16(qi[0], qi[1]); qp.y = pk_bf16(qi[2], qi[3]); qp.z = pk_bf16(qi[4], qi[5]); qp.w = pk_bf16(qi[6], qi[7]);
        kp.x = pk_bf16(ki[0], ki[1]); kp.y = pk_bf16(ki[2], ki[3]); kp.z = pk_bf16(ki[4], ki[5]); kp.w = pk_bf16(ki[6], ki[7]);
        att = MFMA32(__builtin_bit_cast(bf16x8, kp), __builtin_bit_cast(bf16x8, qp), att);
        *(LAS u32x4*)(vt + r * (K * 2) + ((((cl >> 3) ^ r) & (K / 8 - 1)) << 4)) = qp;
#pragma unroll
        for (int e = 0; e < 8; e += 2) {
            const unsigned pkd = pk_bf16(kd[e], kd[e + 1]);
            *(LAS unsigned short*)(kt + (cl + e) * 64 + r * 2) = (unsigned short)(pkd & 0xffffu);
            *(LAS unsigned short*)(kt + (cl + e + 1) * 64 + r * 2) = (unsigned short)(pkd >> 16);
        }
        if (r == 0) { f32x4 d0 = {eb[0], eb[1], eb[2], eb[3]}, d1 = {eb[4], eb[5], eb[6], eb[7]}; *(LAS f32x4*)(dl + cl * 4) = d0; *(LAS f32x4*)(dl + cl * 4 + 16) = d1; }
    }
    u32x4 vreg[8];
#pragma unroll
    for (int i = 0; i < 8; ++i) { const int p = lane + 64 * i, vr = (p >> 4) < nt1 ? (p >> 4) : nt1; vreg[i] = *(const u32x4*)(c.P + (size_t)(row0 + vr) * PLD + vcol0 + (p & 15) * 8); }
#pragma unroll
    for (int i = 0; i < K / 16; ++i) {
        const int p = lane + 64 * i, L = p * 8, qr_ = p / (K / 8), qc_ = p % (K / 8);
        if ((ALLV || qr_ < ntok) && !dry) *(u32x4*)(c.P + (size_t)(row0 + qr_) * PLD + qcol0 + qc_ * 8) = *(const LAS u32x4*)(vt + qr_ * (K * 2) + (((qc_ ^ qr_) & (K / 8 - 1)) << 4));
        *(u32x4*)(kdt_base + (size_t)(L / K) * kdt_stride + (L % K)) = *(const LAS u32x4*)(kt + p * 16);
    }
    if (lane < K / 4) *(f32x4*)(dch + lane * 4) = *(const LAS f32x4*)(dl + lane * 16);
#pragma unroll
    for (int i = 0; i < 8; ++i) { const int p = lane + 64 * i; *(LAS u32x4*)(vt + (p >> 4) * 256 + (p & 15) * 16) = vreg[i]; }
#pragma unroll
    for (int i = 0; i < 16; ++i) if (crow(i, kg) > r) att[i] = 0.f;
    u32x4 pa0, pa1;
    pa0.x = pk_bf16(att[0], att[1]); pa0.y = pk_bf16(att[2], att[3]); pa0.z = pk_bf16(att[4], att[5]); pa0.w = pk_bf16(att[6], att[7]);
    pa1.x = pk_bf16(att[8], att[9]); pa1.y = pk_bf16(att[10], att[11]); pa1.z = pk_bf16(att[12], att[13]); pa1.w = pk_bf16(att[14], att[15]);
#pragma unroll 1
    for (int vb = 0; vb < 4; ++vb) {
        unsigned short vs[16];
#pragma unroll
        for (int i = 0; i < 16; ++i) vs[i] = *(const LAS unsigned short*)(vt + crow(i, kg) * 256 + (vb * 32 + r) * 2);
        u32x4 b0, b1;
        b0.x = vs[0] | ((unsigned)vs[1] << 16); b0.y = vs[2] | ((unsigned)vs[3] << 16); b0.z = vs[4] | ((unsigned)vs[5] << 16); b0.w = vs[6] | ((unsigned)vs[7] << 16);
        b1.x = vs[8] | ((unsigned)vs[9] << 16); b1.y = vs[10] | ((unsigned)vs[11] << 16); b1.z = vs[12] | ((unsigned)vs[13] << 16); b1.w = vs[14] | ((unsigned)vs[15] << 16);
        f32x16 o;
#pragma unroll
        for (int i = 0; i < 16; ++i) o[i] = 0.f;
        o = MFMA32(__builtin_bit_cast(bf16x8, pa0), __builtin_bit_cast(bf16x8, b0), o);
        o = MFMA32(__builtin_bit_cast(bf16x8, pa1), __builtin_bit_cast(bf16x8, b1), o);
#pragma unroll
        for (int i = 0; i < 16; ++i) *(LAS unsigned short*)(kt + crow(i, kg) * 256 + (vb * 32 + r) * 2) = (unsigned short)(pk_bf16(o[i], 0.f) & 0xffffu);
    }
#pragma unroll
    for (int i = 0; i < 8; ++i) {
        const int p = lane + 64 * i, t = p >> 4;
        if (t < ntok) *(u32x4*)(c.OI + (size_t)(row0 + t) * 1024 + ocol0 + (p & 15) * 8) = *(const LAS u32x4*)(kt + p * 16);
    }
}
__device__ __forceinline__ void p2_prepass(const Ptrs& c, LAS unsigned char* lds, int G, int tid, int wave, int lane, bool dry) {
    LAS float* wa2_l = (LAS float*)lds; LAS float* ba_l = wa2_l + 4096; LAS float* lb_l = ba_l + 256;
    for (int i = tid; i < 4096; i += NTHR) wa2_l[i] = c.in[6][i];
    if (tid < 256) ba_l[tid] = c.in[7][tid];
    { const float p0 = c.in[8][tid], p1 = c.in[8][512 + tid]; lb_l[tid] = 1.0f / (1.0f + __expf(p1 - p0)); }
    WG_BAR();
    const int gw = blockIdx.x * NWAVES + wave, NGW = G * NWAVES;
    const bool bal = (G == 256);
    const int n_it = bal ? 4096 : 4096 + 1024;
    for (int it0 = gw; ; it0 += NGW) {
        int it = it0;
        if (it0 >= n_it) { if (!bal || wave >= 4 || it0 >= n_it + NGW) break; it = 4096 + blockIdx.x * 4 + wave; }
        int row0, ntok, h; bf16_t* kdt; int kst;
        if (it < 4096) { h = it & 7; const int ch = (it >> 3) & 63, b = it >> 9; row0 = b * 2048 + ch * 32; ntok = 32; kst = PLD;
                         kdt = c.P + (size_t)row0 * PLD + (h < 4 ? 256 + h * 64 : 2048 + (h - 4) * 128); }
        else { const int j = it - 4096; h = j & 7; row0 = MP + (j >> 3) * 8; ntok = 8; kst = h < 4 ? 64 : 128; kdt = c.KDTS + (size_t)j * 4096; }
        if (dry) { kst = h < 4 ? 64 : 128; kdt = (bf16_t*)((unsigned char*)c.DUMP + 203 * MiB) + (size_t)(it & 2047) * 4096; }
        if (it < 4096) { if (h < 4) pre_item<64, true, true>(c, row0, ntok, h, it, kdt, kst, wa2_l, ba_l, lb_l, lds + 20480 + wave * 16896, lane, dry);
                         else pre_item<128, false, true>(c, row0, ntok, h - 4, it, kdt, kst, wa2_l, ba_l, lb_l, lds + 20480 + wave * 16896, lane, dry); }
        else { if (h < 4) pre_item<64, true, false>(c, row0, ntok, h, it, kdt, kst, wa2_l, ba_l, lb_l, lds + 20480 + wave * 16896, lane, dry);
               else pre_item<128, false, false>(c, row0, ntok, h - 4, it, kdt, kst, wa2_l, ba_l, lb_l, lds + 20480 + wave * 16896, lane, dry); }
    }
    if (bal && wave >= 4) weight_items(c, (LAS float*)(lds + 20480 + wave * 16896), 1, blockIdx.x * 4 + wave - 4, G * 4, lane);
}

template <int K>
__device__ __forceinline__ void seq_item(const Ptrs& c, LAS unsigned char* lds, int row0, int nch, int ntok, int h8, int colbase, int ncw, const float* S0, float* Sout,
                                         const bf16_t* kdt0, int kdt_rstride, size_t kdt_cstep, const float* dch0, size_t dch_cstep, int tid, int wave, int lane) {
    constexpr int QROW = 2 * K + 16, VROW = 272;
    constexpr int KOFF = 8704, DOFF = 18944, VOFF = 19456, BUFB = 28160, NMB = K / 16, NPC = 4 * K;
    const int n = lane & 15, q = lane >> 4, col = colbase + 16 * (wave < ncw ? wave : 0) + n;
    const bool cw = wave < ncw;
    const bool gla = h8 < 4; const int hh = h8 & 3;
    const int qcol0 = gla ? hh * 64 : 1536 + hh * 128, vcol0 = gla ? 512 + hh * 128 : 2560 + hh * 128, ocol = h8 * 128 + col;
    f32x4 S[NMB];
#pragma unroll
    for (int mb = 0; mb < NMB; ++mb)
#pragma unroll
        for (int i = 0; i < 4; ++i) S[mb][i] = (S0 && cw) ? S0[(size_t)(16 * mb + 4 * q + i) * 128 + col] : 0.f;
    const int nt1 = ntok - 1;
    const int pq = tid % NPC, prow_q = pq / (K / 8), pc8 = pq % (K / 8), prq = prow_q < nt1 ? prow_q : nt1;
    const int vrow = tid >> 4, vc8 = tid & 15, vr = vrow < nt1 ? vrow : nt1;
    const int dpi = tid % (K / 4);
    const bf16_t* gq = c.P + (size_t)(row0 + prq) * PLD + qcol0 + pc8 * 8;
    const bf16_t* gk = kdt0 + (size_t)prow_q * kdt_rstride + pc8 * 8;
    const float* gd = dch0 + dpi * 4;
    const bf16_t* gvp = c.P + (size_t)(row0 + vr) * PLD + vcol0 + vc8 * 8;
    struct Stage { u32x4 q, k, v; f32x4 d; };
    const int nch1 = nch - 1;
#define SEQ_LOAD(R, cc) do { const int c_ = (cc) < nch1 ? (cc) : nch1; const size_t ro_ = (size_t)c_ * 32; \
        R.q = *(const u32x4*)(gq + ro_ * PLD); R.k = *(const u32x4*)(gk + (size_t)c_ * kdt_cstep); R.d = *(const f32x4*)(gd + (size_t)c_ * dch_cstep); \
        R.v = *(const u32x4*)(gvp + ro_ * PLD); } while (0)
#define SEQ_STORE(R, buf) do { LAS unsigned char* B_ = lds + (buf) * BUFB; \
        *(LAS u32x4*)(B_ + prow_q * QROW + pc8 * 16) = R.q; *(LAS u32x4*)(B_ + KOFF + (pq >> 2) * 80 + (pq & 3) * 16) = R.k; *(LAS f32x4*)(B_ + DOFF + dpi * 16) = R.d; \
        *(LAS u32x4*)(B_ + VOFF + vrow * VROW + vc8 * 16) = R.v; } while (0)
#define SEQ_ITER(ci, buf, RST) do { \
        const LAS unsigned char* B = lds + (buf) * BUFB; \
        if (cw) { \
        f32x4 o[2] = {{0.f, 0.f, 0.f, 0.f}, {0.f, 0.f, 0.f, 0.f}}; \
        _Pragma("unroll") for (int js = 0; js < K / 32; ++js) { \
            u32x4 sb; sb.x = pk_bf16(S[2 * js][0], S[2 * js][1]); sb.y = pk_bf16(S[2 * js][2], S[2 * js][3]); sb.z = pk_bf16(S[2 * js + 1][0], S[2 * js + 1][1]); sb.w = pk_bf16(S[2 * js + 1][2], S[2 * js + 1][3]); \
            _Pragma("unroll") for (int mb2 = 0; mb2 < 2; ++mb2) { \
                const LAS unsigned char* qp = B + (16 * mb2 + n) * QROW + (32 * js + 4 * q) * 2; \
                const u32x2 lo = *(const LAS u32x2*)qp, hi = *(const LAS u32x2*)(qp + 32); \
                u32x4 qa; qa.x = lo.x; qa.y = lo.y; qa.z = hi.x; qa.w = hi.y; \
                o[mb2] = MFMA16(__builtin_bit_cast(bf16x8, qa), __builtin_bit_cast(bf16x8, sb), o[mb2]); } } \
        { unsigned short vs[8]; \
            _Pragma("unroll") for (int j = 0; j < 8; ++j) vs[j] = *(const LAS unsigned short*)(B + VOFF + (8 * q + j) * VROW + col * 2); \
            u32x4 vb; vb.x = vs[0] | ((unsigned)vs[1] << 16); vb.y = vs[2] | ((unsigned)vs[3] << 16); vb.z = vs[4] | ((unsigned)vs[5] << 16); vb.w = vs[6] | ((unsigned)vs[7] << 16); \
            _Pragma("unroll") for (int mb = 0; mb < NMB; ++mb) { \
                const u32x4 ka = *(const LAS u32x4*)(B + KOFF + (16 * mb + n) * 80 + q * 16); \
                const f32x4 dv = *(const LAS f32x4*)(B + DOFF + (16 * mb + 4 * q) * 4); \
                S[mb] = S[mb] * dv; \
                S[mb] = MFMA16(__builtin_bit_cast(bf16x8, ka), __builtin_bit_cast(bf16x8, vb), S[mb]); } } \
        bf16_t* ob = c.OX + (size_t)(row0 + 32 * (ci)) * 1024 + ocol; \
        _Pragma("unroll") for (int x = 0; x < 8; x += 2) { \
            const int t = 16 * (x >> 2) + 4 * q + (x & 3); const unsigned pv = pk_bf16(o[x >> 2][x & 3], o[x >> 2][(x & 3) + 1]); \
            bf16_t* d0 = t < ntok ? ob + (size_t)t * 1024 : c.DUMP + tid; bf16_t* d1 = t + 1 < ntok ? ob + (size_t)(t + 1) * 1024 : c.DUMP + tid; \
            *d0 = (bf16_t)(pv & 0xffffu); *d1 = (bf16_t)(pv >> 16); } \
        } \
        WG_BAR(); \
        SEQ_STORE(RST, buf); \
    } while (0)
    Stage R0, R1, R2, R3;
    SEQ_LOAD(R0, 0); SEQ_STORE(R0, 0);
    SEQ_LOAD(R1, 1); SEQ_LOAD(R2, 2); SEQ_LOAD(R3, 3); SEQ_LOAD(R0, 4);
    SEQ_STORE(R1, 1);
    WG_BAR();
    for (int ci = 0; ci < nch; ci += 4) {
        SEQ_LOAD(R1, ci + 5); SEQ_ITER(ci, 0, R2);
        if (ci + 1 >= nch) break;
        SEQ_LOAD(R2, ci + 6); SEQ_ITER(ci + 1, 1, R3);
        if (ci + 2 >= nch) break;
        SEQ_LOAD(R3, ci + 7); SEQ_ITER(ci + 2, 0, R0);
        if (ci + 3 >= nch) break;
        SEQ_LOAD(R0, ci + 8); SEQ_ITER(ci + 3, 1, R1);
    }
    if (cw) {
#pragma unroll
    for (int mb = 0; mb < NMB; ++mb)
#pragma unroll
        for (int i = 0; i < 4; ++i) Sout[(size_t)(16 * mb + 4 * q + i) * 128 + col] = S[mb][i];
    }
    WG_BAR();
#undef SEQ_LOAD
#undef SEQ_STORE
#undef SEQ_ITER
}
__device__ __forceinline__ void seq_dispatch(const Ptrs& c, LAS unsigned char* lds, int item, int tid, int wave, int lane) {
    int row0, nch, ntok, h8, colbase, ncw; const float* S0; float* Sout; const bf16_t* kdt0; int kst; size_t kcs, dcs; const float* dch0;
    if (item < 128) {
        const int bh = item >> 1, b = bh >> 3; h8 = bh & 7; const int hh = h8 & 3; row0 = b * 2048; nch = 64; ntok = 32; S0 = nullptr; colbase = (item & 1) * 64; ncw = 4;
        Sout = h8 < 4 ? c.out + OUT_SAP + (size_t)(b * 4 + hh) * 64 * 128 : c.out + OUT_SBP + (size_t)(b * 4 + hh) * 128 * 128;
        kdt0 = c.P + (size_t)row0 * PLD + (h8 < 4 ? 256 + hh * 64 : 2048 + hh * 128); kst = PLD; kcs = (size_t)32 * PLD;
        dch0 = c.DCH + (size_t)(b * 64 * 8 + h8) * 128; dcs = 8 * 128;
    } else {
        const int j = item - 128, b = j >> 3; h8 = j & 7; const int hh = h8 & 3; row0 = MP + b * 8; nch = 1; ntok = 8; colbase = 0; ncw = 8;
        S0 = h8 < 4 ? c.in[2] + (size_t)(b * 4 + hh) * 64 * 128 : c.in[3] + (size_t)(b * 4 + hh) * 128 * 128;
        Sout = h8 < 4 ? c.out + OUT_SAS + (size_t)(b * 4 + hh) * 64 * 128 : c.out + OUT_SBS + (size_t)(b * 4 + hh) * 128 * 128;
        kdt0 = c.KDTS + (size_t)j * 4096; kst = h8 < 4 ? 64 : 128; kcs = 0; dch0 = c.DCH + (size_t)(4096 + j) * 128; dcs = 0;
    }
    if (h8 < 4) seq_item<64>(c, lds, row0, nch, ntok, h8, colbase, ncw, S0, Sout, kdt0, kst, kcs, dch0, dcs, tid, wave, lane);
    else seq_item<128>(c, lds, row0, nch, ntok, h8, colbase, ncw, S0, Sout, kdt0, kst, kcs, dch0, dcs, tid, wave, lane);
}
__device__ __forceinline__ void p3b_finalize(const Ptrs& c, int G, int wave, int lane) {
    const int gw = blockIdx.x * NWAVES + wave, NGW = G * NWAVES, h8 = lane >> 3, cw = (lane & 7) * 16;
    const float* gp = (h8 < 4 ? c.in[9] : c.in[10]) + cw;
    f32x4 gn[4];
#pragma unroll
    for (int j = 0; j < 4; ++j) gn[j] = *(const f32x4*)(gp + 4 * j);
    const int gcol = (h8 < 4 ? 1024 + h8 * 128 : 3072 + (h8 - 4) * 128) + cw;
    for (int m = gw; m < M; m += NGW) {
        f32x4 o[4]; u32x4 x[2], g[2], oi[2];
#pragma unroll
        for (int j = 0; j < 2; ++j) { oi[j] = *(const u32x4*)(c.OI + (size_t)m * 1024 + lane * 16 + 8 * j); x[j] = *(const u32x4*)(c.OX + (size_t)m * 1024 + lane * 16 + 8 * j); g[j] = *(const u32x4*)(c.P + (size_t)m * PLD + gcol + 8 * j); }
        o[0][0] = bf_lo(oi[0].x); o[0][1] = bf_hi(oi[0].x); o[0][2] = bf_lo(oi[0].y); o[0][3] = bf_hi(oi[0].y); o[1][0] = bf_lo(oi[0].z); o[1][1] = bf_hi(oi[0].z); o[1][2] = bf_lo(oi[0].w); o[1][3] = bf_hi(oi[0].w);
        o[2][0] = bf_lo(oi[1].x); o[2][1] = bf_hi(oi[1].x); o[2][2] = bf_lo(oi[1].y); o[2][3] = bf_hi(oi[1].y); o[3][0] = bf_lo(oi[1].z); o[3][1] = bf_hi(oi[1].z); o[3][2] = bf_lo(oi[1].w); o[3][3] = bf_hi(oi[1].w);
        float ss = 0.f;
#pragma unroll
        for (int j = 0; j < 4; ++j) {
            const unsigned w0 = j < 2 ? (j == 0 ? x[0].x : x[0].z) : (j == 2 ? x[1].x : x[1].z), w1 = j < 2 ? (j == 0 ? x[0].y : x[0].w) : (j == 2 ? x[1].y : x[1].w);
            o[j][0] += bf_lo(w0); o[j][1] += bf_hi(w0); o[j][2] += bf_lo(w1); o[j][3] += bf_hi(w1);
            ss += (o[j][0] * o[j][0] + o[j][1] * o[j][1]) + (o[j][2] * o[j][2] + o[j][3] * o[j][3]);
        }
        ss += dpp_f<0xB1, 0xF>(ss); ss += dpp_f<0x4E, 0xF>(ss); ss += dpp_f<0x141, 0xF>(ss);
        const float rs = __builtin_amdgcn_rsqf(ss * (1.0f / 128.0f) + EPS);
        u32x4 w[2];
#pragma unroll
        for (int j = 0; j < 4; ++j) {
            const unsigned g0 = j < 2 ? (j == 0 ? g[0].x : g[0].z) : (j == 2 ? g[1].x : g[1].z), g1 = j < 2 ? (j == 0 ? g[0].y : g[0].w) : (j == 2 ? g[1].y : g[1].w);
            float gg[4] = {bf_lo(g0), bf_hi(g0), bf_lo(g1), bf_hi(g1)}, v[4];
#pragma unroll
            for (int e = 0; e < 4; ++e) v[e] = o[j][e] * rs * gn[j][e] * (gg[e] * __builtin_amdgcn_rcpf(1.0f + __expf(-gg[e])));
            const unsigned p0 = pk_bf16(v[0], v[1]), p1 = pk_bf16(v[2], v[3]);
            if (j == 0) { w[0].x = p0; w[0].y = p1; } else if (j == 1) { w[0].z = p0; w[0].w = p1; } else if (j == 2) { w[1].x = p0; w[1].y = p1; } else { w[1].z = p0; w[1].w = p1; }
        }
        *(u32x4*)(c.OF + (size_t)m * 1024 + lane * 16) = w[0]; *(u32x4*)(c.OF + (size_t)m * 1024 + lane * 16 + 8) = w[1];
    }
}
#define XB_TMO      128
#define XB_XCNT(j)  (256  + 64 * (j))
#define XB_XSUB(j)  (1280 + 64 * (j))
#define XB_XGEN(j)  (2304 + 64 * (j))
#define XB_TOP      3328
#define XB_TOPGEN   3392
#define XCD_BAR_WORDS 3456
#define XB_SPIN_CAP (1u << 18)

__device__ __forceinline__ unsigned xb_ld(unsigned* p)              { return __hip_atomic_load(p, __ATOMIC_RELAXED, __HIP_MEMORY_SCOPE_AGENT); }
__device__ __forceinline__ unsigned xb_add(unsigned* p, unsigned v) { return __hip_atomic_fetch_add(p, v, __ATOMIC_RELAXED, __HIP_MEMORY_SCOPE_AGENT); }
__device__ __forceinline__ unsigned xb_xcc_id() { return (unsigned)__builtin_amdgcn_s_getreg((3 << 11) | 20) & 0xFu; }
#define XB_SPIN(cond, bar) do { unsigned _sp = 0; while (cond) { __builtin_amdgcn_s_sleep(1); \
    if ((++_sp & 255u) == 0u) { if (xb_ld(&(bar)[XB_TMO])) break; if (_sp > XB_SPIN_CAP) { atomicAdd(&(bar)[XB_TMO], 1u); break; } } } } while (0)

struct XcdBarrier {
    unsigned* bar; unsigned x;
    volatile LAS unsigned* st;
};

__device__ __forceinline__ XcdBarrier xcd_barrier_post(unsigned* bar, volatile LAS unsigned* st) {
    XcdBarrier b; b.bar = bar; b.x = xb_xcc_id(); b.st = st;
    if (threadIdx.x == 0) (void)xb_add(&bar[XB_XCNT(b.x)], 1u);
    return b;
}
__device__ __forceinline__ void xcd_barrier_complete(unsigned* bar, unsigned x, unsigned& nloc, unsigned& nx) {
    const unsigned G = gridDim.x * gridDim.y * gridDim.z;
    unsigned sum, cnt, mine, sp = 0u;
    for (;;) {
        sum = 0u; cnt = 0u; mine = 0u;
#pragma unroll
        for (unsigned j = 0; j < 16; ++j) { const unsigned c = xb_ld(&bar[XB_XCNT(j)]); sum += c; cnt += (c > 0u) ? 1u : 0u; mine = (j == x) ? c : mine; }
        if (sum == G) break;
        __builtin_amdgcn_s_sleep(1);
        if ((++sp & 255u) == 0u) { if (xb_ld(&bar[XB_TMO])) break; if (sp > XB_SPIN_CAP) { atomicAdd(&bar[XB_TMO], 1u); break; } }
    }
    nloc = mine > 0u ? mine : 1u; nx = cnt > 0u ? cnt : 1u;
}

__device__ __forceinline__ void xcd_barrier(const XcdBarrier& b) {
    asm volatile("s_waitcnt vmcnt(0)" ::: "memory");
    __syncthreads();
    if (threadIdx.x == 0) {
        unsigned* bar = b.bar;
        __builtin_amdgcn_s_waitcnt(0);
        unsigned nloc = b.st[0], nx = b.st[1];
        if (nloc == 0u) { xcd_barrier_complete(bar, b.x, nloc, nx); b.st[0] = nloc; b.st[1] = nx; }
        const unsigned old = xb_add(&bar[XB_XSUB(b.x)], 1u);
        const unsigned gen = old / nloc;
        if (old + 1u == (gen + 1u) * nloc) {
            __builtin_amdgcn_fence(__ATOMIC_RELEASE, "agent");
            asm volatile("s_waitcnt vmcnt(0)" ::: "memory");
            const unsigned og = xb_add(&bar[XB_TOP], 1u);
            const unsigned tg = og / nx;
            if (og + 1u == (tg + 1u) * nx) xb_add(&bar[XB_TOPGEN], 1u);
            else XB_SPIN(xb_ld(&bar[XB_TOPGEN]) == tg, bar);
            __builtin_amdgcn_fence(__ATOMIC_ACQUIRE, "agent");
            xb_add(&bar[XB_XGEN(b.x)], 1u);
            asm volatile("s_waitcnt vmcnt(0)" ::: "memory");
        } else {
            XB_SPIN(xb_ld(&bar[XB_XGEN(b.x)]) == gen, bar);
            __builtin_amdgcn_fence(__ATOMIC_ACQUIRE, "agent");
            asm volatile("s_waitcnt vmcnt(0)" ::: "memory");
        }
    }
    __syncthreads();
}


struct EpiRes2Norm {
    static constexpr bool PERM = true, AFTER_DRAIN = true;
    float* Y; float* SSQ; const float* gfin; XcdBarrier xb;
    __device__ __forceinline__ void fused(pg8::f32x4 (&acc)[2][2][4][2], const pg8::Unit& u, int wr, int wc, int fr, int fq, LAS unsigned char* lds, int wid, int lane) const {
        using pg8::BM; using pg8::HALF;
        const int row0 = u.pm * BM + wr * 64 + fr, ct = u.pn * BM + wc * 32 + 8 * fq;
#pragma unroll
        for (int ai = 0; ai < 2; ++ai)
#pragma unroll
            for (int m = 0; m < 4; ++m) {
                const int row = row0 + ai * HALF + m * 16; const float* yr = Y + (size_t)row * 1024; float ss = 0.f;
#pragma unroll
                for (int bj = 0; bj < 2; ++bj) {
                    const int col = ct + bj * HALF;
                    acc[ai][bj][m][0] += *(const f32x4*)(yr + col); acc[ai][bj][m][1] += *(const f32x4*)(yr + col + 4);
                    const f32x4 v0 = acc[ai][bj][m][0], v1 = acc[ai][bj][m][1];
                    ss += (v0[0] * v0[0] + v0[1] * v0[1]) + (v0[2] * v0[2] + v0[3] * v0[3]) + (v1[0] * v1[0] + v1[1] * v1[1]) + (v1[2] * v1[2] + v1[3] * v1[3]);
                }
                ss += __shfl_xor(ss, 16); ss += __shfl_xor(ss, 32);
                if (fq == 0) SSQ[(size_t)row * 16 + u.pn * 4 + wc] = ss;
            }
        xcd_barrier(xb);
#pragma unroll
        for (int ai = 0; ai < 2; ++ai)
#pragma unroll
            for (int m = 0; m < 4; ++m) {
                const int row = row0 + ai * HALF + m * 16; float* yr = Y + (size_t)row * 1024;
                const f32x4* sp = (const f32x4*)(SSQ + (size_t)row * 16);
                const f32x4 s0 = sp[0], s1 = sp[1], s2 = sp[2], s3 = sp[3];
                const float tot = ((s0[0] + s0[1]) + (s0[2] + s0[3])) + ((s1[0] + s1[1]) + (s1[2] + s1[3])) + ((s2[0] + s2[1]) + (s2[2] + s2[3])) + ((s3[0] + s3[1]) + (s3[2] + s3[3]));
                const float rs = __builtin_amdgcn_rsqf(tot * (1.0f / 1024.0f) + EPS);
#pragma unroll
                for (int bj = 0; bj < 2; ++bj) {
                    const int col = ct + bj * HALF;
                    *(f32x4*)(yr + col) = acc[ai][bj][m][0] * rs * *(const f32x4*)(gfin + col); *(f32x4*)(yr + col + 4) = acc[ai][bj][m][1] * rs * *(const f32x4*)(gfin + col + 4);
                }
            }
    }
};

struct Args { const float* in[17]; float* out; unsigned char* ws; int ph_lo, ph_hi, aux, pad; };
constexpr int NPHASE = 9;
__device__ __forceinline__ void fill_ptrs(Ptrs& c, const Args& args) {
#pragma unroll
    for (int i = 0; i < 17; ++i) c.in[i] = args.in[i];
    c.out = args.out;
    unsigned char* ws = args.ws;
    c.WinT = (bf16_t*)(ws + WS_WIN); c.WoT = (bf16_t*)(ws + WS_WO); c.W13T = (bf16_t*)(ws + WS_W13); c.W2T = (bf16_t*)(ws + WS_W2);
    c.XB = (bf16_t*)(ws + WS_XB); c.OF = (bf16_t*)(ws + WS_XB); c.P = (bf16_t*)(ws + WS_P); c.HID = (bf16_t*)(ws + WS_P); c.KDTS = (bf16_t*)(ws + WS_KDTS);
    c.X1B = (bf16_t*)(ws + WS_FB); c.FB = (float*)(ws + WS_FB);
    c.RSTD1 = (float*)(ws + WS_RSTD1); c.SSQ2 = (float*)(ws + WS_SSQ2); c.LRA = (float*)(ws + WS_LRA); c.DCH = (float*)(ws + WS_DCH); c.OY = args.out + OUT_Y; c.DUMP = (bf16_t*)(ws + 30 * MiB); c.OX = (bf16_t*)(ws + WS_FB); c.OI = (bf16_t*)(ws + WS_XB); c.PART = (float*)(ws + 208 * MiB); c.PART4 = (float*)(ws + WS_P); c.SSQ3 = (float*)(ws + 30 * MiB + 65536);
}

__global__ void __launch_bounds__(NTHR, 2) hymba_fwd(Args args) {
    extern __shared__ __attribute__((aligned(16))) unsigned char lds_raw[];
    LAS unsigned char* lds = (LAS unsigned char*)lds_raw;
    const int tid = threadIdx.x, lane = tid & 63, wave = __builtin_amdgcn_readfirstlane(tid >> 6), G = gridDim.x;
    unsigned char* ws = args.ws;
    const int lo = args.ph_lo, hi = args.ph_hi;
    volatile LAS unsigned* xst = (volatile LAS unsigned*)(lds + 160256);
    if (tid == 0) { xst[0] = 0u; xst[1] = 0u; }
    __syncthreads();
    XcdBarrier xbar; xbar.bar = (unsigned*)(ws + WS_BAR); xbar.x = 0; xbar.st = xst;
    if (hi - lo > 1) xbar = xcd_barrier_post((unsigned*)(ws + WS_BAR), xst);
#define IN(k) (lo <= (k) && (k) < hi)
#define SEAM(k) do { if (IN(k) && IN((k) + 1)) { if (args.pad != 0) cg::this_grid().sync(); else xcd_barrier(xbar); } } while (0)
    if (IN(0)) { Ptrs c; fill_ptrs(c, args); p0_prologue(c, lds, G, wave, lane, G != 256); }
    SEAM(0);
    if (IN(1)) { Ptrs c; fill_ptrs(c, args);
        pg8::Gemm g{c.XB, c.WinT, M, NIN, D}; pg8::StaticOrder S; S.init(M, NIN, G, (int)blockIdx.x, D);
        pg8::EpiIn E{c.P, c.FB, c.LRA, c.RSTD1};
        pg8::gemm_phase<pg8::EpiIn, pg8::StaticOrder, true, true>(lds, g, S, E);
    }
    SEAM(1);
    if (IN(2)) { Ptrs c; fill_ptrs(c, args); p2_prepass(c, lds, G, tid, wave, lane, args.aux != 0); }
    SEAM(2);
    if (IN(3)) { Ptrs c; fill_ptrs(c, args);
        const int wg = blockIdx.x;
        if (G >= 256) {
            if (wg < 128) seq_dispatch(c, lds, wg, tid, wave, lane);
            else for (int j = wg - 128; j < 1024; j += G - 128) seq_dispatch(c, lds, 128 + j, tid, wave, lane);
        }
        else for (int it = wg; it < 128 + 1024; it += G) seq_dispatch(c, lds, it, tid, wave, lane);
    }
    SEAM(3);
    if (IN(4)) { Ptrs c; fill_ptrs(c, args); p3b_finalize(c, G, wave, lane); }
    SEAM(4);
    if (IN(5)) { Ptrs c; fill_ptrs(c, args);
        pg8::Gemm g{c.OF, c.WoT, M, D, D};
        { pg8::StaticOrder S; S.init(MP, D, G, (int)blockIdx.x, D); pg8::EpiRes1 E{c.in[0], c.in[1], c.OY, c.X1B, c.SSQ2};
          pg8::gemm_phase<pg8::EpiRes1, pg8::StaticOrder, true, true>(lds, g, S, E); }
        { pg8::TailOrder S{G, (int)blockIdx.x, 8, D / 64, MP / 256, 4, 16}; pg8::EpiPart E{c.PART4, MP, 1.f};
          pg8::gemm_phase<pg8::EpiPart, pg8::TailOrder, true, true>(lds, g, S, E); }
        if (hi - lo > 1) xcd_barrier(xbar);
        {
            const int gw = blockIdx.x * NWAVES + wave, NGW = G * NWAVES;
            for (int r = gw; r < MS; r += NGW) {
                const int m = MP + r; f32x4 v[4]; float ss = 0.f;
#pragma unroll
                for (int j = 0; j < 4; ++j) v[j] = *(const f32x4*)(c.in[1] + (size_t)r * D + 4 * lane + 256 * j);
#pragma unroll 1
                for (int ks = 0; ks < 8; ++ks)
#pragma unroll
                    for (int j = 0; j < 4; ++j) v[j] += *(const f32x4*)(c.PART4 + ((size_t)ks * 1024 + r) * 1024 + 4 * lane + 256 * j);
#pragma unroll
                for (int j = 0; j < 4; ++j) {
                    *(f32x4*)(c.OY + (size_t)m * D + 4 * lane + 256 * j) = v[j];
                    u32x2 w; w.x = pk_bf16(v[j][0], v[j][1]); w.y = pk_bf16(v[j][2], v[j][3]); *(u32x2*)(c.X1B + (size_t)m * D + 4 * lane + 256 * j) = w;
                    ss += (v[j][0] * v[j][0] + v[j][1] * v[j][1]) + (v[j][2] * v[j][2] + v[j][3] * v[j][3]);
                }
                ss = wave_sum(ss);
                if (lane < 16) c.SSQ2[(size_t)m * 16 + lane] = lane == 0 ? ss : 0.f;
            }
        }
    }
    SEAM(5);
    if (IN(6)) { Ptrs c; fill_ptrs(c, args);
        pg8::Gemm g{c.X1B, c.W13T, M, NUP, D}; pg8::StaticOrder S; S.init(M, NUP, G, (int)blockIdx.x, D);
        pg8::EpiSwiglu E{c.HID, c.SSQ2};
        pg8::gemm_phase<pg8::EpiSwiglu, pg8::StaticOrder, true, true>(lds, g, S, E);
    }
    SEAM(6);
    if (IN(7)) { Ptrs c; fill_ptrs(c, args);
        pg8::Gemm g{c.HID, c.W2T, M, D, FF};
        if (G == 256 && hi - lo > 1) {
            pg8::StaticOrder S; S.init(MP, D, G, (int)blockIdx.x, FF); EpiRes2Norm E{c.OY, c.SSQ3, c.in[16], xbar};
            pg8::gemm_phase<EpiRes2Norm, pg8::StaticOrder, true, true>(lds, g, S, E);
        } else {
            pg8::StaticOrder S; S.init(MP, D, G, (int)blockIdx.x, FF); pg8::EpiRes2 E{c.OY, args.aux ? 0.f : 1.f};
            pg8::gemm_phase<pg8::EpiRes2, pg8::StaticOrder, true, true>(lds, g, S, E);
        }
        { pg8::TailOrder S{G, (int)blockIdx.x, 11, FF / 64, MP / 256, 4, 16}; pg8::EpiPart E{c.PART, MP, args.aux ? 0.f : 1.f};
          pg8::gemm_phase<pg8::EpiPart, pg8::TailOrder, true, true>(lds, g, S, E); }
    }
    SEAM(7);
    if (IN(8)) { Ptrs c; fill_ptrs(c, args);
        const int NGW = G * NWAVES, gw = blockIdx.x * NWAVES + wave + ((G == 256 && hi - lo > 1) ? MP : 0);
        f32x4 gn[4];
#pragma unroll
        for (int j = 0; j < 4; ++j) gn[j] = *(const f32x4*)(c.in[16] + 4 * lane + 256 * j);
        f32x4 v[4], nv[4];
        { const int m0 = gw < M ? gw : M - 1;
#pragma unroll
          for (int j = 0; j < 4; ++j) v[j] = *(const f32x4*)(c.OY + (size_t)m0 * D + 4 * lane + 256 * j); }
#define ADD_PARTS(vv, mm) do { if ((mm) >= MP) { _Pragma("unroll 1") for (int ks = 0; ks < 11; ++ks) { _Pragma("unroll") for (int j = 0; j < 4; ++j) \
            vv[j] += *(const f32x4*)(c.PART + ((size_t)ks * 1024 + ((mm) - MP)) * 1024 + 4 * lane + 256 * j); } } } while (0)
        { const int m0 = gw < M ? gw : M - 1; ADD_PARTS(v, m0); }
        for (int m = gw; m < M; m += NGW) {
            float* yr = c.OY + (size_t)m * D; float s = 0.f;
            { const int mn = m + NGW < M ? m + NGW : m;
#pragma unroll
              for (int j = 0; j < 4; ++j) nv[j] = *(const f32x4*)(c.OY + (size_t)mn * D + 4 * lane + 256 * j);
              ADD_PARTS(nv, mn); }
#pragma unroll
            for (int j = 0; j < 4; ++j) s += (v[j][0] * v[j][0] + v[j][1] * v[j][1]) + (v[j][2] * v[j][2] + v[j][3] * v[j][3]);
            const float rs = __builtin_amdgcn_rsqf(wave_sum(s) * (1.0f / D) + EPS);
#pragma unroll
            for (int j = 0; j < 4; ++j) *(f32x4*)(yr + 4 * lane + 256 * j) = args.aux ? v[j] : v[j] * rs * gn[j];
#pragma unroll
            for (int j = 0; j < 4; ++j) v[j] = nv[j];
        }
    }
#undef IN
#undef SEAM
}

extern "C" void kernel_launch(void* const* d_in, const int* in_sizes, int n_in, void* d_out, int out_size, void* d_ws, size_t ws_size, hipStream_t stream) {
    static int grid = 0;
    if (grid == 0) {
        if (n_in != 17 || ws_size < WS_END) { fprintf(stderr, "kernel_launch: unexpected n_in %d / ws %zu\n", n_in, ws_size); grid = -1; return; }
        int dev = 0, cus = 0, per_cu = 0;
        (void)hipGetDevice(&dev); (void)hipDeviceGetAttribute(&cus, hipDeviceAttributeMultiprocessorCount, dev);
        if (hipFuncSetAttribute((const void*)hymba_fwd, hipFuncAttributeMaxDynamicSharedMemorySize, LDS_BYTES) != hipSuccess) { fprintf(stderr, "kernel_launch: hipFuncSetAttribute failed\n"); grid = -1; return; }
        if (hipOccupancyMaxActiveBlocksPerMultiprocessor(&per_cu, (const void*)hymba_fwd, NTHR, LDS_BYTES) != hipSuccess || per_cu < 1) { fprintf(stderr, "kernel_launch: occupancy query says %d\n", per_cu); per_cu = 1; }
        (void)hipGetLastError();
        grid = cus * per_cu;
        if (grid <= 0) grid = 256;
    }
    if (grid < 0) return;
    if (hipMemsetAsync((char*)d_ws + WS_BAR, 0, 16384, stream) != hipSuccess) { fprintf(stderr, "kernel_launch: memset failed\n"); return; }
    Args a{};
    for (int i = 0; i < 17; ++i) a.in[i] = (const float*)d_in[i];
    a.out = (float*)d_out; a.ws = (unsigned char*)d_ws;
    if (MK_N_LAUNCHES == 1) {
        a.ph_lo = 0; a.ph_hi = NPHASE;
        void* kargs[] = {&a};
        hipError_t e = hipLaunchCooperativeKernel((const void*)hymba_fwd, dim3(grid), dim3(NTHR), kargs, LDS_BYTES, stream);
        if (e != hipSuccess) fprintf(stderr, "kernel_launch: cooperative launch failed: %s (grid %d)\n", hipGetErrorString(e), grid);
    } else {
        for (int p = 0; p < NPHASE; ++p) { a.ph_lo = p; a.ph_hi = p + 1; const int nrep = ((REP_MASK >> p) & 1) ? 3 : 1;
            for (int rr = 0; rr < nrep; ++rr) { a.aux = ((p == 2 || p == 7 || p == 8) && rr + 1 < nrep) ? 1 : 0; hipLaunchKernelGGL(hymba_fwd, dim3(grid), dim3(NTHR), LDS_BYTES, stream, a); } }
    }
}
```

```cpp
#include <hip/hip_runtime.h>
#include <hip/hip_cooperative_groups.h>
#include <cstdio>
#include <cstdint>
namespace cg = cooperative_groups;
namespace pg8 {
#define PG8_LAS __attribute__((address_space(3)))
typedef unsigned short bf16_t;
typedef short bf16x8 __attribute__((ext_vector_type(8)));
typedef float f32x4 __attribute__((ext_vector_type(4)));
typedef unsigned u32x4 __attribute__((ext_vector_type(4)));
constexpr int BM = 256, BK = 64, HALF = 128, HTB = HALF * BK * 2  , STAGE_BYTES = 8 * HTB, NXCD = 8, WGM = 8;

__host__ __device__ __forceinline__ int lds_byte(int r, int c) { const int st = (r >> 4) * 2 + (c >> 5), rr = r & 15, cc = c & 31, ob = rr * 64 + cc * 2; return st * 1024 + (ob ^ (((ob >> 9) & 1) << 5)); }
__host__ __device__ __forceinline__ void stage_rc(int b, int& R, int& C) { const int st = b / 1024, sb = b % 1024, swz = sb ^ (((sb >> 9) & 1) << 5); R = (st >> 1) * 16 + swz / 64; C = (st & 1) * 32 + (swz % 64) / 2; }
__host__ __device__ __forceinline__ int perm32(int rho) { const int n = rho >> 4, i = rho & 15; return 8 * (i >> 2) + 4 * n + (i & 3); }

struct Unit { int pm, pn, k0, nk; };
struct Gemm { const bf16_t* A; const bf16_t* Bt; int M, N, K; };

struct StaticOrder {
    int nM, nN, nwg, G, c, nkt;
    __host__ __device__ void init(int M, int N, int G_, int c_, int K_) { nM = M / BM; nN = N / BM; nwg = nM * nN; G = G_; c = c_; nkt = K_ / BK; }
    __host__ __device__ bool next(int i, Unit& u) const { return at((long)i * G + c, u); }
    __host__ __device__ bool at(long L, Unit& u) const {
        if (L >= nwg) return false;
        int wgid = (int)L; { const int q = nwg / NXCD, r = nwg % NXCD, xcd = wgid % NXCD, off = wgid / NXCD; wgid = (xcd < r ? xcd * (q + 1) : r * (q + 1) + (xcd - r) * q) + off; }
        const int nig = WGM * nN, gid = wgid / nig, fm = gid * WGM, gsz = (nM - fm) < WGM ? (nM - fm) : WGM;
        u.pm = fm + ((wgid % nig) % gsz); u.pn = (wgid % nig) / gsz; u.k0 = 0; u.nk = nkt; return true;
    }
    __device__ __forceinline__ void a_ready(const Unit&) const {}
    __device__ __forceinline__ void done(const Unit&) const {}
};


struct TailOrder {
    int G, c, NS, nkt, pm0, nN, ntu;
    __host__ __device__ bool next(int i, Unit& u) const {
        const int id = i * G + c; if (id >= ntu * NS) return false;
        const int tu = id / NS, ks = id % NS; u.pm = pm0 + tu / nN; u.pn = tu % nN; u.nk = nkt / NS; u.k0 = ks * u.nk; return true;
    }
    __device__ __forceinline__ void a_ready(const Unit&) const {}
    __device__ __forceinline__ void done(const Unit&) const {}
};

__device__ __forceinline__ unsigned cvt_pk_bf16(float lo, float hi) { unsigned r; asm volatile("v_cvt_pk_bf16_f32 %0, %1, %2" : "=v"(r) : "v"(lo), "v"(hi)); return r; }
typedef float f32x2 __attribute__((ext_vector_type(2)));

template <class Epi, class Sched, bool ALIGN_EPI = false, bool SP2 = false>
__device__ __forceinline__ void gemm_phase(PG8_LAS unsigned char* lds, const Gemm g, const Sched& S, const Epi& E) {
    const int tid = threadIdx.x, wid = __builtin_amdgcn_readfirstlane(tid >> 6), lane = tid & 63, wr = wid >> 2, wc = wid & 3, fr = lane & 15, fq = lane >> 4;
    const int K = g.K, nt = K / BK;
    unsigned voffA[2], voffB[2];
#pragma unroll
    for (int i = 0; i < 2; ++i) { int R, C; stage_rc(tid * 16 + i * 8192, R, C); const int Rb = Epi::PERM ? ((R & ~31) + perm32(R & 31)) : R;
        voffA[i] = (unsigned)(R * K + C) * 2u; voffB[i] = (unsigned)(Rb * K + C) * 2u; }
    const size_t kstep = (size_t)(BK * 2);
    const size_t hstep = (size_t)HALF * K * 2;
    const size_t tstep = 2 * hstep;
    const unsigned ldsw = (unsigned)wid * 1024u;
    const int aoff = lds_byte(wr * 64 + fr, fq * 8), boff = lds_byte(wc * 32 + fr, fq * 8);
#define PG8_SA(b, h) (((b) * 2 + (h)) * HTB)
#define PG8_SB(b, h) ((4 + (b) * 2 + (h)) * HTB)
#define PG8_STAGE(bufoff, gbase, voff) do { _Pragma("unroll") for (int _i = 0; _i < 2; ++_i) \
        __builtin_amdgcn_global_load_lds((const unsigned*)((const char*)(gbase) + (voff)[_i]), (PG8_LAS unsigned*)(lds + (bufoff) + ldsw + _i * 8192), 16, 0, 0); } while (0)
#define PG8_LDA(dst, b, h) do { _Pragma("unroll") for (int m = 0; m < 4; ++m) _Pragma("unroll") for (int k = 0; k < 2; ++k) dst[m][k] = *(const PG8_LAS bf16x8*)(lds + PG8_SA(b, h) + aoff + m * 2048 + k * 1024); } while (0)
#define PG8_LDB(dst, b, h) do { _Pragma("unroll") for (int n = 0; n < 2; ++n) _Pragma("unroll") for (int k = 0; k < 2; ++k) dst[n][k] = *(const PG8_LAS bf16x8*)(lds + PG8_SB(b, h) + boff + n * 2048 + k * 1024); } while (0)
#define PG8_MMA(ai, bj, At, Bt) do { __builtin_amdgcn_s_setprio(1); _Pragma("unroll") for (int m = 0; m < 4; ++m) _Pragma("unroll") for (int n = 0; n < 2; ++n) _Pragma("unroll") for (int k = 0; k < 2; ++k) \
        acc[ai][bj][m][n] = __builtin_amdgcn_mfma_f32_16x16x32_bf16(Bt[n][k], At[m][k], acc[ai][bj][m][n], 0, 0, 0); __builtin_amdgcn_s_setprio(0); } while (0)
#define PG8_WAIT_V(n) asm volatile("s_waitcnt vmcnt(" #n ")" ::: "memory")
#define PG8_WAIT_L(n) asm volatile("s_waitcnt lgkmcnt(" #n ")" ::: "memory")
#define PG8_BAR __builtin_amdgcn_s_barrier()
#define PG8_SCHED __builtin_amdgcn_sched_barrier(0)
    Unit cur, nxt; int ui = 0;
    if (!S.next(0, cur)) return;
    f32x4 acc[2][2][4][2];
#pragma unroll
    for (int a = 0; a < 2; ++a)
#pragma unroll
        for (int b = 0; b < 2; ++b)
#pragma unroll
            for (int m = 0; m < 4; ++m)
#pragma unroll
                for (int n = 0; n < 2; ++n) acc[a][b][m][n] = (f32x4){0.f, 0.f, 0.f, 0.f};
    bf16x8 At[4][2], B0[2][2], B1[2][2];
    const char* cA = (const char*)g.A + (size_t)cur.pm * tstep + (size_t)cur.k0 * kstep; const char* cB = (const char*)g.Bt + (size_t)cur.pn * tstep + (size_t)cur.k0 * kstep;
    S.a_ready(cur);
    if constexpr (SP2) {
        PG8_STAGE(PG8_SB(0, 0), cB, voffB); PG8_STAGE(PG8_SB(0, 1), cB + hstep, voffB); PG8_STAGE(PG8_SA(0, 0), cA, voffA); PG8_STAGE(PG8_SA(0, 1), cA + hstep, voffA);
        if (wr == 1) PG8_BAR;
        PG8_WAIT_V(2); PG8_BAR;
        PG8_STAGE(PG8_SB(1, 0), cB + kstep, voffB); PG8_STAGE(PG8_SA(1, 0), cA + kstep, voffA); PG8_STAGE(PG8_SB(1, 1), cB + hstep + kstep, voffB);
        PG8_WAIT_V(6); PG8_BAR;
    } else {
        PG8_STAGE(PG8_SB(0, 0), cB, voffB); PG8_STAGE(PG8_SA(0, 0), cA, voffA); PG8_STAGE(PG8_SB(0, 1), cB + hstep, voffB); PG8_STAGE(PG8_SA(0, 1), cA + hstep, voffA);
        if (wr == 1) PG8_BAR;
        PG8_WAIT_V(4); PG8_BAR;
        PG8_STAGE(PG8_SB(1, 0), cB + kstep, voffB); PG8_STAGE(PG8_SA(1, 0), cA + kstep, voffA); PG8_STAGE(PG8_SB(1, 1), cB + hstep + kstep, voffB);
        PG8_WAIT_V(6); PG8_BAR;
    }
    for (;;) {
        const bool has_next = S.next(ui + 1, nxt);
        const char* nA = has_next ? (const char*)g.A + (size_t)nxt.pm * tstep + (size_t)nxt.k0 * kstep : cA; const char* nB = has_next ? (const char*)g.Bt + (size_t)nxt.pn * tstep + (size_t)nxt.k0 * kstep : cB;
        const int ntc = cur.nk;
        for (int t = 0; t < ntc; t += 2) {
            const bool last = (t == ntc - 2);
            const char* a1 = cA + (size_t)(t + 1) * kstep;
            const char* a2 = last ? nA : cA + (size_t)(t + 2) * kstep; const char* b2 = last ? nB : cB + (size_t)(t + 2) * kstep;
            const char* a3 = a2 + kstep; const char* b3 = b2 + kstep;
            if (last && has_next) S.a_ready(nxt);
            if constexpr (SP2) {
            PG8_LDB(B0, 0, 0); PG8_LDB(B1, 0, 1); PG8_SCHED; PG8_LDA(At, 0, 0); PG8_STAGE(PG8_SA(1, 1), a1 + hstep, voffA);
            PG8_WAIT_V(8); PG8_WAIT_L(0); PG8_BAR; PG8_MMA(0, 0, At, B0); PG8_MMA(0, 1, At, B1); PG8_BAR; PG8_SCHED;
            PG8_LDA(At, 0, 1); PG8_STAGE(PG8_SB(0, 0), b2, voffB); PG8_STAGE(PG8_SB(0, 1), b2 + hstep, voffB); PG8_STAGE(PG8_SA(0, 0), a2, voffA);
            PG8_WAIT_V(8); PG8_WAIT_L(0); PG8_BAR; PG8_MMA(1, 0, At, B0); PG8_MMA(1, 1, At, B1); PG8_BAR; PG8_SCHED;
            PG8_LDB(B0, 1, 0); PG8_LDB(B1, 1, 1); PG8_SCHED; PG8_LDA(At, 1, 0); PG8_STAGE(PG8_SA(0, 1), a2 + hstep, voffA);
            PG8_WAIT_V(8); PG8_WAIT_L(0); PG8_BAR; PG8_MMA(0, 0, At, B0); PG8_MMA(0, 1, At, B1); PG8_BAR; PG8_SCHED;
            PG8_LDA(At, 1, 1); PG8_STAGE(PG8_SB(1, 0), b3, voffB); PG8_STAGE(PG8_SB(1, 1), b3 + hstep, voffB); PG8_STAGE(PG8_SA(1, 0), a3, voffA);
            PG8_WAIT_V(8); PG8_WAIT_L(0); PG8_BAR; PG8_MMA(1, 0, At, B0); PG8_MMA(1, 1, At, B1); PG8_BAR; PG8_SCHED;
            } else {
            PG8_LDB(B0, 0, 0); PG8_SCHED; PG8_LDA(At, 0, 0); PG8_STAGE(PG8_SA(1, 1), a1 + hstep, voffA);
            PG8_WAIT_L(8); PG8_BAR; PG8_WAIT_L(0); PG8_MMA(0, 0, At, B0); PG8_BAR; PG8_SCHED;
            PG8_LDB(B1, 0, 1); PG8_STAGE(PG8_SB(0, 0), b2, voffB);
            PG8_BAR; PG8_WAIT_L(0); PG8_MMA(0, 1, At, B1); PG8_BAR;
            PG8_LDA(At, 0, 1); PG8_STAGE(PG8_SA(0, 0), a2, voffA);
            PG8_BAR; PG8_WAIT_L(0); PG8_MMA(1, 0, At, B0); PG8_BAR; PG8_SCHED;
            PG8_STAGE(PG8_SB(0, 1), b2 + hstep, voffB);
            PG8_WAIT_V(6); PG8_BAR; PG8_MMA(1, 1, At, B1); PG8_BAR;
            PG8_LDB(B0, 1, 0); PG8_SCHED; PG8_LDA(At, 1, 0); PG8_STAGE(PG8_SA(0, 1), a2 + hstep, voffA);
            PG8_WAIT_L(8); PG8_BAR; PG8_WAIT_L(0); PG8_MMA(0, 0, At, B0); PG8_BAR; PG8_SCHED;
            PG8_LDB(B1, 1, 1); PG8_STAGE(PG8_SB(1, 0), b3, voffB);
            PG8_BAR; PG8_WAIT_L(0); PG8_MMA(0, 1, At, B1); PG8_BAR;
            PG8_LDA(At, 1, 1); PG8_STAGE(PG8_SA(1, 0), a3, voffA);
            PG8_BAR; PG8_WAIT_L(0); PG8_MMA(1, 0, At, B0); PG8_BAR; PG8_SCHED;
            PG8_STAGE(PG8_SB(1, 1), b3 + hstep, voffB);
            PG8_WAIT_V(6); PG8_BAR; PG8_MMA(1, 1, At, B1); PG8_BAR;
            }
        }
        if constexpr (ALIGN_EPI) { if (wr == 0) PG8_BAR; }
        if constexpr (!Epi::AFTER_DRAIN) { E(acc, cur, wr, wc, fr, fq); S.done(cur); }
        if (!has_next) break;
#pragma unroll
        for (int a = 0; a < 2; ++a)
#pragma unroll
            for (int b = 0; b < 2; ++b)
#pragma unroll
                for (int m = 0; m < 4; ++m)
#pragma unroll
                    for (int n = 0; n < 2; ++n) acc[a][b][m][n] = (f32x4){0.f, 0.f, 0.f, 0.f};
        cur = nxt; cA = nA; cB = nB; ++ui;
        if constexpr (ALIGN_EPI) { if (wr == 1) PG8_BAR; }
    }
    PG8_WAIT_V(0);
    if constexpr (!ALIGN_EPI) { if (wr == 0) PG8_BAR; }
    PG8_BAR;
    if constexpr (Epi::AFTER_DRAIN) { E.fused(acc, cur, wr, wc, fr, fq, lds, wid, lane); S.done(cur); }
#undef PG8_SA
#undef PG8_SB
#undef PG8_STAGE
#undef PG8_LDA
#undef PG8_LDB
#undef PG8_MMA
#undef PG8_WAIT_V
#undef PG8_WAIT_L
#undef PG8_BAR
#undef PG8_SCHED
}
}

#ifndef MK_N_LAUNCHES
#define MK_N_LAUNCHES 1
#endif
#ifndef REP_MASK
#define REP_MASK 0
#endif
#define LAS __attribute__((address_space(3)))
using pg8::bf16_t; using pg8::bf16x8; using pg8::f32x4; using pg8::u32x4;
typedef float f32x16 __attribute__((ext_vector_type(16)));
typedef __bf16 bf16x2_t __attribute__((ext_vector_type(2)));
typedef float f32x2_t __attribute__((ext_vector_type(2)));
typedef unsigned u32x2 __attribute__((ext_vector_type(2)));

constexpr int NWAVES = 8, NTHR = 512;
constexpr int D = 1024, MP = 16384, MS = 1024, M = MP + MS, NIN = 3840, PLD = 3584, FF = 2816, NUP = 2 * FF;
constexpr float EPS = 1e-6f;
constexpr size_t MiB = 1u << 20;
constexpr size_t WS_BAR = 26 * MiB + 768 * 1024, WS_WIN = 0, WS_WO = 8 * MiB, WS_W13 = 10 * MiB, WS_W2 = 21 * MiB, WS_RSTD1 = 27 * MiB, WS_SSQ2 = 28 * MiB, WS_LRA = 32 * MiB, WS_DCH = 34 * MiB,
                 WS_KDTS = 37 * MiB, WS_XB = 45 * MiB, WS_FB = 79 * MiB, WS_P = 113 * MiB, WS_END = 233 * MiB;
static_assert(WS_P + (size_t)(M + 32) * PLD * 2 <= WS_END && WS_XB + (size_t)M * D * 2 <= WS_FB && WS_FB + (size_t)M * 512 * 4 <= WS_P, "ws map");
constexpr size_t OUT_Y = 0, OUT_SAP = 17825792, OUT_SBP = 18087936, OUT_SAS = 18612224, OUT_SBS = 22806528;
constexpr int LDS_BYTES = 160768;

__device__ __forceinline__ unsigned pk_bf16(float lo, float hi) { f32x2_t v = {lo, hi}; bf16x2_t b = __builtin_convertvector(v, bf16x2_t); return __builtin_bit_cast(unsigned, b); }
__device__ __forceinline__ float bf_lo(unsigned u) { return __uint_as_float(u << 16); }
__device__ __forceinline__ float bf_hi(unsigned u) { return __uint_as_float(u & 0xffff0000u); }
__device__ __forceinline__ float bf_f(unsigned short u) { return __uint_as_float(((unsigned)u) << 16); }


template <int CTRL, int ROWMASK> __device__ __forceinline__ float dpp_f(float v) { return __builtin_bit_cast(float, __builtin_amdgcn_update_dpp(0, __builtin_bit_cast(int, v), CTRL, ROWMASK, 0xF, true)); }
__device__ __forceinline__ float row16_sum(float v) { v += dpp_f<0xB1, 0xF>(v); v += dpp_f<0x4E, 0xF>(v); v += dpp_f<0x141, 0xF>(v); v += dpp_f<0x140, 0xF>(v); return v; }
__device__ __forceinline__ float scan32(float a) {
    a += dpp_f<0x111, 0xF>(a); a += dpp_f<0x112, 0xF>(a); a += dpp_f<0x114, 0xF>(a); a += dpp_f<0x118, 0xF>(a); a += dpp_f<0x142, 0xA>(a); return a; }
template <int CTRL, int ROWMASK> __device__ __forceinline__ float dpp_f1(float v) { return __builtin_bit_cast(float, __builtin_amdgcn_update_dpp(0x3f800000, __builtin_bit_cast(int, v), CTRL, ROWMASK, 0xF, false)); }
__device__ __forceinline__ float scanmul32(float a) {
    a *= dpp_f1<0x111, 0xF>(a); a *= dpp_f1<0x112, 0xF>(a); a *= dpp_f1<0x114, 0xF>(a); a *= dpp_f1<0x118, 0xF>(a); a *= dpp_f1<0x142, 0xA>(a); return a; }
__device__ __forceinline__ float lane_bcast(float v, int l);
__device__ __forceinline__ float wave_sum(float v) { v = row16_sum(v); return (lane_bcast(v, 0) + lane_bcast(v, 16)) + (lane_bcast(v, 32) + lane_bcast(v, 48)); }
__device__ __forceinline__ float lane_bcast(float v, int l) { return __builtin_bit_cast(float, __builtin_amdgcn_readlane(__builtin_bit_cast(int, v), l)); }
#define LDS_WAIT() asm volatile("s_waitcnt lgkmcnt(0)" ::: "memory")
#define WG_BAR() do { asm volatile("s_waitcnt lgkmcnt(0)" ::: "memory"); __builtin_amdgcn_s_barrier(); asm volatile("" ::: "memory"); } while (0)
#define MFMA32(a, b, c) __builtin_amdgcn_mfma_f32_32x32x16_bf16((a), (b), (c), 0, 0, 0)
#define MFMA16(a, b, c) __builtin_amdgcn_mfma_f32_16x16x32_bf16((a), (b), (c), 0, 0, 0)

struct Ptrs {
    const float* in[17]; float* out;
    bf16_t *WinT, *WoT, *W13T, *W2T, *XB, *P, *KDTS, *OF, *X1B, *HID;
    float *RSTD1, *SSQ2, *LRA, *DCH, *FB, *OY; bf16_t *DUMP, *OX, *OI; float *PART, *PART4, *SSQ3;
};

namespace pg8 {
struct EpiIn {
    static constexpr bool PERM = true, AFTER_DRAIN = false;
    bf16_t* P; float* FB; float* LRA; const float* rstd;
    __device__ __forceinline__ void operator()(const f32x4 (&acc)[2][2][4][2], const Unit& u, int wr, int wc, int fr, int fq) const {
        const int row0 = u.pm * BM + wr * 64 + fr, ct = wc * 32 + 8 * fq;
#pragma unroll
        for (int ai = 0; ai < 2; ++ai)
#pragma unroll
            for (int m = 0; m < 4; ++m) {
                const int row = row0 + ai * HALF + m * 16; const float rs = rstd[row];
#pragma unroll
                for (int bj = 0; bj < 2; ++bj) {
                    const f32x4 v0 = acc[ai][bj][m][0] * rs, v1 = acc[ai][bj][m][1] * rs; const int cl = bj * HALF + ct;
                    if (u.pn == 8 || u.pn == 9) { float* o = FB + (size_t)row * 512 + (u.pn - 8) * BM + cl; *(f32x4*)o = v0; *(f32x4*)(o + 4) = v1; }
                    else if (u.pn == 14) { if (cl < 16) { float* o = LRA + (size_t)row * 16 + cl; *(f32x4*)o = v0; *(f32x4*)(o + 4) = v1; } }
                    else { u32x4 w; w.x = cvt_pk_bf16(v0[0], v0[1]); w.y = cvt_pk_bf16(v0[2], v0[3]); w.z = cvt_pk_bf16(v1[0], v1[1]); w.w = cvt_pk_bf16(v1[2], v1[3]);
                           *(u32x4*)(P + (size_t)row * 3584 + u.pn * BM + cl) = w; }
                }
            }
    }
};
struct EpiRes1 {
    static constexpr bool PERM = true, AFTER_DRAIN = false;
    const float* xp; const float* xs; float* Y; bf16_t* X1B; float* SSQ;
    __device__ __forceinline__ void operator()(const f32x4 (&acc)[2][2][4][2], const Unit& u, int wr, int wc, int fr, int fq) const {
        const int row0 = u.pm * BM + wr * 64 + fr, ct = u.pn * BM + wc * 32 + 8 * fq;
#pragma unroll
        for (int ai = 0; ai < 2; ++ai)
#pragma unroll
            for (int m = 0; m < 4; ++m) {
                const int row = row0 + ai * HALF + m * 16;
                const float* xr = row < 16384 ? xp + (size_t)row * 1024 : xs + (size_t)(row - 16384) * 1024;
                float ss = 0.f;
#pragma unroll
                for (int bj = 0; bj < 2; ++bj) {
                    const int col = ct + bj * HALF;
                    const f32x4 v0 = acc[ai][bj][m][0] + *(const f32x4*)(xr + col), v1 = acc[ai][bj][m][1] + *(const f32x4*)(xr + col + 4);
                    u32x4 w; w.x = cvt_pk_bf16(v0[0], v0[1]); w.y = cvt_pk_bf16(v0[2], v0[3]); w.z = cvt_pk_bf16(v1[0], v1[1]); w.w = cvt_pk_bf16(v1[2], v1[3]);
                    *(u32x4*)(X1B + (size_t)row * 1024 + col) = w;
                    ss += (v0[0] * v0[0] + v0[1] * v0[1]) + (v0[2] * v0[2] + v0[3] * v0[3]) + (v1[0] * v1[0] + v1[1] * v1[1]) + (v1[2] * v1[2] + v1[3] * v1[3]);
                }
                ss += __shfl_xor(ss, 16); ss += __shfl_xor(ss, 32);
                if (fq == 0) SSQ[(size_t)row * 16 + u.pn * 4 + wc] = ss;
            }
    }
};
struct EpiSwiglu {
    static constexpr bool PERM = true, AFTER_DRAIN = false;
    bf16_t* H; const float* SSQ;
    __device__ __forceinline__ void operator()(const f32x4 (&acc)[2][2][4][2], const Unit& u, int wr, int wc, int fr, int fq) const {
        const int row0 = u.pm * BM + wr * 64 + fr, hc = u.pn * 128 + wc * 16 + fq * 4;
#pragma unroll
        for (int ai = 0; ai < 2; ++ai)
#pragma unroll
            for (int m = 0; m < 4; ++m) {
                const int row = row0 + ai * HALF + m * 16;
                const f32x4* sp = (const f32x4*)(SSQ + (size_t)row * 16);
                const f32x4 s0 = sp[0], s1 = sp[1], s2 = sp[2], s3 = sp[3];
                const float tot = ((s0[0] + s0[1]) + (s0[2] + s0[3])) + ((s1[0] + s1[1]) + (s1[2] + s1[3])) + ((s2[0] + s2[1]) + (s2[2] + s2[3])) + ((s3[0] + s3[1]) + (s3[2] + s3[3]));
                const float rs = __builtin_amdgcn_rsqf(tot * (1.0f / 1024.0f) + 1e-6f);
#pragma unroll
                for (int bj = 0; bj < 2; ++bj) {
                    const f32x4 a = acc[ai][bj][m][0] * rs, b = acc[ai][bj][m][1] * rs; float h[4];
#pragma unroll
                    for (int e = 0; e < 4; ++e) h[e] = a[e] * __builtin_amdgcn_rcpf(1.0f + __expf(-a[e])) * b[e];
                    unsigned lo = cvt_pk_bf16(h[0], h[1]), hi = cvt_pk_bf16(h[2], h[3]);
                    *(unsigned long long*)(H + (size_t)row * 2816 + hc + bj * 64) = (unsigned long long)lo | ((unsigned long long)hi << 32);
                }
            }
    }
};
struct EpiRes2 {
    static constexpr bool PERM = true, AFTER_DRAIN = false;
    float* Y; float sc; const bf16_t* X1B;
    __device__ __forceinline__ void operator()(const f32x4 (&acc)[2][2][4][2], const Unit& u, int wr, int wc, int fr, int fq) const {
        const int row0 = u.pm * BM + wr * 64 + fr, ct = u.pn * BM + wc * 32 + 8 * fq;
#pragma unroll
        for (int ai = 0; ai < 2; ++ai)
#pragma unroll
            for (int m = 0; m < 4; ++m) {
                float* yr = Y + (size_t)(row0 + ai * HALF + m * 16) * 1024;
#pragma unroll
                for (int bj = 0; bj < 2; ++bj) {
                    const int col = ct + bj * HALF;
                    const pg8::u32x4 xr = *(const pg8::u32x4*)(X1B + (size_t)(row0 + ai * HALF + m * 16) * 1024 + col);
                    const f32x4 v0 = acc[ai][bj][m][0] * sc + (f32x4){__uint_as_float(xr.x << 16), __uint_as_float(xr.x & 0xffff0000u), __uint_as_float(xr.y << 16), __uint_as_float(xr.y & 0xffff0000u)};
                    const f32x4 v1 = acc[ai][bj][m][1] * sc + (f32x4){__uint_as_float(xr.z << 16), __uint_as_float(xr.z & 0xffff0000u), __uint_as_float(xr.w << 16), __uint_as_float(xr.w & 0xffff0000u)};
                    *(f32x4*)(yr + col) = v0; *(f32x4*)(yr + col + 4) = v1;
                }
            }
    }
};
struct EpiPart {
    static constexpr bool PERM = true, AFTER_DRAIN = false;
    float* PART; int rowbase; float sc;
    __device__ __forceinline__ void operator()(const f32x4 (&acc)[2][2][4][2], const Unit& u, int wr, int wc, int fr, int fq) const {
        const int row0 = u.pm * BM + wr * 64 + fr - rowbase, ct = u.pn * BM + wc * 32 + 8 * fq;
        float* base = PART + (size_t)(u.k0 / u.nk) * 1024 * 1024;
#pragma unroll
        for (int ai = 0; ai < 2; ++ai)
#pragma unroll
            for (int m = 0; m < 4; ++m) {
                float* yr = base + (size_t)(row0 + ai * HALF + m * 16) * 1024;
#pragma unroll
                for (int bj = 0; bj < 2; ++bj) { const int col = ct + bj * HALF; *(f32x4*)(yr + col) = acc[ai][bj][m][0] * sc; *(f32x4*)(yr + col + 4) = acc[ai][bj][m][1] * sc; }
            }
    }
};
}

__device__ __forceinline__ void tr_item(const float* colp, int ldw, const float* gain, int k0, int dcol, bf16_t* WT, int K, int nrow0, LAS float* scr, int lane) {
    float tv[32];
#pragma unroll
    for (int i = 0; i < 32; ++i) { const int kk = 2 * i + (lane >> 5); tv[i] = colp ? colp[(size_t)(k0 + kk) * ldw] : 0.f; }
    if (gain) {
        float gv[32];
#pragma unroll
        for (int i = 0; i < 32; ++i) gv[i] = gain[k0 + 2 * i + (lane >> 5)];
#pragma unroll
        for (int i = 0; i < 32; ++i) tv[i] *= gv[i];
    }
#pragma unroll
    for (int i = 0; i < 32; ++i) scr[(2 * i + (lane >> 5)) * 33 + dcol] = tv[i];
    LDS_WAIT();
    const int c = lane & 7;
#pragma unroll
    for (int j = 0; j < 4; ++j) {
        const int n = (lane >> 3) + 8 * j; const LAS float* s = scr + (8 * c) * 33 + n;
        u32x4 o; o.x = pk_bf16(s[0 * 33], s[1 * 33]); o.y = pk_bf16(s[2 * 33], s[3 * 33]); o.z = pk_bf16(s[4 * 33], s[5 * 33]); o.w = pk_bf16(s[6 * 33], s[7 * 33]);
        *(u32x4*)(WT + (size_t)(nrow0 + n) * K + k0 + 8 * c) = o;
    }
    LDS_WAIT();
}
__device__ __forceinline__ void weight_items(const Ptrs& c, LAS float* scr, int part, int gw, int NGW, int lane) {
    const int l31 = lane & 31;
    constexpr int I_IN = 16 * 120, I_O = 16 * 32, I_13 = 16 * 176, I_2 = 44 * 32;
    if (part == 0) {
        for (int r = gw; r < I_IN; r += NGW) { const int kb = r / 120, nb = r % 120, n = nb * 32 + l31;
            const int oc = n < 1536 ? n : (n < 3584 ? n + 16 : (n < 3600 ? n - 3584 + 1536 : -1));
            tr_item(oc >= 0 ? c.in[5] + oc : nullptr, 3600, c.in[4], kb * 64, l31, c.WinT, 1024, nb * 32, scr, lane); }
        return;
    }
    for (int it = gw; it < I_O + I_13 + I_2; it += NGW) {
        int r = it;
        if (r < I_O) { const int kb = r / 32, nb = r % 32; tr_item(c.in[11] + nb * 32 + l31, 1024, nullptr, kb * 64, l31, c.WoT, 1024, nb * 32, scr, lane); continue; }
        r -= I_O;
        if (r < I_13) { const int kb = r / 176, nb = r % 176; const bool is3 = l31 >= 16; const int hcol = nb * 16 + (l31 & 15);
            tr_item((is3 ? c.in[14] : c.in[13]) + hcol, 2816, c.in[12], kb * 64, ((l31 & 15) >> 2) * 8 + (is3 ? 4 : 0) + (l31 & 3), c.W13T, 1024, nb * 32, scr, lane); continue; }
        r -= I_13;
        { const int kb = r / 32, nb = r % 32; tr_item(c.in[15] + nb * 32 + l31, 1024, nullptr, kb * 64, l31, c.W2T, 2816, nb * 32, scr, lane); }
    }
}
__device__ __forceinline__ void p0_prologue(const Ptrs& c, LAS unsigned char* lds, int G, int wave, int lane, bool all_weights) {
    LAS float* scr = (LAS float*)(lds + wave * 16384);
    const int gw = blockIdx.x * NWAVES + wave, NGW = G * NWAVES;
    weight_items(c, scr, 0, gw, NGW, lane);
    if (all_weights) weight_items(c, scr, 1, gw, NGW, lane);
    {
        f32x4 v[4], nv[4];
        { const int m0 = gw < M ? gw : M - 1; const float* xr = m0 < MP ? c.in[0] + (size_t)m0 * D : c.in[1] + (size_t)(m0 - MP) * D;
#pragma unroll
          for (int j = 0; j < 4; ++j) v[j] = *(const f32x4*)(xr + 4 * lane + 256 * j); }
        for (int m = gw; m < M; m += NGW) {
            { const int mn = m + NGW < M ? m + NGW : m; const float* xr = mn < MP ? c.in[0] + (size_t)mn * D : c.in[1] + (size_t)(mn - MP) * D;
#pragma unroll
              for (int j = 0; j < 4; ++j) nv[j] = *(const f32x4*)(xr + 4 * lane + 256 * j); }
            float s = 0.f;
#pragma unroll
            for (int j = 0; j < 4; ++j) s += (v[j][0] * v[j][0] + v[j][1] * v[j][1]) + (v[j][2] * v[j][2] + v[j][3] * v[j][3]);
            s = wave_sum(s);
#pragma unroll
            for (int j = 0; j < 4; ++j) { u32x2 w; w.x = pk_bf16(v[j][0], v[j][1]); w.y = pk_bf16(v[j][2], v[j][3]); *(u32x2*)(c.XB + (size_t)m * D + 4 * lane + 256 * j) = w; }
            if (lane == 0) c.RSTD1[m] = 1.0f / sqrtf(s * (1.0f / D) + EPS);
#pragma unroll
            for (int j = 0; j < 4; ++j) v[j] = nv[j];
        }
    }
}

__device__ __forceinline__ int crow(int i, int h) { return (i & 3) + 8 * (i >> 2) + 4 * h; }
template <int K, bool GLA, bool ALLV>
__device__ __forceinline__ void pre_item(const Ptrs& c, int row0, int ntok, int hh, int item, bf16_t* kdt_base, int kdt_stride,
                                         const LAS float* wa2_l, const LAS float* ba_l, const LAS float* lb_l, LAS unsigned char* vt, int lane, bool dry) {
    const int r = lane & 31, kg = lane >> 5;
    const bool valid = ALLV || r < ntok;
    const int row = row0 + (valid ? r : 0), nt1 = ntok - 1;
    constexpr int NJ = K / 16;
    const int qcol0 = GLA ? hh * 64 : 1536 + hh * 128, kcol0 = 256 + hh * 64, vcol0 = GLA ? 512 + hh * 128 : 2560 + hh * 128, ocol0 = (GLA ? hh : 4 + hh) * 128;
    bf16_t* Prow = c.P + (size_t)row * PLD;
    LAS unsigned char* kt = vt + 8192;
    LAS unsigned char* dl = vt + 16384;
    float lra[16];
    if constexpr (GLA) {
#pragma unroll
        for (int i = 0; i < 4; ++i) { const f32x4 t = *(const f32x4*)(c.LRA + (size_t)row * 16 + 4 * i); lra[4 * i] = t[0]; lra[4 * i + 1] = t[1]; lra[4 * i + 2] = t[2]; lra[4 * i + 3] = t[3]; }
    }
    const bf16_t* qptr = Prow + qcol0 + 8 * kg;
    const bf16_t* kptr = Prow + kcol0 + 8 * kg;
    const float* fptr = c.FB + (size_t)row * 512 + hh * 128 + 8 * kg;
    u32x4 qn = *(const u32x4*)qptr, kn = {0u, 0u, 0u, 0u}; f32x4 fn0 = {0.f, 0.f, 0.f, 0.f}, fn1 = fn0;
    if constexpr (GLA) kn = *(const u32x4*)kptr; else { fn0 = *(const f32x4*)fptr; fn1 = *(const f32x4*)(fptr + 4); }
    f32x16 att;
#pragma unroll
    for (int i = 0; i < 16; ++i) att[i] = 0.f;
    float* dch = c.DCH + (size_t)item * 128;
#pragma unroll 1
    for (int j = 0; j < NJ; ++j) {
        const int cl = 16 * j + 8 * kg;
        const u32x4 qr = qn, kr = kn; const f32x4 f0 = fn0, f1 = fn1;
        { const int jn = j + 1 < NJ ? j + 1 : j;
          qn = *(const u32x4*)(qptr + 16 * jn);
          if constexpr (GLA) kn = *(const u32x4*)(kptr + 16 * jn); else { fn0 = *(const f32x4*)(fptr + 16 * jn); fn1 = *(const f32x4*)(fptr + 16 * jn + 4); } }
        float la[8], kv[8], qv[8];
        if constexpr (GLA) {
            const LAS float* wl = wa2_l + hh * 64 + cl;
            f32x4 a0 = *(const LAS f32x4*)(ba_l + hh * 64 + cl), a1 = *(const LAS f32x4*)(ba_l + hh * 64 + cl + 4);
#pragma unroll
            for (int rb = 0; rb < 16; rb += 4) {
                f32x4 w[8];
#pragma unroll
                for (int rr = 0; rr < 4; ++rr) { w[2 * rr] = *(const LAS f32x4*)(wl + (rb + rr) * 256); w[2 * rr + 1] = *(const LAS f32x4*)(wl + (rb + rr) * 256 + 4); }
#pragma unroll
                for (int rr = 0; rr < 4; ++rr) { a0 += w[2 * rr] * lra[rb + rr]; a1 += w[2 * rr + 1] * lra[rb + rr]; }
            }
            float x[8], t[8];
#pragma unroll
            for (int e = 0; e < 8; ++e) x[e] = e < 4 ? a0[e & 3] : a1[e & 3];
#pragma unroll
            for (int e = 0; e < 8; ++e) t[e] = __expf(-fabsf(x[e]));
#pragma unroll
            for (int e = 0; e < 8; ++e) t[e] = __logf(1.0f + t[e]);
#pragma unroll
            for (int e = 0; e < 8; ++e) la[e] = (fminf(x[e], 0.f) - t[e]) * 0.0625f;
            kv[0] = bf_lo(kr.x); kv[1] = bf_hi(kr.x); kv[2] = bf_lo(kr.y); kv[3] = bf_hi(kr.y); kv[4] = bf_lo(kr.z); kv[5] = bf_hi(kr.z); kv[6] = bf_lo(kr.w); kv[7] = bf_hi(kr.w);
        } else {
            const f32x4 l0 = *(const LAS f32x4*)(lb_l + hh * 128 + cl), l1 = *(const LAS f32x4*)(lb_l + hh * 128 + cl + 4);
            float x[8], lbv[8], ex[8], inv[8];
#pragma unroll
            for (int e = 0; e < 8; ++e) { x[e] = e < 4 ? f0[e & 3] : f1[e & 3]; lbv[e] = e < 4 ? l0[e & 3] : l1[e & 3]; }
#pragma unroll
            for (int e = 0; e < 8; ++e) ex[e] = __expf(-fabsf(x[e]));
#pragma unroll
            for (int e = 0; e < 8; ++e) inv[e] = __builtin_amdgcn_rcpf(1.0f + ex[e]);
#pragma unroll
            for (int e = 0; e < 8; ++e) { const float ei = ex[e] * inv[e]; const float sg = x[e] >= 0.f ? inv[e] : ei, ng = x[e] >= 0.f ? ei : inv[e];
                la[e] = lbv[e] + (1.0f - lbv[e]) * sg; kv[e] = (1.0f - lbv[e]) * ng; }
        }
        qv[0] = bf_lo(qr.x); qv[1] = bf_hi(qr.x); qv[2] = bf_lo(qr.y); qv[3] = bf_hi(qr.y); qv[4] = bf_lo(qr.z); qv[5] = bf_hi(qr.z); qv[6] = bf_lo(qr.w); qv[7] = bf_hi(qr.w);
        float qi[8], ki[8], kd[8], eb[8], q[8], ea[8], ia[8];
        if constexpr (GLA) {
#pragma unroll
            for (int e = 0; e < 8; ++e) q[e] = qv[e] * 0.125f;
        } else {
#pragma unroll
            for (int e = 0; e < 8; ++e) q[e] = __expf(-qv[e]);
#pragma unroll
            for (int e = 0; e < 8; ++e) q[e] = __builtin_amdgcn_rcpf(1.0f + q[e]);
#pragma unroll
            for (int e = 0; e < 8; ++e) q[e] *= qv[e];
        }
        if (!ALLV) {
#pragma unroll
            for (int e = 0; e < 8; ++e) if (!valid) { q[e] = 0.f; kv[e] = 0.f; la[e] = GLA ? 0.f : 1.f; }
        }
        if constexpr (GLA) {
#pragma unroll
            for (int e = 0; e < 8; ++e) la[e] += dpp_f<0x111, 0xF>(la[e]);
#pragma unroll
            for (int e = 0; e < 8; ++e) la[e] += dpp_f<0x112, 0xF>(la[e]);
#pragma unroll
            for (int e = 0; e < 8; ++e) la[e] += dpp_f<0x114, 0xF>(la[e]);
#pragma unroll
            for (int e = 0; e < 8; ++e) la[e] += dpp_f<0x118, 0xF>(la[e]);
#pragma unroll
            for (int e = 0; e < 8; ++e) la[e] += dpp_f<0x142, 0xA>(la[e]);
#pragma unroll
            for (int e = 0; e < 8; ++e) ea[e] = __expf(fmaxf(la[e], -80.f));
        } else {
#pragma unroll
            for (int e = 0; e < 8; ++e) la[e] *= dpp_f1<0x111, 0xF>(la[e]);
#pragma unroll
            for (int e = 0; e < 8; ++e) la[e] *= dpp_f1<0x112, 0xF>(la[e]);
#pragma unroll
            for (int e = 0; e < 8; ++e) la[e] *= dpp_f1<0x114, 0xF>(la[e]);
#pragma unroll
            for (int e = 0; e < 8; ++e) la[e] *= dpp_f1<0x118, 0xF>(la[e]);
#pragma unroll
            for (int e = 0; e < 8; ++e) la[e] *= dpp_f1<0x142, 0xA>(la[e]);
#pragma unroll
            for (int e = 0; e < 8; ++e) ea[e] = fmaxf(la[e], 1e-35f);
        }
#pragma unroll
        for (int e = 0; e < 8; ++e) ia[e] = __builtin_amdgcn_rcpf(ea[e]);
#pragma unroll
        for (int e = 0; e < 8; ++e) { const float e31 = lane_bcast(ea[e], 31), e63 = lane_bcast(ea[e], 63); eb[e] = kg ? e63 : e31; }
#pragma unroll
        for (int e = 0; e < 8; ++e) { qi[e] = q[e] * ea[e]; ki[e] = kv[e] * ia[e]; kd[e] = ki[e] * eb[e]; }
        u32x4 qp, kp;
        qp.x = pk_bf16(qi[0], qi[1]); qp.y = pk_bf16(qi[2], qi[3]); qp.z = pk_bf16(qi[4], qi[5]); qp.w = pk_bf16(qi[6], qi[7]);
        kp.x = pk_bf16(ki[0], ki[1]); kp.y = pk_bf16(ki[2], ki[3]); kp.z = pk_bf16(ki[4], ki[5]); kp.w = pk_bf16(ki[6], ki[7]);
        att = MFMA32(__builtin_bit_cast(bf16x8, kp), __builtin_bit_cast(bf16x8, qp), att);
        *(LAS u32x4*)(vt + r * (K * 2) + ((((cl >> 3) ^ r) & (K / 8 - 1)) << 4)) = qp;
#pragma unroll
        for (int e = 0; e < 8; e += 2) {
            const unsigned pkd = pk_bf16(kd[e], kd[e + 1]);
            *(LAS unsigned short*)(kt + (cl + e) * 64 + r * 2) = (unsigned short)(pkd & 0xffffu);
            *(LAS unsigned short*)(kt + (cl + e + 1) * 64 + r * 2) = (unsigned short)(pkd >> 16);
        }
        if (r == 0) { f32x4 d0 = {eb[0], eb[1], eb[2], eb[3]}, d1 = {eb[4], eb[5], eb[6], eb[7]}; *(LAS f32x4*)(dl + cl * 4) = d0; *(LAS f32x4*)(dl + cl * 4 + 16) = d1; }
    }
    u32x4 vreg[8];
#pragma unroll
    for (int i = 0; i < 8; ++i) { const int p = lane + 64 * i, vr = (p >> 4) < nt1 ? (p >> 4) : nt1; vreg[i] = *(const u32x4*)(c.P + (size_t)(row0 + vr) * PLD + vcol0 + (p & 15) * 8); }
#pragma unroll
    for (int i = 0; i < K / 16; ++i) {
        const int p = lane + 64 * i, L = p * 8, qr_ = p / (K / 8), qc_ = p % (K / 8);
        if ((ALLV || qr_ < ntok) && !dry) *(u32x4*)(c.P + (size_t)(row0 + qr_) * PLD + qcol0 + qc_ * 8) = *(const LAS u32x4*)(vt + qr_ * (K * 2) + (((qc_ ^ qr_) & (K / 8 - 1)) << 4));
        *(u32x4*)(kdt_base + (size_t)(L / K) * kdt_stride + (L % K)) = *(const LAS u32x4*)(kt + p * 16);
    }
    if (lane < K / 4) *(f32x4*)(dch + lane * 4) = *(const LAS f32x4*)(dl + lane * 16);
#pragma unroll
    for (int i = 0; i < 8; ++i) { const int p = lane + 64 * i; *(LAS u32x4*)(vt + (p >> 4) * 256 + (p & 15) * 16) = vreg[i]; }
#pragma unroll
    for (int i = 0; i < 16; ++i) if (crow(i, kg) > r) att[i] = 0.f;
    u32x4 pa0, pa1;
    pa0.x = pk_bf16(att[0], att[1]); pa0.y = pk_bf16(att[2], att[3]); pa0.z = pk_bf16(att[4], att[5]); pa0.w = pk_bf16(att[6], att[7]);
    pa1.x = pk_bf16(att[8], att[9]); pa1.y = pk_bf16(att[10], att[11]); pa1.z = pk_bf16(att[12], att[13]); pa1.w = pk_bf16(att[14], att[15]);
#pragma unroll 1
    for (int vb = 0; vb < 4; ++vb) {
        unsigned short vs[16];
#pragma unroll
        for (int i = 0; i < 16; ++i) vs[i] = *(const LAS unsigned short*)(vt + crow(i, kg) * 256 + (vb * 32 + r) * 2);
        u32x4 b0, b1;
        b0.x = vs[0] | ((unsigned)vs[1] << 16); b0.y = vs[2] | ((unsigned)vs[3] << 16); b0.z = vs[4] | ((unsigned)vs[5] << 16); b0.w = vs[6] | ((unsigned)vs[7] << 16);
        b1.x = vs[8] | ((unsigned)vs[9] << 16); b1.y = vs[10] | ((unsigned)vs[11] << 16); b1.z = vs[12] | ((unsigned)vs[13] << 16); b1.w = vs[14] | ((unsigned)vs[15] << 16);
        f32x16 o;
#pragma unroll
        for (int i = 0; i < 16; ++i) o[i] = 0.f;
        o = MFMA32(__builtin_bit_cast(bf16x8, pa0), __builtin_bit_cast(bf16x8, b0), o);
        o = MFMA32(__builtin_bit_cast(bf16x8, pa1), __builtin_bit_cast(bf16x8, b1), o);
#pragma unroll
        for (int i = 0; i < 16; ++i) *(LAS unsigned short*)(kt + crow(i, kg) * 256 + (vb * 32 + r) * 2) = (unsigned short)(pk_bf16(o[i], 0.f) & 0xffffu);
    }
#pragma unroll
    for (int i = 0; i < 8; ++i) {
        const int p = lane + 64 * i, t = p >> 4;
        if (t < ntok) *(u32x4*)(c.OI + (size_t)(row0 + t) * 1024 + ocol0 + (p & 15) * 8) = *(const LAS u32x4*)(kt + p * 16);
    }
}
__device__ __forceinline__ void p2_prepass(const Ptrs& c, LAS unsigned char* lds, int G, int tid, int wave, int lane, bool dry) {
    LAS float* wa2_l = (LAS float*)lds; LAS float* ba_l = wa2_l + 4096; LAS float* lb_l = ba_l + 256;
    for (int i = tid; i < 4096; i += NTHR) wa2_l[i] = c.in[6][i];
    if (tid < 256) ba_l[tid] = c.in[7][tid];
    { const float p0 = c.in[8][tid], p1 = c.in[8][512 + tid]; lb_l[tid] = 1.0f / (1.0f + __expf(p1 - p0)); }
    WG_BAR();
    const int gw = blockIdx.x * NWAVES + wave, NGW = G * NWAVES;
    const bool bal = (G == 256);
    const int n_it = bal ? 4096 : 4096 + 1024;
    for (int it0 = gw; ; it0 += NGW) {
        int it = it0;
        if (it0 >= n_it) { if (!bal || wave >= 4 || it0 >= n_it + NGW) break; it = 4096 + blockIdx.x * 4 + wave; }
        int row0, ntok, h; bf16_t* kdt; int kst;
        if (it < 4096) { h = it & 7; const int ch = (it >> 3) & 63, b = it >> 9; row0 = b * 2048 + ch * 32; ntok = 32; kst = PLD;
                         kdt = c.P + (size_t)row0 * PLD + (h < 4 ? 256 + h * 64 : 2048 + (h - 4) * 128); }
        else { const int j = it - 4096; h = j & 7; row0 = MP + (j >> 3) * 8; ntok = 8; kst = h < 4 ? 64 : 128; kdt = c.KDTS + (size_t)j * 4096; }
        if (dry) { kst = h < 4 ? 64 : 128; kdt = (bf16_t*)((unsigned char*)c.DUMP + 203 * MiB) + (size_t)(it & 2047) * 4096; }
        if (it < 4096) { if (h < 4) pre_item<64, true, true>(c, row0, ntok, h, it, kdt, kst, wa2_l, ba_l, lb_l, lds + 20480 + wave * 16896, lane, dry);
                         else pre_item<128, false, true>(c, row0, ntok, h - 4, it, kdt, kst, wa2_l, ba_l, lb_l, lds + 20480 + wave * 16896, lane, dry); }
        else { if (h < 4) pre_item<64, true, false>(c, row0, ntok, h, it, kdt, kst, wa2_l, ba_l, lb_l, lds + 20480 + wave * 16896, lane, dry);
               else pre_item<128, false, false>(c, row0, ntok, h - 4, it, kdt, kst, wa2_l, ba_l, lb_l, lds + 20480 + wave * 16896, lane, dry); }
    }
}

template <int K>
__device__ __forceinline__ void seq_item(const Ptrs& c, LAS unsigned char* lds, int row0, int nch, int ntok, int h8, int colbase, int ncw, const float* S0, float* Sout,
                                         const bf16_t* kdt0, int kdt_rstride, size_t kdt_cstep, const float* dch0, size_t dch_cstep, int tid, int wave, int lane) {
    constexpr int QROW = 2 * K + 16, VROW = 272;
    constexpr int KOFF = 8704, DOFF = 18944, VOFF = 19456, BUFB = 28160, NMB = K / 16, NPC = 4 * K;
    const int n = lane & 15, q = lane >> 4, col = colbase + 16 * (wave < ncw ? wave : 0) + n;
    const bool cw = wave < ncw;
    const bool gla = h8 < 4; const int hh = h8 & 3;
    const int qcol0 = gla ? hh * 64 : 1536 + hh * 128, vcol0 = gla ? 512 + hh * 128 : 2560 + hh * 128, ocol = h8 * 128 + col;
    f32x4 S[NMB];
#pragma unroll
    for (int mb = 0; mb < NMB; ++mb)
#pragma unroll
        for (int i = 0; i < 4; ++i) S[mb][i] = (S0 && cw) ? S0[(size_t)(16 * mb + 4 * q + i) * 128 + col] : 0.f;
    const int nt1 = ntok - 1;
    const int pq = tid % NPC, prow_q = pq / (K / 8), pc8 = pq % (K / 8), prq = prow_q < nt1 ? prow_q : nt1;
    const int vrow = tid >> 4, vc8 = tid & 15, vr = vrow < nt1 ? vrow : nt1;
    const int dpi = tid % (K / 4);
    const bf16_t* gq = c.P + (size_t)(row0 + prq) * PLD + qcol0 + pc8 * 8;
    const bf16_t* gk = kdt0 + (size_t)prow_q * kdt_rstride + pc8 * 8;
    const float* gd = dch0 + dpi * 4;
    const bf16_t* gvp = c.P + (size_t)(row0 + vr) * PLD + vcol0 + vc8 * 8;
    struct Stage { u32x4 q, k, v; f32x4 d; };
    const int nch1 = nch - 1;
#define SEQ_LOAD(R, cc) do { const int c_ = (cc) < nch1 ? (cc) : nch1; const size_t ro_ = (size_t)c_ * 32; \
        R.q = *(const u32x4*)(gq + ro_ * PLD); R.k = *(const u32x4*)(gk + (size_t)c_ * kdt_cstep); R.d = *(const f32x4*)(gd + (size_t)c_ * dch_cstep); \
        R.v = *(const u32x4*)(gvp + ro_ * PLD); } while (0)
#define SEQ_STORE(R, buf) do { LAS unsigned char* B_ = lds + (buf) * BUFB; \
        *(LAS u32x4*)(B_ + prow_q * QROW + pc8 * 16) = R.q; *(LAS u32x4*)(B_ + KOFF + (pq >> 2) * 80 + (pq & 3) * 16) = R.k; *(LAS f32x4*)(B_ + DOFF + dpi * 16) = R.d; \
        *(LAS u32x4*)(B_ + VOFF + vrow * VROW + vc8 * 16) = R.v; } while (0)
#define SEQ_ITER(ci, buf, RST) do { \
        const LAS unsigned char* B = lds + (buf) * BUFB; \
        if (cw) { \
        f32x4 o[2] = {{0.f, 0.f, 0.f, 0.f}, {0.f, 0.f, 0.f, 0.f}}; \
        _Pragma("unroll") for (int js = 0; js < K / 32; ++js) { \
            u32x4 sb; sb.x = pk_bf16(S[2 * js][0], S[2 * js][1]); sb.y = pk_bf16(S[2 * js][2], S[2 * js][3]); sb.z = pk_bf16(S[2 * js + 1][0], S[2 * js + 1][1]); sb.w = pk_bf16(S[2 * js + 1][2], S[2 * js + 1][3]); \
            _Pragma("unroll") for (int mb2 = 0; mb2 < 2; ++mb2) { \
                const LAS unsigned char* qp = B + (16 * mb2 + n) * QROW + (32 * js + 4 * q) * 2; \
                const u32x2 lo = *(const LAS u32x2*)qp, hi = *(const LAS u32x2*)(qp + 32); \
                u32x4 qa; qa.x = lo.x; qa.y = lo.y; qa.z = hi.x; qa.w = hi.y; \
                o[mb2] = MFMA16(__builtin_bit_cast(bf16x8, qa), __builtin_bit_cast(bf16x8, sb), o[mb2]); } } \
        { unsigned short vs[8]; \
            _Pragma("unroll") for (int j = 0; j < 8; ++j) vs[j] = *(const LAS unsigned short*)(B + VOFF + (8 * q + j) * VROW + col * 2); \
            u32x4 vb; vb.x = vs[0] | ((unsigned)vs[1] << 16); vb.y = vs[2] | ((unsigned)vs[3] << 16); vb.z = vs[4] | ((unsigned)vs[5] << 16); vb.w = vs[6] | ((unsigned)vs[7] << 16); \
            _Pragma("unroll") for (int mb = 0; mb < NMB; ++mb) { \
                const u32x4 ka = *(const LAS u32x4*)(B + KOFF + (16 * mb + n) * 80 + q * 16); \
                const f32x4 dv = *(const LAS f32x4*)(B + DOFF + (16 * mb + 4 * q) * 4); \
                S[mb] = S[mb] * dv; \
                S[mb] = MFMA16(__builtin_bit_cast(bf16x8, ka), __builtin_bit_cast(bf16x8, vb), S[mb]); } } \
        bf16_t* ob = c.OX + (size_t)(row0 + 32 * (ci)) * 1024 + ocol; \
        _Pragma("unroll") for (int x = 0; x < 8; x += 2) { \
            const int t = 16 * (x >> 2) + 4 * q + (x & 3); const unsigned pv = pk_bf16(o[x >> 2][x & 3], o[x >> 2][(x & 3) + 1]); \
            bf16_t* d0 = t < ntok ? ob + (size_t)t * 1024 : c.DUMP + tid; bf16_t* d1 = t + 1 < ntok ? ob + (size_t)(t + 1) * 1024 : c.DUMP + tid; \
            *d0 = (bf16_t)(pv & 0xffffu); *d1 = (bf16_t)(pv >> 16); } \
        } \
        WG_BAR(); \
        SEQ_STORE(RST, buf); \
    } while (0)
    Stage R0, R1, R2, R3;
    SEQ_LOAD(R0, 0); SEQ_STORE(R0, 0);
    SEQ_LOAD(R1, 1); SEQ_LOAD(R2, 2); SEQ_LOAD(R3, 3); SEQ_LOAD(R0, 4);
    SEQ_STORE(R1, 1);
    WG_BAR();
    for (int ci = 0; ci < nch; ci += 4) {
        SEQ_LOAD(R1, ci + 5); SEQ_ITER(ci, 0, R2);
        if (ci + 1 >= nch) break;
        SEQ_LOAD(R2, ci + 6); SEQ_ITER(ci + 1, 1, R3);
        if (ci + 2 >= nch) break;
        SEQ_LOAD(R3, ci + 7); SEQ_ITER(ci + 2, 0, R0);
        if (ci + 3 >= nch) break;
        SEQ_LOAD(R0, ci + 8); SEQ_ITER(ci + 3, 1, R1);
    }
    if (cw) {
#pragma unroll
    for (int mb = 0; mb < NMB; ++mb)
#pragma unroll
        for (int i = 0; i < 4; ++i) Sout[(size_t)(16 * mb + 4 * q + i) * 128 + col] = S[mb][i];
    }
    WG_BAR();
#undef SEQ_LOAD
#undef SEQ_STORE
#undef SEQ_ITER
}
__device__ __forceinline__ void seq_dispatch(const Ptrs& c, LAS unsigned char* lds, int item, int tid, int wave, int lane) {
    int row0, nch, ntok, h8, colbase, ncw; const float* S0; float* Sout; const bf16_t* kdt0; int kst; size_t kcs, dcs; const float* dch0;
    if (item < 128) {
        const int bh = item >> 1, b = bh >> 3; h8 = bh & 7; const int hh = h8 & 3; row0 = b * 2048; nch = 64; ntok = 32; S0 = nullptr; colbase = (item & 1) * 64; ncw = 4;
        Sout = h8 < 4 ? c.out + OUT_SAP + (size_t)(b * 4 + hh) * 64 * 128 : c.out + OUT_SBP + (size_t)(b * 4 + hh) * 128 * 128;
        kdt0 = c.P + (size_t)row0 * PLD + (h8 < 4 ? 256 + hh * 64 : 2048 + hh * 128); kst = PLD; kcs = (size_t)32 * PLD;
        dch0 = c.DCH + (size_t)(b * 64 * 8 + h8) * 128; dcs = 8 * 128;
    } else {
        const int j = item - 128, b = j >> 3; h8 = j & 7; const int hh = h8 & 3; row0 = MP + b * 8; nch = 1; ntok = 8; colbase = 0; ncw = 8;
        S0 = h8 < 4 ? c.in[2] + (size_t)(b * 4 + hh) * 64 * 128 : c.in[3] + (size_t)(b * 4 + hh) * 128 * 128;
        Sout = h8 < 4 ? c.out + OUT_SAS + (size_t)(b * 4 + hh) * 64 * 128 : c.out + OUT_SBS + (size_t)(b * 4 + hh) * 128 * 128;
        kdt0 = c.KDTS + (size_t)j * 4096; kst = h8 < 4 ? 64 : 128; kcs = 0; dch0 = c.DCH + (size_t)(4096 + j) * 128; dcs = 0;
    }
    if (h8 < 4) seq_item<64>(c, lds, row0, nch, ntok, h8, colbase, ncw, S0, Sout, kdt0, kst, kcs, dch0, dcs, tid, wave, lane);
    else seq_item<128>(c, lds, row0, nch, ntok, h8, colbase, ncw, S0, Sout, kdt0, kst, kcs, dch0, dcs, tid, wave, lane);
}
__device__ __forceinline__ void p3b_finalize(const Ptrs& c, int G, int wave, int lane) {
    const int gw = blockIdx.x * NWAVES + wave, NGW = G * NWAVES, h8 = lane >> 3, cw = (lane & 7) * 16;
    const float* gp = (h8 < 4 ? c.in[9] : c.in[10]) + cw;
    f32x4 gn[4];
#pragma unroll
    for (int j = 0; j < 4; ++j) gn[j] = *(const f32x4*)(gp + 4 * j);
    const int gcol = (h8 < 4 ? 1024 + h8 * 128 : 3072 + (h8 - 4) * 128) + cw;
    u32x4 nx[2], ng[2], noi[2];
    { const int m0 = gw < M ? gw : M - 1;
#pragma unroll
      for (int j = 0; j < 2; ++j) { noi[j] = *(const u32x4*)(c.OI + (size_t)m0 * 1024 + lane * 16 + 8 * j); nx[j] = *(const u32x4*)(c.OX + (size_t)m0 * 1024 + lane * 16 + 8 * j); ng[j] = *(const u32x4*)(c.P + (size_t)m0 * PLD + gcol + 8 * j); } }
    for (int m = gw; m < M; m += NGW) {
        f32x4 o[4]; u32x4 x[2], g[2], oi[2];
#pragma unroll
        for (int j = 0; j < 2; ++j) { oi[j] = noi[j]; x[j] = nx[j]; g[j] = ng[j]; }
        { const int mn = m + NGW < M ? m + NGW : m;
#pragma unroll
          for (int j = 0; j < 2; ++j) { noi[j] = *(const u32x4*)(c.OI + (size_t)mn * 1024 + lane * 16 + 8 * j); nx[j] = *(const u32x4*)(c.OX + (size_t)mn * 1024 + lane * 16 + 8 * j); ng[j] = *(const u32x4*)(c.P + (size_t)mn * PLD + gcol + 8 * j); } }
        o[0][0] = bf_lo(oi[0].x); o[0][1] = bf_hi(oi[0].x); o[0][2] = bf_lo(oi[0].y); o[0][3] = bf_hi(oi[0].y); o[1][0] = bf_lo(oi[0].z); o[1][1] = bf_hi(oi[0].z); o[1][2] = bf_lo(oi[0].w); o[1][3] = bf_hi(oi[0].w);
        o[2][0] = bf_lo(oi[1].x); o[2][1] = bf_hi(oi[1].x); o[2][2] = bf_lo(oi[1].y); o[2][3] = bf_hi(oi[1].y); o[3][0] = bf_lo(oi[1].z); o[3][1] = bf_hi(oi[1].z); o[3][2] = bf_lo(oi[1].w); o[3][3] = bf_hi(oi[1].w);
        float ss = 0.f;
#pragma unroll
        for (int j = 0; j < 4; ++j) {
            const unsigned w0 = j < 2 ? (j == 0 ? x[0].x : x[0].z) : (j == 2 ? x[1].x : x[1].z), w1 = j < 2 ? (j == 0 ? x[0].y : x[0].w) : (j == 2 ? x[1].y : x[1].w);
            o[j][0] += bf_lo(w0); o[j][1] += bf_hi(w0); o[j][2] += bf_lo(w1); o[j][3] += bf_hi(w1);
            ss += (o[j][0] * o[j][0] + o[j][1] * o[j][1]) + (o[j][2] * o[j][2] + o[j][3] * o[j][3]);
        }
        ss += dpp_f<0xB1, 0xF>(ss); ss += dpp_f<0x4E, 0xF>(ss); ss += dpp_f<0x141, 0xF>(ss);
        const float rs = __builtin_amdgcn_rsqf(ss * (1.0f / 128.0f) + EPS);
        u32x4 w[2];
#pragma unroll
        for (int j = 0; j < 4; ++j) {
            const unsigned g0 = j < 2 ? (j == 0 ? g[0].x : g[0].z) : (j == 2 ? g[1].x : g[1].z), g1 = j < 2 ? (j == 0 ? g[0].y : g[0].w) : (j == 2 ? g[1].y : g[1].w);
            float gg[4] = {bf_lo(g0), bf_hi(g0), bf_lo(g1), bf_hi(g1)}, v[4];
#pragma unroll
            for (int e = 0; e < 4; ++e) v[e] = o[j][e] * rs * gn[j][e] * (gg[e] * __builtin_amdgcn_rcpf(1.0f + __expf(-gg[e])));
            const unsigned p0 = pk_bf16(v[0], v[1]), p1 = pk_bf16(v[2], v[3]);
            if (j == 0) { w[0].x = p0; w[0].y = p1; } else if (j == 1) { w[0].z = p0; w[0].w = p1; } else if (j == 2) { w[1].x = p0; w[1].y = p1; } else { w[1].z = p0; w[1].w = p1; }
        }
        *(u32x4*)(c.OF + (size_t)m * 1024 + lane * 16) = w[0]; *(u32x4*)(c.OF + (size_t)m * 1024 + lane * 16 + 8) = w[1];
    }
}
#define XB_TMO      128
#define XB_XCNT(j)  (256  + 64 * (j))
#define XB_XSUB(j)  (1280 + 64 * (j))
#define XB_XGEN(j)  (2304 + 64 * (j))
#define XB_TOP      3328
#define XB_TOPGEN   3392
#define XCD_BAR_WORDS 3456
#define XB_SPIN_CAP (1u << 18)

__device__ __forceinline__ unsigned xb_ld(unsigned* p)              { return __hip_atomic_load(p, __ATOMIC_RELAXED, __HIP_MEMORY_SCOPE_AGENT); }
__device__ __forceinline__ unsigned xb_add(unsigned* p, unsigned v) { return __hip_atomic_fetch_add(p, v, __ATOMIC_RELAXED, __HIP_MEMORY_SCOPE_AGENT); }
__device__ __forceinline__ unsigned xb_xcc_id() { return (unsigned)__builtin_amdgcn_s_getreg((3 << 11) | 20) & 0xFu; }
#define XB_SPIN(cond, bar) do { unsigned _sp = 0; while (cond) { __builtin_amdgcn_s_sleep(1); \
    if ((++_sp & 255u) == 0u) { if (xb_ld(&(bar)[XB_TMO])) break; if (_sp > XB_SPIN_CAP) { atomicAdd(&(bar)[XB_TMO], 1u); break; } } } } while (0)

struct XcdBarrier {
    unsigned* bar; unsigned x;
    volatile LAS unsigned* st;
};

__device__ __forceinline__ XcdBarrier xcd_barrier_post(unsigned* bar, volatile LAS unsigned* st) {
    XcdBarrier b; b.bar = bar; b.x = xb_xcc_id(); b.st = st;
    if (threadIdx.x == 0) (void)xb_add(&bar[XB_XCNT(b.x)], 1u);
    return b;
}
__device__ __forceinline__ void xcd_barrier_complete(unsigned* bar, unsigned x, unsigned& nloc, unsigned& nx) {
    const unsigned G = gridDim.x * gridDim.y * gridDim.z;
    unsigned sum, cnt, mine, sp = 0u;
    for (;;) {
        sum = 0u; cnt = 0u; mine = 0u;
#pragma unroll
        for (unsigned j = 0; j < 16; ++j) { const unsigned c = xb_ld(&bar[XB_XCNT(j)]); sum += c; cnt += (c > 0u) ? 1u : 0u; mine = (j == x) ? c : mine; }
        if (sum == G) break;
        __builtin_amdgcn_s_sleep(1);
        if ((++sp & 255u) == 0u) { if (xb_ld(&bar[XB_TMO])) break; if (sp > XB_SPIN_CAP) { atomicAdd(&bar[XB_TMO], 1u); break; } }
    }
    nloc = mine > 0u ? mine : 1u; nx = cnt > 0u ? cnt : 1u;
}

__device__ __forceinline__ void xcd_barrier(const XcdBarrier& b) {
    asm volatile("s_waitcnt vmcnt(0)" ::: "memory");
    __syncthreads();
    if (threadIdx.x == 0) {
        unsigned* bar = b.bar;
        __builtin_amdgcn_s_waitcnt(0);
        unsigned nloc = b.st[0], nx = b.st[1];
        if (nloc == 0u) { xcd_barrier_complete(bar, b.x, nloc, nx); b.st[0] = nloc; b.st[1] = nx; }
        const unsigned old = xb_add(&bar[XB_XSUB(b.x)], 1u);
        const unsigned gen = old / nloc;
        if (old + 1u == (gen + 1u) * nloc) {
            __builtin_amdgcn_fence(__ATOMIC_RELEASE, "agent");
            asm volatile("s_waitcnt vmcnt(0)" ::: "memory");
            const unsigned og = xb_add(&bar[XB_TOP], 1u);
            const unsigned tg = og / nx;
            if (og + 1u == (tg + 1u) * nx) xb_add(&bar[XB_TOPGEN], 1u);
            else XB_SPIN(xb_ld(&bar[XB_TOPGEN]) == tg, bar);
            __builtin_amdgcn_fence(__ATOMIC_ACQUIRE, "agent");
            xb_add(&bar[XB_XGEN(b.x)], 1u);
            asm volatile("s_waitcnt vmcnt(0)" ::: "memory");
        } else {
            XB_SPIN(xb_ld(&bar[XB_XGEN(b.x)]) == gen, bar);
            __builtin_amdgcn_fence(__ATOMIC_ACQUIRE, "agent");
            asm volatile("s_waitcnt vmcnt(0)" ::: "memory");
        }
    }
    __syncthreads();
}


struct EpiRes2Norm {
    static constexpr bool PERM = true, AFTER_DRAIN = true;
    float* Y; const bf16_t* X1B; float* SSQ; const float* gfin; XcdBarrier xb;
    __device__ __forceinline__ void fused(pg8::f32x4 (&acc)[2][2][4][2], const pg8::Unit& u, int wr, int wc, int fr, int fq, LAS unsigned char* lds, int wid, int lane) const {
        using pg8::BM; using pg8::HALF;
        const int row0 = u.pm * BM + wr * 64 + fr, ct = u.pn * BM + wc * 32 + 8 * fq;
#pragma unroll
        for (int ai = 0; ai < 2; ++ai)
#pragma unroll
            for (int m = 0; m < 4; ++m) {
                const int row = row0 + ai * HALF + m * 16; float ss = 0.f;
#pragma unroll
                for (int bj = 0; bj < 2; ++bj) {
                    const int col = ct + bj * HALF;
                    { const u32x4 xr = *(const u32x4*)(X1B + (size_t)row * 1024 + col);
                      acc[ai][bj][m][0] += (f32x4){bf_lo(xr.x), bf_hi(xr.x), bf_lo(xr.y), bf_hi(xr.y)}; acc[ai][bj][m][1] += (f32x4){bf_lo(xr.z), bf_hi(xr.z), bf_lo(xr.w), bf_hi(xr.w)}; }
                    const f32x4 v0 = acc[ai][bj][m][0], v1 = acc[ai][bj][m][1];
                    ss += (v0[0] * v0[0] + v0[1] * v0[1]) + (v0[2] * v0[2] + v0[3] * v0[3]) + (v1[0] * v1[0] + v1[1] * v1[1]) + (v1[2] * v1[2] + v1[3] * v1[3]);
                }
                ss += __shfl_xor(ss, 16); ss += __shfl_xor(ss, 32);
                if (fq == 0) SSQ[(size_t)row * 16 + u.pn * 4 + wc] = ss;
            }
        xcd_barrier(xb);
#pragma unroll
        for (int ai = 0; ai < 2; ++ai)
#pragma unroll
            for (int m = 0; m < 4; ++m) {
                const int row = row0 + ai * HALF + m * 16; float* yr = Y + (size_t)row * 1024;
                const f32x4* sp = (const f32x4*)(SSQ + (size_t)row * 16);
                const f32x4 s0 = sp[0], s1 = sp[1], s2 = sp[2], s3 = sp[3];
                const float tot = ((s0[0] + s0[1]) + (s0[2] + s0[3])) + ((s1[0] + s1[1]) + (s1[2] + s1[3])) + ((s2[0] + s2[1]) + (s2[2] + s2[3])) + ((s3[0] + s3[1]) + (s3[2] + s3[3]));
                const float rs = __builtin_amdgcn_rsqf(tot * (1.0f / 1024.0f) + EPS);
#pragma unroll
                for (int bj = 0; bj < 2; ++bj) {
                    const int col = ct + bj * HALF;
                    *(f32x4*)(yr + col) = acc[ai][bj][m][0] * rs * *(const f32x4*)(gfin + col); *(f32x4*)(yr + col + 4) = acc[ai][bj][m][1] * rs * *(const f32x4*)(gfin + col + 4);
                }
            }
    }
};

struct Args { const float* in[17]; float* out; unsigned char* ws; int ph_lo, ph_hi, aux, pad; };
constexpr int NPHASE = 9;
__device__ __forceinline__ void fill_ptrs(Ptrs& c, const Args& args) {
#pragma unroll
    for (int i = 0; i < 17; ++i) c.in[i] = args.in[i];
    c.out = args.out;
    unsigned char* ws = args.ws;
    c.WinT = (bf16_t*)(ws + WS_WIN); c.WoT = (bf16_t*)(ws + WS_WO); c.W13T = (bf16_t*)(ws + WS_W13); c.W2T = (bf16_t*)(ws + WS_W2);
    c.XB = (bf16_t*)(ws + WS_XB); c.OF = (bf16_t*)(ws + WS_XB); c.P = (bf16_t*)(ws + WS_P); c.HID = (bf16_t*)(ws + WS_P); c.KDTS = (bf16_t*)(ws + WS_KDTS);
    c.X1B = (bf16_t*)(ws + WS_FB); c.FB = (float*)(ws + WS_FB);
    c.RSTD1 = (float*)(ws + WS_RSTD1); c.SSQ2 = (float*)(ws + WS_SSQ2); c.LRA = (float*)(ws + WS_LRA); c.DCH = (float*)(ws + WS_DCH); c.OY = args.out + OUT_Y; c.DUMP = (bf16_t*)(ws + 30 * MiB); c.OX = (bf16_t*)(ws + WS_FB); c.OI = (bf16_t*)(ws + WS_XB); c.PART = (float*)(ws + 208 * MiB); c.PART4 = (float*)(ws + WS_P); c.SSQ3 = (float*)(ws + 30 * MiB + 65536);
}

__global__ void __launch_bounds__(NTHR, 2) hymba_fwd(Args args) {
    extern __shared__ __attribute__((aligned(16))) unsigned char lds_raw[];
    LAS unsigned char* lds = (LAS unsigned char*)lds_raw;
    const int tid = threadIdx.x, lane = tid & 63, wave = __builtin_amdgcn_readfirstlane(tid >> 6), G = gridDim.x;
    unsigned char* ws = args.ws;
    const int lo = args.ph_lo, hi = args.ph_hi;
    volatile LAS unsigned* xst = (volatile LAS unsigned*)(lds + 160256);
    if (tid == 0) { xst[0] = 0u; xst[1] = 0u; }
    __syncthreads();
    XcdBarrier xbar; xbar.bar = (unsigned*)(ws + WS_BAR); xbar.x = 0; xbar.st = xst;
    if (hi - lo > 1) xbar = xcd_barrier_post((unsigned*)(ws + WS_BAR), xst);
#define IN(k) (lo <= (k) && (k) < hi)
#define SEAM(k) do { if (IN(k) && IN((k) + 1)) { if (args.pad != 0) cg::this_grid().sync(); else xcd_barrier(xbar); } } while (0)
    if (IN(0)) { Ptrs c; fill_ptrs(c, args); p0_prologue(c, lds, G, wave, lane, G != 256); }
    SEAM(0);
    if (IN(1)) { Ptrs c; fill_ptrs(c, args);
        pg8::Gemm g{c.XB, c.WinT, M, NIN, D}; pg8::StaticOrder S; S.init(M, NIN, G, (int)blockIdx.x, D);
        pg8::EpiIn E{c.P, c.FB, c.LRA, c.RSTD1};
        pg8::gemm_phase<pg8::EpiIn, pg8::StaticOrder, true, true>(lds, g, S, E);
    }
    SEAM(1);
    if (IN(2)) { Ptrs c; fill_ptrs(c, args); p2_prepass(c, lds, G, tid, wave, lane, args.aux != 0); }
    SEAM(2);
    if (IN(3)) { Ptrs c; fill_ptrs(c, args);
        const int wg = blockIdx.x;
        if (G >= 256) {
            if (wg < 128) seq_dispatch(c, lds, wg, tid, wave, lane);
            else { for (int j = wg - 128; j < 1024; j += G - 128) seq_dispatch(c, lds, 128 + j, tid, wave, lane);
                   weight_items(c, (LAS float*)(lds + wave * 16384), 1, (wg - 128) * NWAVES + wave, (G - 128) * NWAVES, lane); }
        }
        else for (int it = wg; it < 128 + 1024; it += G) seq_dispatch(c, lds, it, tid, wave, lane);
    }
    SEAM(3);
    if (IN(4)) { Ptrs c; fill_ptrs(c, args); p3b_finalize(c, G, wave, lane); }
    SEAM(4);
    if (IN(5)) { Ptrs c; fill_ptrs(c, args);
        pg8::Gemm g{c.OF, c.WoT, M, D, D};
        { pg8::StaticOrder S; S.init(MP, D, G, (int)blockIdx.x, D); pg8::EpiRes1 E{c.in[0], c.in[1], c.OY, c.X1B, c.SSQ2};
          pg8::gemm_phase<pg8::EpiRes1, pg8::StaticOrder, true, true>(lds, g, S, E); }
        { pg8::TailOrder S{G, (int)blockIdx.x, 8, D / 64, MP / 256, 4, 16}; pg8::EpiPart E{c.PART4, MP, 1.f};
          pg8::gemm_phase<pg8::EpiPart, pg8::TailOrder, true, true>(lds, g, S, E); }
        if (hi - lo > 1) xcd_barrier(xbar);
        {
            const int gw = blockIdx.x * NWAVES + wave, NGW = G * NWAVES;
            for (int r = gw; r < MS; r += NGW) {
                const int m = MP + r; f32x4 v[4]; float ss = 0.f;
#pragma unroll
                for (int j = 0; j < 4; ++j) v[j] = *(const f32x4*)(c.in[1] + (size_t)r * D + 4 * lane + 256 * j);
#pragma unroll 1
                for (int ks = 0; ks < 8; ++ks)
#pragma unroll
                    for (int j = 0; j < 4; ++j) v[j] += *(const f32x4*)(c.PART4 + ((size_t)ks * 1024 + r) * 1024 + 4 * lane + 256 * j);
#pragma unroll
                for (int j = 0; j < 4; ++j) {
                    *(f32x4*)(c.OY + (size_t)m * D + 4 * lane + 256 * j) = v[j];
                    u32x2 w; w.x = pk_bf16(v[j][0], v[j][1]); w.y = pk_bf16(v[j][2], v[j][3]); *(u32x2*)(c.X1B + (size_t)m * D + 4 * lane + 256 * j) = w;
                    ss += (v[j][0] * v[j][0] + v[j][1] * v[j][1]) + (v[j][2] * v[j][2] + v[j][3] * v[j][3]);
                }
                ss = wave_sum(ss);
                if (lane < 16) c.SSQ2[(size_t)m * 16 + lane] = lane == 0 ? ss : 0.f;
            }
        }
    }
    SEAM(5);
    if (IN(6)) { Ptrs c; fill_ptrs(c, args);
        pg8::Gemm g{c.X1B, c.W13T, M, NUP, D}; pg8::StaticOrder S; S.init(M, NUP, G, (int)blockIdx.x, D);
        pg8::EpiSwiglu E{c.HID, c.SSQ2};
        pg8::gemm_phase<pg8::EpiSwiglu, pg8::StaticOrder, true, true>(lds, g, S, E);
    }
    SEAM(6);
    if (IN(7)) { Ptrs c; fill_ptrs(c, args);
        pg8::Gemm g{c.HID, c.W2T, M, D, FF};
        if (G == 256 && hi - lo > 1) {
            pg8::StaticOrder S; S.init(MP, D, G, (int)blockIdx.x, FF); EpiRes2Norm E{c.OY, c.X1B, c.SSQ3, c.in[16], xbar};
            pg8::gemm_phase<EpiRes2Norm, pg8::StaticOrder, true, true>(lds, g, S, E);
        } else {
            pg8::StaticOrder S; S.init(MP, D, G, (int)blockIdx.x, FF); pg8::EpiRes2 E{c.OY, args.aux ? 0.f : 1.f, c.X1B};
            pg8::gemm_phase<pg8::EpiRes2, pg8::StaticOrder, true, true>(lds, g, S, E);
        }
        { pg8::TailOrder S{G, (int)blockIdx.x, 11, FF / 64, MP / 256, 4, 16}; pg8::EpiPart E{c.PART, MP, args.aux ? 0.f : 1.f};
          pg8::gemm_phase<pg8::EpiPart, pg8::TailOrder, true, true>(lds, g, S, E); }
    }
    SEAM(7);
    if (IN(8)) { Ptrs c; fill_ptrs(c, args);
        const int NGW = G * NWAVES, gw = blockIdx.x * NWAVES + wave + ((G == 256 && hi - lo > 1) ? MP : 0);
        f32x4 gn[4];
#pragma unroll
        for (int j = 0; j < 4; ++j) gn[j] = *(const f32x4*)(c.in[16] + 4 * lane + 256 * j);
        f32x4 v[4], nv[4];
        { const int m0 = gw < M ? gw : M - 1;
#pragma unroll
          for (int j = 0; j < 4; ++j) v[j] = *(const f32x4*)(c.OY + (size_t)m0 * D + 4 * lane + 256 * j); }
#define ADD_PARTS(vv, mm) do { if ((mm) >= MP) { _Pragma("unroll 1") for (int ks = 0; ks < 11; ++ks) { _Pragma("unroll") for (int j = 0; j < 4; ++j) \
            vv[j] += *(const f32x4*)(c.PART + ((size_t)ks * 1024 + ((mm) - MP)) * 1024 + 4 * lane + 256 * j); } } } while (0)
        { const int m0 = gw < M ? gw : M - 1; ADD_PARTS(v, m0); }
        for (int m = gw; m < M; m += NGW) {
            float* yr = c.OY + (size_t)m * D; float s = 0.f;
            { const int mn = m + NGW < M ? m + NGW : m;
#pragma unroll
              for (int j = 0; j < 4; ++j) nv[j] = *(const f32x4*)(c.OY + (size_t)mn * D + 4 * lane + 256 * j);
              ADD_PARTS(nv, mn); }
#pragma unroll
            for (int j = 0; j < 4; ++j) s += (v[j][0] * v[j][0] + v[j][1] * v[j][1]) + (v[j][2] * v[j][2] + v[j][3] * v[j][3]);
            const float rs = __builtin_amdgcn_rsqf(wave_sum(s) * (1.0f / D) + EPS);
#pragma unroll
            for (int j = 0; j < 4; ++j) *(f32x4*)(yr + 4 * lane + 256 * j) = args.aux ? v[j] : v[j] * rs * gn[j];
#pragma unroll
            for (int j = 0; j < 4; ++j) v[j] = nv[j];
        }
    }
#undef IN
#undef SEAM
}

extern "C" void kernel_launch(void* const* d_in, const int* in_sizes, int n_in, void* d_out, int out_size, void* d_ws, size_t ws_size, hipStream_t stream) {
    static int grid = 0;
    if (grid == 0) {
        if (n_in != 17 || ws_size < WS_END) { fprintf(stderr, "kernel_launch: unexpected n_in %d / ws %zu\n", n_in, ws_size); grid = -1; return; }
        int dev = 0, cus = 0, per_cu = 0;
        (void)hipGetDevice(&dev); (void)hipDeviceGetAttribute(&cus, hipDeviceAttributeMultiprocessorCount, dev);
        if (hipFuncSetAttribute((const void*)hymba_fwd, hipFuncAttributeMaxDynamicSharedMemorySize, LDS_BYTES) != hipSuccess) { fprintf(stderr, "kernel_launch: hipFuncSetAttribute failed\n"); grid = -1; return; }
        if (hipOccupancyMaxActiveBlocksPerMultiprocessor(&per_cu, (const void*)hymba_fwd, NTHR, LDS_BYTES) != hipSuccess || per_cu < 1) { fprintf(stderr, "kernel_launch: occupancy query says %d\n", per_cu); per_cu = 1; }
        (void)hipGetLastError();
        grid = cus * per_cu;
        if (grid <= 0) grid = 256;
    }
    if (grid < 0) return;
    if (hipMemsetAsync((char*)d_ws + WS_BAR, 0, 16384, stream) != hipSuccess) { fprintf(stderr, "kernel_launch: memset failed\n"); return; }
    Args a{};
    for (int i = 0; i < 17; ++i) a.in[i] = (const float*)d_in[i];
    a.out = (float*)d_out; a.ws = (unsigned char*)d_ws;
    if (MK_N_LAUNCHES == 1) {
        a.ph_lo = 0; a.ph_hi = NPHASE;
        void* kargs[] = {&a};
        hipError_t e = hipLaunchCooperativeKernel((const void*)hymba_fwd, dim3(grid), dim3(NTHR), kargs, LDS_BYTES, stream);
        if (e != hipSuccess) fprintf(stderr, "kernel_launch: cooperative launch failed: %s (grid %d)\n", hipGetErrorString(e), grid);
    } else {
        for (int p = 0; p < NPHASE; ++p) { a.ph_lo = p; a.ph_hi = p + 1; const int nrep = ((REP_MASK >> p) & 1) ? 3 : 1;
            for (int rr = 0; rr < nrep; ++rr) { a.aux = ((p == 2 || p == 7 || p == 8) && rr + 1 < nrep) ? 1 : 0; hipLaunchKernelGGL(hymba_fwd, dim3(grid), dim3(NTHR), LDS_BYTES, stream, a); } }
    }
}
```

```cpp
#include <hip/hip_runtime.h>
#include <hip/hip_cooperative_groups.h>
#include <cstdio>
#include <cstdint>
namespace cg = cooperative_groups;
namespace pg8 {
#define PG8_LAS __attribute__((address_space(3)))
typedef unsigned short bf16_t;
typedef short bf16x8 __attribute__((ext_vector_type(8)));
typedef float f32x4 __attribute__((ext_vector_type(4)));
typedef unsigned u32x4 __attribute__((ext_vector_type(4)));
constexpr int BM = 256, BK = 64, HALF = 128, HTB = HALF * BK * 2  , STAGE_BYTES = 8 * HTB, NXCD = 8, WGM = 8;

__host__ __device__ __forceinline__ int lds_byte(int r, int c) { const int st = (r >> 4) * 2 + (c >> 5), rr = r & 15, cc = c & 31, ob = rr * 64 + cc * 2; return st * 1024 + (ob ^ (((ob >> 9) & 1) << 5)); }
__host__ __device__ __forceinline__ void stage_rc(int b, int& R, int& C) { const int st = b / 1024, sb = b % 1024, swz = sb ^ (((sb >> 9) & 1) << 5); R = (st >> 1) * 16 + swz / 64; C = (st & 1) * 32 + (swz % 64) / 2; }
__host__ __device__ __forceinline__ int perm32(int rho) { const int n = rho >> 4, i = rho & 15; return 8 * (i >> 2) + 4 * n + (i & 3); }

struct Unit { int pm, pn, k0, nk; };
struct Gemm { const bf16_t* A; const bf16_t* Bt; int M, N, K; };

struct StaticOrder {
    int nM, nN, nwg, G, c, nkt;
    __host__ __device__ void init(int M, int N, int G_, int c_, int K_) { nM = M / BM; nN = N / BM; nwg = nM * nN; G = G_; c = c_; nkt = K_ / BK; }
    __host__ __device__ bool next(int i, Unit& u) const { return at((long)i * G + c, u); }
    __host__ __device__ bool at(long L, Unit& u) const {
        if (L >= nwg) return false;
        int wgid = (int)L; { const int q = nwg / NXCD, r = nwg % NXCD, xcd = wgid % NXCD, off = wgid / NXCD; wgid = (xcd < r ? xcd * (q + 1) : r * (q + 1) + (xcd - r) * q) + off; }
        const int nig = WGM * nN, gid = wgid / nig, fm = gid * WGM, gsz = (nM - fm) < WGM ? (nM - fm) : WGM;
        u.pm = fm + ((wgid % nig) % gsz); u.pn = (wgid % nig) / gsz; u.k0 = 0; u.nk = nkt; return true;
    }
    __device__ __forceinline__ void a_ready(const Unit&) const {}
    __device__ __forceinline__ void done(const Unit&) const {}
};


struct TailOrder {
    int G, c, NS, nkt, pm0, nN, ntu;
    __host__ __device__ bool next(int i, Unit& u) const {
        const int id = i * G + c; if (id >= ntu * NS) return false;
        const int tu = id / NS, ks = id % NS; u.pm = pm0 + tu / nN; u.pn = tu % nN; u.nk = nkt / NS; u.k0 = ks * u.nk; return true;
    }
    __device__ __forceinline__ void a_ready(const Unit&) const {}
    __device__ __forceinline__ void done(const Unit&) const {}
};

__device__ __forceinline__ unsigned cvt_pk_bf16(float lo, float hi) { unsigned r; asm volatile("v_cvt_pk_bf16_f32 %0, %1, %2" : "=v"(r) : "v"(lo), "v"(hi)); return r; }
typedef float f32x2 __attribute__((ext_vector_type(2)));

template <class Epi, class Sched, bool ALIGN_EPI = false, bool SP2 = false>
__device__ __forceinline__ void gemm_phase(PG8_LAS unsigned char* lds, const Gemm g, const Sched& S, const Epi& E) {
    const int tid = threadIdx.x, wid = __builtin_amdgcn_readfirstlane(tid >> 6), lane = tid & 63, wr = wid >> 2, wc = wid & 3, fr = lane & 15, fq = lane >> 4;
    const int K = g.K, nt = K / BK;
    unsigned voffA[2], voffB[2];
#pragma unroll
    for (int i = 0; i < 2; ++i) { int R, C; stage_rc(tid * 16 + i * 8192, R, C); const int Rb = Epi::PERM ? ((R & ~31) + perm32(R & 31)) : R;
        voffA[i] = (unsigned)(R * K + C) * 2u; voffB[i] = (unsigned)(Rb * K + C) * 2u; }
    const size_t kstep = (size_t)(BK * 2);
    const size_t hstep = (size_t)HALF * K * 2;
    const size_t tstep = 2 * hstep;
    const unsigned ldsw = (unsigned)wid * 1024u;
    const int aoff = lds_byte(wr * 64 + fr, fq * 8), boff = lds_byte(wc * 32 + fr, fq * 8);
#define PG8_SA(b, h) (((b) * 2 + (h)) * HTB)
#define PG8_SB(b, h) ((4 + (b) * 2 + (h)) * HTB)
#define PG8_STAGE(bufoff, gbase, voff) do { _Pragma("unroll") for (int _i = 0; _i < 2; ++_i) \
        __builtin_amdgcn_global_load_lds((const unsigned*)((const char*)(gbase) + (voff)[_i]), (PG8_LAS unsigned*)(lds + (bufoff) + ldsw + _i * 8192), 16, 0, 0); } while (0)
#define PG8_LDA(dst, b, h) do { _Pragma("unroll") for (int m = 0; m < 4; ++m) _Pragma("unroll") for (int k = 0; k < 2; ++k) dst[m][k] = *(const PG8_LAS bf16x8*)(lds + PG8_SA(b, h) + aoff + m * 2048 + k * 1024); } while (0)
#define PG8_LDB(dst, b, h) do { _Pragma("unroll") for (int n = 0; n < 2; ++n) _Pragma("unroll") for (int k = 0; k < 2; ++k) dst[n][k] = *(const PG8_LAS bf16x8*)(lds + PG8_SB(b, h) + boff + n * 2048 + k * 1024); } while (0)
#define PG8_MMA(ai, bj, At, Bt) do { __builtin_amdgcn_s_setprio(1); _Pragma("unroll") for (int m = 0; m < 4; ++m) _Pragma("unroll") for (int n = 0; n < 2; ++n) _Pragma("unroll") for (int k = 0; k < 2; ++k) \
        acc[ai][bj][m][n] = __builtin_amdgcn_mfma_f32_16x16x32_bf16(Bt[n][k], At[m][k], acc[ai][bj][m][n], 0, 0, 0); __builtin_amdgcn_s_setprio(0); } while (0)
#define PG8_WAIT_V(n) asm volatile("s_waitcnt vmcnt(" #n ")" ::: "memory")
#define PG8_WAIT_L(n) asm volatile("s_waitcnt lgkmcnt(" #n ")" ::: "memory")
#define PG8_BAR __builtin_amdgcn_s_barrier()
#define PG8_SCHED __builtin_amdgcn_sched_barrier(0)
    Unit cur, nxt; int ui = 0;
    if (!S.next(0, cur)) return;
    f32x4 acc[2][2][4][2];
#pragma unroll
    for (int a = 0; a < 2; ++a)
#pragma unroll
        for (int b = 0; b < 2; ++b)
#pragma unroll
            for (int m = 0; m < 4; ++m)
#pragma unroll
                for (int n = 0; n < 2; ++n) acc[a][b][m][n] = (f32x4){0.f, 0.f, 0.f, 0.f};
    bf16x8 At[4][2], B0[2][2], B1[2][2];
    const char* cA = (const char*)g.A + (size_t)cur.pm * tstep + (size_t)cur.k0 * kstep; const char* cB = (const char*)g.Bt + (size_t)cur.pn * tstep + (size_t)cur.k0 * kstep;
    S.a_ready(cur);
    if constexpr (SP2) {
        PG8_STAGE(PG8_SB(0, 0), cB, voffB); PG8_STAGE(PG8_SB(0, 1), cB + hstep, voffB); PG8_STAGE(PG8_SA(0, 0), cA, voffA); PG8_STAGE(PG8_SA(0, 1), cA + hstep, voffA);
        if (wr == 1) PG8_BAR;
        PG8_WAIT_V(2); PG8_BAR;
        PG8_STAGE(PG8_SB(1, 0), cB + kstep, voffB); PG8_STAGE(PG8_SA(1, 0), cA + kstep, voffA); PG8_STAGE(PG8_SB(1, 1), cB + hstep + kstep, voffB);
        PG8_WAIT_V(6); PG8_BAR;
    } else {
        PG8_STAGE(PG8_SB(0, 0), cB, voffB); PG8_STAGE(PG8_SA(0, 0), cA, voffA); PG8_STAGE(PG8_SB(0, 1), cB + hstep, voffB); PG8_STAGE(PG8_SA(0, 1), cA + hstep, voffA);
        if (wr == 1) PG8_BAR;
        PG8_WAIT_V(4); PG8_BAR;
        PG8_STAGE(PG8_SB(1, 0), cB + kstep, voffB); PG8_STAGE(PG8_SA(1, 0), cA + kstep, voffA); PG8_STAGE(PG8_SB(1, 1), cB + hstep + kstep, voffB);
        PG8_WAIT_V(6); PG8_BAR;
    }
    for (;;) {
        const bool has_next = S.next(ui + 1, nxt);
        const char* nA = has_next ? (const char*)g.A + (size_t)nxt.pm * tstep + (size_t)nxt.k0 * kstep : cA; const char* nB = has_next ? (const char*)g.Bt + (size_t)nxt.pn * tstep + (size_t)nxt.k0 * kstep : cB;
        const int ntc = cur.nk;
        for (int t = 0; t < ntc; t += 2) {
            const bool last = (t == ntc - 2);
            const char* a1 = cA + (size_t)(t + 1) * kstep;
            const char* a2 = last ? nA : cA + (size_t)(t + 2) * kstep; const char* b2 = last ? nB : cB + (size_t)(t + 2) * kstep;
            const char* a3 = a2 + kstep; const char* b3 = b2 + kstep;
            if (last && has_next) S.a_ready(nxt);
            if constexpr (SP2) {
            PG8_LDB(B0, 0, 0); PG8_LDB(B1, 0, 1); PG8_SCHED; PG8_LDA(At, 0, 0); PG8_STAGE(PG8_SA(1, 1), a1 + hstep, voffA);
            PG8_WAIT_V(8); PG8_WAIT_L(0); PG8_BAR; PG8_MMA(0, 0, At, B0); PG8_MMA(0, 1, At, B1); PG8_BAR; PG8_SCHED;
            PG8_LDA(At, 0, 1); PG8_STAGE(PG8_SB(0, 0), b2, voffB); PG8_STAGE(PG8_SB(0, 1), b2 + hstep, voffB); PG8_STAGE(PG8_SA(0, 0), a2, voffA);
            PG8_WAIT_V(8); PG8_WAIT_L(0); PG8_BAR; PG8_MMA(1, 0, At, B0); PG8_MMA(1, 1, At, B1); PG8_BAR; PG8_SCHED;
            PG8_LDB(B0, 1, 0); PG8_LDB(B1, 1, 1); PG8_SCHED; PG8_LDA(At, 1, 0); PG8_STAGE(PG8_SA(0, 1), a2 + hstep, voffA);
            PG8_WAIT_V(8); PG8_WAIT_L(0); PG8_BAR; PG8_MMA(0, 0, At, B0); PG8_MMA(0, 1, At, B1); PG8_BAR; PG8_SCHED;
            PG8_LDA(At, 1, 1); PG8_STAGE(PG8_SB(1, 0), b3, voffB); PG8_STAGE(PG8_SB(1, 1), b3 + hstep, voffB); PG8_STAGE(PG8_SA(1, 0), a3, voffA);
            PG8_WAIT_V(8); PG8_WAIT_L(0); PG8_BAR; PG8_MMA(1, 0, At, B0); PG8_MMA(1, 1, At, B1); PG8_BAR; PG8_SCHED;
            } else {
            PG8_LDB(B0, 0, 0); PG8_SCHED; PG8_LDA(At, 0, 0); PG8_STAGE(PG8_SA(1, 1), a1 + hstep, voffA);
            PG8_WAIT_L(8); PG8_BAR; PG8_WAIT_L(0); PG8_MMA(0, 0, At, B0); PG8_BAR; PG8_SCHED;
            PG8_LDB(B1, 0, 1); PG8_STAGE(PG8_SB(0, 0), b2, voffB);
            PG8_BAR; PG8_WAIT_L(0); PG8_MMA(0, 1, At, B1); PG8_BAR;
            PG8_LDA(At, 0, 1); PG8_STAGE(PG8_SA(0, 0), a2, voffA);
            PG8_BAR; PG8_WAIT_L(0); PG8_MMA(1, 0, At, B0); PG8_BAR; PG8_SCHED;
            PG8_STAGE(PG8_SB(0, 1), b2 + hstep, voffB);
            PG8_WAIT_V(6); PG8_BAR; PG8_MMA(1, 1, At, B1); PG8_BAR;
            PG8_LDB(B0, 1, 0); PG8_SCHED; PG8_LDA(At, 1, 0); PG8_STAGE(PG8_SA(0, 1), a2 + hstep, voffA);
            PG8_WAIT_L(8); PG8_BAR; PG8_WAIT_L(0); PG8_MMA(0, 0, At, B0); PG8_BAR; PG8_SCHED;
            PG8_LDB(B1, 1, 1); PG8_STAGE(PG8_SB(1, 0), b3, voffB);
            PG8_BAR; PG8_WAIT_L(0); PG8_MMA(0, 1, At, B1); PG8_BAR;
            PG8_LDA(At, 1, 1); PG8_STAGE(PG8_SA(1, 0), a3, voffA);
            PG8_BAR; PG8_WAIT_L(0); PG8_MMA(1, 0, At, B0); PG8_BAR; PG8_SCHED;
            PG8_STAGE(PG8_SB(1, 1), b3 + hstep, voffB);
            PG8_WAIT_V(6); PG8_BAR; PG8_MMA(1, 1, At, B1); PG8_BAR;
            }
        }
        if constexpr (ALIGN_EPI) { if (wr == 0) PG8_BAR; }
        if constexpr (!Epi::AFTER_DRAIN) { E(acc, cur, wr, wc, fr, fq); S.done(cur); }
        if (!has_next) break;
#pragma unroll
        for (int a = 0; a < 2; ++a)
#pragma unroll
            for (int b = 0; b < 2; ++b)
#pragma unroll
                for (int m = 0; m < 4; ++m)
#pragma unroll
                    for (int n = 0; n < 2; ++n) acc[a][b][m][n] = (f32x4){0.f, 0.f, 0.f, 0.f};
        cur = nxt; cA = nA; cB = nB; ++ui;
        if constexpr (ALIGN_EPI) { if (wr == 1) PG8_BAR; }
    }
    PG8_WAIT_V(0);
    if constexpr (!ALIGN_EPI) { if (wr == 0) PG8_BAR; }
    PG8_BAR;
    if constexpr (Epi::AFTER_DRAIN) { E.fused(acc, cur, wr, wc, fr, fq, lds, wid, lane); S.done(cur); }
#undef PG8_SA
#undef PG8_SB
#undef PG8_STAGE
#undef PG8_LDA
#undef PG8_LDB
#undef PG8_MMA
#undef PG8_WAIT_V
#undef PG8_WAIT_L
#undef PG8_BAR
#undef PG8_SCHED
}
}

#ifndef MK_N_LAUNCHES
#define MK_N_LAUNCHES 1
#endif
#ifndef REP_MASK
#define REP_MASK 0
#endif
#define LAS __attribute__((address_space(3)))
using pg8::bf16_t; using pg8::bf16x8; using pg8::f32x4; using pg8::u32x4;
typedef float f32x16 __attribute__((ext_vector_type(16)));
typedef __bf16 bf16x2_t __attribute__((ext_vector_type(2)));
typedef float f32x2_t __attribute__((ext_vector_type(2)));
typedef unsigned u32x2 __attribute__((ext_vector_type(2)));

constexpr int NWAVES = 8, NTHR = 512;
constexpr int D = 1024, MP = 16384, MS = 1024, M = MP + MS, NIN = 3840, PLD = 3584, FF = 2816, NUP = 2 * FF;
constexpr float EPS = 1e-6f;
constexpr size_t MiB = 1u << 20;
constexpr size_t WS_BAR = 26 * MiB + 768 * 1024, WS_WIN = 0, WS_WO = 8 * MiB, WS_W13 = 10 * MiB, WS_W2 = 21 * MiB, WS_RSTD1 = 27 * MiB, WS_SSQ2 = 28 * MiB, WS_LRA = 32 * MiB, WS_DCH = 34 * MiB,
                 WS_KDTS = 37 * MiB, WS_XB = 45 * MiB, WS_FB = 79 * MiB, WS_P = 113 * MiB, WS_END = 233 * MiB;
static_assert(WS_P + (size_t)(M + 32) * PLD * 2 <= WS_END && WS_XB + (size_t)M * D * 2 <= WS_FB && WS_FB + (size_t)M * 512 * 4 <= WS_P, "ws map");
constexpr size_t OUT_Y = 0, OUT_SAP = 17825792, OUT_SBP = 18087936, OUT_SAS = 18612224, OUT_SBS = 22806528;
constexpr int LDS_BYTES = 160768;

__device__ __forceinline__ unsigned pk_bf16(float lo, float hi) { f32x2_t v = {lo, hi}; bf16x2_t b = __builtin_convertvector(v, bf16x2_t); return __builtin_bit_cast(unsigned, b); }
__device__ __forceinline__ float bf_lo(unsigned u) { return __uint_as_float(u << 16); }
__device__ __forceinline__ float bf_hi(unsigned u) { return __uint_as_float(u & 0xffff0000u); }
__device__ __forceinline__ float bf_f(unsigned short u) { return __uint_as_float(((unsigned)u) << 16); }


template <int CTRL, int ROWMASK> __device__ __forceinline__ float dpp_f(float v) { return __builtin_bit_cast(float, __builtin_amdgcn_update_dpp(0, __builtin_bit_cast(int, v), CTRL, ROWMASK, 0xF, true)); }
__device__ __forceinline__ float row16_sum(float v) { v += dpp_f<0xB1, 0xF>(v); v += dpp_f<0x4E, 0xF>(v); v += dpp_f<0x141, 0xF>(v); v += dpp_f<0x140, 0xF>(v); return v; }
__device__ __forceinline__ float scan32(float a) {
    a += dpp_f<0x111, 0xF>(a); a += dpp_f<0x112, 0xF>(a); a += dpp_f<0x114, 0xF>(a); a += dpp_f<0x118, 0xF>(a); a += dpp_f<0x142, 0xA>(a); return a; }
template <int CTRL, int ROWMASK> __device__ __forceinline__ float dpp_f1(float v) { return __builtin_bit_cast(float, __builtin_amdgcn_update_dpp(0x3f800000, __builtin_bit_cast(int, v), CTRL, ROWMASK, 0xF, false)); }
__device__ __forceinline__ float scanmul32(float a) {
    a *= dpp_f1<0x111, 0xF>(a); a *= dpp_f1<0x112, 0xF>(a); a *= dpp_f1<0x114, 0xF>(a); a *= dpp_f1<0x118, 0xF>(a); a *= dpp_f1<0x142, 0xA>(a); return a; }
__device__ __forceinline__ float lane_bcast(float v, int l);
__device__ __forceinline__ float wave_sum(float v) { v = row16_sum(v); return (lane_bcast(v, 0) + lane_bcast(v, 16)) + (lane_bcast(v, 32) + lane_bcast(v, 48)); }
__device__ __forceinline__ float lane_bcast(float v, int l) { return __builtin_bit_cast(float, __builtin_amdgcn_readlane(__builtin_bit_cast(int, v), l)); }
#define LDS_WAIT() asm volatile("s_waitcnt lgkmcnt(0)" ::: "memory")
#define WG_BAR() do { asm volatile("s_waitcnt lgkmcnt(0)" ::: "memory"); __builtin_amdgcn_s_barrier(); asm volatile("" ::: "memory"); } while (0)
#define MFMA32(a, b, c) __builtin_amdgcn_mfma_f32_32x32x16_bf16((a), (b), (c), 0, 0, 0)
#define MFMA16(a, b, c) __builtin_amdgcn_mfma_f32_16x16x32_bf16((a), (b), (c), 0, 0, 0)

struct Ptrs {
    const float* in[17]; float* out;
    bf16_t *WinT, *WoT, *W13T, *W2T, *XB, *P, *KDTS, *OF, *X1B, *HID;
    float *RSTD1, *SSQ2, *LRA, *DCH, *FB, *OY; bf16_t *DUMP, *OX, *OI; float *PART, *PART4, *SSQ3;
};

namespace pg8 {
struct EpiIn {
    static constexpr bool PERM = true, AFTER_DRAIN = false;
    bf16_t* P; float* FB; float* LRA; const float* rstd;
    __device__ __forceinline__ void operator()(const f32x4 (&acc)[2][2][4][2], const Unit& u, int wr, int wc, int fr, int fq) const {
        const int row0 = u.pm * BM + wr * 64 + fr, ct = wc * 32 + 8 * fq;
#pragma unroll
        for (int ai = 0; ai < 2; ++ai)
#pragma unroll
            for (int m = 0; m < 4; ++m) {
                const int row = row0 + ai * HALF + m * 16; const float rs = 1.0f;
#pragma unroll
                for (int bj = 0; bj < 2; ++bj) {
                    const f32x4 v0 = acc[ai][bj][m][0] * rs, v1 = acc[ai][bj][m][1] * rs; const int cl = bj * HALF + ct;
                    if (u.pn == 8 || u.pn == 9) { float* o = FB + (size_t)row * 512 + (u.pn - 8) * BM + cl; *(f32x4*)o = v0; *(f32x4*)(o + 4) = v1; }
                    else if (u.pn == 14) { if (cl < 16) { float* o = LRA + (size_t)row * 16 + cl; *(f32x4*)o = v0; *(f32x4*)(o + 4) = v1; } }
                    else { u32x4 w; w.x = cvt_pk_bf16(v0[0], v0[1]); w.y = cvt_pk_bf16(v0[2], v0[3]); w.z = cvt_pk_bf16(v1[0], v1[1]); w.w = cvt_pk_bf16(v1[2], v1[3]);
                           *(u32x4*)(P + (size_t)row * 3584 + u.pn * BM + cl) = w; }
                }
            }
    }
};
struct EpiRes1 {
    static constexpr bool PERM = true, AFTER_DRAIN = false;
    const float* xp; const float* xs; float* Y; bf16_t* X1B; float* SSQ;
    __device__ __forceinline__ void operator()(const f32x4 (&acc)[2][2][4][2], const Unit& u, int wr, int wc, int fr, int fq) const {
        const int row0 = u.pm * BM + wr * 64 + fr, ct = u.pn * BM + wc * 32 + 8 * fq;
#pragma unroll
        for (int ai = 0; ai < 2; ++ai)
#pragma unroll
            for (int m = 0; m < 4; ++m) {
                const int row = row0 + ai * HALF + m * 16;
                const float* xr = row < 16384 ? xp + (size_t)row * 1024 : xs + (size_t)(row - 16384) * 1024;
                float ss = 0.f;
#pragma unroll
                for (int bj = 0; bj < 2; ++bj) {
                    const int col = ct + bj * HALF;
                    const f32x4 v0 = acc[ai][bj][m][0] + *(const f32x4*)(xr + col), v1 = acc[ai][bj][m][1] + *(const f32x4*)(xr + col + 4);
                    u32x4 w; w.x = cvt_pk_bf16(v0[0], v0[1]); w.y = cvt_pk_bf16(v0[2], v0[3]); w.z = cvt_pk_bf16(v1[0], v1[1]); w.w = cvt_pk_bf16(v1[2], v1[3]);
                    *(u32x4*)(X1B + (size_t)row * 1024 + col) = w;
                    ss += (v0[0] * v0[0] + v0[1] * v0[1]) + (v0[2] * v0[2] + v0[3] * v0[3]) + (v1[0] * v1[0] + v1[1] * v1[1]) + (v1[2] * v1[2] + v1[3] * v1[3]);
                }
                ss += __shfl_xor(ss, 16); ss += __shfl_xor(ss, 32);
                if (fq == 0) SSQ[(size_t)row * 16 + u.pn * 4 + wc] = ss;
            }
    }
};
struct EpiSwiglu {
    static constexpr bool PERM = true, AFTER_DRAIN = false;
    bf16_t* H; const float* SSQ;
    __device__ __forceinline__ void operator()(const f32x4 (&acc)[2][2][4][2], const Unit& u, int wr, int wc, int fr, int fq) const {
        const int row0 = u.pm * BM + wr * 64 + fr, hc = u.pn * 128 + wc * 16 + fq * 4;
#pragma unroll
        for (int ai = 0; ai < 2; ++ai)
#pragma unroll
            for (int m = 0; m < 4; ++m) {
                const int row = row0 + ai * HALF + m * 16;
                const float rs = SSQ[row];
#pragma unroll
                for (int bj = 0; bj < 2; ++bj) {
                    const f32x4 a = acc[ai][bj][m][0] * rs, b = acc[ai][bj][m][1] * rs; float h[4];
#pragma unroll
                    for (int e = 0; e < 4; ++e) h[e] = a[e] * __builtin_amdgcn_rcpf(1.0f + __expf(-a[e])) * b[e];
                    unsigned lo = cvt_pk_bf16(h[0], h[1]), hi = cvt_pk_bf16(h[2], h[3]);
                    *(unsigned long long*)(H + (size_t)row * 2816 + hc + bj * 64) = (unsigned long long)lo | ((unsigned long long)hi << 32);
                }
            }
    }
};
struct EpiRes2 {
    static constexpr bool PERM = true, AFTER_DRAIN = false;
    float* Y; float sc; const bf16_t* X1B;
    __device__ __forceinline__ void operator()(const f32x4 (&acc)[2][2][4][2], const Unit& u, int wr, int wc, int fr, int fq) const {
        const int row0 = u.pm * BM + wr * 64 + fr, ct = u.pn * BM + wc * 32 + 8 * fq;
#pragma unroll
        for (int ai = 0; ai < 2; ++ai)
#pragma unroll
            for (int m = 0; m < 4; ++m) {
                float* yr = Y + (size_t)(row0 + ai * HALF + m * 16) * 1024;
#pragma unroll
                for (int bj = 0; bj < 2; ++bj) {
                    const int col = ct + bj * HALF;
                    const pg8::u32x4 xr = *(const pg8::u32x4*)(X1B + (size_t)(row0 + ai * HALF + m * 16) * 1024 + col);
                    const f32x4 v0 = acc[ai][bj][m][0] * sc + (f32x4){__uint_as_float(xr.x << 16), __uint_as_float(xr.x & 0xffff0000u), __uint_as_float(xr.y << 16), __uint_as_float(xr.y & 0xffff0000u)};
                    const f32x4 v1 = acc[ai][bj][m][1] * sc + (f32x4){__uint_as_float(xr.z << 16), __uint_as_float(xr.z & 0xffff0000u), __uint_as_float(xr.w << 16), __uint_as_float(xr.w & 0xffff0000u)};
                    *(f32x4*)(yr + col) = v0; *(f32x4*)(yr + col + 4) = v1;
                }
            }
    }
};
struct EpiPart {
    static constexpr bool PERM = true, AFTER_DRAIN = false;
    float* PART; int rowbase; float sc;
    __device__ __forceinline__ void operator()(const f32x4 (&acc)[2][2][4][2], const Unit& u, int wr, int wc, int fr, int fq) const {
        const int row0 = u.pm * BM + wr * 64 + fr - rowbase, ct = u.pn * BM + wc * 32 + 8 * fq;
        float* base = PART + (size_t)(u.k0 / u.nk) * 1024 * 1024;
#pragma unroll
        for (int ai = 0; ai < 2; ++ai)
#pragma unroll
            for (int m = 0; m < 4; ++m) {
                float* yr = base + (size_t)(row0 + ai * HALF + m * 16) * 1024;
#pragma unroll
                for (int bj = 0; bj < 2; ++bj) { const int col = ct + bj * HALF; *(f32x4*)(yr + col) = acc[ai][bj][m][0] * sc; *(f32x4*)(yr + col + 4) = acc[ai][bj][m][1] * sc; }
            }
    }
};
}

__device__ __forceinline__ void tr_item(const float* colp, int ldw, const float* gain, int k0, int dcol, bf16_t* WT, int K, int nrow0, LAS float* scr, int lane) {
    float tv[32];
#pragma unroll
    for (int i = 0; i < 32; ++i) { const int kk = 2 * i + (lane >> 5); tv[i] = colp ? colp[(size_t)(k0 + kk) * ldw] : 0.f; }
    if (gain) {
        float gv[32];
#pragma unroll
        for (int i = 0; i < 32; ++i) gv[i] = gain[k0 + 2 * i + (lane >> 5)];
#pragma unroll
        for (int i = 0; i < 32; ++i) tv[i] *= gv[i];
    }
#pragma unroll
    for (int i = 0; i < 32; ++i) scr[(2 * i + (lane >> 5)) * 33 + dcol] = tv[i];
    LDS_WAIT();
    const int c = lane & 7;
#pragma unroll
    for (int j = 0; j < 4; ++j) {
        const int n = (lane >> 3) + 8 * j; const LAS float* s = scr + (8 * c) * 33 + n;
        u32x4 o; o.x = pk_bf16(s[0 * 33], s[1 * 33]); o.y = pk_bf16(s[2 * 33], s[3 * 33]); o.z = pk_bf16(s[4 * 33], s[5 * 33]); o.w = pk_bf16(s[6 * 33], s[7 * 33]);
        *(u32x4*)(WT + (size_t)(nrow0 + n) * K + k0 + 8 * c) = o;
    }
    LDS_WAIT();
}
__device__ __forceinline__ void weight_items(const Ptrs& c, LAS float* scr, int part, int gw, int NGW, int lane) {
    const int l31 = lane & 31;
    constexpr int I_IN = 16 * 120, I_O = 16 * 32, I_13 = 16 * 176, I_2 = 44 * 32;
    if (part == 0) {
        for (int r = gw; r < I_IN; r += NGW) { const int kb = r / 120, nb = r % 120, n = nb * 32 + l31;
            const int oc = n < 1536 ? n : (n < 3584 ? n + 16 : (n < 3600 ? n - 3584 + 1536 : -1));
            tr_item(oc >= 0 ? c.in[5] + oc : nullptr, 3600, c.in[4], kb * 64, l31, c.WinT, 1024, nb * 32, scr, lane); }
        return;
    }
    for (int it = gw; it < I_O + I_13 + I_2; it += NGW) {
        int r = it;
        if (r < I_O) { const int kb = r / 32, nb = r % 32; tr_item(c.in[11] + nb * 32 + l31, 1024, nullptr, kb * 64, l31, c.WoT, 1024, nb * 32, scr, lane); continue; }
        r -= I_O;
        if (r < I_13) { const int kb = r / 176, nb = r % 176; const bool is3 = l31 >= 16; const int hcol = nb * 16 + (l31 & 15);
            tr_item((is3 ? c.in[14] : c.in[13]) + hcol, 2816, c.in[12], kb * 64, ((l31 & 15) >> 2) * 8 + (is3 ? 4 : 0) + (l31 & 3), c.W13T, 1024, nb * 32, scr, lane); continue; }
        r -= I_13;
        { const int kb = r / 32, nb = r % 32; tr_item(c.in[15] + nb * 32 + l31, 1024, nullptr, kb * 64, l31, c.W2T, 2816, nb * 32, scr, lane); }
    }
}
__device__ __forceinline__ void p0_prologue(const Ptrs& c, LAS unsigned char* lds, int G, int wave, int lane, bool all_weights) {
    LAS float* scr = (LAS float*)(lds + wave * 16384);
    const int gw = blockIdx.x * NWAVES + wave, NGW = G * NWAVES;
    weight_items(c, scr, 0, gw, NGW, lane);
    if (all_weights) weight_items(c, scr, 1, gw, NGW, lane);
    {
        f32x4 v[4], nv[4];
        { const int m0 = gw < M ? gw : M - 1; const float* xr = m0 < MP ? c.in[0] + (size_t)m0 * D : c.in[1] + (size_t)(m0 - MP) * D;
#pragma unroll
          for (int j = 0; j < 4; ++j) v[j] = *(const f32x4*)(xr + 4 * lane + 256 * j); }
        for (int m = gw; m < M; m += NGW) {
            { const int mn = m + NGW < M ? m + NGW : m; const float* xr = mn < MP ? c.in[0] + (size_t)mn * D : c.in[1] + (size_t)(mn - MP) * D;
#pragma unroll
              for (int j = 0; j < 4; ++j) nv[j] = *(const f32x4*)(xr + 4 * lane + 256 * j); }
            float s = 0.f;
#pragma unroll
            for (int j = 0; j < 4; ++j) s += (v[j][0] * v[j][0] + v[j][1] * v[j][1]) + (v[j][2] * v[j][2] + v[j][3] * v[j][3]);
            s = wave_sum(s);
            const float rs = __builtin_amdgcn_rsqf(s * (1.0f / D) + EPS);
#pragma unroll
            for (int j = 0; j < 4; ++j) { u32x2 w; w.x = pk_bf16(v[j][0] * rs, v[j][1] * rs); w.y = pk_bf16(v[j][2] * rs, v[j][3] * rs); *(u32x2*)(c.XB + (size_t)m * D + 4 * lane + 256 * j) = w; }
#pragma unroll
            for (int j = 0; j < 4; ++j) v[j] = nv[j];
        }
    }
}

__device__ __forceinline__ int crow(int i, int h) { return (i & 3) + 8 * (i >> 2) + 4 * h; }
template <int K, bool GLA, bool ALLV>
__device__ __forceinline__ void pre_item(const Ptrs& c, int row0, int ntok, int hh, int item, bf16_t* kdt_base, int kdt_stride,
                                         const LAS float* wa2_l, const LAS float* ba_l, const LAS float* lb_l, LAS unsigned char* vt, int lane, bool dry) {
    const int r = lane & 31, kg = lane >> 5;
    const bool valid = ALLV || r < ntok;
    const int row = row0 + (valid ? r : 0), nt1 = ntok - 1;
    constexpr int NJ = K / 16;
    const int qcol0 = GLA ? hh * 64 : 1536 + hh * 128, kcol0 = 256 + hh * 64, vcol0 = GLA ? 512 + hh * 128 : 2560 + hh * 128, ocol0 = (GLA ? hh : 4 + hh) * 128;
    bf16_t* Prow = c.P + (size_t)row * PLD;
    LAS unsigned char* kt = vt + 8192;
    LAS unsigned char* dl = vt + 16384;
    float lra[16];
    if constexpr (GLA) {
#pragma unroll
        for (int i = 0; i < 4; ++i) { const f32x4 t = *(const f32x4*)(c.LRA + (size_t)row * 16 + 4 * i); lra[4 * i] = t[0]; lra[4 * i + 1] = t[1]; lra[4 * i + 2] = t[2]; lra[4 * i + 3] = t[3]; }
    }
    const bf16_t* qptr = Prow + qcol0 + 8 * kg;
    const bf16_t* kptr = Prow + kcol0 + 8 * kg;
    const float* fptr = c.FB + (size_t)row * 512 + hh * 128 + 8 * kg;
    u32x4 qn = *(const u32x4*)qptr, kn = {0u, 0u, 0u, 0u}; f32x4 fn0 = {0.f, 0.f, 0.f, 0.f}, fn1 = fn0;
    if constexpr (GLA) kn = *(const u32x4*)kptr; else { fn0 = *(const f32x4*)fptr; fn1 = *(const f32x4*)(fptr + 4); }
    f32x16 att;
#pragma unroll
    for (int i = 0; i < 16; ++i) att[i] = 0.f;
    float* dch = c.DCH + (size_t)item * 128;
#pragma unroll 1
    for (int j = 0; j < NJ; ++j) {
        const int cl = 16 * j + 8 * kg;
        const u32x4 qr = qn, kr = kn; const f32x4 f0 = fn0, f1 = fn1;
        { const int jn = j + 1 < NJ ? j + 1 : j;
          qn = *(const u32x4*)(qptr + 16 * jn);
          if constexpr (GLA) kn = *(const u32x4*)(kptr + 16 * jn); else { fn0 = *(const f32x4*)(fptr + 16 * jn); fn1 = *(const f32x4*)(fptr + 16 * jn + 4); } }
        float la[8], kv[8], qv[8];
        if constexpr (GLA) {
            const LAS float* wl = wa2_l + hh * 64 + cl;
            f32x4 a0 = *(const LAS f32x4*)(ba_l + hh * 64 + cl), a1 = *(const LAS f32x4*)(ba_l + hh * 64 + cl + 4);
#pragma unroll
            for (int rb = 0; rb < 16; rb += 4) {
                f32x4 w[8];
#pragma unroll
                for (int rr = 0; rr < 4; ++rr) { w[2 * rr] = *(const LAS f32x4*)(wl + (rb + rr) * 256); w[2 * rr + 1] = *(const LAS f32x4*)(wl + (rb + rr) * 256 + 4); }
#pragma unroll
                for (int rr = 0; rr < 4; ++rr) { a0 += w[2 * rr] * lra[rb + rr]; a1 += w[2 * rr + 1] * lra[rb + rr]; }
            }
            float x[8], t[8];
#pragma unroll
            for (int e = 0; e < 8; ++e) x[e] = e < 4 ? a0[e & 3] : a1[e & 3];
#pragma unroll
            for (int e = 0; e < 8; ++e) t[e] = __expf(-fabsf(x[e]));
#pragma unroll
            for (int e = 0; e < 8; ++e) t[e] = __logf(1.0f + t[e]);
#pragma unroll
            for (int e = 0; e < 8; ++e) la[e] = (fminf(x[e], 0.f) - t[e]) * 0.0625f;
            kv[0] = bf_lo(kr.x); kv[1] = bf_hi(kr.x); kv[2] = bf_lo(kr.y); kv[3] = bf_hi(kr.y); kv[4] = bf_lo(kr.z); kv[5] = bf_hi(kr.z); kv[6] = bf_lo(kr.w); kv[7] = bf_hi(kr.w);
        } else {
            const f32x4 l0 = *(const LAS f32x4*)(lb_l + hh * 128 + cl), l1 = *(const LAS f32x4*)(lb_l + hh * 128 + cl + 4);
            float x[8], lbv[8], ex[8], inv[8];
#pragma unroll
            for (int e = 0; e < 8; ++e) { x[e] = e < 4 ? f0[e & 3] : f1[e & 3]; lbv[e] = e < 4 ? l0[e & 3] : l1[e & 3]; }
#pragma unroll
            for (int e = 0; e < 8; ++e) ex[e] = __expf(-fabsf(x[e]));
#pragma unroll
            for (int e = 0; e < 8; ++e) inv[e] = __builtin_amdgcn_rcpf(1.0f + ex[e]);
#pragma unroll
            for (int e = 0; e < 8; ++e) { const float ei = ex[e] * inv[e]; const float sg = x[e] >= 0.f ? inv[e] : ei, ng = x[e] >= 0.f ? ei : inv[e];
                la[e] = lbv[e] + (1.0f - lbv[e]) * sg; kv[e] = (1.0f - lbv[e]) * ng; }
        }
        qv[0] = bf_lo(qr.x); qv[1] = bf_hi(qr.x); qv[2] = bf_lo(qr.y); qv[3] = bf_hi(qr.y); qv[4] = bf_lo(qr.z); qv[5] = bf_hi(qr.z); qv[6] = bf_lo(qr.w); qv[7] = bf_hi(qr.w);
        float qi[8], ki[8], kd[8], eb[8], q[8], ea[8], ia[8];
        if constexpr (GLA) {
#pragma unroll
            for (int e = 0; e < 8; ++e) q[e] = qv[e] * 0.125f;
        } else {
#pragma unroll
            for (int e = 0; e < 8; ++e) q[e] = __expf(-qv[e]);
#pragma unroll
            for (int e = 0; e < 8; ++e) q[e] = __builtin_amdgcn_rcpf(1.0f + q[e]);
#pragma unroll
            for (int e = 0; e < 8; ++e) q[e] *= qv[e];
        }
        if (!ALLV) {
#pragma unroll
            for (int e = 0; e < 8; ++e) if (!valid) { q[e] = 0.f; kv[e] = 0.f; la[e] = GLA ? 0.f : 1.f; }
        }
        if constexpr (GLA) {
#pragma unroll
            for (int e = 0; e < 8; ++e) la[e] += dpp_f<0x111, 0xF>(la[e]);
#pragma unroll
            for (int e = 0; e < 8; ++e) la[e] += dpp_f<0x112, 0xF>(la[e]);
#pragma unroll
            for (int e = 0; e < 8; ++e) la[e] += dpp_f<0x114, 0xF>(la[e]);
#pragma unroll
            for (int e = 0; e < 8; ++e) la[e] += dpp_f<0x118, 0xF>(la[e]);
#pragma unroll
            for (int e = 0; e < 8; ++e) la[e] += dpp_f<0x142, 0xA>(la[e]);
#pragma unroll
            for (int e = 0; e < 8; ++e) ea[e] = __expf(fmaxf(la[e], -80.f));
        } else {
#pragma unroll
            for (int e = 0; e < 8; ++e) la[e] *= dpp_f1<0x111, 0xF>(la[e]);
#pragma unroll
            for (int e = 0; e < 8; ++e) la[e] *= dpp_f1<0x112, 0xF>(la[e]);
#pragma unroll
            for (int e = 0; e < 8; ++e) la[e] *= dpp_f1<0x114, 0xF>(la[e]);
#pragma unroll
            for (int e = 0; e < 8; ++e) la[e] *= dpp_f1<0x118, 0xF>(la[e]);
#pragma unroll
            for (int e = 0; e < 8; ++e) la[e] *= dpp_f1<0x142, 0xA>(la[e]);
#pragma unroll
            for (int e = 0; e < 8; ++e) ea[e] = fmaxf(la[e], 1e-35f);
        }
#pragma unroll
        for (int e = 0; e < 8; ++e) ia[e] = __builtin_amdgcn_rcpf(ea[e]);
#pragma unroll
        for (int e = 0; e < 8; ++e) { const float e31 = lane_bcast(ea[e], 31), e63 = lane_bcast(ea[e], 63); eb[e] = kg ? e63 : e31; }
#pragma unroll
        for (int e = 0; e < 8; ++e) { qi[e] = q[e] * ea[e]; ki[e] = kv[e] * ia[e]; kd[e] = ki[e] * eb[e]; }
        u32x4 qp, kp;
        qp.x = pk_bf16(qi[0], qi[1]); qp.y = pk_bf16(qi[2], qi[3]); qp.z = pk_bf16(qi[4], qi[5]); qp.w = pk_bf16(qi[6], qi[7]);
        kp.x = pk_bf16(ki[0], ki[1]); kp.y = pk_bf16(ki[2], ki[3]); kp.z = pk_bf16(ki[4], ki[5]); kp.w = pk_bf16(ki[6], ki[7]);
        att = MFMA32(__builtin_bit_cast(bf16x8, kp), __builtin_bit_cast(bf16x8, qp), att);
        *(LAS u32x4*)(vt + r * (K * 2) + ((((cl >> 3) ^ r) & (K / 8 - 1)) << 4)) = qp;
#pragma unroll
        for (int e = 0; e < 8; e += 2) {
            const unsigned pkd = pk_bf16(kd[e], kd[e + 1]);
            *(LAS unsigned short*)(kt + (cl + e) * 64 + r * 2) = (unsigned short)(pkd & 0xffffu);
            *(LAS unsigned short*)(kt + (cl + e + 1) * 64 + r * 2) = (unsigned short)(pkd >> 16);
        }
        if (r == 0) { f32x4 d0 = {eb[0], eb[1], eb[2], eb[3]}, d1 = {eb[4], eb[5], eb[6], eb[7]}; *(LAS f32x4*)(dl + cl * 4) = d0; *(LAS f32x4*)(dl + cl * 4 + 16) = d1; }
    }
    u32x4 vreg[8];
#pragma unroll
    for (int i = 0; i < 8; ++i) { const int p = lane + 64 * i, vr = (p >> 4) < nt1 ? (p >> 4) : nt1; vreg[i] = *(const u32x4*)(c.P + (size_t)(row0 + vr) * PLD + vcol0 + (p & 15) * 8); }
#pragma unroll
    for (int i = 0; i < K / 16; ++i) {
        const int p = lane + 64 * i, L = p * 8, qr_ = p / (K / 8), qc_ = p % (K / 8);
        if ((ALLV || qr_ < ntok) && !dry) *(u32x4*)(c.P + (size_t)(row0 + qr_) * PLD + qcol0 + qc_ * 8) = *(const LAS u32x4*)(vt + qr_ * (K * 2) + (((qc_ ^ qr_) & (K / 8 - 1)) << 4));
        *(u32x4*)(kdt_base + (size_t)(L / K) * kdt_stride + (L % K)) = *(const LAS u32x4*)(kt + p * 16);
    }
    if (lane < K / 4) *(f32x4*)(dch + lane * 4) = *(const LAS f32x4*)(dl + lane * 16);
#pragma unroll
    for (int i = 0; i < 8; ++i) { const int p = lane + 64 * i; *(LAS u32x4*)(vt + (p >> 4) * 256 + (p & 15) * 16) = vreg[i]; }
#pragma unroll
    for (int i = 0; i < 16; ++i) if (crow(i, kg) > r) att[i] = 0.f;
    u32x4 pa0, pa1;
    pa0.x = pk_bf16(att[0], att[1]); pa0.y = pk_bf16(att[2], att[3]); pa0.z = pk_bf16(att[4], att[5]); pa0.w = pk_bf16(att[6], att[7]);
    pa1.x = pk_bf16(att[8], att[9]); pa1.y = pk_bf16(att[10], att[11]); pa1.z = pk_bf16(att[12], att[13]); pa1.w = pk_bf16(att[14], att[15]);
#pragma unroll 1
    for (int vb = 0; vb < 4; ++vb) {
        unsigned short vs[16];
#pragma unroll
        for (int i = 0; i < 16; ++i) vs[i] = *(const LAS unsigned short*)(vt + crow(i, kg) * 256 + (vb * 32 + r) * 2);
        u32x4 b0, b1;
        b0.x = vs[0] | ((unsigned)vs[1] << 16); b0.y = vs[2] | ((unsigned)vs[3] << 16); b0.z = vs[4] | ((unsigned)vs[5] << 16); b0.w = vs[6] | ((unsigned)vs[7] << 16);
        b1.x = vs[8] | ((unsigned)vs[9] << 16); b1.y = vs[10] | ((unsigned)vs[11] << 16); b1.z = vs[12] | ((unsigned)vs[13] << 16); b1.w = vs[14] | ((unsigned)vs[15] << 16);
        f32x16 o;
#pragma unroll
        for (int i = 0; i < 16; ++i) o[i] = 0.f;
        o = MFMA32(__builtin_bit_cast(bf16x8, pa0), __builtin_bit_cast(bf16x8, b0), o);
        o = MFMA32(__builtin_bit_cast(bf16x8, pa1), __builtin_bit_cast(bf16x8, b1), o);
#pragma unroll
        for (int i = 0; i < 16; ++i) *(LAS unsigned short*)(kt + crow(i, kg) * 256 + (vb * 32 + r) * 2) = (unsigned short)(pk_bf16(o[i], 0.f) & 0xffffu);
    }
#pragma unroll
    for (int i = 0; i < 8; ++i) {
        const int p = lane + 64 * i, t = p >> 4;
        if (t < ntok) *(u32x4*)(c.OI + (size_t)(row0 + t) * 1024 + ocol0 + (p & 15) * 8) = *(const LAS u32x4*)(kt + p * 16);
    }
}
__device__ __forceinline__ void p2_prepass(const Ptrs& c, LAS unsigned char* lds, int G, int tid, int wave, int lane, bool dry) {
    LAS float* wa2_l = (LAS float*)lds; LAS float* ba_l = wa2_l + 4096; LAS float* lb_l = ba_l + 256;
    for (int i = tid; i < 4096; i += NTHR) wa2_l[i] = c.in[6][i];
    if (tid < 256) ba_l[tid] = c.in[7][tid];
    { const float p0 = c.in[8][tid], p1 = c.in[8][512 + tid]; lb_l[tid] = 1.0f / (1.0f + __expf(p1 - p0)); }
    WG_BAR();
    const int gw = blockIdx.x * NWAVES + wave, NGW = G * NWAVES;
    const bool bal = (G == 256);
    const int n_it = bal ? 4096 : 4096 + 1024;
    for (int it0 = gw; ; it0 += NGW) {
        int it = it0;
        if (it0 >= n_it) { if (!bal || wave >= 4 || it0 >= n_it + NGW) break; it = 4096 + blockIdx.x * 4 + wave; }
        int row0, ntok, h; bf16_t* kdt; int kst;
        if (it < 4096) { h = it & 7; const int ch = (it >> 3) & 63, b = it >> 9; row0 = b * 2048 + ch * 32; ntok = 32; kst = PLD;
                         kdt = c.P + (size_t)row0 * PLD + (h < 4 ? 256 + h * 64 : 2048 + (h - 4) * 128); }
        else { const int j = it - 4096; h = j & 7; row0 = MP + (j >> 3) * 8; ntok = 8; kst = h < 4 ? 64 : 128; kdt = c.KDTS + (size_t)j * 4096; }
        if (dry) { kst = h < 4 ? 64 : 128; kdt = (bf16_t*)((unsigned char*)c.DUMP + 203 * MiB) + (size_t)(it & 2047) * 4096; }
        if (it < 4096) { if (h < 4) pre_item<64, true, true>(c, row0, ntok, h, it, kdt, kst, wa2_l, ba_l, lb_l, lds + 20480 + wave * 16896, lane, dry);
                         else pre_item<128, false, true>(c, row0, ntok, h - 4, it, kdt, kst, wa2_l, ba_l, lb_l, lds + 20480 + wave * 16896, lane, dry); }
        else { if (h < 4) pre_item<64, true, false>(c, row0, ntok, h, it, kdt, kst, wa2_l, ba_l, lb_l, lds + 20480 + wave * 16896, lane, dry);
               else pre_item<128, false, false>(c, row0, ntok, h - 4, it, kdt, kst, wa2_l, ba_l, lb_l, lds + 20480 + wave * 16896, lane, dry); }
    }
}

template <int K>
__device__ __forceinline__ void seq_item(const Ptrs& c, LAS unsigned char* lds, int row0, int nch, int ntok, int h8, int colbase, int ncw, const float* S0, float* Sout,
                                         const bf16_t* kdt0, int kdt_rstride, size_t kdt_cstep, const float* dch0, size_t dch_cstep, int tid, int wave, int lane) {
    constexpr int QROW = 2 * K + 16, VROW = 272;
    constexpr int KOFF = 8704, DOFF = 18944, VOFF = 19456, BUFB = 28160, NMB = K / 16, NPC = 4 * K;
    const int n = lane & 15, q = lane >> 4, col = colbase + 16 * (wave < ncw ? wave : 0) + n;
    const bool cw = wave < ncw;
    const bool gla = h8 < 4; const int hh = h8 & 3;
    const int qcol0 = gla ? hh * 64 : 1536 + hh * 128, vcol0 = gla ? 512 + hh * 128 : 2560 + hh * 128, ocol = h8 * 128 + col;
    f32x4 S[NMB];
#pragma unroll
    for (int mb = 0; mb < NMB; ++mb)
#pragma unroll
        for (int i = 0; i < 4; ++i) S[mb][i] = (S0 && cw) ? S0[(size_t)(16 * mb + 4 * q + i) * 128 + col] : 0.f;
    const int nt1 = ntok - 1;
    const int pq = tid % NPC, prow_q = pq / (K / 8), pc8 = pq % (K / 8), prq = prow_q < nt1 ? prow_q : nt1;
    const int vrow = tid >> 4, vc8 = tid & 15, vr = vrow < nt1 ? vrow : nt1;
    const int dpi = tid % (K / 4);
    const bf16_t* gq = c.P + (size_t)(row0 + prq) * PLD + qcol0 + pc8 * 8;
    const bf16_t* gk = kdt0 + (size_t)prow_q * kdt_rstride + pc8 * 8;
    const float* gd = dch0 + dpi * 4;
    const bf16_t* gvp = c.P + (size_t)(row0 + vr) * PLD + vcol0 + vc8 * 8;
    struct Stage { u32x4 q, k, v; f32x4 d; };
    const int nch1 = nch - 1;
#define SEQ_LOAD(R, cc) do { const int c_ = (cc) < nch1 ? (cc) : nch1; const size_t ro_ = (size_t)c_ * 32; \
        R.q = *(const u32x4*)(gq + ro_ * PLD); R.k = *(const u32x4*)(gk + (size_t)c_ * kdt_cstep); R.d = *(const f32x4*)(gd + (size_t)c_ * dch_cstep); \
        R.v = *(const u32x4*)(gvp + ro_ * PLD); } while (0)
#define SEQ_STORE(R, buf) do { LAS unsigned char* B_ = lds + (buf) * BUFB; \
        *(LAS u32x4*)(B_ + prow_q * QROW + pc8 * 16) = R.q; *(LAS u32x4*)(B_ + KOFF + (pq >> 2) * 80 + (pq & 3) * 16) = R.k; *(LAS f32x4*)(B_ + DOFF + dpi * 16) = R.d; \
        *(LAS u32x4*)(B_ + VOFF + vrow * VROW + vc8 * 16) = R.v; } while (0)
#define SEQ_ITER(ci, buf, RST) do { \
        const LAS unsigned char* B = lds + (buf) * BUFB; \
        if (cw) { \
        f32x4 o[2] = {{0.f, 0.f, 0.f, 0.f}, {0.f, 0.f, 0.f, 0.f}}; \
        _Pragma("unroll") for (int js = 0; js < K / 32; ++js) { \
            u32x4 sb; sb.x = pk_bf16(S[2 * js][0], S[2 * js][1]); sb.y = pk_bf16(S[2 * js][2], S[2 * js][3]); sb.z = pk_bf16(S[2 * js + 1][0], S[2 * js + 1][1]); sb.w = pk_bf16(S[2 * js + 1][2], S[2 * js + 1][3]); \
            _Pragma("unroll") for (int mb2 = 0; mb2 < 2; ++mb2) { \
                const LAS unsigned char* qp = B + (16 * mb2 + n) * QROW + (32 * js + 4 * q) * 2; \
                const u32x2 lo = *(const LAS u32x2*)qp, hi = *(const LAS u32x2*)(qp + 32); \
                u32x4 qa; qa.x = lo.x; qa.y = lo.y; qa.z = hi.x; qa.w = hi.y; \
                o[mb2] = MFMA16(__builtin_bit_cast(bf16x8, qa), __builtin_bit_cast(bf16x8, sb), o[mb2]); } } \
        { unsigned short vs[8]; \
            _Pragma("unroll") for (int j = 0; j < 8; ++j) vs[j] = *(const LAS unsigned short*)(B + VOFF + (8 * q + j) * VROW + col * 2); \
            u32x4 vb; vb.x = vs[0] | ((unsigned)vs[1] << 16); vb.y = vs[2] | ((unsigned)vs[3] << 16); vb.z = vs[4] | ((unsigned)vs[5] << 16); vb.w = vs[6] | ((unsigned)vs[7] << 16); \
            _Pragma("unroll") for (int mb = 0; mb < NMB; ++mb) { \
                const u32x4 ka = *(const LAS u32x4*)(B + KOFF + (16 * mb + n) * 80 + q * 16); \
                const f32x4 dv = *(const LAS f32x4*)(B + DOFF + (16 * mb + 4 * q) * 4); \
                S[mb] = S[mb] * dv; \
                S[mb] = MFMA16(__builtin_bit_cast(bf16x8, ka), __builtin_bit_cast(bf16x8, vb), S[mb]); } } \
        bf16_t* ob = c.OX + (size_t)(row0 + 32 * (ci)) * 1024 + ocol; \
        _Pragma("unroll") for (int x = 0; x < 8; x += 2) { \
            const int t = 16 * (x >> 2) + 4 * q + (x & 3); const unsigned pv = pk_bf16(o[x >> 2][x & 3], o[x >> 2][(x & 3) + 1]); \
            bf16_t* d0 = t < ntok ? ob + (size_t)t * 1024 : c.DUMP + tid; bf16_t* d1 = t + 1 < ntok ? ob + (size_t)(t + 1) * 1024 : c.DUMP + tid; \
            *d0 = (bf16_t)(pv & 0xffffu); *d1 = (bf16_t)(pv >> 16); } \
        } \
        WG_BAR(); \
        SEQ_STORE(RST, buf); \
    } while (0)
    Stage R0, R1, R2, R3;
    SEQ_LOAD(R0, 0); SEQ_STORE(R0, 0);
    SEQ_LOAD(R1, 1); SEQ_LOAD(R2, 2); SEQ_LOAD(R3, 3); SEQ_LOAD(R0, 4);
    SEQ_STORE(R1, 1);
    WG_BAR();
    for (int ci = 0; ci < nch; ci += 4) {
        SEQ_LOAD(R1, ci + 5); SEQ_ITER(ci, 0, R2);
        if (ci + 1 >= nch) break;
        SEQ_LOAD(R2, ci + 6); SEQ_ITER(ci + 1, 1, R3);
        if (ci + 2 >= nch) break;
        SEQ_LOAD(R3, ci + 7); SEQ_ITER(ci + 2, 0, R0);
        if (ci + 3 >= nch) break;
        SEQ_LOAD(R0, ci + 8); SEQ_ITER(ci + 3, 1, R1);
    }
    if (cw) {
#pragma unroll
    for (int mb = 0; mb < NMB; ++mb)
#pragma unroll
        for (int i = 0; i < 4; ++i) Sout[(size_t)(16 * mb + 4 * q + i) * 128 + col] = S[mb][i];
    }
    WG_BAR();
#undef SEQ_LOAD
#undef SEQ_STORE
#undef SEQ_ITER
}
__device__ __forceinline__ void seq_dispatch(const Ptrs& c, LAS unsigned char* lds, int item, int tid, int wave, int lane) {
    int row0, nch, ntok, h8, colbase, ncw; const float* S0; float* Sout; const bf16_t* kdt0; int kst; size_t kcs, dcs; const float* dch0;
    if (item < 128) {
        const int bh = item >> 1, b = bh >> 3; h8 = bh & 7; const int hh = h8 & 3; row0 = b * 2048; nch = 64; ntok = 32; S0 = nullptr; colbase = (item & 1) * 64; ncw = 4;
        Sout = h8 < 4 ? c.out + OUT_SAP + (size_t)(b * 4 + hh) * 64 * 128 : c.out + OUT_SBP + (size_t)(b * 4 + hh) * 128 * 128;
        kdt0 = c.P + (size_t)row0 * PLD + (h8 < 4 ? 256 + hh * 64 : 2048 + hh * 128); kst = PLD; kcs = (size_t)32 * PLD;
        dch0 = c.DCH + (size_t)(b * 64 * 8 + h8) * 128; dcs = 8 * 128;
    } else {
        const int j = item - 128, b = j >> 3; h8 = j & 7; const int hh = h8 & 3; row0 = MP + b * 8; nch = 1; ntok = 8; colbase = 0; ncw = 8;
        S0 = h8 < 4 ? c.in[2] + (size_t)(b * 4 + hh) * 64 * 128 : c.in[3] + (size_t)(b * 4 + hh) * 128 * 128;
        Sout = h8 < 4 ? c.out + OUT_SAS + (size_t)(b * 4 + hh) * 64 * 128 : c.out + OUT_SBS + (size_t)(b * 4 + hh) * 128 * 128;
        kdt0 = c.KDTS + (size_t)j * 4096; kst = h8 < 4 ? 64 : 128; kcs = 0; dch0 = c.DCH + (size_t)(4096 + j) * 128; dcs = 0;
    }
    if (h8 < 4) seq_item<64>(c, lds, row0, nch, ntok, h8, colbase, ncw, S0, Sout, kdt0, kst, kcs, dch0, dcs, tid, wave, lane);
    else seq_item<128>(c, lds, row0, nch, ntok, h8, colbase, ncw, S0, Sout, kdt0, kst, kcs, dch0, dcs, tid, wave, lane);
}
__device__ __forceinline__ void p3b_finalize(const Ptrs& c, int G, int wave, int lane) {
    const int gw = blockIdx.x * NWAVES + wave, NGW = G * NWAVES, h8 = lane >> 3, cw = (lane & 7) * 16;
    const float* gp = (h8 < 4 ? c.in[9] : c.in[10]) + cw;
    f32x4 gn[4];
#pragma unroll
    for (int j = 0; j < 4; ++j) gn[j] = *(const f32x4*)(gp + 4 * j);
    const int gcol = (h8 < 4 ? 1024 + h8 * 128 : 3072 + (h8 - 4) * 128) + cw;
    u32x4 nx[2], ng[2], noi[2];
    { const int m0 = gw < M ? gw : M - 1;
#pragma unroll
      for (int j = 0; j < 2; ++j) { noi[j] = *(const u32x4*)(c.OI + (size_t)m0 * 1024 + lane * 16 + 8 * j); nx[j] = *(const u32x4*)(c.OX + (size_t)m0 * 1024 + lane * 16 + 8 * j); ng[j] = *(const u32x4*)(c.P + (size_t)m0 * PLD + gcol + 8 * j); } }
    for (int m = gw; m < M; m += NGW) {
        f32x4 o[4]; u32x4 x[2], g[2], oi[2];
#pragma unroll
        for (int j = 0; j < 2; ++j) { oi[j] = noi[j]; x[j] = nx[j]; g[j] = ng[j]; }
        { const int mn = m + NGW < M ? m + NGW : m;
#pragma unroll
          for (int j = 0; j < 2; ++j) { noi[j] = *(const u32x4*)(c.OI + (size_t)mn * 1024 + lane * 16 + 8 * j); nx[j] = *(const u32x4*)(c.OX + (size_t)mn * 1024 + lane * 16 + 8 * j); ng[j] = *(const u32x4*)(c.P + (size_t)mn * PLD + gcol + 8 * j); } }
        o[0][0] = bf_lo(oi[0].x); o[0][1] = bf_hi(oi[0].x); o[0][2] = bf_lo(oi[0].y); o[0][3] = bf_hi(oi[0].y); o[1][0] = bf_lo(oi[0].z); o[1][1] = bf_hi(oi[0].z); o[1][2] = bf_lo(oi[0].w); o[1][3] = bf_hi(oi[0].w);
        o[2][0] = bf_lo(oi[1].x); o[2][1] = bf_hi(oi[1].x); o[2][2] = bf_lo(oi[1].y); o[2][3] = bf_hi(oi[1].y); o[3][0] = bf_lo(oi[1].z); o[3][1] = bf_hi(oi[1].z); o[3][2] = bf_lo(oi[1].w); o[3][3] = bf_hi(oi[1].w);
        float ss = 0.f;
#pragma unroll
        for (int j = 0; j < 4; ++j) {
            const unsigned w0 = j < 2 ? (j == 0 ? x[0].x : x[0].z) : (j == 2 ? x[1].x : x[1].z), w1 = j < 2 ? (j == 0 ? x[0].y : x[0].w) : (j == 2 ? x[1].y : x[1].w);
            o[j][0] += bf_lo(w0); o[j][1] += bf_hi(w0); o[j][2] += bf_lo(w1); o[j][3] += bf_hi(w1);
            ss += (o[j][0] * o[j][0] + o[j][1] * o[j][1]) + (o[j][2] * o[j][2] + o[j][3] * o[j][3]);
        }
        ss += dpp_f<0xB1, 0xF>(ss); ss += dpp_f<0x4E, 0xF>(ss); ss += dpp_f<0x141, 0xF>(ss);
        const float rs = __builtin_amdgcn_rsqf(ss * (1.0f / 128.0f) + EPS);
        u32x4 w[2];
#pragma unroll
        for (int j = 0; j < 4; ++j) {
            const unsigned g0 = j < 2 ? (j == 0 ? g[0].x : g[0].z) : (j == 2 ? g[1].x : g[1].z), g1 = j < 2 ? (j == 0 ? g[0].y : g[0].w) : (j == 2 ? g[1].y : g[1].w);
            float gg[4] = {bf_lo(g0), bf_hi(g0), bf_lo(g1), bf_hi(g1)}, v[4];
#pragma unroll
            for (int e = 0; e < 4; ++e) v[e] = o[j][e] * rs * gn[j][e] * (gg[e] * __builtin_amdgcn_rcpf(1.0f + __expf(-gg[e])));
            const unsigned p0 = pk_bf16(v[0], v[1]), p1 = pk_bf16(v[2], v[3]);
            if (j == 0) { w[0].x = p0; w[0].y = p1; } else if (j == 1) { w[0].z = p0; w[0].w = p1; } else if (j == 2) { w[1].x = p0; w[1].y = p1; } else { w[1].z = p0; w[1].w = p1; }
        }
        *(u32x4*)(c.OF + (size_t)m * 1024 + lane * 16) = w[0]; *(u32x4*)(c.OF + (size_t)m * 1024 + lane * 16 + 8) = w[1];
    }
}
#define XB_TMO      128
#define XB_XCNT(j)  (256  + 64 * (j))
#define XB_XSUB(j)  (1280 + 64 * (j))
#define XB_XGEN(j)  (2304 + 64 * (j))
#define XB_TOP      3328
#define XB_TOPGEN   3392
#define XCD_BAR_WORDS 3456
#define XB_SPIN_CAP (1u << 18)

__device__ __forceinline__ unsigned xb_ld(unsigned* p)              { return __hip_atomic_load(p, __ATOMIC_RELAXED, __HIP_MEMORY_SCOPE_AGENT); }
__device__ __forceinline__ unsigned xb_add(unsigned* p, unsigned v) { return __hip_atomic_fetch_add(p, v, __ATOMIC_RELAXED, __HIP_MEMORY_SCOPE_AGENT); }
__device__ __forceinline__ unsigned xb_xcc_id() { return (unsigned)__builtin_amdgcn_s_getreg((3 << 11) | 20) & 0xFu; }
#define XB_SPIN(cond, bar) do { unsigned _sp = 0; while (cond) { __builtin_amdgcn_s_sleep(1); \
    if ((++_sp & 255u) == 0u) { if (xb_ld(&(bar)[XB_TMO])) break; if (_sp > XB_SPIN_CAP) { atomicAdd(&(bar)[XB_TMO], 1u); break; } } } } while (0)

struct XcdBarrier {
    unsigned* bar; unsigned x;
    volatile LAS unsigned* st;
};

__device__ __forceinline__ XcdBarrier xcd_barrier_post(unsigned* bar, volatile LAS unsigned* st) {
    XcdBarrier b; b.bar = bar; b.x = xb_xcc_id(); b.st = st;
    if (threadIdx.x == 0) (void)xb_add(&bar[XB_XCNT(b.x)], 1u);
    return b;
}
__device__ __forceinline__ void xcd_barrier_complete(unsigned* bar, unsigned x, unsigned& nloc, unsigned& nx) {
    const unsigned G = gridDim.x * gridDim.y * gridDim.z;
    unsigned sum, cnt, mine, sp = 0u;
    for (;;) {
        sum = 0u; cnt = 0u; mine = 0u;
#pragma unroll
        for (unsigned j = 0; j < 16; ++j) { const unsigned c = xb_ld(&bar[XB_XCNT(j)]); sum += c; cnt += (c > 0u) ? 1u : 0u; mine = (j == x) ? c : mine; }
        if (sum == G) break;
        __builtin_amdgcn_s_sleep(1);
        if ((++sp & 255u) == 0u) { if (xb_ld(&bar[XB_TMO])) break; if (sp > XB_SPIN_CAP) { atomicAdd(&bar[XB_TMO], 1u); break; } }
    }
    nloc = mine > 0u ? mine : 1u; nx = cnt > 0u ? cnt : 1u;
}

__device__ __forceinline__ void xcd_barrier(const XcdBarrier& b) {
    asm volatile("s_waitcnt vmcnt(0)" ::: "memory");
    __syncthreads();
    if (threadIdx.x == 0) {
        unsigned* bar = b.bar;
        __builtin_amdgcn_s_waitcnt(0);
        unsigned nloc = b.st[0], nx = b.st[1];
        if (nloc == 0u) { xcd_barrier_complete(bar, b.x, nloc, nx); b.st[0] = nloc; b.st[1] = nx; }
        const unsigned old = xb_add(&bar[XB_XSUB(b.x)], 1u);
        const unsigned gen = old / nloc;
        if (old + 1u == (gen + 1u) * nloc) {
            __builtin_amdgcn_fence(__ATOMIC_RELEASE, "agent");
            asm volatile("s_waitcnt vmcnt(0)" ::: "memory");
            const unsigned og = xb_add(&bar[XB_TOP], 1u);
            const unsigned tg = og / nx;
            if (og + 1u == (tg + 1u) * nx) xb_add(&bar[XB_TOPGEN], 1u);
            else XB_SPIN(xb_ld(&bar[XB_TOPGEN]) == tg, bar);
            __builtin_amdgcn_fence(__ATOMIC_ACQUIRE, "agent");
            xb_add(&bar[XB_XGEN(b.x)], 1u);
            asm volatile("s_waitcnt vmcnt(0)" ::: "memory");
        } else {
            XB_SPIN(xb_ld(&bar[XB_XGEN(b.x)]) == gen, bar);
            __builtin_amdgcn_fence(__ATOMIC_ACQUIRE, "agent");
            asm volatile("s_waitcnt vmcnt(0)" ::: "memory");
        }
    }
    __syncthreads();
}


struct EpiRes2Norm {
    static constexpr bool PERM = true, AFTER_DRAIN = true;
    float* Y; const bf16_t* X1B; float* SSQ; const float* gfin; XcdBarrier xb;
    __device__ __forceinline__ void fused(pg8::f32x4 (&acc)[2][2][4][2], const pg8::Unit& u, int wr, int wc, int fr, int fq, LAS unsigned char* lds, int wid, int lane) const {
        using pg8::BM; using pg8::HALF;
        const int row0 = u.pm * BM + wr * 64 + fr, ct = u.pn * BM + wc * 32 + 8 * fq;
#pragma unroll
        for (int ai = 0; ai < 2; ++ai)
#pragma unroll
            for (int m = 0; m < 4; ++m) {
                const int row = row0 + ai * HALF + m * 16; float ss = 0.f;
#pragma unroll
                for (int bj = 0; bj < 2; ++bj) {
                    const int col = ct + bj * HALF;
                    { const u32x4 xr = *(const u32x4*)(X1B + (size_t)row * 1024 + col);
                      acc[ai][bj][m][0] += (f32x4){bf_lo(xr.x), bf_hi(xr.x), bf_lo(xr.y), bf_hi(xr.y)}; acc[ai][bj][m][1] += (f32x4){bf_lo(xr.z), bf_hi(xr.z), bf_lo(xr.w), bf_hi(xr.w)}; }
                    const f32x4 v0 = acc[ai][bj][m][0], v1 = acc[ai][bj][m][1];
                    ss += (v0[0] * v0[0] + v0[1] * v0[1]) + (v0[2] * v0[2] + v0[3] * v0[3]) + (v1[0] * v1[0] + v1[1] * v1[1]) + (v1[2] * v1[2] + v1[3] * v1[3]);
                }
                ss += __shfl_xor(ss, 16); ss += __shfl_xor(ss, 32);
                if (fq == 0) SSQ[(size_t)row * 16 + u.pn * 4 + wc] = ss;
            }
        xcd_barrier(xb);
#pragma unroll
        for (int ai = 0; ai < 2; ++ai)
#pragma unroll
            for (int m = 0; m < 4; ++m) {
                const int row = row0 + ai * HALF + m * 16; float* yr = Y + (size_t)row * 1024;
                const f32x4* sp = (const f32x4*)(SSQ + (size_t)row * 16);
                const f32x4 s0 = sp[0], s1 = sp[1], s2 = sp[2], s3 = sp[3];
                const float tot = ((s0[0] + s0[1]) + (s0[2] + s0[3])) + ((s1[0] + s1[1]) + (s1[2] + s1[3])) + ((s2[0] + s2[1]) + (s2[2] + s2[3])) + ((s3[0] + s3[1]) + (s3[2] + s3[3]));
                const float rs = __builtin_amdgcn_rsqf(tot * (1.0f / 1024.0f) + EPS);
#pragma unroll
                for (int bj = 0; bj < 2; ++bj) {
                    const int col = ct + bj * HALF;
                    *(f32x4*)(yr + col) = acc[ai][bj][m][0] * rs * *(const f32x4*)(gfin + col); *(f32x4*)(yr + col + 4) = acc[ai][bj][m][1] * rs * *(const f32x4*)(gfin + col + 4);
                }
            }
    }
};

struct Args { const float* in[17]; float* out; unsigned char* ws; int ph_lo, ph_hi, aux, pad; };
constexpr int NPHASE = 9;
__device__ __forceinline__ void fill_ptrs(Ptrs& c, const Args& args) {
#pragma unroll
    for (int i = 0; i < 17; ++i) c.in[i] = args.in[i];
    c.out = args.out;
    unsigned char* ws = args.ws;
    c.WinT = (bf16_t*)(ws + WS_WIN); c.WoT = (bf16_t*)(ws + WS_WO); c.W13T = (bf16_t*)(ws + WS_W13); c.W2T = (bf16_t*)(ws + WS_W2);
    c.XB = (bf16_t*)(ws + WS_XB); c.OF = (bf16_t*)(ws + WS_XB); c.P = (bf16_t*)(ws + WS_P); c.HID = (bf16_t*)(ws + WS_P); c.KDTS = (bf16_t*)(ws + WS_KDTS);
    c.X1B = (bf16_t*)(ws + WS_FB); c.FB = (float*)(ws + WS_FB);
    c.RSTD1 = (float*)(ws + WS_RSTD1); c.SSQ2 = (float*)(ws + WS_SSQ2); c.LRA = (float*)(ws + WS_LRA); c.DCH = (float*)(ws + WS_DCH); c.OY = args.out + OUT_Y; c.DUMP = (bf16_t*)(ws + 30 * MiB); c.OX = (bf16_t*)(ws + WS_FB); c.OI = (bf16_t*)(ws + WS_XB); c.PART = (float*)(ws + 208 * MiB); c.PART4 = (float*)(ws + WS_P); c.SSQ3 = (float*)(ws + 30 * MiB + 65536);
}

__global__ void __launch_bounds__(NTHR, 2) hymba_fwd(Args args) {
    extern __shared__ __attribute__((aligned(16))) unsigned char lds_raw[];
    LAS unsigned char* lds = (LAS unsigned char*)lds_raw;
    const int tid = threadIdx.x, lane = tid & 63, wave = __builtin_amdgcn_readfirstlane(tid >> 6), G = gridDim.x;
    unsigned char* ws = args.ws;
    const int lo = args.ph_lo, hi = args.ph_hi;
    volatile LAS unsigned* xst = (volatile LAS unsigned*)(lds + 160256);
    if (tid == 0) { xst[0] = 0u; xst[1] = 0u; }
    __syncthreads();
    XcdBarrier xbar; xbar.bar = (unsigned*)(ws + WS_BAR); xbar.x = 0; xbar.st = xst;
    if (hi - lo > 1) xbar = xcd_barrier_post((unsigned*)(ws + WS_BAR), xst);
#define IN(k) (lo <= (k) && (k) < hi)
#define SEAM(k) do { if (IN(k) && IN((k) + 1)) { if (args.pad != 0) cg::this_grid().sync(); else xcd_barrier(xbar); } } while (0)
    if (IN(0)) { Ptrs c; fill_ptrs(c, args); p0_prologue(c, lds, G, wave, lane, G != 256); }
    SEAM(0);
    if (IN(1)) { Ptrs c; fill_ptrs(c, args);
        pg8::Gemm g{c.XB, c.WinT, M, NIN, D}; pg8::StaticOrder S; S.init(M, NIN, G, (int)blockIdx.x, D);
        pg8::EpiIn E{c.P, c.FB, c.LRA, c.RSTD1};
        pg8::gemm_phase<pg8::EpiIn, pg8::StaticOrder, true, true>(lds, g, S, E);
    }
    SEAM(1);
    if (IN(2)) { Ptrs c; fill_ptrs(c, args); p2_prepass(c, lds, G, tid, wave, lane, args.aux != 0); }
    SEAM(2);
    if (IN(3)) { Ptrs c; fill_ptrs(c, args);
        const int wg = blockIdx.x;
        if (G >= 256) {
            if (wg < 128) seq_dispatch(c, lds, wg, tid, wave, lane);
            else { for (int j = wg - 128; j < 1024; j += G - 128) seq_dispatch(c, lds, 128 + j, tid, wave, lane);
                   weight_items(c, (LAS float*)(lds + wave * 16384), 1, (wg - 128) * NWAVES + wave, (G - 128) * NWAVES, lane); }
        }
        else for (int it = wg; it < 128 + 1024; it += G) seq_dispatch(c, lds, it, tid, wave, lane);
    }
    SEAM(3);
    if (IN(4)) { Ptrs c; fill_ptrs(c, args); p3b_finalize(c, G, wave, lane); }
    SEAM(4);
    if (IN(5)) { Ptrs c; fill_ptrs(c, args);
        pg8::Gemm g{c.OF, c.WoT, M, D, D};
        { pg8::StaticOrder S; S.init(MP, D, G, (int)blockIdx.x, D); pg8::EpiRes1 E{c.in[0], c.in[1], c.OY, c.X1B, c.SSQ2};
          pg8::gemm_phase<pg8::EpiRes1, pg8::StaticOrder, true, true>(lds, g, S, E); }
        { pg8::TailOrder S{G, (int)blockIdx.x, 8, D / 64, MP / 256, 4, 16}; pg8::EpiPart E{c.PART4, MP, 1.f};
          pg8::gemm_phase<pg8::EpiPart, pg8::TailOrder, true, true>(lds, g, S, E); }
        if (hi - lo > 1) xcd_barrier(xbar);
        {
            const int gw = blockIdx.x * NWAVES + wave, NGW = G * NWAVES;
            for (int r = gw; r < MS; r += NGW) {
                const int m = MP + r; f32x4 v[4]; float ss = 0.f;
#pragma unroll
                for (int j = 0; j < 4; ++j) v[j] = *(const f32x4*)(c.in[1] + (size_t)r * D + 4 * lane + 256 * j);
#pragma unroll 1
                for (int ks = 0; ks < 8; ++ks)
#pragma unroll
                    for (int j = 0; j < 4; ++j) v[j] += *(const f32x4*)(c.PART4 + ((size_t)ks * 1024 + r) * 1024 + 4 * lane + 256 * j);
#pragma unroll
                for (int j = 0; j < 4; ++j) {
                    *(f32x4*)(c.OY + (size_t)m * D + 4 * lane + 256 * j) = v[j];
                    u32x2 w; w.x = pk_bf16(v[j][0], v[j][1]); w.y = pk_bf16(v[j][2], v[j][3]); *(u32x2*)(c.X1B + (size_t)m * D + 4 * lane + 256 * j) = w;
                    ss += (v[j][0] * v[j][0] + v[j][1] * v[j][1]) + (v[j][2] * v[j][2] + v[j][3] * v[j][3]);
                }
                ss = wave_sum(ss);
                if (lane == 0) c.RSTD1[m] = __builtin_amdgcn_rsqf(ss * (1.0f / D) + EPS);
            }
            for (int r4 = gw; r4 < MP / 4; r4 += NGW) {
                const int m = 4 * r4 + (lane >> 4); float ss = c.SSQ2[(size_t)m * 16 + (lane & 15)];
                ss = row16_sum(ss);
                if ((lane & 15) == 0) c.RSTD1[m] = __builtin_amdgcn_rsqf(ss * (1.0f / D) + EPS);
            }
        }
    }
    SEAM(5);
    if (IN(6)) { Ptrs c; fill_ptrs(c, args);
        pg8::Gemm g{c.X1B, c.W13T, M, NUP, D}; pg8::StaticOrder S; S.init(M, NUP, G, (int)blockIdx.x, D);
        pg8::EpiSwiglu E{c.HID, c.RSTD1};
        pg8::gemm_phase<pg8::EpiSwiglu, pg8::StaticOrder, true, true>(lds, g, S, E);
    }
    SEAM(6);
    if (IN(7)) { Ptrs c; fill_ptrs(c, args);
        pg8::Gemm g{c.HID, c.W2T, M, D, FF};
        if (G == 256 && hi - lo > 1) {
            pg8::StaticOrder S; S.init(MP, D, G, (int)blockIdx.x, FF); EpiRes2Norm E{c.OY, c.X1B, c.SSQ3, c.in[16], xbar};
            pg8::gemm_phase<EpiRes2Norm, pg8::StaticOrder, true, true>(lds, g, S, E);
        } else {
            pg8::StaticOrder S; S.init(MP, D, G, (int)blockIdx.x, FF); pg8::EpiRes2 E{c.OY, args.aux ? 0.f : 1.f, c.X1B};
            pg8::gemm_phase<pg8::EpiRes2, pg8::StaticOrder, true, true>(lds, g, S, E);
        }
        { pg8::TailOrder S{G, (int)blockIdx.x, 11, FF / 64, MP / 256, 4, 16}; pg8::EpiPart E{c.PART, MP, args.aux ? 0.f : 1.f};
          pg8::gemm_phase<pg8::EpiPart, pg8::TailOrder, true, true>(lds, g, S, E); }
    }
    SEAM(7);
    if (IN(8)) { Ptrs c; fill_ptrs(c, args);
        const int NGW = G * NWAVES, gw = blockIdx.x * NWAVES + wave + ((G == 256 && hi - lo > 1) ? MP : 0);
        f32x4 gn[4];
#pragma unroll
        for (int j = 0; j < 4; ++j) gn[j] = *(const f32x4*)(c.in[16] + 4 * lane + 256 * j);
        f32x4 v[4], nv[4];
        { const int m0 = gw < M ? gw : M - 1;
#pragma unroll
          for (int j = 0; j < 4; ++j) v[j] = *(const f32x4*)(c.OY + (size_t)m0 * D + 4 * lane + 256 * j); }
#define ADD_PARTS(vv, mm) do { if ((mm) >= MP) { _Pragma("unroll 1") for (int ks = 0; ks < 11; ++ks) { _Pragma("unroll") for (int j = 0; j < 4; ++j) \
            vv[j] += *(const f32x4*)(c.PART + ((size_t)ks * 1024 + ((mm) - MP)) * 1024 + 4 * lane + 256 * j); } } } while (0)
        { const int m0 = gw < M ? gw : M - 1; ADD_PARTS(v, m0); }
        for (int m = gw; m < M; m += NGW) {
            float* yr = c.OY + (size_t)m * D; float s = 0.f;
            { const int mn = m + NGW < M ? m + NGW : m;
#pragma unroll
              for (int j = 0; j < 4; ++j) nv[j] = *(const f32x4*)(c.OY + (size_t)mn * D + 4 * lane + 256 * j);
              ADD_PARTS(nv, mn); }
#pragma unroll
            for (int j = 0; j < 4; ++j) s += (v[j][0] * v[j][0] + v[j][1] * v[j][1]) + (v[j][2] * v[j][2] + v[j][3] * v[j][3]);
            const float rs = __builtin_amdgcn_rsqf(wave_sum(s) * (1.0f / D) + EPS);
#pragma unroll
            for (int j = 0; j < 4; ++j) *(f32x4*)(yr + 4 * lane + 256 * j) = args.aux ? v[j] : v[j] * rs * gn[j];
#pragma unroll
            for (int j = 0; j < 4; ++j) v[j] = nv[j];
        }
    }
#undef IN
#undef SEAM
}

extern "C" void kernel_launch(void* const* d_in, const int* in_sizes, int n_in, void* d_out, int out_size, void* d_ws, size_t ws_size, hipStream_t stream) {
    static int grid = 0;
    if (grid == 0) {
        if (n_in != 17 || ws_size < WS_END) { fprintf(stderr, "kernel_launch: unexpected n_in %d / ws %zu\n", n_in, ws_size); grid = -1; return; }
        int dev = 0, cus = 0, per_cu = 0;
        (void)hipGetDevice(&dev); (void)hipDeviceGetAttribute(&cus, hipDeviceAttributeMultiprocessorCount, dev);
        if (hipFuncSetAttribute((const void*)hymba_fwd, hipFuncAttributeMaxDynamicSharedMemorySize, LDS_BYTES) != hipSuccess) { fprintf(stderr, "kernel_launch: hipFuncSetAttribute failed\n"); grid = -1; return; }
        if (hipOccupancyMaxActiveBlocksPerMultiprocessor(&per_cu, (const void*)hymba_fwd, NTHR, LDS_BYTES) != hipSuccess || per_cu < 1) { fprintf(stderr, "kernel_launch: occupancy query says %d\n", per_cu); per_cu = 1; }
        (void)hipGetLastError();
        grid = cus * per_cu;
        if (grid <= 0) grid = 256;
    }
    if (grid < 0) return;
    if (hipMemsetAsync((char*)d_ws + WS_BAR, 0, 16384, stream) != hipSuccess) { fprintf(stderr, "kernel_launch: memset failed\n"); return; }
    Args a{};
    for (int i = 0; i < 17; ++i) a.in[i] = (const float*)d_in[i];
    a.out = (float*)d_out; a.ws = (unsigned char*)d_ws;
    if (MK_N_LAUNCHES == 1) {
        a.ph_lo = 0; a.ph_hi = NPHASE;
        void* kargs[] = {&a};
        hipError_t e = hipLaunchCooperativeKernel((const void*)hymba_fwd, dim3(grid), dim3(NTHR), kargs, LDS_BYTES, stream);
        if (e != hipSuccess) fprintf(stderr, "kernel_launch: cooperative launch failed: %s (grid %d)\n", hipGetErrorString(e), grid);
    } else {
        for (int p = 0; p < NPHASE; ++p) { a.ph_lo = p; a.ph_hi = p + 1; const int nrep = ((REP_MASK >> p) & 1) ? 3 : 1;
            for (int rr = 0; rr < nrep; ++rr) { a.aux = ((p == 2 || p == 7 || p == 8) && rr + 1 < nrep) ? 1 : 0; hipLaunchKernelGGL(hymba_fwd, dim3(grid), dim3(NTHR), LDS_BYTES, stream, a); } }
    }
}
```

```cpp
#include <hip/hip_runtime.h>
#include <hip/hip_cooperative_groups.h>
#include <cstdio>
#include <cstdint>
namespace cg = cooperative_groups;
namespace pg8 {
#define PG8_LAS __attribute__((address_space(3)))
typedef unsigned short bf16_t;
typedef short bf16x8 __attribute__((ext_vector_type(8)));
typedef float f32x4 __attribute__((ext_vector_type(4)));
typedef unsigned u32x4 __attribute__((ext_vector_type(4)));
constexpr int BM = 256, BK = 64, HALF = 128, HTB = HALF * BK * 2  , STAGE_BYTES = 8 * HTB, NXCD = 8, WGM = 8;

__host__ __device__ __forceinline__ int lds_byte(int r, int c) { const int st = (r >> 4) * 2 + (c >> 5), rr = r & 15, cc = c & 31, ob = rr * 64 + cc * 2; return st * 1024 + (ob ^ (((ob >> 9) & 1) << 5)); }
__host__ __device__ __forceinline__ void stage_rc(int b, int& R, int& C) { const int st = b / 1024, sb = b % 1024, swz = sb ^ (((sb >> 9) & 1) << 5); R = (st >> 1) * 16 + swz / 64; C = (st & 1) * 32 + (swz % 64) / 2; }
__host__ __device__ __forceinline__ int perm32(int rho) { const int n = rho >> 4, i = rho & 15; return 8 * (i >> 2) + 4 * n + (i & 3); }

struct Unit { int pm, pn, k0, nk; };
struct Gemm { const bf16_t* A; const bf16_t* Bt; int M, N, K; };

struct StaticOrder {
    int nM, nN, nwg, G, c, nkt;
    __host__ __device__ void init(int M, int N, int G_, int c_, int K_) { nM = M / BM; nN = N / BM; nwg = nM * nN; G = G_; c = c_; nkt = K_ / BK; }
    __host__ __device__ bool next(int i, Unit& u) const { return at((long)i * G + c, u); }
    __host__ __device__ bool at(long L, Unit& u) const {
        if (L >= nwg) return false;
        int wgid = (int)L; { const int q = nwg / NXCD, r = nwg % NXCD, xcd = wgid % NXCD, off = wgid / NXCD; wgid = (xcd < r ? xcd * (q + 1) : r * (q + 1) + (xcd - r) * q) + off; }
        const int nig = WGM * nN, gid = wgid / nig, fm = gid * WGM, gsz = (nM - fm) < WGM ? (nM - fm) : WGM;
        u.pm = fm + ((wgid % nig) % gsz); u.pn = (wgid % nig) / gsz; u.k0 = 0; u.nk = nkt; return true;
    }
    __device__ __forceinline__ void a_ready(const Unit&) const {}
    __device__ __forceinline__ void done(const Unit&) const {}
};


struct TailOrder {
    int G, c, NS, nkt, pm0, nN, ntu;
    __host__ __device__ bool next(int i, Unit& u) const {
        const int id = i * G + c; if (id >= ntu * NS) return false;
        const int tu = id / NS, ks = id % NS; u.pm = pm0 + tu / nN; u.pn = tu % nN; u.nk = nkt / NS; u.k0 = ks * u.nk; return true;
    }
    __device__ __forceinline__ void a_ready(const Unit&) const {}
    __device__ __forceinline__ void done(const Unit&) const {}
};

__device__ __forceinline__ unsigned cvt_pk_bf16(float lo, float hi) { unsigned r; asm volatile("v_cvt_pk_bf16_f32 %0, %1, %2" : "=v"(r) : "v"(lo), "v"(hi)); return r; }
typedef float f32x2 __attribute__((ext_vector_type(2)));

template <class Epi, class Sched, bool ALIGN_EPI = false, bool SP2 = false>
__device__ __forceinline__ void gemm_phase(PG8_LAS unsigned char* lds, const Gemm g, const Sched& S, const Epi& E) {
    const int tid = threadIdx.x, wid = __builtin_amdgcn_readfirstlane(tid >> 6), lane = tid & 63, wr = wid >> 2, wc = wid & 3, fr = lane & 15, fq = lane >> 4;
    const int K = g.K, nt = K / BK;
    unsigned voffA[2], voffB[2];
#pragma unroll
    for (int i = 0; i < 2; ++i) { int R, C; stage_rc(tid * 16 + i * 8192, R, C); const int Rb = Epi::PERM ? ((R & ~31) + perm32(R & 31)) : R;
        voffA[i] = (unsigned)(R * K + C) * 2u; voffB[i] = (unsigned)(Rb * K + C) * 2u; }
    const size_t kstep = (size_t)(BK * 2);
    const size_t hstep = (size_t)HALF * K * 2;
    const size_t tstep = 2 * hstep;
    const unsigned ldsw = (unsigned)wid * 1024u;
    const int aoff = lds_byte(wr * 64 + fr, fq * 8), boff = lds_byte(wc * 32 + fr, fq * 8);
#define PG8_SA(b, h) (((b) * 2 + (h)) * HTB)
#define PG8_SB(b, h) ((4 + (b) * 2 + (h)) * HTB)
#define PG8_STAGE(bufoff, gbase, voff) do { _Pragma("unroll") for (int _i = 0; _i < 2; ++_i) \
        __builtin_amdgcn_global_load_lds((const unsigned*)((const char*)(gbase) + (voff)[_i]), (PG8_LAS unsigned*)(lds + (bufoff) + ldsw + _i * 8192), 16, 0, 0); } while (0)
#define PG8_LDA(dst, b, h) do { _Pragma("unroll") for (int m = 0; m < 4; ++m) _Pragma("unroll") for (int k = 0; k < 2; ++k) dst[m][k] = *(const PG8_LAS bf16x8*)(lds + PG8_SA(b, h) + aoff + m * 2048 + k * 1024); } while (0)
#define PG8_LDB(dst, b, h) do { _Pragma("unroll") for (int n = 0; n < 2; ++n) _Pragma("unroll") for (int k = 0; k < 2; ++k) dst[n][k] = *(const PG8_LAS bf16x8*)(lds + PG8_SB(b, h) + boff + n * 2048 + k * 1024); } while (0)
#define PG8_MMA(ai, bj, At, Bt) do { __builtin_amdgcn_s_setprio(1); _Pragma("unroll") for (int m = 0; m < 4; ++m) _Pragma("unroll") for (int n = 0; n < 2; ++n) _Pragma("unroll") for (int k = 0; k < 2; ++k) \
        acc[ai][bj][m][n] = __builtin_amdgcn_mfma_f32_16x16x32_bf16(Bt[n][k], At[m][k], acc[ai][bj][m][n], 0, 0, 0); __builtin_amdgcn_s_setprio(0); } while (0)
#define PG8_WAIT_V(n) asm volatile("s_waitcnt vmcnt(" #n ")" ::: "memory")
#define PG8_WAIT_L(n) asm volatile("s_waitcnt lgkmcnt(" #n ")" ::: "memory")
#define PG8_BAR __builtin_amdgcn_s_barrier()
#define PG8_SCHED __builtin_amdgcn_sched_barrier(0)
    Unit cur, nxt; int ui = 0;
    if (!S.next(0, cur)) return;
    f32x4 acc[2][2][4][2];
#pragma unroll
    for (int a = 0; a < 2; ++a)
#pragma unroll
        for (int b = 0; b < 2; ++b)
#pragma unroll
            for (int m = 0; m < 4; ++m)
#pragma unroll
                for (int n = 0; n < 2; ++n) acc[a][b][m][n] = (f32x4){0.f, 0.f, 0.f, 0.f};
    bf16x8 At[4][2], B0[2][2], B1[2][2];
    const char* cA = (const char*)g.A + (size_t)cur.pm * tstep + (size_t)cur.k0 * kstep; const char* cB = (const char*)g.Bt + (size_t)cur.pn * tstep + (size_t)cur.k0 * kstep;
    S.a_ready(cur);
    if constexpr (SP2) {
        PG8_STAGE(PG8_SB(0, 0), cB, voffB); PG8_STAGE(PG8_SB(0, 1), cB + hstep, voffB); PG8_STAGE(PG8_SA(0, 0), cA, voffA); PG8_STAGE(PG8_SA(0, 1), cA + hstep, voffA);
        if (wr == 1) PG8_BAR;
        PG8_WAIT_V(2); PG8_BAR;
        PG8_STAGE(PG8_SB(1, 0), cB + kstep, voffB); PG8_STAGE(PG8_SA(1, 0), cA + kstep, voffA); PG8_STAGE(PG8_SB(1, 1), cB + hstep + kstep, voffB);
        PG8_WAIT_V(6); PG8_BAR;
    } else {
        PG8_STAGE(PG8_SB(0, 0), cB, voffB); PG8_STAGE(PG8_SA(0, 0), cA, voffA); PG8_STAGE(PG8_SB(0, 1), cB + hstep, voffB); PG8_STAGE(PG8_SA(0, 1), cA + hstep, voffA);
        if (wr == 1) PG8_BAR;
        PG8_WAIT_V(4); PG8_BAR;
        PG8_STAGE(PG8_SB(1, 0), cB + kstep, voffB); PG8_STAGE(PG8_SA(1, 0), cA + kstep, voffA); PG8_STAGE(PG8_SB(1, 1), cB + hstep + kstep, voffB);
        PG8_WAIT_V(6); PG8_BAR;
    }
    for (;;) {
        const bool has_next = S.next(ui + 1, nxt);
        const char* nA = has_next ? (const char*)g.A + (size_t)nxt.pm * tstep + (size_t)nxt.k0 * kstep : cA; const char* nB = has_next ? (const char*)g.Bt + (size_t)nxt.pn * tstep + (size_t)nxt.k0 * kstep : cB;
        const int ntc = cur.nk;
        for (int t = 0; t < ntc; t += 2) {
            const bool last = (t == ntc - 2);
            const char* a1 = cA + (size_t)(t + 1) * kstep;
            const char* a2 = last ? nA : cA + (size_t)(t + 2) * kstep; const char* b2 = last ? nB : cB + (size_t)(t + 2) * kstep;
            const char* a3 = a2 + kstep; const char* b3 = b2 + kstep;
            if (last && has_next) S.a_ready(nxt);
            if constexpr (SP2) {
            PG8_LDB(B0, 0, 0); PG8_LDB(B1, 0, 1); PG8_SCHED; PG8_LDA(At, 0, 0); PG8_STAGE(PG8_SA(1, 1), a1 + hstep, voffA);
            PG8_WAIT_V(8); PG8_WAIT_L(0); PG8_BAR; PG8_MMA(0, 0, At, B0); PG8_MMA(0, 1, At, B1); PG8_BAR; PG8_SCHED;
            PG8_LDA(At, 0, 1); PG8_STAGE(PG8_SB(0, 0), b2, voffB); PG8_STAGE(PG8_SB(0, 1), b2 + hstep, voffB); PG8_STAGE(PG8_SA(0, 0), a2, voffA);
            PG8_WAIT_V(8); PG8_WAIT_L(0); PG8_BAR; PG8_MMA(1, 0, At, B0); PG8_MMA(1, 1, At, B1); PG8_BAR; PG8_SCHED;
            PG8_LDB(B0, 1, 0); PG8_LDB(B1, 1, 1); PG8_SCHED; PG8_LDA(At, 1, 0); PG8_STAGE(PG8_SA(0, 1), a2 + hstep, voffA);
            PG8_WAIT_V(8); PG8_WAIT_L(0); PG8_BAR; PG8_MMA(0, 0, At, B0); PG8_MMA(0, 1, At, B1); PG8_BAR; PG8_SCHED;
            PG8_LDA(At, 1, 1); PG8_STAGE(PG8_SB(1, 0), b3, voffB); PG8_STAGE(PG8_SB(1, 1), b3 + hstep, voffB); PG8_STAGE(PG8_SA(1, 0), a3, voffA);
            PG8_WAIT_V(8); PG8_WAIT_L(0); PG8_BAR; PG8_MMA(1, 0, At, B0); PG8_MMA(1, 1, At, B1); PG8_BAR; PG8_SCHED;
            } else {
            PG8_LDB(B0, 0, 0); PG8_SCHED; PG8_LDA(At, 0, 0); PG8_STAGE(PG8_SA(1, 1), a1 + hstep, voffA);
            PG8_WAIT_L(8); PG8_BAR; PG8_WAIT_L(0); PG8_MMA(0, 0, At, B0); PG8_BAR; PG8_SCHED;
            PG8_LDB(B1, 0, 1); PG8_STAGE(PG8_SB(0, 0), b2, voffB);
            PG8_BAR; PG8_WAIT_L(0); PG8_MMA(0, 1, At, B1); PG8_BAR;
            PG8_LDA(At, 0, 1); PG8_STAGE(PG8_SA(0, 0), a2, voffA);
            PG8_BAR; PG8_WAIT_L(0); PG8_MMA(1, 0, At, B0); PG8_BAR; PG8_SCHED;
            PG8_STAGE(PG8_SB(0, 1), b2 + hstep, voffB);
            PG8_WAIT_V(6); PG8_BAR; PG8_MMA(1, 1, At, B1); PG8_BAR;
            PG8_LDB(B0, 1, 0); PG8_SCHED; PG8_LDA(At, 1, 0); PG8_STAGE(PG8_SA(0, 1), a2 + hstep, voffA);
            PG8_WAIT_L(8); PG8_BAR; PG8_WAIT_L(0); PG8_MMA(0, 0, At, B0); PG8_BAR; PG8_SCHED;
            PG8_LDB(B1, 1, 1); PG8_STAGE(PG8_SB(1, 0), b3, voffB);
            PG8_BAR; PG8_WAIT_L(0); PG8_MMA(0, 1, At, B1); PG8_BAR;
            PG8_LDA(At, 1, 1); PG8_STAGE(PG8_SA(1, 0), a3, voffA);
            PG8_BAR; PG8_WAIT_L(0); PG8_MMA(1, 0, At, B0); PG8_BAR; PG8_SCHED;
            PG8_STAGE(PG8_SB(1, 1), b3 + hstep, voffB);
            PG8_WAIT_V(6); PG8_BAR; PG8_MMA(1, 1, At, B1); PG8_BAR;
            }
        }
        if constexpr (ALIGN_EPI) { if (wr == 0) PG8_BAR; }
        if constexpr (!Epi::AFTER_DRAIN) { E(acc, cur, wr, wc, fr, fq); S.done(cur); }
        if (!has_next) break;
#pragma unroll
        for (int a = 0; a < 2; ++a)
#pragma unroll
            for (int b = 0; b < 2; ++b)
#pragma unroll
                for (int m = 0; m < 4; ++m)
#pragma unroll
                    for (int n = 0; n < 2; ++n) acc[a][b][m][n] = (f32x4){0.f, 0.f, 0.f, 0.f};
        cur = nxt; cA = nA; cB = nB; ++ui;
        if constexpr (ALIGN_EPI) { if (wr == 1) PG8_BAR; }
    }
    PG8_WAIT_V(0);
    if constexpr (!ALIGN_EPI) { if (wr == 0) PG8_BAR; }
    PG8_BAR;
    if constexpr (Epi::AFTER_DRAIN) { E.fused(acc, cur, wr, wc, fr, fq, lds, wid, lane); S.done(cur); }
#undef PG8_SA
#undef PG8_SB
#undef PG8_STAGE
#undef PG8_LDA
#undef PG8_LDB
#undef PG8_MMA
#undef PG8_WAIT_V
#undef PG8_WAIT_L
#undef PG8_BAR
#undef PG8_SCHED
}
}

#ifndef MK_N_LAUNCHES
#define MK_N_LAUNCHES 1
#endif
#ifndef REP_MASK
#define REP_MASK 0
#endif
#define LAS __attribute__((address_space(3)))
using pg8::bf16_t; using pg8::bf16x8; using pg8::f32x4; using pg8::u32x4;
typedef float f32x16 __attribute__((ext_vector_type(16)));
typedef __bf16 bf16x2_t __attribute__((ext_vector_type(2)));
typedef float f32x2_t __attribute__((ext_vector_type(2)));
typedef unsigned u32x2 __attribute__((ext_vector_type(2)));

constexpr int NWAVES = 8, NTHR = 512;
constexpr int D = 1024, MP = 16384, MS = 1024, M = MP + MS, NIN = 3840, PLD = 3584, FF = 2816, NUP = 2 * FF;
constexpr float EPS = 1e-6f;
constexpr size_t MiB = 1u << 20;
constexpr size_t WS_BAR = 26 * MiB + 768 * 1024, WS_WIN = 0, WS_WO = 8 * MiB, WS_W13 = 10 * MiB, WS_W2 = 21 * MiB, WS_RSTD1 = 27 * MiB, WS_SSQ2 = 28 * MiB, WS_LRA = 32 * MiB, WS_DCH = 34 * MiB,
                 WS_KDTS = 37 * MiB, WS_XB = 45 * MiB, WS_FB = 79 * MiB, WS_P = 113 * MiB, WS_END = 233 * MiB;
static_assert(WS_P + (size_t)(M + 32) * PLD * 2 <= WS_END && WS_XB + (size_t)M * D * 2 <= WS_FB && WS_FB + (size_t)M * 512 * 4 <= WS_P, "ws map");
constexpr size_t OUT_Y = 0, OUT_SAP = 17825792, OUT_SBP = 18087936, OUT_SAS = 18612224, OUT_SBS = 22806528;
constexpr int LDS_BYTES = 160768;

__device__ __forceinline__ unsigned pk_bf16(float lo, float hi) { f32x2_t v = {lo, hi}; bf16x2_t b = __builtin_convertvector(v, bf16x2_t); return __builtin_bit_cast(unsigned, b); }
__device__ __forceinline__ float bf_lo(unsigned u) { return __uint_as_float(u << 16); }
__device__ __forceinline__ float bf_hi(unsigned u) { return __uint_as_float(u & 0xffff0000u); }
__device__ __forceinline__ float bf_f(unsigned short u) { return __uint_as_float(((unsigned)u) << 16); }


template <int CTRL, int ROWMASK> __device__ __forceinline__ float dpp_f(float v) { return __builtin_bit_cast(float, __builtin_amdgcn_update_dpp(0, __builtin_bit_cast(int, v), CTRL, ROWMASK, 0xF, true)); }
__device__ __forceinline__ float row16_sum(float v) { v += dpp_f<0xB1, 0xF>(v); v += dpp_f<0x4E, 0xF>(v); v += dpp_f<0x141, 0xF>(v); v += dpp_f<0x140, 0xF>(v); return v; }
__device__ __forceinline__ float scan32(float a) {
    a += dpp_f<0x111, 0xF>(a); a += dpp_f<0x112, 0xF>(a); a += dpp_f<0x114, 0xF>(a); a += dpp_f<0x118, 0xF>(a); a += dpp_f<0x142, 0xA>(a); return a; }
template <int CTRL, int ROWMASK> __device__ __forceinline__ float dpp_f1(float v) { return __builtin_bit_cast(float, __builtin_amdgcn_update_dpp(0x3f800000, __builtin_bit_cast(int, v), CTRL, ROWMASK, 0xF, false)); }
__device__ __forceinline__ float scanmul32(float a) {
    a *= dpp_f1<0x111, 0xF>(a); a *= dpp_f1<0x112, 0xF>(a); a *= dpp_f1<0x114, 0xF>(a); a *= dpp_f1<0x118, 0xF>(a); a *= dpp_f1<0x142, 0xA>(a); return a; }
__device__ __forceinline__ float lane_bcast(float v, int l);
__device__ __forceinline__ float wave_sum(float v) { v = row16_sum(v); return (lane_bcast(v, 0) + lane_bcast(v, 16)) + (lane_bcast(v, 32) + lane_bcast(v, 48)); }
__device__ __forceinline__ float lane_bcast(float v, int l) { return __builtin_bit_cast(float, __builtin_amdgcn_readlane(__builtin_bit_cast(int, v), l)); }
#define LDS_WAIT() asm volatile("s_waitcnt lgkmcnt(0)" ::: "memory")
#define WG_BAR() do { asm volatile("s_waitcnt lgkmcnt(0)" ::: "memory"); __builtin_amdgcn_s_barrier(); asm volatile("" ::: "memory"); } while (0)
#define MFMA32(a, b, c) __builtin_amdgcn_mfma_f32_32x32x16_bf16((a), (b), (c), 0, 0, 0)
#define MFMA16(a, b, c) __builtin_amdgcn_mfma_f32_16x16x32_bf16((a), (b), (c), 0, 0, 0)

struct Ptrs {
    const float* in[17]; float* out;
    bf16_t *WinT, *WoT, *W13T, *W2T, *XB, *P, *KDTS, *OF, *X1B, *HID;
    float *RSTD1, *SSQ2, *LRA, *DCH, *FB, *OY; bf16_t *DUMP, *OX, *OI; float *PART, *PART4, *SSQ3;
};

namespace pg8 {
struct EpiIn {
    static constexpr bool PERM = true, AFTER_DRAIN = false;
    bf16_t* P; float* FB; float* LRA; const float* rstd;
    __device__ __forceinline__ void operator()(const f32x4 (&acc)[2][2][4][2], const Unit& u, int wr, int wc, int fr, int fq) const {
        const int row0 = u.pm * BM + wr * 64 + fr, ct = wc * 32 + 8 * fq;
#pragma unroll
        for (int ai = 0; ai < 2; ++ai)
#pragma unroll
            for (int m = 0; m < 4; ++m) {
                const int row = row0 + ai * HALF + m * 16; const float rs = 1.0f;
#pragma unroll
                for (int bj = 0; bj < 2; ++bj) {
                    const f32x4 v0 = acc[ai][bj][m][0] * rs, v1 = acc[ai][bj][m][1] * rs; const int cl = bj * HALF + ct;
                    if (u.pn == 8 || u.pn == 9) { float* o = FB + (size_t)row * 512 + (u.pn - 8) * BM + cl; *(f32x4*)o = v0; *(f32x4*)(o + 4) = v1; }
                    else if (u.pn == 14) { if (cl < 16) { float* o = LRA + (size_t)row * 16 + cl; *(f32x4*)o = v0; *(f32x4*)(o + 4) = v1; } }
                    else { u32x4 w; w.x = cvt_pk_bf16(v0[0], v0[1]); w.y = cvt_pk_bf16(v0[2], v0[3]); w.z = cvt_pk_bf16(v1[0], v1[1]); w.w = cvt_pk_bf16(v1[2], v1[3]);
                           *(u32x4*)(P + (size_t)row * 3584 + u.pn * BM + cl) = w; }
                }
            }
    }
};
struct EpiRes1 {
    static constexpr bool PERM = true, AFTER_DRAIN = false;
    const float* xp; const float* xs; float* Y; bf16_t* X1B; float* SSQ;
    __device__ __forceinline__ void operator()(const f32x4 (&acc)[2][2][4][2], const Unit& u, int wr, int wc, int fr, int fq) const {
        const int row0 = u.pm * BM + wr * 64 + fr, ct = u.pn * BM + wc * 32 + 8 * fq;
#pragma unroll
        for (int ai = 0; ai < 2; ++ai) {
            f32x4 xv[4][2][2];
#pragma unroll
            for (int m = 0; m < 4; ++m) {
                const int row = row0 + ai * HALF + m * 16;
                const float* xr = row < 16384 ? xp + (size_t)row * 1024 : xs + (size_t)(row - 16384) * 1024;
#pragma unroll
                for (int bj = 0; bj < 2; ++bj) { xv[m][bj][0] = *(const f32x4*)(xr + ct + bj * HALF); xv[m][bj][1] = *(const f32x4*)(xr + ct + bj * HALF + 4); }
            }
            asm volatile("" ::: "memory");
#pragma unroll
            for (int m = 0; m < 4; ++m) {
                const int row = row0 + ai * HALF + m * 16; float ss = 0.f;
#pragma unroll
                for (int bj = 0; bj < 2; ++bj) {
                    const int col = ct + bj * HALF;
                    const f32x4 v0 = acc[ai][bj][m][0] + xv[m][bj][0], v1 = acc[ai][bj][m][1] + xv[m][bj][1];
                    u32x4 w; w.x = cvt_pk_bf16(v0[0], v0[1]); w.y = cvt_pk_bf16(v0[2], v0[3]); w.z = cvt_pk_bf16(v1[0], v1[1]); w.w = cvt_pk_bf16(v1[2], v1[3]);
                    *(u32x4*)(X1B + (size_t)row * 1024 + col) = w;
                    ss += (v0[0] * v0[0] + v0[1] * v0[1]) + (v0[2] * v0[2] + v0[3] * v0[3]) + (v1[0] * v1[0] + v1[1] * v1[1]) + (v1[2] * v1[2] + v1[3] * v1[3]);
                }
                ss += __shfl_xor(ss, 16); ss += __shfl_xor(ss, 32);
                if (fq == 0) SSQ[(size_t)row * 16 + u.pn * 4 + wc] = ss;
            }
        }
    }
};
struct EpiSwiglu {
    static constexpr bool PERM = true, AFTER_DRAIN = false;
    bf16_t* H; const float* SSQ;
    __device__ __forceinline__ void operator()(const f32x4 (&acc)[2][2][4][2], const Unit& u, int wr, int wc, int fr, int fq) const {
        const int row0 = u.pm * BM + wr * 64 + fr, hc = u.pn * 128 + wc * 32 + fq * 8;
#pragma unroll
        for (int ai = 0; ai < 2; ++ai)
#pragma unroll
            for (int m = 0; m < 4; ++m) {
                const int row = row0 + ai * HALF + m * 16;
                const float rs = SSQ[row];
                float h[8];
#pragma unroll
                for (int n = 0; n < 2; ++n) {
                    const f32x4 a = acc[ai][0][m][n] * rs, b = acc[ai][1][m][n] * rs;
#pragma unroll
                    for (int e = 0; e < 4; ++e) h[4 * n + e] = a[e] * __builtin_amdgcn_rcpf(1.0f + __expf(-a[e])) * b[e];
                }
                u32x4 w; w.x = cvt_pk_bf16(h[0], h[1]); w.y = cvt_pk_bf16(h[2], h[3]); w.z = cvt_pk_bf16(h[4], h[5]); w.w = cvt_pk_bf16(h[6], h[7]);
                *(u32x4*)(H + (size_t)row * 2816 + hc) = w;
            }
    }
};
struct EpiRes2 {
    static constexpr bool PERM = true, AFTER_DRAIN = false;
    float* Y; float sc; const bf16_t* X1B;
    __device__ __forceinline__ void operator()(const f32x4 (&acc)[2][2][4][2], const Unit& u, int wr, int wc, int fr, int fq) const {
        const int row0 = u.pm * BM + wr * 64 + fr, ct = u.pn * BM + wc * 32 + 8 * fq;
#pragma unroll
        for (int ai = 0; ai < 2; ++ai)
#pragma unroll
            for (int m = 0; m < 4; ++m) {
                float* yr = Y + (size_t)(row0 + ai * HALF + m * 16) * 1024;
#pragma unroll
                for (int bj = 0; bj < 2; ++bj) {
                    const int col = ct + bj * HALF;
                    const pg8::u32x4 xr = *(const pg8::u32x4*)(X1B + (size_t)(row0 + ai * HALF + m * 16) * 1024 + col);
                    const f32x4 v0 = acc[ai][bj][m][0] * sc + (f32x4){__uint_as_float(xr.x << 16), __uint_as_float(xr.x & 0xffff0000u), __uint_as_float(xr.y << 16), __uint_as_float(xr.y & 0xffff0000u)};
                    const f32x4 v1 = acc[ai][bj][m][1] * sc + (f32x4){__uint_as_float(xr.z << 16), __uint_as_float(xr.z & 0xffff0000u), __uint_as_float(xr.w << 16), __uint_as_float(xr.w & 0xffff0000u)};
                    *(f32x4*)(yr + col) = v0; *(f32x4*)(yr + col + 4) = v1;
                }
            }
    }
};
struct EpiPart {
    static constexpr bool PERM = true, AFTER_DRAIN = false;
    float* PART; int rowbase; float sc;
    __device__ __forceinline__ void operator()(const f32x4 (&acc)[2][2][4][2], const Unit& u, int wr, int wc, int fr, int fq) const {
        const int row0 = u.pm * BM + wr * 64 + fr - rowbase, ct = u.pn * BM + wc * 32 + 8 * fq;
        float* base = PART + (size_t)(u.k0 / u.nk) * 1024 * 1024;
#pragma unroll
        for (int ai = 0; ai < 2; ++ai)
#pragma unroll
            for (int m = 0; m < 4; ++m) {
                float* yr = base + (size_t)(row0 + ai * HALF + m * 16) * 1024;
#pragma unroll
                for (int bj = 0; bj < 2; ++bj) { const int col = ct + bj * HALF; *(f32x4*)(yr + col) = acc[ai][bj][m][0] * sc; *(f32x4*)(yr + col + 4) = acc[ai][bj][m][1] * sc; }
            }
    }
};
}

__device__ __forceinline__ void tr_item(const float* colp, int ldw, const float* gain, int k0, int dcol, bf16_t* WT, int K, int nrow0, LAS float* scr, int lane) {
    float tv[32];
#pragma unroll
    for (int i = 0; i < 32; ++i) { const int kk = 2 * i + (lane >> 5); tv[i] = colp ? colp[(size_t)(k0 + kk) * ldw] : 0.f; }
    if (gain) {
        float gv[32];
#pragma unroll
        for (int i = 0; i < 32; ++i) gv[i] = gain[k0 + 2 * i + (lane >> 5)];
#pragma unroll
        for (int i = 0; i < 32; ++i) tv[i] *= gv[i];
    }
#pragma unroll
    for (int i = 0; i < 32; ++i) scr[(2 * i + (lane >> 5)) * 33 + dcol] = tv[i];
    LDS_WAIT();
    const int c = lane & 7;
#pragma unroll
    for (int j = 0; j < 4; ++j) {
        const int n = (lane >> 3) + 8 * j; const LAS float* s = scr + (8 * c) * 33 + n;
        u32x4 o; o.x = pk_bf16(s[0 * 33], s[1 * 33]); o.y = pk_bf16(s[2 * 33], s[3 * 33]); o.z = pk_bf16(s[4 * 33], s[5 * 33]); o.w = pk_bf16(s[6 * 33], s[7 * 33]);
        *(u32x4*)(WT + (size_t)(nrow0 + n) * K + k0 + 8 * c) = o;
    }
    LDS_WAIT();
}
__device__ __forceinline__ void weight_items(const Ptrs& c, LAS float* scr, int part, int gw, int NGW, int lane) {
    const int l31 = lane & 31;
    constexpr int I_IN = 16 * 120, I_O = 16 * 32, I_13 = 16 * 176, I_2 = 44 * 32;
    if (part == 0) {
        for (int r = gw; r < I_IN; r += NGW) { const int kb = r / 120, nb = r % 120, n = nb * 32 + l31;
            const int oc = n < 1536 ? n : (n < 3584 ? n + 16 : (n < 3600 ? n - 3584 + 1536 : -1));
            tr_item(oc >= 0 ? c.in[5] + oc : nullptr, 3600, c.in[4], kb * 64, l31, c.WinT, 1024, nb * 32, scr, lane); }
        return;
    }
    for (int it = gw; it < I_O + I_13 + I_2; it += NGW) {
        int r = it;
        if (r < I_O) { const int kb = r / 32, nb = r % 32; tr_item(c.in[11] + nb * 32 + l31, 1024, nullptr, kb * 64, l31, c.WoT, 1024, nb * 32, scr, lane); continue; }
        r -= I_O;
        if (r < I_13) { const int kb = r / 176, nb = r % 176, t = nb >> 3, wb = nb & 7; const bool is3 = wb >= 4; const int hcol = 128 * t + 32 * (wb & 3) + l31;
            tr_item((is3 ? c.in[14] : c.in[13]) + hcol, 2816, c.in[12], kb * 64, l31, c.W13T, 1024, nb * 32, scr, lane); continue; }
        r -= I_13;
        { const int kb = r / 32, nb = r % 32; tr_item(c.in[15] + nb * 32 + l31, 1024, nullptr, kb * 64, l31, c.W2T, 2816, nb * 32, scr, lane); }
    }
}
__device__ __forceinline__ void p0_prologue(const Ptrs& c, LAS unsigned char* lds, int G, int wave, int lane, bool all_weights) {
    LAS float* scr = (LAS float*)(lds + wave * 16384);
    const int gw = blockIdx.x * NWAVES + wave, NGW = G * NWAVES;
    weight_items(c, scr, 0, gw, NGW, lane);
    if (all_weights) weight_items(c, scr, 1, gw, NGW, lane);
    {
        f32x4 v[4], nv[4];
        { const int m0 = gw < M ? gw : M - 1; const float* xr = m0 < MP ? c.in[0] + (size_t)m0 * D : c.in[1] + (size_t)(m0 - MP) * D;
#pragma unroll
          for (int j = 0; j < 4; ++j) v[j] = *(const f32x4*)(xr + 4 * lane + 256 * j); }
        for (int m = gw; m < M; m += NGW) {
            { const int mn = m + NGW < M ? m + NGW : m; const float* xr = mn < MP ? c.in[0] + (size_t)mn * D : c.in[1] + (size_t)(mn - MP) * D;
#pragma unroll
              for (int j = 0; j < 4; ++j) nv[j] = *(const f32x4*)(xr + 4 * lane + 256 * j); }
            float s = 0.f;
#pragma unroll
            for (int j = 0; j < 4; ++j) s += (v[j][0] * v[j][0] + v[j][1] * v[j][1]) + (v[j][2] * v[j][2] + v[j][3] * v[j][3]);
            s = wave_sum(s);
            const float rs = __builtin_amdgcn_rsqf(s * (1.0f / D) + EPS);
#pragma unroll
            for (int j = 0; j < 4; ++j) { u32x2 w; w.x = pk_bf16(v[j][0] * rs, v[j][1] * rs); w.y = pk_bf16(v[j][2] * rs, v[j][3] * rs); *(u32x2*)(c.XB + (size_t)m * D + 4 * lane + 256 * j) = w; }
#pragma unroll
            for (int j = 0; j < 4; ++j) v[j] = nv[j];
        }
    }
}

__device__ __forceinline__ int crow(int i, int h) { return (i & 3) + 8 * (i >> 2) + 4 * h; }
template <int K, bool GLA, bool ALLV>
__device__ __forceinline__ void pre_item(const Ptrs& c, int row0, int ntok, int hh, int item, bf16_t* kdt_base, int kdt_stride,
                                         const LAS float* wa2_l, const LAS float* ba_l, const LAS float* lb_l, LAS unsigned char* vt, int lane, bool dry) {
    const int r = lane & 31, kg = lane >> 5;
    const bool valid = ALLV || r < ntok;
    const int row = row0 + (valid ? r : 0), nt1 = ntok - 1;
    constexpr int NJ = K / 16;
    const int qcol0 = GLA ? hh * 64 : 1536 + hh * 128, kcol0 = 256 + hh * 64, vcol0 = GLA ? 512 + hh * 128 : 2560 + hh * 128, ocol0 = (GLA ? hh : 4 + hh) * 128;
    bf16_t* Prow = c.P + (size_t)row * PLD;
    LAS unsigned char* kt = vt + 8192;
    LAS unsigned char* dl = vt + 16384;
    float lra[16];
    if constexpr (GLA) {
#pragma unroll
        for (int i = 0; i < 4; ++i) { const f32x4 t = *(const f32x4*)(c.LRA + (size_t)row * 16 + 4 * i); lra[4 * i] = t[0]; lra[4 * i + 1] = t[1]; lra[4 * i + 2] = t[2]; lra[4 * i + 3] = t[3]; }
    }
    const bf16_t* qptr = Prow + qcol0 + 8 * kg;
    const bf16_t* kptr = Prow + kcol0 + 8 * kg;
    const float* fptr = c.FB + (size_t)row * 512 + hh * 128 + 8 * kg;
    u32x4 qn = *(const u32x4*)qptr, kn = {0u, 0u, 0u, 0u}; f32x4 fn0 = {0.f, 0.f, 0.f, 0.f}, fn1 = fn0;
    if constexpr (GLA) kn = *(const u32x4*)kptr; else { fn0 = *(const f32x4*)fptr; fn1 = *(const f32x4*)(fptr + 4); }
    f32x16 att;
#pragma unroll
    for (int i = 0; i < 16; ++i) att[i] = 0.f;
    float* dch = c.DCH + (size_t)item * 128;
#pragma unroll 1
    for (int j = 0; j < NJ; ++j) {
        const int cl = 16 * j + 8 * kg;
        const u32x4 qr = qn, kr = kn; const f32x4 f0 = fn0, f1 = fn1;
        { const int jn = j + 1 < NJ ? j + 1 : j;
          qn = *(const u32x4*)(qptr + 16 * jn);
          if constexpr (GLA) kn = *(const u32x4*)(kptr + 16 * jn); else { fn0 = *(const f32x4*)(fptr + 16 * jn); fn1 = *(const f32x4*)(fptr + 16 * jn + 4); } }
        float la[8], kv[8], qv[8];
        if constexpr (GLA) {
            const LAS float* wl = wa2_l + hh * 64 + cl;
            f32x4 a0 = *(const LAS f32x4*)(ba_l + hh * 64 + cl), a1 = *(const LAS f32x4*)(ba_l + hh * 64 + cl + 4);
#pragma unroll
            for (int rb = 0; rb < 16; rb += 4) {
                f32x4 w[8];
#pragma unroll
                for (int rr = 0; rr < 4; ++rr) { w[2 * rr] = *(const LAS f32x4*)(wl + (rb + rr) * 256); w[2 * rr + 1] = *(const LAS f32x4*)(wl + (rb + rr) * 256 + 4); }
#pragma unroll
                for (int rr = 0; rr < 4; ++rr) { a0 += w[2 * rr] * lra[rb + rr]; a1 += w[2 * rr + 1] * lra[rb + rr]; }
            }
            float x[8], t[8];
#pragma unroll
            for (int e = 0; e < 8; ++e) x[e] = e < 4 ? a0[e & 3] : a1[e & 3];
#pragma unroll
            for (int e = 0; e < 8; ++e) t[e] = __expf(-fabsf(x[e]));
#pragma unroll
            for (int e = 0; e < 8; ++e) t[e] = __logf(1.0f + t[e]);
#pragma unroll
            for (int e = 0; e < 8; ++e) la[e] = (fminf(x[e], 0.f) - t[e]) * 0.0625f;
            kv[0] = bf_lo(kr.x); kv[1] = bf_hi(kr.x); kv[2] = bf_lo(kr.y); kv[3] = bf_hi(kr.y); kv[4] = bf_lo(kr.z); kv[5] = bf_hi(kr.z); kv[6] = bf_lo(kr.w); kv[7] = bf_hi(kr.w);
        } else {
            const f32x4 l0 = *(const LAS f32x4*)(lb_l + hh * 128 + cl), l1 = *(const LAS f32x4*)(lb_l + hh * 128 + cl + 4);
            float x[8], lbv[8], ex[8], inv[8];
#pragma unroll
            for (int e = 0; e < 8; ++e) { x[e] = e < 4 ? f0[e & 3] : f1[e & 3]; lbv[e] = e < 4 ? l0[e & 3] : l1[e & 3]; }
#pragma unroll
            for (int e = 0; e < 8; ++e) ex[e] = __expf(-fabsf(x[e]));
#pragma unroll
            for (int e = 0; e < 8; ++e) inv[e] = __builtin_amdgcn_rcpf(1.0f + ex[e]);
#pragma unroll
            for (int e = 0; e < 8; ++e) { const float ei = ex[e] * inv[e]; const float sg = x[e] >= 0.f ? inv[e] : ei, ng = x[e] >= 0.f ? ei : inv[e];
                la[e] = lbv[e] + (1.0f - lbv[e]) * sg; kv[e] = (1.0f - lbv[e]) * ng; }
        }
        qv[0] = bf_lo(qr.x); qv[1] = bf_hi(qr.x); qv[2] = bf_lo(qr.y); qv[3] = bf_hi(qr.y); qv[4] = bf_lo(qr.z); qv[5] = bf_hi(qr.z); qv[6] = bf_lo(qr.w); qv[7] = bf_hi(qr.w);
        float qi[8], ki[8], kd[8], eb[8], q[8], ea[8], ia[8];
        if constexpr (GLA) {
#pragma unroll
            for (int e = 0; e < 8; ++e) q[e] = qv[e] * 0.125f;
        } else {
#pragma unroll
            for (int e = 0; e < 8; ++e) q[e] = __expf(-qv[e]);
#pragma unroll
            for (int e = 0; e < 8; ++e) q[e] = __builtin_amdgcn_rcpf(1.0f + q[e]);
#pragma unroll
            for (int e = 0; e < 8; ++e) q[e] *= qv[e];
        }
        if (!ALLV) {
#pragma unroll
            for (int e = 0; e < 8; ++e) if (!valid) { q[e] = 0.f; kv[e] = 0.f; la[e] = GLA ? 0.f : 1.f; }
        }
        if constexpr (GLA) {
#pragma unroll
            for (int e = 0; e < 8; ++e) la[e] += dpp_f<0x111, 0xF>(la[e]);
#pragma unroll
            for (int e = 0; e < 8; ++e) la[e] += dpp_f<0x112, 0xF>(la[e]);
#pragma unroll
            for (int e = 0; e < 8; ++e) la[e] += dpp_f<0x114, 0xF>(la[e]);
#pragma unroll
            for (int e = 0; e < 8; ++e) la[e] += dpp_f<0x118, 0xF>(la[e]);
#pragma unroll
            for (int e = 0; e < 8; ++e) la[e] += dpp_f<0x142, 0xA>(la[e]);
#pragma unroll
            for (int e = 0; e < 8; ++e) ea[e] = __expf(fmaxf(la[e], -80.f));
        } else {
#pragma unroll
            for (int e = 0; e < 8; ++e) la[e] *= dpp_f1<0x111, 0xF>(la[e]);
#pragma unroll
            for (int e = 0; e < 8; ++e) la[e] *= dpp_f1<0x112, 0xF>(la[e]);
#pragma unroll
            for (int e = 0; e < 8; ++e) la[e] *= dpp_f1<0x114, 0xF>(la[e]);
#pragma unroll
            for (int e = 0; e < 8; ++e) la[e] *= dpp_f1<0x118, 0xF>(la[e]);
#pragma unroll
            for (int e = 0; e < 8; ++e) la[e] *= dpp_f1<0x142, 0xA>(la[e]);
#pragma unroll
            for (int e = 0; e < 8; ++e) ea[e] = fmaxf(la[e], 1e-35f);
        }
#pragma unroll
        for (int e = 0; e < 8; ++e) ia[e] = __builtin_amdgcn_rcpf(ea[e]);
#pragma unroll
        for (int e = 0; e < 8; ++e) { const float e31 = lane_bcast(ea[e], 31), e63 = lane_bcast(ea[e], 63); eb[e] = kg ? e63 : e31; }
#pragma unroll
        for (int e = 0; e < 8; ++e) { qi[e] = q[e] * ea[e]; ki[e] = kv[e] * ia[e]; kd[e] = ki[e] * eb[e]; }
        u32x4 qp, kp;
        qp.x = pk_bf16(qi[0], qi[1]); qp.y = pk_bf16(qi[2], qi[3]); qp.z = pk_bf16(qi[4], qi[5]); qp.w = pk_bf16(qi[6], qi[7]);
        kp.x = pk_bf16(ki[0], ki[1]); kp.y = pk_bf16(ki[2], ki[3]); kp.z = pk_bf16(ki[4], ki[5]); kp.w = pk_bf16(ki[6], ki[7]);
        att = MFMA32(__builtin_bit_cast(bf16x8, kp), __builtin_bit_cast(bf16x8, qp), att);
        *(LAS u32x4*)(vt + r * (K * 2) + ((((cl >> 3) ^ r) & (K / 8 - 1)) << 4)) = qp;
#pragma unroll
        for (int e = 0; e < 8; e += 2) {
            const unsigned pkd = pk_bf16(kd[e], kd[e + 1]);
            *(LAS unsigned short*)(kt + (cl + e) * 64 + r * 2) = (unsigned short)(pkd & 0xffffu);
            *(LAS unsigned short*)(kt + (cl + e + 1) * 64 + r * 2) = (unsigned short)(pkd >> 16);
        }
        if (r == 0) { f32x4 d0 = {eb[0], eb[1], eb[2], eb[3]}, d1 = {eb[4], eb[5], eb[6], eb[7]}; *(LAS f32x4*)(dl + cl * 4) = d0; *(LAS f32x4*)(dl + cl * 4 + 16) = d1; }
    }
    u32x4 vreg[8];
#pragma unroll
    for (int i = 0; i < 8; ++i) { const int p = lane + 64 * i, vr = (p >> 4) < nt1 ? (p >> 4) : nt1; vreg[i] = *(const u32x4*)(c.P + (size_t)(row0 + vr) * PLD + vcol0 + (p & 15) * 8); }
#pragma unroll
    for (int i = 0; i < K / 16; ++i) {
        const int p = lane + 64 * i, L = p * 8, qr_ = p / (K / 8), qc_ = p % (K / 8);
        if ((ALLV || qr_ < ntok) && !dry) *(u32x4*)(c.P + (size_t)(row0 + qr_) * PLD + qcol0 + qc_ * 8) = *(const LAS u32x4*)(vt + qr_ * (K * 2) + (((qc_ ^ qr_) & (K / 8 - 1)) << 4));
        *(u32x4*)(kdt_base + (size_t)(L / K) * kdt_stride + (L % K)) = *(const LAS u32x4*)(kt + p * 16);
    }
    if (lane < K / 4) *(f32x4*)(dch + lane * 4) = *(const LAS f32x4*)(dl + lane * 16);
#pragma unroll
    for (int i = 0; i < 8; ++i) { const int p = lane + 64 * i; *(LAS u32x4*)(vt + (p >> 4) * 256 + (p & 15) * 16) = vreg[i]; }
#pragma unroll
    for (int i = 0; i < 16; ++i) if (crow(i, kg) > r) att[i] = 0.f;
    u32x4 pa0, pa1;
    pa0.x = pk_bf16(att[0], att[1]); pa0.y = pk_bf16(att[2], att[3]); pa0.z = pk_bf16(att[4], att[5]); pa0.w = pk_bf16(att[6], att[7]);
    pa1.x = pk_bf16(att[8], att[9]); pa1.y = pk_bf16(att[10], att[11]); pa1.z = pk_bf16(att[12], att[13]); pa1.w = pk_bf16(att[14], att[15]);
#pragma unroll 1
    for (int vb = 0; vb < 4; ++vb) {
        unsigned short vs[16];
#pragma unroll
        for (int i = 0; i < 16; ++i) vs[i] = *(const LAS unsigned short*)(vt + crow(i, kg) * 256 + (vb * 32 + r) * 2);
        u32x4 b0, b1;
        b0.x = vs[0] | ((unsigned)vs[1] << 16); b0.y = vs[2] | ((unsigned)vs[3] << 16); b0.z = vs[4] | ((unsigned)vs[5] << 16); b0.w = vs[6] | ((unsigned)vs[7] << 16);
        b1.x = vs[8] | ((unsigned)vs[9] << 16); b1.y = vs[10] | ((unsigned)vs[11] << 16); b1.z = vs[12] | ((unsigned)vs[13] << 16); b1.w = vs[14] | ((unsigned)vs[15] << 16);
        f32x16 o;
#pragma unroll
        for (int i = 0; i < 16; ++i) o[i] = 0.f;
        o = MFMA32(__builtin_bit_cast(bf16x8, pa0), __builtin_bit_cast(bf16x8, b0), o);
        o = MFMA32(__builtin_bit_cast(bf16x8, pa1), __builtin_bit_cast(bf16x8, b1), o);
#pragma unroll
        for (int i = 0; i < 16; ++i) *(LAS unsigned short*)(kt + crow(i, kg) * 256 + (vb * 32 + r) * 2) = (unsigned short)(pk_bf16(o[i], 0.f) & 0xffffu);
    }
#pragma unroll
    for (int i = 0; i < 8; ++i) {
        const int p = lane + 64 * i, t = p >> 4;
        if (t < ntok) *(u32x4*)(c.OI + (size_t)(row0 + t) * 1024 + ocol0 + (p & 15) * 8) = *(const LAS u32x4*)(kt + p * 16);
    }
}
__device__ __forceinline__ void p2_prepass(const Ptrs& c, LAS unsigned char* lds, int G, int tid, int wave, int lane, bool dry) {
    LAS float* wa2_l = (LAS float*)lds; LAS float* ba_l = wa2_l + 4096; LAS float* lb_l = ba_l + 256;
    for (int i = tid; i < 4096; i += NTHR) wa2_l[i] = c.in[6][i];
    if (tid < 256) ba_l[tid] = c.in[7][tid];
    { const float p0 = c.in[8][tid], p1 = c.in[8][512 + tid]; lb_l[tid] = 1.0f / (1.0f + __expf(p1 - p0)); }
    WG_BAR();
    const int gw = blockIdx.x * NWAVES + wave, NGW = G * NWAVES;
    const bool bal = (G == 256);
    const int n_it = bal ? 4096 : 4096 + 1024;
    for (int it0 = gw; ; it0 += NGW) {
        int it = it0;
        if (it0 >= n_it) { if (!bal || wave >= 4 || it0 >= n_it + NGW) break; it = 4096 + blockIdx.x * 4 + wave; }
        int row0, ntok, h; bf16_t* kdt; int kst;
        if (it < 4096) { h = it & 7; const int ch = (it >> 3) & 63, b = it >> 9; row0 = b * 2048 + ch * 32; ntok = 32; kst = PLD;
                         kdt = c.P + (size_t)row0 * PLD + (h < 4 ? 256 + h * 64 : 2048 + (h - 4) * 128); }
        else { const int j = it - 4096; h = j & 7; row0 = MP + (j >> 3) * 8; ntok = 8; kst = h < 4 ? 64 : 128; kdt = c.KDTS + (size_t)j * 4096; }
        if (dry) { kst = h < 4 ? 64 : 128; kdt = (bf16_t*)((unsigned char*)c.DUMP + 203 * MiB) + (size_t)(it & 2047) * 4096; }
        if (it < 4096) { if (h < 4) pre_item<64, true, true>(c, row0, ntok, h, it, kdt, kst, wa2_l, ba_l, lb_l, lds + 20480 + wave * 16896, lane, dry);
                         else pre_item<128, false, true>(c, row0, ntok, h - 4, it, kdt, kst, wa2_l, ba_l, lb_l, lds + 20480 + wave * 16896, lane, dry); }
        else { if (h < 4) pre_item<64, true, false>(c, row0, ntok, h, it, kdt, kst, wa2_l, ba_l, lb_l, lds + 20480 + wave * 16896, lane, dry);
               else pre_item<128, false, false>(c, row0, ntok, h - 4, it, kdt, kst, wa2_l, ba_l, lb_l, lds + 20480 + wave * 16896, lane, dry); }
    }
}

template <int K>
__device__ __forceinline__ void seq_item(const Ptrs& c, LAS unsigned char* lds, int row0, int nch, int ntok, int h8, int colbase, int ncw, const float* S0, float* Sout,
                                         const bf16_t* kdt0, int kdt_rstride, size_t kdt_cstep, const float* dch0, size_t dch_cstep, int tid, int wave, int lane) {
    constexpr int QROW = 2 * K + 16, VROW = 272;
    constexpr int KOFF = 8704, DOFF = 18944, VOFF = 19456, BUFB = 28160, NMB = K / 16, NPC = 4 * K;
    const int n = lane & 15, q = lane >> 4, col = colbase + 16 * (wave < ncw ? wave : 0) + n;
    const bool cw = wave < ncw;
    const bool gla = h8 < 4; const int hh = h8 & 3;
    const int qcol0 = gla ? hh * 64 : 1536 + hh * 128, vcol0 = gla ? 512 + hh * 128 : 2560 + hh * 128, ocol = h8 * 128 + col;
    f32x4 S[NMB];
#pragma unroll
    for (int mb = 0; mb < NMB; ++mb)
#pragma unroll
        for (int i = 0; i < 4; ++i) S[mb][i] = (S0 && cw) ? S0[(size_t)(16 * mb + 4 * q + i) * 128 + col] : 0.f;
    const int nt1 = ntok - 1;
    const int pq = tid % NPC, prow_q = pq / (K / 8), pc8 = pq % (K / 8), prq = prow_q < nt1 ? prow_q : nt1;
    const int vrow = tid >> 4, vc8 = tid & 15, vr = vrow < nt1 ? vrow : nt1;
    const int dpi = tid % (K / 4);
    const bf16_t* gq = c.P + (size_t)(row0 + prq) * PLD + qcol0 + pc8 * 8;
    const bf16_t* gk = kdt0 + (size_t)prow_q * kdt_rstride + pc8 * 8;
    const float* gd = dch0 + dpi * 4;
    const bf16_t* gvp = c.P + (size_t)(row0 + vr) * PLD + vcol0 + vc8 * 8;
    struct Stage { u32x4 q, k, v; f32x4 d; };
    const int nch1 = nch - 1;
#define SEQ_LOAD(R, cc) do { const int c_ = (cc) < nch1 ? (cc) : nch1; const size_t ro_ = (size_t)c_ * 32; \
        R.q = *(const u32x4*)(gq + ro_ * PLD); R.k = *(const u32x4*)(gk + (size_t)c_ * kdt_cstep); R.d = *(const f32x4*)(gd + (size_t)c_ * dch_cstep); \
        R.v = *(const u32x4*)(gvp + ro_ * PLD); } while (0)
#define SEQ_STORE(R, buf) do { LAS unsigned char* B_ = lds + (buf) * BUFB; \
        *(LAS u32x4*)(B_ + prow_q * QROW + pc8 * 16) = R.q; *(LAS u32x4*)(B_ + KOFF + (pq >> 2) * 80 + (pq & 3) * 16) = R.k; *(LAS f32x4*)(B_ + DOFF + dpi * 16) = R.d; \
        *(LAS u32x4*)(B_ + VOFF + vrow * VROW + vc8 * 16) = R.v; } while (0)
#define SEQ_ITER(ci, buf, RST) do { \
        const LAS unsigned char* B = lds + (buf) * BUFB; \
        if (cw) { \
        f32x4 o[2] = {{0.f, 0.f, 0.f, 0.f}, {0.f, 0.f, 0.f, 0.f}}; \
        _Pragma("unroll") for (int js = 0; js < K / 32; ++js) { \
            u32x4 sb; sb.x = pk_bf16(S[2 * js][0], S[2 * js][1]); sb.y = pk_bf16(S[2 * js][2], S[2 * js][3]); sb.z = pk_bf16(S[2 * js + 1][0], S[2 * js + 1][1]); sb.w = pk_bf16(S[2 * js + 1][2], S[2 * js + 1][3]); \
            _Pragma("unroll") for (int mb2 = 0; mb2 < 2; ++mb2) { \
                const LAS unsigned char* qp = B + (16 * mb2 + n) * QROW + (32 * js + 4 * q) * 2; \
                const u32x2 lo = *(const LAS u32x2*)qp, hi = *(const LAS u32x2*)(qp + 32); \
                u32x4 qa; qa.x = lo.x; qa.y = lo.y; qa.z = hi.x; qa.w = hi.y; \
                o[mb2] = MFMA16(__builtin_bit_cast(bf16x8, qa), __builtin_bit_cast(bf16x8, sb), o[mb2]); } } \
        { unsigned short vs[8]; \
            _Pragma("unroll") for (int j = 0; j < 8; ++j) vs[j] = *(const LAS unsigned short*)(B + VOFF + (8 * q + j) * VROW + col * 2); \
            u32x4 vb; vb.x = vs[0] | ((unsigned)vs[1] << 16); vb.y = vs[2] | ((unsigned)vs[3] << 16); vb.z = vs[4] | ((unsigned)vs[5] << 16); vb.w = vs[6] | ((unsigned)vs[7] << 16); \
            _Pragma("unroll") for (int mb = 0; mb < NMB; ++mb) { \
                const u32x4 ka = *(const LAS u32x4*)(B + KOFF + (16 * mb + n) * 80 + q * 16); \
                const f32x4 dv = *(const LAS f32x4*)(B + DOFF + (16 * mb + 4 * q) * 4); \
                S[mb] = S[mb] * dv; \
                S[mb] = MFMA16(__builtin_bit_cast(bf16x8, ka), __builtin_bit_cast(bf16x8, vb), S[mb]); } } \
        bf16_t* ob = c.OX + (size_t)(row0 + 32 * (ci)) * 1024 + ocol; \
        _Pragma("unroll") for (int x = 0; x < 8; x += 2) { \
            const int t = 16 * (x >> 2) + 4 * q + (x & 3); const unsigned pv = pk_bf16(o[x >> 2][x & 3], o[x >> 2][(x & 3) + 1]); \
            bf16_t* d0 = t < ntok ? ob + (size_t)t * 1024 : c.DUMP + tid; bf16_t* d1 = t + 1 < ntok ? ob + (size_t)(t + 1) * 1024 : c.DUMP + tid; \
            *d0 = (bf16_t)(pv & 0xffffu); *d1 = (bf16_t)(pv >> 16); } \
        } \
        WG_BAR(); \
        SEQ_STORE(RST, buf); \
    } while (0)
    Stage R0, R1, R2, R3;
    SEQ_LOAD(R0, 0); SEQ_STORE(R0, 0);
    SEQ_LOAD(R1, 1); SEQ_LOAD(R2, 2); SEQ_LOAD(R3, 3); SEQ_LOAD(R0, 4);
    SEQ_STORE(R1, 1);
    WG_BAR();
    for (int ci = 0; ci < nch; ci += 4) {
        SEQ_LOAD(R1, ci + 5); SEQ_ITER(ci, 0, R2);
        if (ci + 1 >= nch) break;
        SEQ_LOAD(R2, ci + 6); SEQ_ITER(ci + 1, 1, R3);
        if (ci + 2 >= nch) break;
        SEQ_LOAD(R3, ci + 7); SEQ_ITER(ci + 2, 0, R0);
        if (ci + 3 >= nch) break;
        SEQ_LOAD(R0, ci + 8); SEQ_ITER(ci + 3, 1, R1);
    }
    if (cw) {
#pragma unroll
    for (int mb = 0; mb < NMB; ++mb)
#pragma unroll
        for (int i = 0; i < 4; ++i) Sout[(size_t)(16 * mb + 4 * q + i) * 128 + col] = S[mb][i];
    }
    WG_BAR();
#undef SEQ_LOAD
#undef SEQ_STORE
#undef SEQ_ITER
}
__device__ __forceinline__ void seq_dispatch(const Ptrs& c, LAS unsigned char* lds, int item, int tid, int wave, int lane) {
    int row0, nch, ntok, h8, colbase, ncw; const float* S0; float* Sout; const bf16_t* kdt0; int kst; size_t kcs, dcs; const float* dch0;
    if (item < 128) {
        const int bh = item >> 1, b = bh >> 3; h8 = bh & 7; const int hh = h8 & 3; row0 = b * 2048; nch = 64; ntok = 32; S0 = nullptr; colbase = (item & 1) * 64; ncw = 4;
        Sout = h8 < 4 ? c.out + OUT_SAP + (size_t)(b * 4 + hh) * 64 * 128 : c.out + OUT_SBP + (size_t)(b * 4 + hh) * 128 * 128;
        kdt0 = c.P + (size_t)row0 * PLD + (h8 < 4 ? 256 + hh * 64 : 2048 + hh * 128); kst = PLD; kcs = (size_t)32 * PLD;
        dch0 = c.DCH + (size_t)(b * 64 * 8 + h8) * 128; dcs = 8 * 128;
    } else {
        const int j = item - 128, b = j >> 3; h8 = j & 7; const int hh = h8 & 3; row0 = MP + b * 8; nch = 1; ntok = 8; colbase = 0; ncw = 8;
        S0 = h8 < 4 ? c.in[2] + (size_t)(b * 4 + hh) * 64 * 128 : c.in[3] + (size_t)(b * 4 + hh) * 128 * 128;
        Sout = h8 < 4 ? c.out + OUT_SAS + (size_t)(b * 4 + hh) * 64 * 128 : c.out + OUT_SBS + (size_t)(b * 4 + hh) * 128 * 128;
        kdt0 = c.KDTS + (size_t)j * 4096; kst = h8 < 4 ? 64 : 128; kcs = 0; dch0 = c.DCH + (size_t)(4096 + j) * 128; dcs = 0;
    }
    if (h8 < 4) seq_item<64>(c, lds, row0, nch, ntok, h8, colbase, ncw, S0, Sout, kdt0, kst, kcs, dch0, dcs, tid, wave, lane);
    else seq_item<128>(c, lds, row0, nch, ntok, h8, colbase, ncw, S0, Sout, kdt0, kst, kcs, dch0, dcs, tid, wave, lane);
}
__device__ __forceinline__ void p3b_finalize(const Ptrs& c, int G, int wave, int lane) {
    const int gw = blockIdx.x * NWAVES + wave, NGW = G * NWAVES, h8 = lane >> 3, cw = (lane & 7) * 16;
    const float* gp = (h8 < 4 ? c.in[9] : c.in[10]) + cw;
    f32x4 gn[4];
#pragma unroll
    for (int j = 0; j < 4; ++j) gn[j] = *(const f32x4*)(gp + 4 * j);
    const int gcol = (h8 < 4 ? 1024 + h8 * 128 : 3072 + (h8 - 4) * 128) + cw;
    u32x4 nx[2], ng[2], noi[2];
    { const int m0 = gw < M ? gw : M - 1;
#pragma unroll
      for (int j = 0; j < 2; ++j) { noi[j] = *(const u32x4*)(c.OI + (size_t)m0 * 1024 + lane * 16 + 8 * j); nx[j] = *(const u32x4*)(c.OX + (size_t)m0 * 1024 + lane * 16 + 8 * j); ng[j] = *(const u32x4*)(c.P + (size_t)m0 * PLD + gcol + 8 * j); } }
    for (int m = gw; m < M; m += NGW) {
        f32x4 o[4]; u32x4 x[2], g[2], oi[2];
#pragma unroll
        for (int j = 0; j < 2; ++j) { oi[j] = noi[j]; x[j] = nx[j]; g[j] = ng[j]; }
        { const int mn = m + NGW < M ? m + NGW : m;
#pragma unroll
          for (int j = 0; j < 2; ++j) { noi[j] = *(const u32x4*)(c.OI + (size_t)mn * 1024 + lane * 16 + 8 * j); nx[j] = *(const u32x4*)(c.OX + (size_t)mn * 1024 + lane * 16 + 8 * j); ng[j] = *(const u32x4*)(c.P + (size_t)mn * PLD + gcol + 8 * j); } }
        o[0][0] = bf_lo(oi[0].x); o[0][1] = bf_hi(oi[0].x); o[0][2] = bf_lo(oi[0].y); o[0][3] = bf_hi(oi[0].y); o[1][0] = bf_lo(oi[0].z); o[1][1] = bf_hi(oi[0].z); o[1][2] = bf_lo(oi[0].w); o[1][3] = bf_hi(oi[0].w);
        o[2][0] = bf_lo(oi[1].x); o[2][1] = bf_hi(oi[1].x); o[2][2] = bf_lo(oi[1].y); o[2][3] = bf_hi(oi[1].y); o[3][0] = bf_lo(oi[1].z); o[3][1] = bf_hi(oi[1].z); o[3][2] = bf_lo(oi[1].w); o[3][3] = bf_hi(oi[1].w);
        float ss = 0.f;
#pragma unroll
        for (int j = 0; j < 4; ++j) {
            const unsigned w0 = j < 2 ? (j == 0 ? x[0].x : x[0].z) : (j == 2 ? x[1].x : x[1].z), w1 = j < 2 ? (j == 0 ? x[0].y : x[0].w) : (j == 2 ? x[1].y : x[1].w);
            o[j][0] += bf_lo(w0); o[j][1] += bf_hi(w0); o[j][2] += bf_lo(w1); o[j][3] += bf_hi(w1);
            ss += (o[j][0] * o[j][0] + o[j][1] * o[j][1]) + (o[j][2] * o[j][2] + o[j][3] * o[j][3]);
        }
        ss += dpp_f<0xB1, 0xF>(ss); ss += dpp_f<0x4E, 0xF>(ss); ss += dpp_f<0x141, 0xF>(ss);
        const float rs = __builtin_amdgcn_rsqf(ss * (1.0f / 128.0f) + EPS);
        u32x4 w[2];
#pragma unroll
        for (int j = 0; j < 4; ++j) {
            const unsigned g0 = j < 2 ? (j == 0 ? g[0].x : g[0].z) : (j == 2 ? g[1].x : g[1].z), g1 = j < 2 ? (j == 0 ? g[0].y : g[0].w) : (j == 2 ? g[1].y : g[1].w);
            float gg[4] = {bf_lo(g0), bf_hi(g0), bf_lo(g1), bf_hi(g1)}, v[4];
#pragma unroll
            for (int e = 0; e < 4; ++e) v[e] = o[j][e] * rs * gn[j][e] * (gg[e] * __builtin_amdgcn_rcpf(1.0f + __expf(-gg[e])));
            const unsigned p0 = pk_bf16(v[0], v[1]), p1 = pk_bf16(v[2], v[3]);
            if (j == 0) { w[0].x = p0; w[0].y = p1; } else if (j == 1) { w[0].z = p0; w[0].w = p1; } else if (j == 2) { w[1].x = p0; w[1].y = p1; } else { w[1].z = p0; w[1].w = p1; }
        }
        *(u32x4*)(c.OF + (size_t)m * 1024 + lane * 16) = w[0]; *(u32x4*)(c.OF + (size_t)m * 1024 + lane * 16 + 8) = w[1];
    }
}
#define XB_TMO      128
#define XB_XCNT(j)  (256  + 64 * (j))
#define XB_XSUB(j)  (1280 + 64 * (j))
#define XB_XGEN(j)  (2304 + 64 * (j))
#define XB_TOP      3328
#define XB_TOPGEN   3392
#define XCD_BAR_WORDS 3456
#define XB_SPIN_CAP (1u << 18)

__device__ __forceinline__ unsigned xb_ld(unsigned* p)              { return __hip_atomic_load(p, __ATOMIC_RELAXED, __HIP_MEMORY_SCOPE_AGENT); }
__device__ __forceinline__ unsigned xb_add(unsigned* p, unsigned v) { return __hip_atomic_fetch_add(p, v, __ATOMIC_RELAXED, __HIP_MEMORY_SCOPE_AGENT); }
__device__ __forceinline__ unsigned xb_xcc_id() { return (unsigned)__builtin_amdgcn_s_getreg((3 << 11) | 20) & 0xFu; }
#define XB_SPIN(cond, bar) do { unsigned _sp = 0; while (cond) { __builtin_amdgcn_s_sleep(1); \
    if ((++_sp & 255u) == 0u) { if (xb_ld(&(bar)[XB_TMO])) break; if (_sp > XB_SPIN_CAP) { atomicAdd(&(bar)[XB_TMO], 1u); break; } } } } while (0)

struct XcdBarrier {
    unsigned* bar; unsigned x;
    volatile LAS unsigned* st;
};

__device__ __forceinline__ XcdBarrier xcd_barrier_post(unsigned* bar, volatile LAS unsigned* st) {
    XcdBarrier b; b.bar = bar; b.x = xb_xcc_id(); b.st = st;
    if (threadIdx.x == 0) (void)xb_add(&bar[XB_XCNT(b.x)], 1u);
    return b;
}
__device__ __forceinline__ void xcd_barrier_complete(unsigned* bar, unsigned x, unsigned& nloc, unsigned& nx) {
    const unsigned G = gridDim.x * gridDim.y * gridDim.z;
    unsigned sum, cnt, mine, sp = 0u;
    for (;;) {
        sum = 0u; cnt = 0u; mine = 0u;
#pragma unroll
        for (unsigned j = 0; j < 16; ++j) { const unsigned c = xb_ld(&bar[XB_XCNT(j)]); sum += c; cnt += (c > 0u) ? 1u : 0u; mine = (j == x) ? c : mine; }
        if (sum == G) break;
        __builtin_amdgcn_s_sleep(1);
        if ((++sp & 255u) == 0u) { if (xb_ld(&bar[XB_TMO])) break; if (sp > XB_SPIN_CAP) { atomicAdd(&bar[XB_TMO], 1u); break; } }
    }
    nloc = mine > 0u ? mine : 1u; nx = cnt > 0u ? cnt : 1u;
}

__device__ __forceinline__ void xcd_barrier(const XcdBarrier& b) {
    asm volatile("s_waitcnt vmcnt(0)" ::: "memory");
    __syncthreads();
    if (threadIdx.x == 0) {
        unsigned* bar = b.bar;
        __builtin_amdgcn_s_waitcnt(0);
        unsigned nloc = b.st[0], nx = b.st[1];
        if (nloc == 0u) { xcd_barrier_complete(bar, b.x, nloc, nx); b.st[0] = nloc; b.st[1] = nx; }
        const unsigned old = xb_add(&bar[XB_XSUB(b.x)], 1u);
        const unsigned gen = old / nloc;
        if (old + 1u == (gen + 1u) * nloc) {
            __builtin_amdgcn_fence(__ATOMIC_RELEASE, "agent");
            asm volatile("s_waitcnt vmcnt(0)" ::: "memory");
            const unsigned og = xb_add(&bar[XB_TOP], 1u);
            const unsigned tg = og / nx;
            if (og + 1u == (tg + 1u) * nx) xb_add(&bar[XB_TOPGEN], 1u);
            else XB_SPIN(xb_ld(&bar[XB_TOPGEN]) == tg, bar);
            __builtin_amdgcn_fence(__ATOMIC_ACQUIRE, "agent");
            xb_add(&bar[XB_XGEN(b.x)], 1u);
            asm volatile("s_waitcnt vmcnt(0)" ::: "memory");
        } else {
            XB_SPIN(xb_ld(&bar[XB_XGEN(b.x)]) == gen, bar);
            __builtin_amdgcn_fence(__ATOMIC_ACQUIRE, "agent");
            asm volatile("s_waitcnt vmcnt(0)" ::: "memory");
        }
    }
    __syncthreads();
}


struct EpiRes2Norm {
    static constexpr bool PERM = true, AFTER_DRAIN = true;
    float* Y; const bf16_t* X1B; float* SSQ; const float* gfin; XcdBarrier xb;
    __device__ __forceinline__ void fused(pg8::f32x4 (&acc)[2][2][4][2], const pg8::Unit& u, int wr, int wc, int fr, int fq, LAS unsigned char* lds, int wid, int lane) const {
        using pg8::BM; using pg8::HALF;
        const int row0 = u.pm * BM + wr * 64 + fr, ct = u.pn * BM + wc * 32 + 8 * fq;
        LAS float* ssl = (LAS float*)lds;
        f32x4 gv[2][2];
#pragma unroll
        for (int bj = 0; bj < 2; ++bj) { gv[bj][0] = *(const f32x4*)(gfin + ct + bj * HALF); gv[bj][1] = *(const f32x4*)(gfin + ct + bj * HALF + 4); }
#pragma unroll
        for (int ai = 0; ai < 2; ++ai) {
            pg8::u32x4 xr[4][2];
#pragma unroll
            for (int m = 0; m < 4; ++m)
#pragma unroll
                for (int bj = 0; bj < 2; ++bj) xr[m][bj] = *(const pg8::u32x4*)(X1B + (size_t)(row0 + ai * HALF + m * 16) * 1024 + ct + bj * HALF);
#pragma unroll
            for (int m = 0; m < 4; ++m) {
                float ss = 0.f;
#pragma unroll
                for (int bj = 0; bj < 2; ++bj) {
                    const pg8::u32x4 x = xr[m][bj];
                    acc[ai][bj][m][0] += (f32x4){bf_lo(x.x), bf_hi(x.x), bf_lo(x.y), bf_hi(x.y)}; acc[ai][bj][m][1] += (f32x4){bf_lo(x.z), bf_hi(x.z), bf_lo(x.w), bf_hi(x.w)};
                    const f32x4 v0 = acc[ai][bj][m][0], v1 = acc[ai][bj][m][1];
                    ss += (v0[0] * v0[0] + v0[1] * v0[1]) + (v0[2] * v0[2] + v0[3] * v0[3]) + (v1[0] * v1[0] + v1[1] * v1[1]) + (v1[2] * v1[2] + v1[3] * v1[3]);
                }
                ss += __shfl_xor(ss, 16); ss += __shfl_xor(ss, 32);
                if (fq == 0) ssl[(ai * HALF + wr * 64 + m * 16 + fr) * 4 + wc] = ss;
            }
        }
        WG_BAR();
        { const int t = wid * 64 + lane; if (t < 256) { const f32x4 p = *(const LAS f32x4*)(ssl + t * 4); SSQ[(size_t)(u.pm * BM + t) * 4 + u.pn] = (p[0] + p[1]) + (p[2] + p[3]); } }
        xcd_barrier(xb);
        f32x4 st[2][4];
#pragma unroll
        for (int ai = 0; ai < 2; ++ai)
#pragma unroll
            for (int m = 0; m < 4; ++m) st[ai][m] = *(const f32x4*)(SSQ + (size_t)(row0 + ai * HALF + m * 16) * 4);
#pragma unroll
        for (int ai = 0; ai < 2; ++ai)
#pragma unroll
            for (int m = 0; m < 4; ++m) {
                float* yr = Y + (size_t)(row0 + ai * HALF + m * 16) * 1024;
                const float rs = __builtin_amdgcn_rsqf(((st[ai][m][0] + st[ai][m][1]) + (st[ai][m][2] + st[ai][m][3])) * (1.0f / 1024.0f) + EPS);
#pragma unroll
                for (int bj = 0; bj < 2; ++bj) {
                    const int col = ct + bj * HALF;
                    *(f32x4*)(yr + col) = acc[ai][bj][m][0] * rs * gv[bj][0]; *(f32x4*)(yr + col + 4) = acc[ai][bj][m][1] * rs * gv[bj][1];
                }
            }
    }
};

struct Args { const float* in[17]; float* out; unsigned char* ws; int ph_lo, ph_hi, aux, pad; };
constexpr int NPHASE = 9;
__device__ __forceinline__ void fill_ptrs(Ptrs& c, const Args& args) {
#pragma unroll
    for (int i = 0; i < 17; ++i) c.in[i] = args.in[i];
    c.out = args.out;
    unsigned char* ws = args.ws;
    c.WinT = (bf16_t*)(ws + WS_WIN); c.WoT = (bf16_t*)(ws + WS_WO); c.W13T = (bf16_t*)(ws + WS_W13); c.W2T = (bf16_t*)(ws + WS_W2);
    c.XB = (bf16_t*)(ws + WS_XB); c.OF = (bf16_t*)(ws + WS_XB); c.P = (bf16_t*)(ws + WS_P); c.HID = (bf16_t*)(ws + WS_P); c.KDTS = (bf16_t*)(ws + WS_KDTS);
    c.X1B = (bf16_t*)(ws + WS_FB); c.FB = (float*)(ws + WS_FB);
    c.RSTD1 = (float*)(ws + WS_RSTD1); c.SSQ2 = (float*)(ws + WS_SSQ2); c.LRA = (float*)(ws + WS_LRA); c.DCH = (float*)(ws + WS_DCH); c.OY = args.out + OUT_Y; c.DUMP = (bf16_t*)(ws + 30 * MiB); c.OX = (bf16_t*)(ws + WS_FB); c.OI = (bf16_t*)(ws + WS_XB); c.PART = (float*)(ws + 208 * MiB); c.PART4 = (float*)(ws + WS_P); c.SSQ3 = (float*)(ws + 30 * MiB + 65536);
}

__global__ void __launch_bounds__(NTHR, 2) hymba_fwd(Args args) {
    extern __shared__ __attribute__((aligned(16))) unsigned char lds_raw[];
    LAS unsigned char* lds = (LAS unsigned char*)lds_raw;
    const int tid = threadIdx.x, lane = tid & 63, wave = __builtin_amdgcn_readfirstlane(tid >> 6), G = gridDim.x;
    unsigned char* ws = args.ws;
    const int lo = args.ph_lo, hi = args.ph_hi;
    volatile LAS unsigned* xst = (volatile LAS unsigned*)(lds + 160256);
    if (tid == 0) { xst[0] = 0u; xst[1] = 0u; }
    __syncthreads();
    XcdBarrier xbar; xbar.bar = (unsigned*)(ws + WS_BAR); xbar.x = 0; xbar.st = xst;
    if (hi - lo > 1) xbar = xcd_barrier_post((unsigned*)(ws + WS_BAR), xst);
#define IN(k) (lo <= (k) && (k) < hi)
#define SEAM(k) do { if (IN(k) && IN((k) + 1)) { if (args.pad != 0) cg::this_grid().sync(); else xcd_barrier(xbar); } } while (0)
    if (IN(0)) { Ptrs c; fill_ptrs(c, args); p0_prologue(c, lds, G, wave, lane, G != 256); }
    SEAM(0);
    if (IN(1)) { Ptrs c; fill_ptrs(c, args);
        pg8::Gemm g{c.XB, c.WinT, M, NIN, D}; pg8::StaticOrder S; S.init(M, NIN, G, (int)blockIdx.x, D);
        pg8::EpiIn E{c.P, c.FB, c.LRA, c.RSTD1};
        pg8::gemm_phase<pg8::EpiIn, pg8::StaticOrder, true, true>(lds, g, S, E);
    }
    SEAM(1);
    if (IN(2)) { Ptrs c; fill_ptrs(c, args); p2_prepass(c, lds, G, tid, wave, lane, args.aux != 0); }
    SEAM(2);
    if (IN(3)) { Ptrs c; fill_ptrs(c, args);
        const int wg = blockIdx.x;
        if (G >= 256) {
            if (wg < 128) seq_dispatch(c, lds, wg, tid, wave, lane);
            else { for (int j = wg - 128; j < 1024; j += G - 128) seq_dispatch(c, lds, 128 + j, tid, wave, lane);
                   weight_items(c, (LAS float*)(lds + wave * 16384), 1, (wg - 128) * NWAVES + wave, (G - 128) * NWAVES, lane); }
        }
        else for (int it = wg; it < 128 + 1024; it += G) seq_dispatch(c, lds, it, tid, wave, lane);
    }
    SEAM(3);
    if (IN(4)) { Ptrs c; fill_ptrs(c, args); p3b_finalize(c, G, wave, lane); }
    SEAM(4);
    if (IN(5)) { Ptrs c; fill_ptrs(c, args);
        pg8::Gemm g{c.OF, c.WoT, M, D, D};
        { pg8::StaticOrder S; S.init(MP, D, G, (int)blockIdx.x, D); pg8::EpiRes1 E{c.in[0], c.in[1], c.OY, c.X1B, c.SSQ2};
          pg8::gemm_phase<pg8::EpiRes1, pg8::StaticOrder, true, true>(lds, g, S, E); }
        { pg8::TailOrder S{G, (int)blockIdx.x, 8, D / 64, MP / 256, 4, 16}; pg8::EpiPart E{c.PART4, MP, 1.f};
          pg8::gemm_phase<pg8::EpiPart, pg8::TailOrder, true, true>(lds, g, S, E); }
        if (hi - lo > 1) xcd_barrier(xbar);
        {
            const int gw = blockIdx.x * NWAVES + wave, NGW = G * NWAVES;
            for (int r = gw; r < MS; r += NGW) {
                const int m = MP + r; f32x4 v[4]; float ss = 0.f;
#pragma unroll
                for (int j = 0; j < 4; ++j) v[j] = *(const f32x4*)(c.in[1] + (size_t)r * D + 4 * lane + 256 * j);
#pragma unroll 1
                for (int ks = 0; ks < 8; ++ks)
#pragma unroll
                    for (int j = 0; j < 4; ++j) v[j] += *(const f32x4*)(c.PART4 + ((size_t)ks * 1024 + r) * 1024 + 4 * lane + 256 * j);
#pragma unroll
                for (int j = 0; j < 4; ++j) {
                    *(f32x4*)(c.OY + (size_t)m * D + 4 * lane + 256 * j) = v[j];
                    u32x2 w; w.x = pk_bf16(v[j][0], v[j][1]); w.y = pk_bf16(v[j][2], v[j][3]); *(u32x2*)(c.X1B + (size_t)m * D + 4 * lane + 256 * j) = w;
                    ss += (v[j][0] * v[j][0] + v[j][1] * v[j][1]) + (v[j][2] * v[j][2] + v[j][3] * v[j][3]);
                }
                ss = wave_sum(ss);
                if (lane == 0) c.RSTD1[m] = __builtin_amdgcn_rsqf(ss * (1.0f / D) + EPS);
            }
            for (int r4 = gw; r4 < MP / 4; r4 += NGW) {
                const int m = 4 * r4 + (lane >> 4); float ss = c.SSQ2[(size_t)m * 16 + (lane & 15)];
                ss = row16_sum(ss);
                if ((lane & 15) == 0) c.RSTD1[m] = __builtin_amdgcn_rsqf(ss * (1.0f / D) + EPS);
            }
        }
    }
    SEAM(5);
    if (IN(6)) { Ptrs c; fill_ptrs(c, args);
        pg8::Gemm g{c.X1B, c.W13T, M, NUP, D}; pg8::StaticOrder S; S.init(M, NUP, G, (int)blockIdx.x, D);
        pg8::EpiSwiglu E{c.HID, c.RSTD1};
        pg8::gemm_phase<pg8::EpiSwiglu, pg8::StaticOrder, true, true>(lds, g, S, E);
    }
    SEAM(6);
    if (IN(7)) { Ptrs c; fill_ptrs(c, args);
        pg8::Gemm g{c.HID, c.W2T, M, D, FF};
        if (G == 256 && hi - lo > 1) {
            pg8::StaticOrder S; S.init(MP, D, G, (int)blockIdx.x, FF); EpiRes2Norm E{c.OY, c.X1B, c.SSQ3, c.in[16], xbar};
            pg8::gemm_phase<EpiRes2Norm, pg8::StaticOrder, true, true>(lds, g, S, E);
        } else {
            pg8::StaticOrder S; S.init(MP, D, G, (int)blockIdx.x, FF); pg8::EpiRes2 E{c.OY, args.aux ? 0.f : 1.f, c.X1B};
            pg8::gemm_phase<pg8::EpiRes2, pg8::StaticOrder, true, true>(lds, g, S, E);
        }
        { pg8::TailOrder S{G, (int)blockIdx.x, 11, FF / 64, MP / 256, 4, 16}; pg8::EpiPart E{c.PART, MP, args.aux ? 0.f : 1.f};
          pg8::gemm_phase<pg8::EpiPart, pg8::TailOrder, true, true>(lds, g, S, E); }
    }
    SEAM(7);
    if (IN(8)) { Ptrs c; fill_ptrs(c, args);
        const int NGW = G * NWAVES, gw = blockIdx.x * NWAVES + wave + ((G == 256 && hi - lo > 1) ? MP : 0);
        f32x4 gn[4];
#pragma unroll
        for (int j = 0; j < 4; ++j) gn[j] = *(const f32x4*)(c.in[16] + 4 * lane + 256 * j);
        f32x4 v[4], nv[4];
        { const int m0 = gw < M ? gw : M - 1;
#pragma unroll
          for (int j = 0; j < 4; ++j) v[j] = *(const f32x4*)(c.OY + (size_t)m0 * D + 4 * lane + 256 * j); }
#define ADD_PARTS(vv, mm) do { if ((mm) >= MP) { _Pragma("unroll 1") for (int ks = 0; ks < 11; ++ks) { _Pragma("unroll") for (int j = 0; j < 4; ++j) \
            vv[j] += *(const f32x4*)(c.PART + ((size_t)ks * 1024 + ((mm) - MP)) * 1024 + 4 * lane + 256 * j); } } } while (0)
        { const int m0 = gw < M ? gw : M - 1; ADD_PARTS(v, m0); }
        for (int m = gw; m < M; m += NGW) {
            float* yr = c.OY + (size_t)m * D; float s = 0.f;
            { const int mn = m + NGW < M ? m + NGW : m;
#pragma unroll
              for (int j = 0; j < 4; ++j) nv[j] = *(const f32x4*)(c.OY + (size_t)mn * D + 4 * lane + 256 * j);
              ADD_PARTS(nv, mn); }
#pragma unroll
            for (int j = 0; j < 4; ++j) s += (v[j][0] * v[j][0] + v[j][1] * v[j][1]) + (v[j][2] * v[j][2] + v[j][3] * v[j][3]);
            const float rs = __builtin_amdgcn_rsqf(wave_sum(s) * (1.0f / D) + EPS);
#pragma unroll
            for (int j = 0; j < 4; ++j) *(f32x4*)(yr + 4 * lane + 256 * j) = args.aux ? v[j] : v[j] * rs * gn[j];
#pragma unroll
            for (int j = 0; j < 4; ++j) v[j] = nv[j];
        }
    }
#undef IN
#undef SEAM
}

extern "C" void kernel_launch(void* const* d_in, const int* in_sizes, int n_in, void* d_out, int out_size, void* d_ws, size_t ws_size, hipStream_t stream) {
    static int grid = 0;
    if (grid == 0) {
        if (n_in != 17 || ws_size < WS_END) { fprintf(stderr, "kernel_launch: unexpected n_in %d / ws %zu\n", n_in, ws_size); grid = -1; return; }
        int dev = 0, cus = 0, per_cu = 0;
        (void)hipGetDevice(&dev); (void)hipDeviceGetAttribute(&cus, hipDeviceAttributeMultiprocessorCount, dev);
        if (hipFuncSetAttribute((const void*)hymba_fwd, hipFuncAttributeMaxDynamicSharedMemorySize, LDS_BYTES) != hipSuccess) { fprintf(stderr, "kernel_launch: hipFuncSetAttribute failed\n"); grid = -1; return; }
        if (hipOccupancyMaxActiveBlocksPerMultiprocessor(&per_cu, (const void*)hymba_fwd, NTHR, LDS_BYTES) != hipSuccess || per_cu < 1) { fprintf(stderr, "kernel_launch: occupancy query says %d\n", per_cu); per_cu = 1; }
        (void)hipGetLastError();
        grid = cus * per_cu;
        if (grid <= 0) grid = 256;
    }
    if (grid < 0) return;
    if (hipMemsetAsync((char*)d_ws + WS_BAR, 0, 16384, stream) != hipSuccess) { fprintf(stderr, "kernel_launch: memset failed\n"); return; }
    Args a{};
    for (int i = 0; i < 17; ++i) a.in[i] = (const float*)d_in[i];
    a.out = (float*)d_out; a.ws = (unsigned char*)d_ws;
    if (MK_N_LAUNCHES == 1) {
        a.ph_lo = 0; a.ph_hi = NPHASE;
        void* kargs[] = {&a};
        hipError_t e = hipLaunchCooperativeKernel((const void*)hymba_fwd, dim3(grid), dim3(NTHR), kargs, LDS_BYTES, stream);
        if (e != hipSuccess) fprintf(stderr, "kernel_launch: cooperative launch failed: %s (grid %d)\n", hipGetErrorString(e), grid);
    } else {
        for (int p = 0; p < NPHASE; ++p) { a.ph_lo = p; a.ph_hi = p + 1; const int nrep = ((REP_MASK >> p) & 1) ? 3 : 1;
            for (int rr = 0; rr < nrep; ++rr) { a.aux = ((p == 2 || p == 7 || p == 8) && rr + 1 < nrep) ? 1 : 0; hipLaunchKernelGGL(hymba_fwd, dim3(grid), dim3(NTHR), LDS_BYTES, stream, a); } }
    }
}
```

```cpp
#include <hip/hip_runtime.h>
#include <hip/hip_cooperative_groups.h>
#include <cstdio>
#include <cstdint>
namespace cg = cooperative_groups;
namespace pg8 {
#define PG8_LAS __attribute__((address_space(3)))
typedef unsigned short bf16_t;
typedef short bf16x8 __attribute__((ext_vector_type(8)));
typedef float f32x4 __attribute__((ext_vector_type(4)));
typedef unsigned u32x4 __attribute__((ext_vector_type(4)));
constexpr int BM = 256, BK = 64, HALF = 128, HTB = HALF * BK * 2  , STAGE_BYTES = 8 * HTB, NXCD = 8, WGM = 8;

__host__ __device__ __forceinline__ int lds_byte(int r, int c) { const int st = (r >> 4) * 2 + (c >> 5), rr = r & 15, cc = c & 31, ob = rr * 64 + cc * 2; return st * 1024 + (ob ^ (((ob >> 9) & 1) << 5)); }
__host__ __device__ __forceinline__ void stage_rc(int b, int& R, int& C) { const int st = b / 1024, sb = b % 1024, swz = sb ^ (((sb >> 9) & 1) << 5); R = (st >> 1) * 16 + swz / 64; C = (st & 1) * 32 + (swz % 64) / 2; }
__host__ __device__ __forceinline__ int perm32(int rho) { const int n = rho >> 4, i = rho & 15; return 8 * (i >> 2) + 4 * n + (i & 3); }

struct Unit { int pm, pn, k0, nk; };
struct Gemm { const bf16_t* A; const bf16_t* Bt; int M, N, K; };

struct StaticOrder {
    int nM, nN, nwg, G, c, nkt;
    __host__ __device__ void init(int M, int N, int G_, int c_, int K_) { nM = M / BM; nN = N / BM; nwg = nM * nN; G = G_; c = c_; nkt = K_ / BK; }
    __host__ __device__ bool next(int i, Unit& u) const { return at((long)i * G + c, u); }
    __host__ __device__ bool at(long L, Unit& u) const {
        if (L >= nwg) return false;
        int wgid = (int)L; { const int q = nwg / NXCD, r = nwg % NXCD, xcd = wgid % NXCD, off = wgid / NXCD; wgid = (xcd < r ? xcd * (q + 1) : r * (q + 1) + (xcd - r) * q) + off; }
        const int nig = WGM * nN, gid = wgid / nig, fm = gid * WGM, gsz = (nM - fm) < WGM ? (nM - fm) : WGM;
        u.pm = fm + ((wgid % nig) % gsz); u.pn = (wgid % nig) / gsz; u.k0 = 0; u.nk = nkt; return true;
    }
    __device__ __forceinline__ void a_ready(const Unit&) const {}
    __device__ __forceinline__ void done(const Unit&) const {}
};


struct TailOrder {
    int G, c, NS, nkt, pm0, nN, ntu;
    __host__ __device__ bool next(int i, Unit& u) const {
        const int id = i * G + c; if (id >= ntu * NS) return false;
        const int tu = id / NS, ks = id % NS; u.pm = pm0 + tu / nN; u.pn = tu % nN; u.nk = nkt / NS; u.k0 = ks * u.nk; return true;
    }
    __device__ __forceinline__ void a_ready(const Unit&) const {}
    __device__ __forceinline__ void done(const Unit&) const {}
};

__device__ __forceinline__ unsigned cvt_pk_bf16(float lo, float hi) { unsigned r; asm volatile("v_cvt_pk_bf16_f32 %0, %1, %2" : "=v"(r) : "v"(lo), "v"(hi)); return r; }
typedef float f32x2 __attribute__((ext_vector_type(2)));

template <class Epi, class Sched, bool ALIGN_EPI = false, bool SP2 = false>
__device__ __forceinline__ void gemm_phase(PG8_LAS unsigned char* lds, const Gemm g, const Sched& S, const Epi& E) {
    const int tid = threadIdx.x, wid = __builtin_amdgcn_readfirstlane(tid >> 6), lane = tid & 63, wr = wid >> 2, wc = wid & 3, fr = lane & 15, fq = lane >> 4;
    const int K = g.K, nt = K / BK;
    unsigned voffA[2], voffB[2];
#pragma unroll
    for (int i = 0; i < 2; ++i) { int R, C; stage_rc(tid * 16 + i * 8192, R, C); const int Rb = Epi::PERM ? ((R & ~31) + perm32(R & 31)) : R;
        voffA[i] = (unsigned)(R * K + C) * 2u; voffB[i] = (unsigned)(Rb * K + C) * 2u; }
    const size_t kstep = (size_t)(BK * 2);
    const size_t hstep = (size_t)HALF * K * 2;
    const size_t tstep = 2 * hstep;
    const unsigned ldsw = (unsigned)wid * 1024u;
    const int aoff = lds_byte(wr * 64 + fr, fq * 8), boff = lds_byte(wc * 32 + fr, fq * 8);
#define PG8_SA(b, h) (((b) * 2 + (h)) * HTB)
#define PG8_SB(b, h) ((4 + (b) * 2 + (h)) * HTB)
#define PG8_STAGE(bufoff, gbase, voff) do { _Pragma("unroll") for (int _i = 0; _i < 2; ++_i) \
        __builtin_amdgcn_global_load_lds((const unsigned*)((const char*)(gbase) + (voff)[_i]), (PG8_LAS unsigned*)(lds + (bufoff) + ldsw + _i * 8192), 16, 0, 0); } while (0)
#define PG8_LDA(dst, b, h) do { _Pragma("unroll") for (int m = 0; m < 4; ++m) _Pragma("unroll") for (int k = 0; k < 2; ++k) dst[m][k] = *(const PG8_LAS bf16x8*)(lds + PG8_SA(b, h) + aoff + m * 2048 + k * 1024); } while (0)
#define PG8_LDB(dst, b, h) do { _Pragma("unroll") for (int n = 0; n < 2; ++n) _Pragma("unroll") for (int k = 0; k < 2; ++k) dst[n][k] = *(const PG8_LAS bf16x8*)(lds + PG8_SB(b, h) + boff + n * 2048 + k * 1024); } while (0)
#define PG8_MMA(ai, bj, At, Bt) do { __builtin_amdgcn_s_setprio(1); _Pragma("unroll") for (int m = 0; m < 4; ++m) _Pragma("unroll") for (int n = 0; n < 2; ++n) _Pragma("unroll") for (int k = 0; k < 2; ++k) \
        acc[ai][bj][m][n] = __builtin_amdgcn_mfma_f32_16x16x32_bf16(Bt[n][k], At[m][k], acc[ai][bj][m][n], 0, 0, 0); __builtin_amdgcn_s_setprio(0); } while (0)
#define PG8_WAIT_V(n) asm volatile("s_waitcnt vmcnt(" #n ")" ::: "memory")
#define PG8_WAIT_L(n) asm volatile("s_waitcnt lgkmcnt(" #n ")" ::: "memory")
#define PG8_BAR __builtin_amdgcn_s_barrier()
#define PG8_SCHED __builtin_amdgcn_sched_barrier(0)
    Unit cur, nxt; int ui = 0;
    if (!S.next(0, cur)) return;
    f32x4 acc[2][2][4][2];
#pragma unroll
    for (int a = 0; a < 2; ++a)
#pragma unroll
        for (int b = 0; b < 2; ++b)
#pragma unroll
            for (int m = 0; m < 4; ++m)
#pragma unroll
                for (int n = 0; n < 2; ++n) acc[a][b][m][n] = (f32x4){0.f, 0.f, 0.f, 0.f};
    bf16x8 At[4][2], B0[2][2], B1[2][2];
    const char* cA = (const char*)g.A + (size_t)cur.pm * tstep + (size_t)cur.k0 * kstep; const char* cB = (const char*)g.Bt + (size_t)cur.pn * tstep + (size_t)cur.k0 * kstep;
    S.a_ready(cur);
    if constexpr (SP2) {
        PG8_STAGE(PG8_SB(0, 0), cB, voffB); PG8_STAGE(PG8_SB(0, 1), cB + hstep, voffB); PG8_STAGE(PG8_SA(0, 0), cA, voffA); PG8_STAGE(PG8_SA(0, 1), cA + hstep, voffA);
        if (wr == 1) PG8_BAR;
        PG8_WAIT_V(2); PG8_BAR;
        PG8_STAGE(PG8_SB(1, 0), cB + kstep, voffB); PG8_STAGE(PG8_SA(1, 0), cA + kstep, voffA); PG8_STAGE(PG8_SB(1, 1), cB + hstep + kstep, voffB);
        PG8_WAIT_V(6); PG8_BAR;
    } else {
        PG8_STAGE(PG8_SB(0, 0), cB, voffB); PG8_STAGE(PG8_SA(0, 0), cA, voffA); PG8_STAGE(PG8_SB(0, 1), cB + hstep, voffB); PG8_STAGE(PG8_SA(0, 1), cA + hstep, voffA);
        if (wr == 1) PG8_BAR;
        PG8_WAIT_V(4); PG8_BAR;
        PG8_STAGE(PG8_SB(1, 0), cB + kstep, voffB); PG8_STAGE(PG8_SA(1, 0), cA + kstep, voffA); PG8_STAGE(PG8_SB(1, 1), cB + hstep + kstep, voffB);
        PG8_WAIT_V(6); PG8_BAR;
    }
    for (;;) {
        const bool has_next = S.next(ui + 1, nxt);
        const char* nA = has_next ? (const char*)g.A + (size_t)nxt.pm * tstep + (size_t)nxt.k0 * kstep : cA; const char* nB = has_next ? (const char*)g.Bt + (size_t)nxt.pn * tstep + (size_t)nxt.k0 * kstep : cB;
        const int ntc = cur.nk;
        for (int t = 0; t < ntc; t += 2) {
            const bool last = (t == ntc - 2);
            const char* a1 = cA + (size_t)(t + 1) * kstep;
            const char* a2 = last ? nA : cA + (size_t)(t + 2) * kstep; const char* b2 = last ? nB : cB + (size_t)(t + 2) * kstep;
            const char* a3 = a2 + kstep; const char* b3 = b2 + kstep;
            if (last && has_next) S.a_ready(nxt);
            if constexpr (SP2) {
            PG8_LDB(B0, 0, 0); PG8_LDB(B1, 0, 1); PG8_SCHED; PG8_LDA(At, 0, 0); PG8_STAGE(PG8_SA(1, 1), a1 + hstep, voffA);
            PG8_WAIT_V(8); PG8_WAIT_L(0); PG8_BAR; PG8_MMA(0, 0, At, B0); PG8_MMA(0, 1, At, B1); PG8_BAR; PG8_SCHED;
            PG8_LDA(At, 0, 1); PG8_STAGE(PG8_SB(0, 0), b2, voffB); PG8_STAGE(PG8_SB(0, 1), b2 + hstep, voffB); PG8_STAGE(PG8_SA(0, 0), a2, voffA);
            PG8_WAIT_V(8); PG8_WAIT_L(0); PG8_BAR; PG8_MMA(1, 0, At, B0); PG8_MMA(1, 1, At, B1); PG8_BAR; PG8_SCHED;
            PG8_LDB(B0, 1, 0); PG8_LDB(B1, 1, 1); PG8_SCHED; PG8_LDA(At, 1, 0); PG8_STAGE(PG8_SA(0, 1), a2 + hstep, voffA);
            PG8_WAIT_V(8); PG8_WAIT_L(0); PG8_BAR; PG8_MMA(0, 0, At, B0); PG8_MMA(0, 1, At, B1); PG8_BAR; PG8_SCHED;
            PG8_LDA(At, 1, 1); PG8_STAGE(PG8_SB(1, 0), b3, voffB); PG8_STAGE(PG8_SB(1, 1), b3 + hstep, voffB); PG8_STAGE(PG8_SA(1, 0), a3, voffA);
            PG8_WAIT_V(8); PG8_WAIT_L(0); PG8_BAR; PG8_MMA(1, 0, At, B0); PG8_MMA(1, 1, At, B1); PG8_BAR; PG8_SCHED;
            } else {
            PG8_LDB(B0, 0, 0); PG8_SCHED; PG8_LDA(At, 0, 0); PG8_STAGE(PG8_SA(1, 1), a1 + hstep, voffA);
            PG8_WAIT_L(8); PG8_BAR; PG8_WAIT_L(0); PG8_MMA(0, 0, At, B0); PG8_BAR; PG8_SCHED;
            PG8_LDB(B1, 0, 1); PG8_STAGE(PG8_SB(0, 0), b2, voffB);
            PG8_BAR; PG8_WAIT_L(0); PG8_MMA(0, 1, At, B1); PG8_BAR;
            PG8_LDA(At, 0, 1); PG8_STAGE(PG8_SA(0, 0), a2, voffA);
            PG8_BAR; PG8_WAIT_L(0); PG8_MMA(1, 0, At, B0); PG8_BAR; PG8_SCHED;
            PG8_STAGE(PG8_SB(0, 1), b2 + hstep, voffB);
            PG8_WAIT_V(6); PG8_BAR; PG8_MMA(1, 1, At, B1); PG8_BAR;
            PG8_LDB(B0, 1, 0); PG8_SCHED; PG8_LDA(At, 1, 0); PG8_STAGE(PG8_SA(0, 1), a2 + hstep, voffA);
            PG8_WAIT_L(8); PG8_BAR; PG8_WAIT_L(0); PG8_MMA(0, 0, At, B0); PG8_BAR; PG8_SCHED;
            PG8_LDB(B1, 1, 1); PG8_STAGE(PG8_SB(1, 0), b3, voffB);
            PG8_BAR; PG8_WAIT_L(0); PG8_MMA(0, 1, At, B1); PG8_BAR;
            PG8_LDA(At, 1, 1); PG8_STAGE(PG8_SA(1, 0), a3, voffA);
            PG8_BAR; PG8_WAIT_L(0); PG8_MMA(1, 0, At, B0); PG8_BAR; PG8_SCHED;
            PG8_STAGE(PG8_SB(1, 1), b3 + hstep, voffB);
            PG8_WAIT_V(6); PG8_BAR; PG8_MMA(1, 1, At, B1); PG8_BAR;
            }
        }
        if constexpr (ALIGN_EPI) { if (wr == 0) PG8_BAR; }
        if constexpr (!Epi::AFTER_DRAIN) { E(acc, cur, wr, wc, fr, fq); S.done(cur); }
        if (!has_next) break;
#pragma unroll
        for (int a = 0; a < 2; ++a)
#pragma unroll
            for (int b = 0; b < 2; ++b)
#pragma unroll
                for (int m = 0; m < 4; ++m)
#pragma unroll
                    for (int n = 0; n < 2; ++n) acc[a][b][m][n] = (f32x4){0.f, 0.f, 0.f, 0.f};
        cur = nxt; cA = nA; cB = nB; ++ui;
        if constexpr (ALIGN_EPI) { if (wr == 1) PG8_BAR; }
    }
    PG8_WAIT_V(0);
    if constexpr (!ALIGN_EPI) { if (wr == 0) PG8_BAR; }
    PG8_BAR;
    if constexpr (Epi::AFTER_DRAIN) { E.fused(acc, cur, wr, wc, fr, fq, lds, wid, lane); S.done(cur); }
#undef PG8_SA
#undef PG8_SB
#undef PG8_STAGE
#undef PG8_LDA
#undef PG8_LDB
#undef PG8_MMA
#undef PG8_WAIT_V
#undef PG8_WAIT_L
#undef PG8_BAR
#undef PG8_SCHED
}
}

#ifndef MK_N_LAUNCHES
#define MK_N_LAUNCHES 1
#endif
#ifndef REP_MASK
#define REP_MASK 0
#endif
#define LAS __attribute__((address_space(3)))
using pg8::bf16_t; using pg8::bf16x8; using pg8::f32x4; using pg8::u32x4;
typedef float f32x16 __attribute__((ext_vector_type(16)));
typedef __bf16 bf16x2_t __attribute__((ext_vector_type(2)));
typedef float f32x2_t __attribute__((ext_vector_type(2)));
typedef unsigned u32x2 __attribute__((ext_vector_type(2)));

constexpr int NWAVES = 8, NTHR = 512;
constexpr int D = 1024, MP = 16384, MS = 1024, M = MP + MS, NIN = 3840, PLD = 3584, FF = 2816, NUP = 2 * FF;
constexpr float EPS = 1e-6f;
constexpr size_t MiB = 1u << 20;
constexpr size_t WS_BAR = 26 * MiB + 768 * 1024, WS_WIN = 0, WS_WO = 8 * MiB, WS_W13 = 10 * MiB, WS_W2 = 21 * MiB, WS_RSTD1 = 27 * MiB, WS_SSQ2 = 28 * MiB, WS_LRA = 32 * MiB, WS_DCH = 34 * MiB,
                 WS_KDTS = 37 * MiB, WS_XB = 45 * MiB, WS_FB = 79 * MiB, WS_P = 113 * MiB, WS_END = 233 * MiB;
static_assert(WS_P + (size_t)(M + 32) * PLD * 2 <= WS_END && WS_XB + (size_t)M * D * 2 <= WS_FB && WS_FB + (size_t)M * 512 * 4 <= WS_P, "ws map");
constexpr size_t OUT_Y = 0, OUT_SAP = 17825792, OUT_SBP = 18087936, OUT_SAS = 18612224, OUT_SBS = 22806528;
constexpr int LDS_BYTES = 160768;

__device__ __forceinline__ unsigned pk_bf16(float lo, float hi) { f32x2_t v = {lo, hi}; bf16x2_t b = __builtin_convertvector(v, bf16x2_t); return __builtin_bit_cast(unsigned, b); }
__device__ __forceinline__ float bf_lo(unsigned u) { return __uint_as_float(u << 16); }
__device__ __forceinline__ float bf_hi(unsigned u) { return __uint_as_float(u & 0xffff0000u); }
__device__ __forceinline__ float bf_f(unsigned short u) { return __uint_as_float(((unsigned)u) << 16); }


template <int CTRL, int ROWMASK> __device__ __forceinline__ float dpp_f(float v) { return __builtin_bit_cast(float, __builtin_amdgcn_update_dpp(0, __builtin_bit_cast(int, v), CTRL, ROWMASK, 0xF, true)); }
__device__ __forceinline__ float row16_sum(float v) { v += dpp_f<0xB1, 0xF>(v); v += dpp_f<0x4E, 0xF>(v); v += dpp_f<0x141, 0xF>(v); v += dpp_f<0x140, 0xF>(v); return v; }
__device__ __forceinline__ float scan32(float a) {
    a += dpp_f<0x111, 0xF>(a); a += dpp_f<0x112, 0xF>(a); a += dpp_f<0x114, 0xF>(a); a += dpp_f<0x118, 0xF>(a); a += dpp_f<0x142, 0xA>(a); return a; }
template <int CTRL, int ROWMASK> __device__ __forceinline__ float dpp_f1(float v) { return __builtin_bit_cast(float, __builtin_amdgcn_update_dpp(0x3f800000, __builtin_bit_cast(int, v), CTRL, ROWMASK, 0xF, false)); }
__device__ __forceinline__ float scanmul32(float a) {
    a *= dpp_f1<0x111, 0xF>(a); a *= dpp_f1<0x112, 0xF>(a); a *= dpp_f1<0x114, 0xF>(a); a *= dpp_f1<0x118, 0xF>(a); a *= dpp_f1<0x142, 0xA>(a); return a; }
__device__ __forceinline__ float lane_bcast(float v, int l);
__device__ __forceinline__ float wave_sum(float v) { v = row16_sum(v); return (lane_bcast(v, 0) + lane_bcast(v, 16)) + (lane_bcast(v, 32) + lane_bcast(v, 48)); }
__device__ __forceinline__ float lane_bcast(float v, int l) { return __builtin_bit_cast(float, __builtin_amdgcn_readlane(__builtin_bit_cast(int, v), l)); }
#define LDS_WAIT() asm volatile("s_waitcnt lgkmcnt(0)" ::: "memory")
#define WG_BAR() do { asm volatile("s_waitcnt lgkmcnt(0)" ::: "memory"); __builtin_amdgcn_s_barrier(); asm volatile("" ::: "memory"); } while (0)
#define MFMA32(a, b, c) __builtin_amdgcn_mfma_f32_32x32x16_bf16((a), (b), (c), 0, 0, 0)
#define MFMA16(a, b, c) __builtin_amdgcn_mfma_f32_16x16x32_bf16((a), (b), (c), 0, 0, 0)

struct Ptrs {
    const float* in[17]; float* out;
    bf16_t *WinT, *WoT, *W13T, *W2T, *XB, *P, *KDTS, *OF, *X1B, *HID;
    float *RSTD1, *SSQ2, *LRA, *DCH, *FB, *OY; bf16_t *DUMP, *OX, *OI; bf16_t *PART, *PART4; float *SSQ3;
};

namespace pg8 {
struct EpiIn {
    static constexpr bool PERM = true, AFTER_DRAIN = false;
    bf16_t* P; float* FB; float* LRA; const float* rstd;
    __device__ __forceinline__ void operator()(const f32x4 (&acc)[2][2][4][2], const Unit& u, int wr, int wc, int fr, int fq) const {
        const int row0 = u.pm * BM + wr * 64 + fr, ct = wc * 32 + 8 * fq;
#pragma unroll
        for (int ai = 0; ai < 2; ++ai)
#pragma unroll
            for (int m = 0; m < 4; ++m) {
                const int row = row0 + ai * HALF + m * 16; const float rs = 1.0f;
#pragma unroll
                for (int bj = 0; bj < 2; ++bj) {
                    const f32x4 v0 = acc[ai][bj][m][0] * rs, v1 = acc[ai][bj][m][1] * rs; const int cl = bj * HALF + ct;
                    if (u.pn == 8 || u.pn == 9) { float* o = FB + (size_t)row * 512 + (u.pn - 8) * BM + cl; *(f32x4*)o = v0; *(f32x4*)(o + 4) = v1; }
                    else if (u.pn == 14) { if (cl < 16) { float* o = LRA + (size_t)row * 16 + cl; *(f32x4*)o = v0; *(f32x4*)(o + 4) = v1; } }
                    else { u32x4 w; w.x = cvt_pk_bf16(v0[0], v0[1]); w.y = cvt_pk_bf16(v0[2], v0[3]); w.z = cvt_pk_bf16(v1[0], v1[1]); w.w = cvt_pk_bf16(v1[2], v1[3]);
                           *(u32x4*)(P + (size_t)row * 3584 + u.pn * BM + cl) = w; }
                }
            }
    }
};
struct EpiRes1 {
    static constexpr bool PERM = true, AFTER_DRAIN = false;
    const float* xp; const float* xs; float* Y; bf16_t* X1B; float* SSQ;
    __device__ __forceinline__ void operator()(const f32x4 (&acc)[2][2][4][2], const Unit& u, int wr, int wc, int fr, int fq) const {
        const int row0 = u.pm * BM + wr * 64 + fr, ct = u.pn * BM + wc * 32 + 8 * fq;
#pragma unroll
        for (int ai = 0; ai < 2; ++ai) {
            f32x4 xv[4][2][2];
#pragma unroll
            for (int m = 0; m < 4; ++m) {
                const int row = row0 + ai * HALF + m * 16;
                const float* xr = row < 16384 ? xp + (size_t)row * 1024 : xs + (size_t)(row - 16384) * 1024;
#pragma unroll
                for (int bj = 0; bj < 2; ++bj) { xv[m][bj][0] = *(const f32x4*)(xr + ct + bj * HALF); xv[m][bj][1] = *(const f32x4*)(xr + ct + bj * HALF + 4); }
            }
            asm volatile("" ::: "memory");
#pragma unroll
            for (int m = 0; m < 4; ++m) {
                const int row = row0 + ai * HALF + m * 16; float ss = 0.f;
#pragma unroll
                for (int bj = 0; bj < 2; ++bj) {
                    const int col = ct + bj * HALF;
                    const f32x4 v0 = acc[ai][bj][m][0] + xv[m][bj][0], v1 = acc[ai][bj][m][1] + xv[m][bj][1];
                    u32x4 w; w.x = cvt_pk_bf16(v0[0], v0[1]); w.y = cvt_pk_bf16(v0[2], v0[3]); w.z = cvt_pk_bf16(v1[0], v1[1]); w.w = cvt_pk_bf16(v1[2], v1[3]);
                    *(u32x4*)(X1B + (size_t)row * 1024 + col) = w;
                    ss += (v0[0] * v0[0] + v0[1] * v0[1]) + (v0[2] * v0[2] + v0[3] * v0[3]) + (v1[0] * v1[0] + v1[1] * v1[1]) + (v1[2] * v1[2] + v1[3] * v1[3]);
                }
                ss += __shfl_xor(ss, 16); ss += __shfl_xor(ss, 32);
                if (fq == 0) SSQ[(size_t)row * 16 + u.pn * 4 + wc] = ss;
            }
        }
    }
};
struct EpiSwiglu {
    static constexpr bool PERM = true, AFTER_DRAIN = false;
    bf16_t* H; const float* SSQ;
    __device__ __forceinline__ void operator()(const f32x4 (&acc)[2][2][4][2], const Unit& u, int wr, int wc, int fr, int fq) const {
        const int row0 = u.pm * BM + wr * 64 + fr, hc = u.pn * 128 + wc * 32 + fq * 8;
#pragma unroll
        for (int ai = 0; ai < 2; ++ai)
#pragma unroll
            for (int m = 0; m < 4; ++m) {
                const int row = row0 + ai * HALF + m * 16;
                const float rs = SSQ[row];
                float h[8];
#pragma unroll
                for (int n = 0; n < 2; ++n) {
                    const f32x4 a = acc[ai][0][m][n] * rs, b = acc[ai][1][m][n] * rs;
#pragma unroll
                    for (int e = 0; e < 4; ++e) h[4 * n + e] = a[e] * __builtin_amdgcn_rcpf(1.0f + __expf(-a[e])) * b[e];
                }
                u32x4 w; w.x = cvt_pk_bf16(h[0], h[1]); w.y = cvt_pk_bf16(h[2], h[3]); w.z = cvt_pk_bf16(h[4], h[5]); w.w = cvt_pk_bf16(h[6], h[7]);
                *(u32x4*)(H + (size_t)row * 2816 + hc) = w;
            }
    }
};
struct EpiRes2 {
    static constexpr bool PERM = true, AFTER_DRAIN = false;
    float* Y; float sc; const bf16_t* X1B;
    __device__ __forceinline__ void operator()(const f32x4 (&acc)[2][2][4][2], const Unit& u, int wr, int wc, int fr, int fq) const {
        const int row0 = u.pm * BM + wr * 64 + fr, ct = u.pn * BM + wc * 32 + 8 * fq;
#pragma unroll
        for (int ai = 0; ai < 2; ++ai)
#pragma unroll
            for (int m = 0; m < 4; ++m) {
                float* yr = Y + (size_t)(row0 + ai * HALF + m * 16) * 1024;
#pragma unroll
                for (int bj = 0; bj < 2; ++bj) {
                    const int col = ct + bj * HALF;
                    const pg8::u32x4 xr = *(const pg8::u32x4*)(X1B + (size_t)(row0 + ai * HALF + m * 16) * 1024 + col);
                    const f32x4 v0 = acc[ai][bj][m][0] * sc + (f32x4){__uint_as_float(xr.x << 16), __uint_as_float(xr.x & 0xffff0000u), __uint_as_float(xr.y << 16), __uint_as_float(xr.y & 0xffff0000u)};
                    const f32x4 v1 = acc[ai][bj][m][1] * sc + (f32x4){__uint_as_float(xr.z << 16), __uint_as_float(xr.z & 0xffff0000u), __uint_as_float(xr.w << 16), __uint_as_float(xr.w & 0xffff0000u)};
                    *(f32x4*)(yr + col) = v0; *(f32x4*)(yr + col + 4) = v1;
                }
            }
    }
};
struct EpiPart {
    static constexpr bool PERM = true, AFTER_DRAIN = false;
    bf16_t* PART; int rowbase; float sc;
    __device__ __forceinline__ void operator()(const f32x4 (&acc)[2][2][4][2], const Unit& u, int wr, int wc, int fr, int fq) const {
        const int row0 = u.pm * BM + wr * 64 + fr - rowbase, ct = u.pn * BM + wc * 32 + 8 * fq;
        bf16_t* base = PART + (size_t)(u.k0 / u.nk) * 1024 * 1024;
#pragma unroll
        for (int ai = 0; ai < 2; ++ai)
#pragma unroll
            for (int m = 0; m < 4; ++m) {
                bf16_t* yr = base + (size_t)(row0 + ai * HALF + m * 16) * 1024;
#pragma unroll
                for (int bj = 0; bj < 2; ++bj) { const f32x4 v0 = acc[ai][bj][m][0] * sc, v1 = acc[ai][bj][m][1] * sc;
                    u32x4 w; w.x = cvt_pk_bf16(v0[0], v0[1]); w.y = cvt_pk_bf16(v0[2], v0[3]); w.z = cvt_pk_bf16(v1[0], v1[1]); w.w = cvt_pk_bf16(v1[2], v1[3]);
                    *(u32x4*)(yr + ct + bj * HALF) = w; }
            }
    }
};
}

__device__ __forceinline__ void tr_item(const float* colp, int ldw, const float* gain, int k0, int dcol, bf16_t* WT, int K, int nrow0, LAS float* scr, int lane) {
    float tv[32];
#pragma unroll
    for (int i = 0; i < 32; ++i) { const int kk = 2 * i + (lane >> 5); tv[i] = colp ? colp[(size_t)(k0 + kk) * ldw] : 0.f; }
    if (gain) {
        float gv[32];
#pragma unroll
        for (int i = 0; i < 32; ++i) gv[i] = gain[k0 + 2 * i + (lane >> 5)];
#pragma unroll
        for (int i = 0; i < 32; ++i) tv[i] *= gv[i];
    }
#pragma unroll
    for (int i = 0; i < 32; ++i) scr[(2 * i + (lane >> 5)) * 33 + dcol] = tv[i];
    LDS_WAIT();
    const int c = lane & 7;
#pragma unroll
    for (int j = 0; j < 4; ++j) {
        const int n = (lane >> 3) + 8 * j; const LAS float* s = scr + (8 * c) * 33 + n;
        u32x4 o; o.x = pk_bf16(s[0 * 33], s[1 * 33]); o.y = pk_bf16(s[2 * 33], s[3 * 33]); o.z = pk_bf16(s[4 * 33], s[5 * 33]); o.w = pk_bf16(s[6 * 33], s[7 * 33]);
        *(u32x4*)(WT + (size_t)(nrow0 + n) * K + k0 + 8 * c) = o;
    }
    LDS_WAIT();
}
__device__ __forceinline__ void weight_items(const Ptrs& c, LAS float* scr, int part, int gw, int NGW, int lane) {
    const int l31 = lane & 31;
    constexpr int I_IN = 16 * 120, I_O = 16 * 32, I_13 = 16 * 176, I_2 = 44 * 32;
    if (part == 0) {
        for (int r = gw; r < I_IN; r += NGW) { const int kb = r / 120, nb = r % 120, n = nb * 32 + l31;
            const int oc = n < 1536 ? n : (n < 3584 ? n + 16 : (n < 3600 ? n - 3584 + 1536 : -1));
            tr_item(oc >= 0 ? c.in[5] + oc : nullptr, 3600, c.in[4], kb * 64, l31, c.WinT, 1024, nb * 32, scr, lane); }
        return;
    }
    for (int it = gw; it < I_O + I_13 + I_2; it += NGW) {
        int r = it;
        if (r < I_O) { const int kb = r / 32, nb = r % 32; tr_item(c.in[11] + nb * 32 + l31, 1024, nullptr, kb * 64, l31, c.WoT, 1024, nb * 32, scr, lane); continue; }
        r -= I_O;
        if (r < I_13) { const int kb = r / 176, nb = r % 176, t = nb >> 3, wb = nb & 7; const bool is3 = wb >= 4; const int hcol = 128 * t + 32 * (wb & 3) + l31;
            tr_item((is3 ? c.in[14] : c.in[13]) + hcol, 2816, c.in[12], kb * 64, l31, c.W13T, 1024, nb * 32, scr, lane); continue; }
        r -= I_13;
        { const int kb = r / 32, nb = r % 32; tr_item(c.in[15] + nb * 32 + l31, 1024, nullptr, kb * 64, l31, c.W2T, 2816, nb * 32, scr, lane); }
    }
}
__device__ __forceinline__ void p0_prologue(const Ptrs& c, LAS unsigned char* lds, int G, int wave, int lane, bool all_weights) {
    LAS float* scr = (LAS float*)(lds + wave * 16384);
    const int gw = blockIdx.x * NWAVES + wave, NGW = G * NWAVES;
    weight_items(c, scr, 0, gw, NGW, lane);
    if (all_weights) weight_items(c, scr, 1, gw, NGW, lane);
    {
        f32x4 v[4], nv[4];
        { const int m0 = gw < M ? gw : M - 1; const float* xr = m0 < MP ? c.in[0] + (size_t)m0 * D : c.in[1] + (size_t)(m0 - MP) * D;
#pragma unroll
          for (int j = 0; j < 4; ++j) v[j] = *(const f32x4*)(xr + 4 * lane + 256 * j); }
        for (int m = gw; m < M; m += NGW) {
            { const int mn = m + NGW < M ? m + NGW : m; const float* xr = mn < MP ? c.in[0] + (size_t)mn * D : c.in[1] + (size_t)(mn - MP) * D;
#pragma unroll
              for (int j = 0; j < 4; ++j) nv[j] = *(const f32x4*)(xr + 4 * lane + 256 * j); }
            float s = 0.f;
#pragma unroll
            for (int j = 0; j < 4; ++j) s += (v[j][0] * v[j][0] + v[j][1] * v[j][1]) + (v[j][2] * v[j][2] + v[j][3] * v[j][3]);
            s = wave_sum(s);
            const float rs = __builtin_amdgcn_rsqf(s * (1.0f / D) + EPS);
#pragma unroll
            for (int j = 0; j < 4; ++j) { u32x2 w; w.x = pk_bf16(v[j][0] * rs, v[j][1] * rs); w.y = pk_bf16(v[j][2] * rs, v[j][3] * rs); *(u32x2*)(c.XB + (size_t)m * D + 4 * lane + 256 * j) = w; }
#pragma unroll
            for (int j = 0; j < 4; ++j) v[j] = nv[j];
        }
    }
}

__device__ __forceinline__ int crow(int i, int h) { return (i & 3) + 8 * (i >> 2) + 4 * h; }
template <int K, bool GLA, bool ALLV>
__device__ __forceinline__ void pre_item(const Ptrs& c, int row0, int ntok, int hh, int item, bf16_t* kdt_base, int kdt_stride,
                                         const LAS float* wa2_l, const LAS float* ba_l, const LAS float* lb_l, LAS unsigned char* vt, int lane, bool dry) {
    const int r = lane & 31, kg = lane >> 5;
    const bool valid = ALLV || r < ntok;
    const int row = row0 + (valid ? r : 0), nt1 = ntok - 1;
    constexpr int NJ = K / 16;
    const int qcol0 = GLA ? hh * 64 : 1536 + hh * 128, kcol0 = 256 + hh * 64, vcol0 = GLA ? 512 + hh * 128 : 2560 + hh * 128, ocol0 = (GLA ? hh : 4 + hh) * 128;
    bf16_t* Prow = c.P + (size_t)row * PLD;
    LAS unsigned char* kt = vt + 8192;
    LAS unsigned char* dl = vt + 16384;
    float lra[16];
    if constexpr (GLA) {
#pragma unroll
        for (int i = 0; i < 4; ++i) { const f32x4 t = *(const f32x4*)(c.LRA + (size_t)row * 16 + 4 * i); lra[4 * i] = t[0]; lra[4 * i + 1] = t[1]; lra[4 * i + 2] = t[2]; lra[4 * i + 3] = t[3]; }
    }
    const bf16_t* qptr = Prow + qcol0 + 8 * kg;
    const bf16_t* kptr = Prow + kcol0 + 8 * kg;
    const float* fptr = c.FB + (size_t)row * 512 + hh * 128 + 8 * kg;
    u32x4 qn = *(const u32x4*)qptr, kn = {0u, 0u, 0u, 0u}; f32x4 fn0 = {0.f, 0.f, 0.f, 0.f}, fn1 = fn0;
    if constexpr (GLA) kn = *(const u32x4*)kptr; else { fn0 = *(const f32x4*)fptr; fn1 = *(const f32x4*)(fptr + 4); }
    f32x16 att;
#pragma unroll
    for (int i = 0; i < 16; ++i) att[i] = 0.f;
    float* dch = c.DCH + (size_t)item * 128;
#pragma unroll 1
    for (int j = 0; j < NJ; ++j) {
        const int cl = 16 * j + 8 * kg;
        const u32x4 qr = qn, kr = kn; const f32x4 f0 = fn0, f1 = fn1;
        { const int jn = j + 1 < NJ ? j + 1 : j;
          qn = *(const u32x4*)(qptr + 16 * jn);
          if constexpr (GLA) kn = *(const u32x4*)(kptr + 16 * jn); else { fn0 = *(const f32x4*)(fptr + 16 * jn); fn1 = *(const f32x4*)(fptr + 16 * jn + 4); } }
        float la[8], kv[8], qv[8];
        if constexpr (GLA) {
            const LAS float* wl = wa2_l + hh * 64 + cl;
            f32x4 a0 = *(const LAS f32x4*)(ba_l + hh * 64 + cl), a1 = *(const LAS f32x4*)(ba_l + hh * 64 + cl + 4);
#pragma unroll
            for (int rb = 0; rb < 16; rb += 4) {
                f32x4 w[8];
#pragma unroll
                for (int rr = 0; rr < 4; ++rr) { w[2 * rr] = *(const LAS f32x4*)(wl + (rb + rr) * 256); w[2 * rr + 1] = *(const LAS f32x4*)(wl + (rb + rr) * 256 + 4); }
#pragma unroll
                for (int rr = 0; rr < 4; ++rr) { a0 += w[2 * rr] * lra[rb + rr]; a1 += w[2 * rr + 1] * lra[rb + rr]; }
            }
            float x[8], t[8];
#pragma unroll
            for (int e = 0; e < 8; ++e) x[e] = e < 4 ? a0[e & 3] : a1[e & 3];
#pragma unroll
            for (int e = 0; e < 8; ++e) t[e] = __expf(-fabsf(x[e]));
#pragma unroll
            for (int e = 0; e < 8; ++e) t[e] = __logf(1.0f + t[e]);
#pragma unroll
            for (int e = 0; e < 8; ++e) la[e] = (fminf(x[e], 0.f) - t[e]) * 0.0625f;
            kv[0] = bf_lo(kr.x); kv[1] = bf_hi(kr.x); kv[2] = bf_lo(kr.y); kv[3] = bf_hi(kr.y); kv[4] = bf_lo(kr.z); kv[5] = bf_hi(kr.z); kv[6] = bf_lo(kr.w); kv[7] = bf_hi(kr.w);
        } else {
            const f32x4 l0 = *(const LAS f32x4*)(lb_l + hh * 128 + cl), l1 = *(const LAS f32x4*)(lb_l + hh * 128 + cl + 4);
            float x[8], lbv[8], ex[8], inv[8];
#pragma unroll
            for (int e = 0; e < 8; ++e) { x[e] = e < 4 ? f0[e & 3] : f1[e & 3]; lbv[e] = e < 4 ? l0[e & 3] : l1[e & 3]; }
#pragma unroll
            for (int e = 0; e < 8; ++e) ex[e] = __expf(-fabsf(x[e]));
#pragma unroll
            for (int e = 0; e < 8; ++e) inv[e] = __builtin_amdgcn_rcpf(1.0f + ex[e]);
#pragma unroll
            for (int e = 0; e < 8; ++e) { const float ei = ex[e] * inv[e]; const float sg = x[e] >= 0.f ? inv[e] : ei, ng = x[e] >= 0.f ? ei : inv[e];
                la[e] = lbv[e] + (1.0f - lbv[e]) * sg; kv[e] = (1.0f - lbv[e]) * ng; }
        }
        qv[0] = bf_lo(qr.x); qv[1] = bf_hi(qr.x); qv[2] = bf_lo(qr.y); qv[3] = bf_hi(qr.y); qv[4] = bf_lo(qr.z); qv[5] = bf_hi(qr.z); qv[6] = bf_lo(qr.w); qv[7] = bf_hi(qr.w);
        float qi[8], ki[8], kd[8], eb[8], q[8], ea[8], ia[8];
        if constexpr (GLA) {
#pragma unroll
            for (int e = 0; e < 8; ++e) q[e] = qv[e] * 0.125f;
        } else {
#pragma unroll
            for (int e = 0; e < 8; ++e) q[e] = __expf(-qv[e]);
#pragma unroll
            for (int e = 0; e < 8; ++e) q[e] = __builtin_amdgcn_rcpf(1.0f + q[e]);
#pragma unroll
            for (int e = 0; e < 8; ++e) q[e] *= qv[e];
        }
        if (!ALLV) {
#pragma unroll
            for (int e = 0; e < 8; ++e) if (!valid) { q[e] = 0.f; kv[e] = 0.f; la[e] = GLA ? 0.f : 1.f; }
        }
        if constexpr (GLA) {
#pragma unroll
            for (int e = 0; e < 8; ++e) la[e] += dpp_f<0x111, 0xF>(la[e]);
#pragma unroll
            for (int e = 0; e < 8; ++e) la[e] += dpp_f<0x112, 0xF>(la[e]);
#pragma unroll
            for (int e = 0; e < 8; ++e) la[e] += dpp_f<0x114, 0xF>(la[e]);
#pragma unroll
            for (int e = 0; e < 8; ++e) la[e] += dpp_f<0x118, 0xF>(la[e]);
#pragma unroll
            for (int e = 0; e < 8; ++e) la[e] += dpp_f<0x142, 0xA>(la[e]);
#pragma unroll
            for (int e = 0; e < 8; ++e) ea[e] = __expf(fmaxf(la[e], -80.f));
        } else {
#pragma unroll
            for (int e = 0; e < 8; ++e) la[e] *= dpp_f1<0x111, 0xF>(la[e]);
#pragma unroll
            for (int e = 0; e < 8; ++e) la[e] *= dpp_f1<0x112, 0xF>(la[e]);
#pragma unroll
            for (int e = 0; e < 8; ++e) la[e] *= dpp_f1<0x114, 0xF>(la[e]);
#pragma unroll
            for (int e = 0; e < 8; ++e) la[e] *= dpp_f1<0x118, 0xF>(la[e]);
#pragma unroll
            for (int e = 0; e < 8; ++e) la[e] *= dpp_f1<0x142, 0xA>(la[e]);
#pragma unroll
            for (int e = 0; e < 8; ++e) ea[e] = fmaxf(la[e], 1e-35f);
        }
#pragma unroll
        for (int e = 0; e < 8; ++e) ia[e] = __builtin_amdgcn_rcpf(ea[e]);
#pragma unroll
        for (int e = 0; e < 8; ++e) { const float e31 = lane_bcast(ea[e], 31), e63 = lane_bcast(ea[e], 63); eb[e] = kg ? e63 : e31; }
#pragma unroll
        for (int e = 0; e < 8; ++e) { qi[e] = q[e] * ea[e]; ki[e] = kv[e] * ia[e]; kd[e] = ki[e] * eb[e]; }
        u32x4 qp, kp;
        qp.x = pk_bf16(qi[0], qi[1]); qp.y = pk_bf16(qi[2], qi[3]); qp.z = pk_bf16(qi[4], qi[5]); qp.w = pk_bf16(qi[6], qi[7]);
        kp.x = pk_bf16(ki[0], ki[1]); kp.y = pk_bf16(ki[2], ki[3]); kp.z = pk_bf16(ki[4], ki[5]); kp.w = pk_bf16(ki[6], ki[7]);
        att = MFMA32(__builtin_bit_cast(bf16x8, kp), __builtin_bit_cast(bf16x8, qp), att);
        *(LAS u32x4*)(vt + r * (K * 2) + ((((cl >> 3) ^ r) & (K / 8 - 1)) << 4)) = qp;
#pragma unroll
        for (int e = 0; e < 8; e += 2) {
            const unsigned pkd = pk_bf16(kd[e], kd[e + 1]);
            *(LAS unsigned short*)(kt + (cl + e) * 64 + r * 2) = (unsigned short)(pkd & 0xffffu);
            *(LAS unsigned short*)(kt + (cl + e + 1) * 64 + r * 2) = (unsigned short)(pkd >> 16);
        }
        if (r == 0) { f32x4 d0 = {eb[0], eb[1], eb[2], eb[3]}, d1 = {eb[4], eb[5], eb[6], eb[7]}; *(LAS f32x4*)(dl + cl * 4) = d0; *(LAS f32x4*)(dl + cl * 4 + 16) = d1; }
    }
    u32x4 vreg[8];
#pragma unroll
    for (int i = 0; i < 8; ++i) { const int p = lane + 64 * i, vr = (p >> 4) < nt1 ? (p >> 4) : nt1; vreg[i] = *(const u32x4*)(c.P + (size_t)(row0 + vr) * PLD + vcol0 + (p & 15) * 8); }
#pragma unroll
    for (int i = 0; i < K / 16; ++i) {
        const int p = lane + 64 * i, L = p * 8, qr_ = p / (K / 8), qc_ = p % (K / 8);
        if ((ALLV || qr_ < ntok) && !dry) *(u32x4*)(c.P + (size_t)(row0 + qr_) * PLD + qcol0 + qc_ * 8) = *(const LAS u32x4*)(vt + qr_ * (K * 2) + (((qc_ ^ qr_) & (K / 8 - 1)) << 4));
        *(u32x4*)(kdt_base + (size_t)(L / K) * kdt_stride + (L % K)) = *(const LAS u32x4*)(kt + p * 16);
    }
    if (lane < K / 4) *(f32x4*)(dch + lane * 4) = *(const LAS f32x4*)(dl + lane * 16);
#pragma unroll
    for (int i = 0; i < 8; ++i) { const int p = lane + 64 * i; *(LAS u32x4*)(vt + (p >> 4) * 256 + (p & 15) * 16) = vreg[i]; }
#pragma unroll
    for (int i = 0; i < 16; ++i) if (crow(i, kg) > r) att[i] = 0.f;
    u32x4 pa0, pa1;
    pa0.x = pk_bf16(att[0], att[1]); pa0.y = pk_bf16(att[2], att[3]); pa0.z = pk_bf16(att[4], att[5]); pa0.w = pk_bf16(att[6], att[7]);
    pa1.x = pk_bf16(att[8], att[9]); pa1.y = pk_bf16(att[10], att[11]); pa1.z = pk_bf16(att[12], att[13]); pa1.w = pk_bf16(att[14], att[15]);
#pragma unroll 1
    for (int vb = 0; vb < 4; ++vb) {
        unsigned short vs[16];
#pragma unroll
        for (int i = 0; i < 16; ++i) vs[i] = *(const LAS unsigned short*)(vt + crow(i, kg) * 256 + (vb * 32 + r) * 2);
        u32x4 b0, b1;
        b0.x = vs[0] | ((unsigned)vs[1] << 16); b0.y = vs[2] | ((unsigned)vs[3] << 16); b0.z = vs[4] | ((unsigned)vs[5] << 16); b0.w = vs[6] | ((unsigned)vs[7] << 16);
        b1.x = vs[8] | ((unsigned)vs[9] << 16); b1.y = vs[10] | ((unsigned)vs[11] << 16); b1.z = vs[12] | ((unsigned)vs[13] << 16); b1.w = vs[14] | ((unsigned)vs[15] << 16);
        f32x16 o;
#pragma unroll
        for (int i = 0; i < 16; ++i) o[i] = 0.f;
        o = MFMA32(__builtin_bit_cast(bf16x8, pa0), __builtin_bit_cast(bf16x8, b0), o);
        o = MFMA32(__builtin_bit_cast(bf16x8, pa1), __builtin_bit_cast(bf16x8, b1), o);
#pragma unroll
        for (int i = 0; i < 16; ++i) *(LAS unsigned short*)(kt + crow(i, kg) * 256 + (vb * 32 + r) * 2) = (unsigned short)(pk_bf16(o[i], 0.f) & 0xffffu);
    }
#pragma unroll
    for (int i = 0; i < 8; ++i) {
        const int p = lane + 64 * i, t = p >> 4;
        if (t < ntok) *(u32x4*)(c.OI + (size_t)(row0 + t) * 1024 + ocol0 + (p & 15) * 8) = *(const LAS u32x4*)(kt + p * 16);
    }
}
__device__ __forceinline__ void p2_prepass(const Ptrs& c, LAS unsigned char* lds, int G, int tid, int wave, int lane, bool dry) {
    LAS float* wa2_l = (LAS float*)lds; LAS float* ba_l = wa2_l + 4096; LAS float* lb_l = ba_l + 256;
    for (int i = tid; i < 4096; i += NTHR) wa2_l[i] = c.in[6][i];
    if (tid < 256) ba_l[tid] = c.in[7][tid];
    { const float p0 = c.in[8][tid], p1 = c.in[8][512 + tid]; lb_l[tid] = 1.0f / (1.0f + __expf(p1 - p0)); }
    WG_BAR();
    const int gw = blockIdx.x * NWAVES + wave, NGW = G * NWAVES;
    const bool bal = (G == 256);
    const int n_it = bal ? 4096 : 4096 + 1024;
    for (int it0 = gw; ; it0 += NGW) {
        int it = it0;
        if (it0 >= n_it) { if (!bal || wave >= 4 || it0 >= n_it + NGW) break; it = 4096 + blockIdx.x * 4 + wave; }
        int row0, ntok, h; bf16_t* kdt; int kst;
        if (it < 4096) { h = it & 7; const int ch = (it >> 3) & 63, b = it >> 9; row0 = b * 2048 + ch * 32; ntok = 32; kst = PLD;
                         kdt = c.P + (size_t)row0 * PLD + (h < 4 ? 256 + h * 64 : 2048 + (h - 4) * 128); }
        else { const int j = it - 4096; h = j & 7; row0 = MP + (j >> 3) * 8; ntok = 8; kst = h < 4 ? 64 : 128; kdt = c.KDTS + (size_t)j * 4096; }
        if (dry) { kst = h < 4 ? 64 : 128; kdt = (bf16_t*)((unsigned char*)c.DUMP + 203 * MiB) + (size_t)(it & 2047) * 4096; }
        if (it < 4096) { if (h < 4) pre_item<64, true, true>(c, row0, ntok, h, it, kdt, kst, wa2_l, ba_l, lb_l, lds + 20480 + wave * 16896, lane, dry);
                         else pre_item<128, false, true>(c, row0, ntok, h - 4, it, kdt, kst, wa2_l, ba_l, lb_l, lds + 20480 + wave * 16896, lane, dry); }
        else { if (h < 4) pre_item<64, true, false>(c, row0, ntok, h, it, kdt, kst, wa2_l, ba_l, lb_l, lds + 20480 + wave * 16896, lane, dry);
               else pre_item<128, false, false>(c, row0, ntok, h - 4, it, kdt, kst, wa2_l, ba_l, lb_l, lds + 20480 + wave * 16896, lane, dry); }
    }
}

template <int K>
__device__ __forceinline__ void seq_item(const Ptrs& c, LAS unsigned char* lds, int row0, int nch, int ntok, int h8, int colbase, int ncw, const float* S0, float* Sout,
                                         const bf16_t* kdt0, int kdt_rstride, size_t kdt_cstep, const float* dch0, size_t dch_cstep, int tid, int wave, int lane) {
    constexpr int QROW = 2 * K + 16, VROW = 272;
    constexpr int KOFF = 8704, DOFF = 18944, VOFF = 19456, BUFB = 28160, NMB = K / 16, NPC = 4 * K;
    const int n = lane & 15, q = lane >> 4, col = colbase + 16 * (wave < ncw ? wave : 0) + n;
    const bool cw = wave < ncw;
    const bool gla = h8 < 4; const int hh = h8 & 3;
    const int qcol0 = gla ? hh * 64 : 1536 + hh * 128, vcol0 = gla ? 512 + hh * 128 : 2560 + hh * 128, ocol = h8 * 128 + col;
    f32x4 S[NMB];
#pragma unroll
    for (int mb = 0; mb < NMB; ++mb)
#pragma unroll
        for (int i = 0; i < 4; ++i) S[mb][i] = (S0 && cw) ? S0[(size_t)(16 * mb + 4 * q + i) * 128 + col] : 0.f;
    const int nt1 = ntok - 1;
    const int pq = tid % NPC, prow_q = pq / (K / 8), pc8 = pq % (K / 8), prq = prow_q < nt1 ? prow_q : nt1;
    const int vrow = tid >> 4, vc8 = tid & 15, vr = vrow < nt1 ? vrow : nt1;
    const int dpi = tid % (K / 4);
    const bf16_t* gq = c.P + (size_t)(row0 + prq) * PLD + qcol0 + pc8 * 8;
    const bf16_t* gk = kdt0 + (size_t)prow_q * kdt_rstride + pc8 * 8;
    const float* gd = dch0 + dpi * 4;
    const bf16_t* gvp = c.P + (size_t)(row0 + vr) * PLD + vcol0 + vc8 * 8;
    struct Stage { u32x4 q, k, v; f32x4 d; };
    const int nch1 = nch - 1;
#define SEQ_LOAD(R, cc) do { const int c_ = (cc) < nch1 ? (cc) : nch1; const size_t ro_ = (size_t)c_ * 32; \
        R.q = *(const u32x4*)(gq + ro_ * PLD); R.k = *(const u32x4*)(gk + (size_t)c_ * kdt_cstep); R.d = *(const f32x4*)(gd + (size_t)c_ * dch_cstep); \
        R.v = *(const u32x4*)(gvp + ro_ * PLD); } while (0)
#define SEQ_STORE(R, buf) do { LAS unsigned char* B_ = lds + (buf) * BUFB; \
        *(LAS u32x4*)(B_ + prow_q * QROW + pc8 * 16) = R.q; *(LAS u32x4*)(B_ + KOFF + (pq >> 2) * 80 + (pq & 3) * 16) = R.k; *(LAS f32x4*)(B_ + DOFF + dpi * 16) = R.d; \
        *(LAS u32x4*)(B_ + VOFF + vrow * VROW + vc8 * 16) = R.v; } while (0)
#define SEQ_ITER(ci, buf, RST) do { \
        const LAS unsigned char* B = lds + (buf) * BUFB; \
        if (cw) { \
        f32x4 o[2] = {{0.f, 0.f, 0.f, 0.f}, {0.f, 0.f, 0.f, 0.f}}; \
        _Pragma("unroll") for (int js = 0; js < K / 32; ++js) { \
            u32x4 sb; sb.x = pk_bf16(S[2 * js][0], S[2 * js][1]); sb.y = pk_bf16(S[2 * js][2], S[2 * js][3]); sb.z = pk_bf16(S[2 * js + 1][0], S[2 * js + 1][1]); sb.w = pk_bf16(S[2 * js + 1][2], S[2 * js + 1][3]); \
            _Pragma("unroll") for (int mb2 = 0; mb2 < 2; ++mb2) { \
                const LAS unsigned char* qp = B + (16 * mb2 + n) * QROW + (32 * js + 4 * q) * 2; \
                const u32x2 lo = *(const LAS u32x2*)qp, hi = *(const LAS u32x2*)(qp + 32); \
                u32x4 qa; qa.x = lo.x; qa.y = lo.y; qa.z = hi.x; qa.w = hi.y; \
                o[mb2] = MFMA16(__builtin_bit_cast(bf16x8, qa), __builtin_bit_cast(bf16x8, sb), o[mb2]); } } \
        { unsigned short vs[8]; \
            _Pragma("unroll") for (int j = 0; j < 8; ++j) vs[j] = *(const LAS unsigned short*)(B + VOFF + (8 * q + j) * VROW + col * 2); \
            u32x4 vb; vb.x = vs[0] | ((unsigned)vs[1] << 16); vb.y = vs[2] | ((unsigned)vs[3] << 16); vb.z = vs[4] | ((unsigned)vs[5] << 16); vb.w = vs[6] | ((unsigned)vs[7] << 16); \
            _Pragma("unroll") for (int mb = 0; mb < NMB; ++mb) { \
                const u32x4 ka = *(const LAS u32x4*)(B + KOFF + (16 * mb + n) * 80 + q * 16); \
                const f32x4 dv = *(const LAS f32x4*)(B + DOFF + (16 * mb + 4 * q) * 4); \
                S[mb] = S[mb] * dv; \
                S[mb] = MFMA16(__builtin_bit_cast(bf16x8, ka), __builtin_bit_cast(bf16x8, vb), S[mb]); } } \
        bf16_t* ob = c.OX + (size_t)(row0 + 32 * (ci)) * 1024 + ocol; \
        _Pragma("unroll") for (int x = 0; x < 8; x += 2) { \
            const int t = 16 * (x >> 2) + 4 * q + (x & 3); const unsigned pv = pk_bf16(o[x >> 2][x & 3], o[x >> 2][(x & 3) + 1]); \
            bf16_t* d0 = t < ntok ? ob + (size_t)t * 1024 : c.DUMP + tid; bf16_t* d1 = t + 1 < ntok ? ob + (size_t)(t + 1) * 1024 : c.DUMP + tid; \
            *d0 = (bf16_t)(pv & 0xffffu); *d1 = (bf16_t)(pv >> 16); } \
        } \
        WG_BAR(); \
        SEQ_STORE(RST, buf); \
    } while (0)
    Stage R0, R1, R2, R3;
    SEQ_LOAD(R0, 0); SEQ_STORE(R0, 0);
    SEQ_LOAD(R1, 1); SEQ_LOAD(R2, 2); SEQ_LOAD(R3, 3); SEQ_LOAD(R0, 4);
    SEQ_STORE(R1, 1);
    WG_BAR();
    for (int ci = 0; ci < nch; ci += 4) {
        SEQ_LOAD(R1, ci + 5); SEQ_ITER(ci, 0, R2);
        if (ci + 1 >= nch) break;
        SEQ_LOAD(R2, ci + 6); SEQ_ITER(ci + 1, 1, R3);
        if (ci + 2 >= nch) break;
        SEQ_LOAD(R3, ci + 7); SEQ_ITER(ci + 2, 0, R0);
        if (ci + 3 >= nch) break;
        SEQ_LOAD(R0, ci + 8); SEQ_ITER(ci + 3, 1, R1);
    }
    if (cw) {
#pragma unroll
    for (int mb = 0; mb < NMB; ++mb)
#pragma unroll
        for (int i = 0; i < 4; ++i) Sout[(size_t)(16 * mb + 4 * q + i) * 128 + col] = S[mb][i];
    }
    WG_BAR();
#undef SEQ_LOAD
#undef SEQ_STORE
#undef SEQ_ITER
}
__device__ __forceinline__ void seq_dispatch(const Ptrs& c, LAS unsigned char* lds, int item, int tid, int wave, int lane) {
    int row0, nch, ntok, h8, colbase, ncw; const float* S0; float* Sout; const bf16_t* kdt0; int kst; size_t kcs, dcs; const float* dch0;
    if (item < 128) {
        const int bh = item >> 1, b = bh >> 3; h8 = bh & 7; const int hh = h8 & 3; row0 = b * 2048; nch = 64; ntok = 32; S0 = nullptr; colbase = (item & 1) * 64; ncw = 4;
        Sout = h8 < 4 ? c.out + OUT_SAP + (size_t)(b * 4 + hh) * 64 * 128 : c.out + OUT_SBP + (size_t)(b * 4 + hh) * 128 * 128;
        kdt0 = c.P + (size_t)row0 * PLD + (h8 < 4 ? 256 + hh * 64 : 2048 + hh * 128); kst = PLD; kcs = (size_t)32 * PLD;
        dch0 = c.DCH + (size_t)(b * 64 * 8 + h8) * 128; dcs = 8 * 128;
    } else {
        const int j = item - 128, b = j >> 3; h8 = j & 7; const int hh = h8 & 3; row0 = MP + b * 8; nch = 1; ntok = 8; colbase = 0; ncw = 8;
        S0 = h8 < 4 ? c.in[2] + (size_t)(b * 4 + hh) * 64 * 128 : c.in[3] + (size_t)(b * 4 + hh) * 128 * 128;
        Sout = h8 < 4 ? c.out + OUT_SAS + (size_t)(b * 4 + hh) * 64 * 128 : c.out + OUT_SBS + (size_t)(b * 4 + hh) * 128 * 128;
        kdt0 = c.KDTS + (size_t)j * 4096; kst = h8 < 4 ? 64 : 128; kcs = 0; dch0 = c.DCH + (size_t)(4096 + j) * 128; dcs = 0;
    }
    if (h8 < 4) seq_item<64>(c, lds, row0, nch, ntok, h8, colbase, ncw, S0, Sout, kdt0, kst, kcs, dch0, dcs, tid, wave, lane);
    else seq_item<128>(c, lds, row0, nch, ntok, h8, colbase, ncw, S0, Sout, kdt0, kst, kcs, dch0, dcs, tid, wave, lane);
}
__device__ __forceinline__ void p3b_finalize(const Ptrs& c, int G, int wave, int lane) {
    const int gw = blockIdx.x * NWAVES + wave, NGW = G * NWAVES, h8 = lane >> 3, cw = (lane & 7) * 16;
    const float* gp = (h8 < 4 ? c.in[9] : c.in[10]) + cw;
    f32x4 gn[4];
#pragma unroll
    for (int j = 0; j < 4; ++j) gn[j] = *(const f32x4*)(gp + 4 * j);
    const int gcol = (h8 < 4 ? 1024 + h8 * 128 : 3072 + (h8 - 4) * 128) + cw;
    u32x4 nx[2], ng[2], noi[2];
    { const int m0 = gw < M ? gw : M - 1;
#pragma unroll
      for (int j = 0; j < 2; ++j) { noi[j] = *(const u32x4*)(c.OI + (size_t)m0 * 1024 + lane * 16 + 8 * j); nx[j] = *(const u32x4*)(c.OX + (size_t)m0 * 1024 + lane * 16 + 8 * j); ng[j] = *(const u32x4*)(c.P + (size_t)m0 * PLD + gcol + 8 * j); } }
    for (int m = gw; m < M; m += NGW) {
        f32x4 o[4]; u32x4 x[2], g[2], oi[2];
#pragma unroll
        for (int j = 0; j < 2; ++j) { oi[j] = noi[j]; x[j] = nx[j]; g[j] = ng[j]; }
        { const int mn = m + NGW < M ? m + NGW : m;
#pragma unroll
          for (int j = 0; j < 2; ++j) { noi[j] = *(const u32x4*)(c.OI + (size_t)mn * 1024 + lane * 16 + 8 * j); nx[j] = *(const u32x4*)(c.OX + (size_t)mn * 1024 + lane * 16 + 8 * j); ng[j] = *(const u32x4*)(c.P + (size_t)mn * PLD + gcol + 8 * j); } }
        o[0][0] = bf_lo(oi[0].x); o[0][1] = bf_hi(oi[0].x); o[0][2] = bf_lo(oi[0].y); o[0][3] = bf_hi(oi[0].y); o[1][0] = bf_lo(oi[0].z); o[1][1] = bf_hi(oi[0].z); o[1][2] = bf_lo(oi[0].w); o[1][3] = bf_hi(oi[0].w);
        o[2][0] = bf_lo(oi[1].x); o[2][1] = bf_hi(oi[1].x); o[2][2] = bf_lo(oi[1].y); o[2][3] = bf_hi(oi[1].y); o[3][0] = bf_lo(oi[1].z); o[3][1] = bf_hi(oi[1].z); o[3][2] = bf_lo(oi[1].w); o[3][3] = bf_hi(oi[1].w);
        float ss = 0.f;
#pragma unroll
        for (int j = 0; j < 4; ++j) {
            const unsigned w0 = j < 2 ? (j == 0 ? x[0].x : x[0].z) : (j == 2 ? x[1].x : x[1].z), w1 = j < 2 ? (j == 0 ? x[0].y : x[0].w) : (j == 2 ? x[1].y : x[1].w);
            o[j][0] += bf_lo(w0); o[j][1] += bf_hi(w0); o[j][2] += bf_lo(w1); o[j][3] += bf_hi(w1);
            ss += (o[j][0] * o[j][0] + o[j][1] * o[j][1]) + (o[j][2] * o[j][2] + o[j][3] * o[j][3]);
        }
        ss += dpp_f<0xB1, 0xF>(ss); ss += dpp_f<0x4E, 0xF>(ss); ss += dpp_f<0x141, 0xF>(ss);
        const float rs = __builtin_amdgcn_rsqf(ss * (1.0f / 128.0f) + EPS);
        u32x4 w[2];
#pragma unroll
        for (int j = 0; j < 4; ++j) {
            const unsigned g0 = j < 2 ? (j == 0 ? g[0].x : g[0].z) : (j == 2 ? g[1].x : g[1].z), g1 = j < 2 ? (j == 0 ? g[0].y : g[0].w) : (j == 2 ? g[1].y : g[1].w);
            float gg[4] = {bf_lo(g0), bf_hi(g0), bf_lo(g1), bf_hi(g1)}, v[4];
#pragma unroll
            for (int e = 0; e < 4; ++e) v[e] = o[j][e] * rs * gn[j][e] * (gg[e] * __builtin_amdgcn_rcpf(1.0f + __expf(-gg[e])));
            const unsigned p0 = pk_bf16(v[0], v[1]), p1 = pk_bf16(v[2], v[3]);
            if (j == 0) { w[0].x = p0; w[0].y = p1; } else if (j == 1) { w[0].z = p0; w[0].w = p1; } else if (j == 2) { w[1].x = p0; w[1].y = p1; } else { w[1].z = p0; w[1].w = p1; }
        }
        *(u32x4*)(c.OF + (size_t)m * 1024 + lane * 16) = w[0]; *(u32x4*)(c.OF + (size_t)m * 1024 + lane * 16 + 8) = w[1];
    }
}
#define XB_TMO      128
#define XB_XCNT(j)  (256  + 64 * (j))
#define XB_XSUB(j)  (1280 + 64 * (j))
#define XB_XGEN(j)  (2304 + 64 * (j))
#define XB_TOP      3328
#define XB_TOPGEN   3392
#define XCD_BAR_WORDS 3456
#define XB_SPIN_CAP (1u << 18)

__device__ __forceinline__ unsigned xb_ld(unsigned* p)              { return __hip_atomic_load(p, __ATOMIC_RELAXED, __HIP_MEMORY_SCOPE_AGENT); }
__device__ __forceinline__ unsigned xb_add(unsigned* p, unsigned v) { return __hip_atomic_fetch_add(p, v, __ATOMIC_RELAXED, __HIP_MEMORY_SCOPE_AGENT); }
__device__ __forceinline__ unsigned xb_xcc_id() { return (unsigned)__builtin_amdgcn_s_getreg((3 << 11) | 20) & 0xFu; }
#define XB_SPIN(cond, bar) do { unsigned _sp = 0; while (cond) { __builtin_amdgcn_s_sleep(1); \
    if ((++_sp & 255u) == 0u) { if (xb_ld(&(bar)[XB_TMO])) break; if (_sp > XB_SPIN_CAP) { atomicAdd(&(bar)[XB_TMO], 1u); break; } } } } while (0)

struct XcdBarrier {
    unsigned* bar; unsigned x;
    volatile LAS unsigned* st;
};

__device__ __forceinline__ XcdBarrier xcd_barrier_post(unsigned* bar, volatile LAS unsigned* st) {
    XcdBarrier b; b.bar = bar; b.x = xb_xcc_id(); b.st = st;
    if (threadIdx.x == 0) (void)xb_add(&bar[XB_XCNT(b.x)], 1u);
    return b;
}
__device__ __forceinline__ void xcd_barrier_complete(unsigned* bar, unsigned x, unsigned& nloc, unsigned& nx) {
    const unsigned G = gridDim.x * gridDim.y * gridDim.z;
    unsigned sum, cnt, mine, sp = 0u;
    for (;;) {
        sum = 0u; cnt = 0u; mine = 0u;
#pragma unroll
        for (unsigned j = 0; j < 16; ++j) { const unsigned c = xb_ld(&bar[XB_XCNT(j)]); sum += c; cnt += (c > 0u) ? 1u : 0u; mine = (j == x) ? c : mine; }
        if (sum == G) break;
        __builtin_amdgcn_s_sleep(1);
        if ((++sp & 255u) == 0u) { if (xb_ld(&bar[XB_TMO])) break; if (sp > XB_SPIN_CAP) { atomicAdd(&bar[XB_TMO], 1u); break; } }
    }
    nloc = mine > 0u ? mine : 1u; nx = cnt > 0u ? cnt : 1u;
}

__device__ __forceinline__ void xcd_barrier(const XcdBarrier& b) {
    asm volatile("s_waitcnt vmcnt(0)" ::: "memory");
    __syncthreads();
    if (threadIdx.x == 0) {
        unsigned* bar = b.bar;
        __builtin_amdgcn_s_waitcnt(0);
        unsigned nloc = b.st[0], nx = b.st[1];
        if (nloc == 0u) { xcd_barrier_complete(bar, b.x, nloc, nx); b.st[0] = nloc; b.st[1] = nx; }
        const unsigned old = xb_add(&bar[XB_XSUB(b.x)], 1u);
        const unsigned gen = old / nloc;
        if (old + 1u == (gen + 1u) * nloc) {
            __builtin_amdgcn_fence(__ATOMIC_RELEASE, "agent");
            asm volatile("s_waitcnt vmcnt(0)" ::: "memory");
            const unsigned og = xb_add(&bar[XB_TOP], 1u);
            const unsigned tg = og / nx;
            if (og + 1u == (tg + 1u) * nx) xb_add(&bar[XB_TOPGEN], 1u);
            else XB_SPIN(xb_ld(&bar[XB_TOPGEN]) == tg, bar);
            __builtin_amdgcn_fence(__ATOMIC_ACQUIRE, "agent");
            xb_add(&bar[XB_XGEN(b.x)], 1u);
            asm volatile("s_waitcnt vmcnt(0)" ::: "memory");
        } else {
            XB_SPIN(xb_ld(&bar[XB_XGEN(b.x)]) == gen, bar);
            __builtin_amdgcn_fence(__ATOMIC_ACQUIRE, "agent");
            asm volatile("s_waitcnt vmcnt(0)" ::: "memory");
        }
    }
    __syncthreads();
}


struct EpiRes2Norm {
    static constexpr bool PERM = true, AFTER_DRAIN = true;
    float* Y; const bf16_t* X1B; float* SSQ; const float* gfin; XcdBarrier xb;
    __device__ __forceinline__ void fused(pg8::f32x4 (&acc)[2][2][4][2], const pg8::Unit& u, int wr, int wc, int fr, int fq, LAS unsigned char* lds, int wid, int lane) const {
        using pg8::BM; using pg8::HALF;
        const int row0 = u.pm * BM + wr * 64 + fr, ct = u.pn * BM + wc * 32 + 8 * fq;
        LAS float* ssl = (LAS float*)lds;
        f32x4 gv[2][2];
#pragma unroll
        for (int bj = 0; bj < 2; ++bj) { gv[bj][0] = *(const f32x4*)(gfin + ct + bj * HALF); gv[bj][1] = *(const f32x4*)(gfin + ct + bj * HALF + 4); }
#pragma unroll
        for (int ai = 0; ai < 2; ++ai) {
            pg8::u32x4 xr[4][2];
#pragma unroll
            for (int m = 0; m < 4; ++m)
#pragma unroll
                for (int bj = 0; bj < 2; ++bj) xr[m][bj] = *(const pg8::u32x4*)(X1B + (size_t)(row0 + ai * HALF + m * 16) * 1024 + ct + bj * HALF);
#pragma unroll
            for (int m = 0; m < 4; ++m) {
                float ss = 0.f;
#pragma unroll
                for (int bj = 0; bj < 2; ++bj) {
                    const pg8::u32x4 x = xr[m][bj];
                    acc[ai][bj][m][0] += (f32x4){bf_lo(x.x), bf_hi(x.x), bf_lo(x.y), bf_hi(x.y)}; acc[ai][bj][m][1] += (f32x4){bf_lo(x.z), bf_hi(x.z), bf_lo(x.w), bf_hi(x.w)};
                    const f32x4 v0 = acc[ai][bj][m][0], v1 = acc[ai][bj][m][1];
                    ss += (v0[0] * v0[0] + v0[1] * v0[1]) + (v0[2] * v0[2] + v0[3] * v0[3]) + (v1[0] * v1[0] + v1[1] * v1[1]) + (v1[2] * v1[2] + v1[3] * v1[3]);
                }
                ss += __shfl_xor(ss, 16); ss += __shfl_xor(ss, 32);
                if (fq == 0) ssl[(ai * HALF + wr * 64 + m * 16 + fr) * 4 + wc] = ss;
            }
        }
        WG_BAR();
        { const int t = wid * 64 + lane; if (t < 256) { const f32x4 p = *(const LAS f32x4*)(ssl + t * 4); SSQ[(size_t)(u.pm * BM + t) * 4 + u.pn] = (p[0] + p[1]) + (p[2] + p[3]); } }
        xcd_barrier(xb);
        f32x4 st[2][4];
#pragma unroll
        for (int ai = 0; ai < 2; ++ai)
#pragma unroll
            for (int m = 0; m < 4; ++m) st[ai][m] = *(const f32x4*)(SSQ + (size_t)(row0 + ai * HALF + m * 16) * 4);
#pragma unroll
        for (int ai = 0; ai < 2; ++ai)
#pragma unroll
            for (int m = 0; m < 4; ++m) {
                float* yr = Y + (size_t)(row0 + ai * HALF + m * 16) * 1024;
                const float rs = __builtin_amdgcn_rsqf(((st[ai][m][0] + st[ai][m][1]) + (st[ai][m][2] + st[ai][m][3])) * (1.0f / 1024.0f) + EPS);
#pragma unroll
                for (int bj = 0; bj < 2; ++bj) {
                    const int col = ct + bj * HALF;
                    *(f32x4*)(yr + col) = acc[ai][bj][m][0] * rs * gv[bj][0]; *(f32x4*)(yr + col + 4) = acc[ai][bj][m][1] * rs * gv[bj][1];
                }
            }
    }
};

struct Args { const float* in[17]; float* out; unsigned char* ws; int ph_lo, ph_hi, aux, pad; };
constexpr int NPHASE = 9;
__device__ __forceinline__ void fill_ptrs(Ptrs& c, const Args& args) {
#pragma unroll
    for (int i = 0; i < 17; ++i) c.in[i] = args.in[i];
    c.out = args.out;
    unsigned char* ws = args.ws;
    c.WinT = (bf16_t*)(ws + WS_WIN); c.WoT = (bf16_t*)(ws + WS_WO); c.W13T = (bf16_t*)(ws + WS_W13); c.W2T = (bf16_t*)(ws + WS_W2);
    c.XB = (bf16_t*)(ws + WS_XB); c.OF = (bf16_t*)(ws + WS_XB); c.P = (bf16_t*)(ws + WS_P); c.HID = (bf16_t*)(ws + WS_P); c.KDTS = (bf16_t*)(ws + WS_KDTS);
    c.X1B = (bf16_t*)(ws + WS_FB); c.FB = (float*)(ws + WS_FB);
    c.RSTD1 = (float*)(ws + WS_RSTD1); c.SSQ2 = (float*)(ws + WS_SSQ2); c.LRA = (float*)(ws + WS_LRA); c.DCH = (float*)(ws + WS_DCH); c.OY = args.out + OUT_Y; c.DUMP = (bf16_t*)(ws + 30 * MiB); c.OX = (bf16_t*)(ws + WS_FB); c.OI = (bf16_t*)(ws + WS_XB); c.PART = (bf16_t*)(ws + 208 * MiB); c.PART4 = (bf16_t*)(ws + WS_P); c.SSQ3 = (float*)(ws + 30 * MiB + 65536);
}

__global__ void __launch_bounds__(NTHR, 2) hymba_fwd(Args args) {
    extern __shared__ __attribute__((aligned(16))) unsigned char lds_raw[];
    LAS unsigned char* lds = (LAS unsigned char*)lds_raw;
    const int tid = threadIdx.x, lane = tid & 63, wave = __builtin_amdgcn_readfirstlane(tid >> 6), G = gridDim.x;
    unsigned char* ws = args.ws;
    const int lo = args.ph_lo, hi = args.ph_hi;
    volatile LAS unsigned* xst = (volatile LAS unsigned*)(lds + 160256);
    if (tid == 0) { xst[0] = 0u; xst[1] = 0u; }
    __syncthreads();
    XcdBarrier xbar; xbar.bar = (unsigned*)(ws + WS_BAR); xbar.x = 0; xbar.st = xst;
    if (hi - lo > 1) xbar = xcd_barrier_post((unsigned*)(ws + WS_BAR), xst);
#define IN(k) (lo <= (k) && (k) < hi)
#define SEAM(k) do { if (IN(k) && IN((k) + 1)) { if (args.pad != 0) cg::this_grid().sync(); else xcd_barrier(xbar); } } while (0)
    if (IN(0)) { Ptrs c; fill_ptrs(c, args); p0_prologue(c, lds, G, wave, lane, G != 256); }
    SEAM(0);
    if (IN(1)) { Ptrs c; fill_ptrs(c, args);
        pg8::Gemm g{c.XB, c.WinT, M, NIN, D}; pg8::StaticOrder S; S.init(M, NIN, G, (int)blockIdx.x, D);
        pg8::EpiIn E{c.P, c.FB, c.LRA, c.RSTD1};
        pg8::gemm_phase<pg8::EpiIn, pg8::StaticOrder, true, true>(lds, g, S, E);
    }
    SEAM(1);
    if (IN(2)) { Ptrs c; fill_ptrs(c, args); p2_prepass(c, lds, G, tid, wave, lane, args.aux != 0); }
    SEAM(2);
    if (IN(3)) { Ptrs c; fill_ptrs(c, args);
        const int wg = blockIdx.x;
        if (G >= 256) {
            if (wg < 128) seq_dispatch(c, lds, wg, tid, wave, lane);
            else { for (int j = wg - 128; j < 1024; j += G - 128) seq_dispatch(c, lds, 128 + j, tid, wave, lane);
                   weight_items(c, (LAS float*)(lds + wave * 16384), 1, (wg - 128) * NWAVES + wave, (G - 128) * NWAVES, lane); }
        }
        else for (int it = wg; it < 128 + 1024; it += G) seq_dispatch(c, lds, it, tid, wave, lane);
    }
    SEAM(3);
    if (IN(4)) { Ptrs c; fill_ptrs(c, args); p3b_finalize(c, G, wave, lane); }
    SEAM(4);
    if (IN(5)) { Ptrs c; fill_ptrs(c, args);
        pg8::Gemm g{c.OF, c.WoT, M, D, D};
        { pg8::StaticOrder S; S.init(MP, D, G, (int)blockIdx.x, D); pg8::EpiRes1 E{c.in[0], c.in[1], c.OY, c.X1B, c.SSQ2};
          pg8::gemm_phase<pg8::EpiRes1, pg8::StaticOrder, true, true>(lds, g, S, E); }
        { pg8::TailOrder S{G, (int)blockIdx.x, 8, D / 64, MP / 256, 4, 16}; pg8::EpiPart E{c.PART4, MP, 1.f};
          pg8::gemm_phase<pg8::EpiPart, pg8::TailOrder, true, true>(lds, g, S, E); }
        if (hi - lo > 1) xcd_barrier(xbar);
        {
            const int gw = blockIdx.x * NWAVES + wave, NGW = G * NWAVES;
            for (int r = gw; r < MS; r += NGW) {
                const int m = MP + r; f32x4 v[4]; float ss = 0.f;
#pragma unroll
                for (int j = 0; j < 4; ++j) v[j] = *(const f32x4*)(c.in[1] + (size_t)r * D + 4 * lane + 256 * j);
#pragma unroll 1
                for (int ks = 0; ks < 8; ++ks)
#pragma unroll
                    for (int j = 0; j < 4; ++j) { const u32x2 pw = *(const u32x2*)(c.PART4 + ((size_t)ks * 1024 + r) * 1024 + 4 * lane + 256 * j); v[j] += (f32x4){bf_lo(pw.x), bf_hi(pw.x), bf_lo(pw.y), bf_hi(pw.y)}; }
#pragma unroll
                for (int j = 0; j < 4; ++j) {
                    *(f32x4*)(c.OY + (size_t)m * D + 4 * lane + 256 * j) = v[j];
                    u32x2 w; w.x = pk_bf16(v[j][0], v[j][1]); w.y = pk_bf16(v[j][2], v[j][3]); *(u32x2*)(c.X1B + (size_t)m * D + 4 * lane + 256 * j) = w;
                    ss += (v[j][0] * v[j][0] + v[j][1] * v[j][1]) + (v[j][2] * v[j][2] + v[j][3] * v[j][3]);
                }
                ss = wave_sum(ss);
                if (lane == 0) c.RSTD1[m] = __builtin_amdgcn_rsqf(ss * (1.0f / D) + EPS);
            }
            for (int r4 = gw; r4 < MP / 4; r4 += NGW) {
                const int m = 4 * r4 + (lane >> 4); float ss = c.SSQ2[(size_t)m * 16 + (lane & 15)];
                ss = row16_sum(ss);
                if ((lane & 15) == 0) c.RSTD1[m] = __builtin_amdgcn_rsqf(ss * (1.0f / D) + EPS);
            }
        }
    }
    SEAM(5);
    if (IN(6)) { Ptrs c; fill_ptrs(c, args);
        pg8::Gemm g{c.X1B, c.W13T, M, NUP, D}; pg8::StaticOrder S; S.init(M, NUP, G, (int)blockIdx.x, D);
        pg8::EpiSwiglu E{c.HID, c.RSTD1};
        pg8::gemm_phase<pg8::EpiSwiglu, pg8::StaticOrder, true, true>(lds, g, S, E);
    }
    SEAM(6);
    if (IN(7)) { Ptrs c; fill_ptrs(c, args);
        pg8::Gemm g{c.HID, c.W2T, M, D, FF};
        if (G == 256 && hi - lo > 1) {
            pg8::StaticOrder S; S.init(MP, D, G, (int)blockIdx.x, FF); EpiRes2Norm E{c.OY, c.X1B, c.SSQ3, c.in[16], xbar};
            pg8::gemm_phase<EpiRes2Norm, pg8::StaticOrder, true, true>(lds, g, S, E);
        } else {
            pg8::StaticOrder S; S.init(MP, D, G, (int)blockIdx.x, FF); pg8::EpiRes2 E{c.OY, args.aux ? 0.f : 1.f, c.X1B};
            pg8::gemm_phase<pg8::EpiRes2, pg8::StaticOrder, true, true>(lds, g, S, E);
        }
        { pg8::TailOrder S{G, (int)blockIdx.x, 11, FF / 64, MP / 256, 4, 16}; pg8::EpiPart E{c.PART, MP, args.aux ? 0.f : 1.f};
          pg8::gemm_phase<pg8::EpiPart, pg8::TailOrder, true, true>(lds, g, S, E); }
    }
    SEAM(7);
    if (IN(8)) { Ptrs c; fill_ptrs(c, args);
        const int NGW = G * NWAVES, gw = blockIdx.x * NWAVES + wave + ((G == 256 && hi - lo > 1) ? MP : 0);
        f32x4 gn[4];
#pragma unroll
        for (int j = 0; j < 4; ++j) gn[j] = *(const f32x4*)(c.in[16] + 4 * lane + 256 * j);
        f32x4 v[4], nv[4];
        { const int m0 = gw < M ? gw : M - 1;
#pragma unroll
          for (int j = 0; j < 4; ++j) v[j] = *(const f32x4*)(c.OY + (size_t)m0 * D + 4 * lane + 256 * j); }
#define ADD_PARTS(vv, mm) do { if ((mm) >= MP) { _Pragma("unroll 1") for (int ks = 0; ks < 11; ++ks) { _Pragma("unroll") for (int j = 0; j < 4; ++j) \
            { const u32x2 pw_ = *(const u32x2*)(c.PART + ((size_t)ks * 1024 + ((mm) - MP)) * 1024 + 4 * lane + 256 * j); vv[j] += (f32x4){bf_lo(pw_.x), bf_hi(pw_.x), bf_lo(pw_.y), bf_hi(pw_.y)}; } } } } while (0)
        { const int m0 = gw < M ? gw : M - 1; ADD_PARTS(v, m0); }
        for (int m = gw; m < M; m += NGW) {
            float* yr = c.OY + (size_t)m * D; float s = 0.f;
            { const int mn = m + NGW < M ? m + NGW : m;
#pragma unroll
              for (int j = 0; j < 4; ++j) nv[j] = *(const f32x4*)(c.OY + (size_t)mn * D + 4 * lane + 256 * j);
              ADD_PARTS(nv, mn); }
#pragma unroll
            for (int j = 0; j < 4; ++j) s += (v[j][0] * v[j][0] + v[j][1] * v[j][1]) + (v[j][2] * v[j][2] + v[j][3] * v[j][3]);
            const float rs = __builtin_amdgcn_rsqf(wave_sum(s) * (1.0f / D) + EPS);
#pragma unroll
            for (int j = 0; j < 4; ++j) *(f32x4*)(yr + 4 * lane + 256 * j) = args.aux ? v[j] : v[j] * rs * gn[j];
#pragma unroll
            for (int j = 0; j < 4; ++j) v[j] = nv[j];
        }
    }
#undef IN
#undef SEAM
}

extern "C" void kernel_launch(void* const* d_in, const int* in_sizes, int n_in, void* d_out, int out_size, void* d_ws, size_t ws_size, hipStream_t stream) {
    static int grid = 0;
    if (grid == 0) {
        if (n_in != 17 || ws_size < WS_END) { fprintf(stderr, "kernel_launch: unexpected n_in %d / ws %zu\n", n_in, ws_size); grid = -1; return; }
        int dev = 0, cus = 0, per_cu = 0;
        (void)hipGetDevice(&dev); (void)hipDeviceGetAttribute(&cus, hipDeviceAttributeMultiprocessorCount, dev);
        if (hipFuncSetAttribute((const void*)hymba_fwd, hipFuncAttributeMaxDynamicSharedMemorySize, LDS_BYTES) != hipSuccess) { fprintf(stderr, "kernel_launch: hipFuncSetAttribute failed\n"); grid = -1; return; }
        if (hipOccupancyMaxActiveBlocksPerMultiprocessor(&per_cu, (const void*)hymba_fwd, NTHR, LDS_BYTES) != hipSuccess || per_cu < 1) { fprintf(stderr, "kernel_launch: occupancy query says %d\n", per_cu); per_cu = 1; }
        (void)hipGetLastError();
        grid = cus * per_cu;
        if (grid <= 0) grid = 256;
    }
    if (grid < 0) return;
    if (hipMemsetAsync((char*)d_ws + WS_BAR, 0, 16384, stream) != hipSuccess) { fprintf(stderr, "kernel_launch: memset failed\n"); return; }
    Args a{};
    for (int i = 0; i < 17; ++i) a.in[i] = (const float*)d_in[i];
    a.out = (float*)d_out; a.ws = (unsigned char*)d_ws;
    if (MK_N_LAUNCHES == 1) {
        a.ph_lo = 0; a.ph_hi = NPHASE;
        void* kargs[] = {&a};
        hipError_t e = hipLaunchCooperativeKernel((const void*)hymba_fwd, dim3(grid), dim3(NTHR), kargs, LDS_BYTES, stream);
        if (e != hipSuccess) fprintf(stderr, "kernel_launch: cooperative launch failed: %s (grid %d)\n", hipGetErrorString(e), grid);
    } else {
        for (int p = 0; p < NPHASE; ++p) { a.ph_lo = p; a.ph_hi = p + 1; const int nrep = ((REP_MASK >> p) & 1) ? 3 : 1;
            for (int rr = 0; rr < nrep; ++rr) { a.aux = ((p == 2 || p == 7 || p == 8) && rr + 1 < nrep) ? 1 : 0; hipLaunchKernelGGL(hymba_fwd, dim3(grid), dim3(NTHR), LDS_BYTES, stream, a); } }
    }
}
```

```cpp
#include <hip/hip_runtime.h>
#include <hip/hip_cooperative_groups.h>
#include <cstdio>
#include <cstdint>
namespace cg = cooperative_groups;
namespace pg8 {
#define PG8_LAS __attribute__((address_space(3)))
typedef unsigned short bf16_t;
typedef short bf16x8 __attribute__((ext_vector_type(8)));
typedef float f32x4 __attribute__((ext_vector_type(4)));
typedef unsigned u32x4 __attribute__((ext_vector_type(4)));
constexpr int BM = 256, BK = 64, HALF = 128, HTB = HALF * BK * 2  , STAGE_BYTES = 8 * HTB, NXCD = 8, WGM = 8;

__host__ __device__ __forceinline__ int lds_byte(int r, int c) { const int st = (r >> 4) * 2 + (c >> 5), rr = r & 15, cc = c & 31, ob = rr * 64 + cc * 2; return st * 1024 + (ob ^ (((ob >> 9) & 1) << 5)); }
__host__ __device__ __forceinline__ void stage_rc(int b, int& R, int& C) { const int st = b / 1024, sb = b % 1024, swz = sb ^ (((sb >> 9) & 1) << 5); R = (st >> 1) * 16 + swz / 64; C = (st & 1) * 32 + (swz % 64) / 2; }
__host__ __device__ __forceinline__ int perm32(int rho) { const int n = rho >> 4, i = rho & 15; return 8 * (i >> 2) + 4 * n + (i & 3); }

struct Unit { int pm, pn, k0, nk; };
struct Gemm { const bf16_t* A; const bf16_t* Bt; int M, N, K; };

struct StaticOrder {
    int nM, nN, nwg, G, c, nkt;
    __host__ __device__ void init(int M, int N, int G_, int c_, int K_) { nM = M / BM; nN = N / BM; nwg = nM * nN; G = G_; c = c_; nkt = K_ / BK; }
    __host__ __device__ bool next(int i, Unit& u) const { return at((long)i * G + c, u); }
    __host__ __device__ bool at(long L, Unit& u) const {
        if (L >= nwg) return false;
        int wgid = (int)L; { const int q = nwg / NXCD, r = nwg % NXCD, xcd = wgid % NXCD, off = wgid / NXCD; wgid = (xcd < r ? xcd * (q + 1) : r * (q + 1) + (xcd - r) * q) + off; }
        const int nig = WGM * nN, gid = wgid / nig, fm = gid * WGM, gsz = (nM - fm) < WGM ? (nM - fm) : WGM;
        u.pm = fm + ((wgid % nig) % gsz); u.pn = (wgid % nig) / gsz; u.k0 = 0; u.nk = nkt; return true;
    }
    __device__ __forceinline__ void a_ready(const Unit&) const {}
    __device__ __forceinline__ void done(const Unit&) const {}
};


struct TailOrder {
    int G, c, NS, nkt, pm0, nN, ntu;
    __host__ __device__ bool next(int i, Unit& u) const {
        const int id = i * G + c; if (id >= ntu * NS) return false;
        const int tu = id / NS, ks = id % NS; u.pm = pm0 + tu / nN; u.pn = tu % nN; u.nk = nkt / NS; u.k0 = ks * u.nk; return true;
    }
    __device__ __forceinline__ void a_ready(const Unit&) const {}
    __device__ __forceinline__ void done(const Unit&) const {}
};

__device__ __forceinline__ unsigned cvt_pk_bf16(float lo, float hi) { unsigned r; asm volatile("v_cvt_pk_bf16_f32 %0, %1, %2" : "=v"(r) : "v"(lo), "v"(hi)); return r; }
typedef float f32x2 __attribute__((ext_vector_type(2)));

template <class Epi, class Sched, bool ALIGN_EPI = false, bool SP2 = false>
__device__ __forceinline__ void gemm_phase(PG8_LAS unsigned char* lds, const Gemm g, const Sched& S, const Epi& E) {
    const int tid = threadIdx.x, wid = __builtin_amdgcn_readfirstlane(tid >> 6), lane = tid & 63, wr = wid >> 2, wc = wid & 3, fr = lane & 15, fq = lane >> 4;
    const int K = g.K, nt = K / BK;
    unsigned voffA[2], voffB[2];
#pragma unroll
    for (int i = 0; i < 2; ++i) { int R, C; stage_rc(tid * 16 + i * 8192, R, C); const int Rb = Epi::PERM ? ((R & ~31) + perm32(R & 31)) : R;
        voffA[i] = (unsigned)(R * K + C) * 2u; voffB[i] = (unsigned)(Rb * K + C) * 2u; }
    const size_t kstep = (size_t)(BK * 2);
    const size_t hstep = (size_t)HALF * K * 2;
    const size_t tstep = 2 * hstep;
    const unsigned ldsw = (unsigned)wid * 1024u;
    const int aoff = lds_byte(wr * 64 + fr, fq * 8), boff = lds_byte(wc * 32 + fr, fq * 8);
#define PG8_SA(b, h) (((b) * 2 + (h)) * HTB)
#define PG8_SB(b, h) ((4 + (b) * 2 + (h)) * HTB)
#define PG8_STAGE(bufoff, gbase, voff) do { _Pragma("unroll") for (int _i = 0; _i < 2; ++_i) \
        __builtin_amdgcn_global_load_lds((const unsigned*)((const char*)(gbase) + (voff)[_i]), (PG8_LAS unsigned*)(lds + (bufoff) + ldsw + _i * 8192), 16, 0, 0); } while (0)
#define PG8_LDA(dst, b, h) do { _Pragma("unroll") for (int m = 0; m < 4; ++m) _Pragma("unroll") for (int k = 0; k < 2; ++k) dst[m][k] = *(const PG8_LAS bf16x8*)(lds + PG8_SA(b, h) + aoff + m * 2048 + k * 1024); } while (0)
#define PG8_LDB(dst, b, h) do { _Pragma("unroll") for (int n = 0; n < 2; ++n) _Pragma("unroll") for (int k = 0; k < 2; ++k) dst[n][k] = *(const PG8_LAS bf16x8*)(lds + PG8_SB(b, h) + boff + n * 2048 + k * 1024); } while (0)
#define PG8_MMA(ai, bj, At, Bt) do { __builtin_amdgcn_s_setprio(1); _Pragma("unroll") for (int m = 0; m < 4; ++m) _Pragma("unroll") for (int n = 0; n < 2; ++n) _Pragma("unroll") for (int k = 0; k < 2; ++k) \
        acc[ai][bj][m][n] = __builtin_amdgcn_mfma_f32_16x16x32_bf16(Bt[n][k], At[m][k], acc[ai][bj][m][n], 0, 0, 0); __builtin_amdgcn_s_setprio(0); } while (0)
#define PG8_WAIT_V(n) asm volatile("s_waitcnt vmcnt(" #n ")" ::: "memory")
#define PG8_WAIT_L(n) asm volatile("s_waitcnt lgkmcnt(" #n ")" ::: "memory")
#define PG8_BAR __builtin_amdgcn_s_barrier()
#define PG8_SCHED __builtin_amdgcn_sched_barrier(0)
    Unit cur, nxt; int ui = 0;
    if (!S.next(0, cur)) return;
    f32x4 acc[2][2][4][2];
#pragma unroll
    for (int a = 0; a < 2; ++a)
#pragma unroll
        for (int b = 0; b < 2; ++b)
#pragma unroll
            for (int m = 0; m < 4; ++m)
#pragma unroll
                for (int n = 0; n < 2; ++n) acc[a][b][m][n] = (f32x4){0.f, 0.f, 0.f, 0.f};
    bf16x8 At[4][2], B0[2][2], B1[2][2];
    const char* cA = (const char*)g.A + (size_t)cur.pm * tstep + (size_t)cur.k0 * kstep; const char* cB = (const char*)g.Bt + (size_t)cur.pn * tstep + (size_t)cur.k0 * kstep;
    S.a_ready(cur);
    if constexpr (SP2) {
        PG8_STAGE(PG8_SB(0, 0), cB, voffB); PG8_STAGE(PG8_SB(0, 1), cB + hstep, voffB); PG8_STAGE(PG8_SA(0, 0), cA, voffA); PG8_STAGE(PG8_SA(0, 1), cA + hstep, voffA);
        if (wr == 1) PG8_BAR;
        PG8_WAIT_V(2); PG8_BAR;
        PG8_STAGE(PG8_SB(1, 0), cB + kstep, voffB); PG8_STAGE(PG8_SA(1, 0), cA + kstep, voffA); PG8_STAGE(PG8_SB(1, 1), cB + hstep + kstep, voffB);
        PG8_WAIT_V(6); PG8_BAR;
    } else {
        PG8_STAGE(PG8_SB(0, 0), cB, voffB); PG8_STAGE(PG8_SA(0, 0), cA, voffA); PG8_STAGE(PG8_SB(0, 1), cB + hstep, voffB); PG8_STAGE(PG8_SA(0, 1), cA + hstep, voffA);
        if (wr == 1) PG8_BAR;
        PG8_WAIT_V(4); PG8_BAR;
        PG8_STAGE(PG8_SB(1, 0), cB + kstep, voffB); PG8_STAGE(PG8_SA(1, 0), cA + kstep, voffA); PG8_STAGE(PG8_SB(1, 1), cB + hstep + kstep, voffB);
        PG8_WAIT_V(6); PG8_BAR;
    }
    for (;;) {
        const bool has_next = S.next(ui + 1, nxt);
        const char* nA = has_next ? (const char*)g.A + (size_t)nxt.pm * tstep + (size_t)nxt.k0 * kstep : cA; const char* nB = has_next ? (const char*)g.Bt + (size_t)nxt.pn * tstep + (size_t)nxt.k0 * kstep : cB;
        const int ntc = cur.nk;
        for (int t = 0; t < ntc; t += 2) {
            const bool last = (t == ntc - 2);
            const char* a1 = cA + (size_t)(t + 1) * kstep;
            const char* a2 = last ? nA : cA + (size_t)(t + 2) * kstep; const char* b2 = last ? nB : cB + (size_t)(t + 2) * kstep;
            const char* a3 = a2 + kstep; const char* b3 = b2 + kstep;
            if (last && has_next) S.a_ready(nxt);
            if constexpr (SP2) {
            PG8_LDB(B0, 0, 0); PG8_LDB(B1, 0, 1); PG8_SCHED; PG8_LDA(At, 0, 0); PG8_STAGE(PG8_SA(1, 1), a1 + hstep, voffA);
            PG8_WAIT_V(8); PG8_WAIT_L(0); PG8_BAR; PG8_MMA(0, 0, At, B0); PG8_MMA(0, 1, At, B1); PG8_BAR; PG8_SCHED;
            PG8_LDA(At, 0, 1); PG8_STAGE(PG8_SB(0, 0), b2, voffB); PG8_STAGE(PG8_SB(0, 1), b2 + hstep, voffB); PG8_STAGE(PG8_SA(0, 0), a2, voffA);
            PG8_WAIT_V(8); PG8_WAIT_L(0); PG8_BAR; PG8_MMA(1, 0, At, B0); PG8_MMA(1, 1, At, B1); PG8_BAR; PG8_SCHED;
            PG8_LDB(B0, 1, 0); PG8_LDB(B1, 1, 1); PG8_SCHED; PG8_LDA(At, 1, 0); PG8_STAGE(PG8_SA(0, 1), a2 + hstep, voffA);
            PG8_WAIT_V(8); PG8_WAIT_L(0); PG8_BAR; PG8_MMA(0, 0, At, B0); PG8_MMA(0, 1, At, B1); PG8_BAR; PG8_SCHED;
            PG8_LDA(At, 1, 1); PG8_STAGE(PG8_SB(1, 0), b3, voffB); PG8_STAGE(PG8_SB(1, 1), b3 + hstep, voffB); PG8_STAGE(PG8_SA(1, 0), a3, voffA);
            PG8_WAIT_V(8); PG8_WAIT_L(0); PG8_BAR; PG8_MMA(1, 0, At, B0); PG8_MMA(1, 1, At, B1); PG8_BAR; PG8_SCHED;
            } else {
            PG8_LDB(B0, 0, 0); PG8_SCHED; PG8_LDA(At, 0, 0); PG8_STAGE(PG8_SA(1, 1), a1 + hstep, voffA);
            PG8_WAIT_L(8); PG8_BAR; PG8_WAIT_L(0); PG8_MMA(0, 0, At, B0); PG8_BAR; PG8_SCHED;
            PG8_LDB(B1, 0, 1); PG8_STAGE(PG8_SB(0, 0), b2, voffB);
            PG8_BAR; PG8_WAIT_L(0); PG8_MMA(0, 1, At, B1); PG8_BAR;
            PG8_LDA(At, 0, 1); PG8_STAGE(PG8_SA(0, 0), a2, voffA);
            PG8_BAR; PG8_WAIT_L(0); PG8_MMA(1, 0, At, B0); PG8_BAR; PG8_SCHED;
            PG8_STAGE(PG8_SB(0, 1), b2 + hstep, voffB);
            PG8_WAIT_V(6); PG8_BAR; PG8_MMA(1, 1, At, B1); PG8_BAR;
            PG8_LDB(B0, 1, 0); PG8_SCHED; PG8_LDA(At, 1, 0); PG8_STAGE(PG8_SA(0, 1), a2 + hstep, voffA);
            PG8_WAIT_L(8); PG8_BAR; PG8_WAIT_L(0); PG8_MMA(0, 0, At, B0); PG8_BAR; PG8_SCHED;
            PG8_LDB(B1, 1, 1); PG8_STAGE(PG8_SB(1, 0), b3, voffB);
            PG8_BAR; PG8_WAIT_L(0); PG8_MMA(0, 1, At, B1); PG8_BAR;
            PG8_LDA(At, 1, 1); PG8_STAGE(PG8_SA(1, 0), a3, voffA);
            PG8_BAR; PG8_WAIT_L(0); PG8_MMA(1, 0, At, B0); PG8_BAR; PG8_SCHED;
            PG8_STAGE(PG8_SB(1, 1), b3 + hstep, voffB);
            PG8_WAIT_V(6); PG8_BAR; PG8_MMA(1, 1, At, B1); PG8_BAR;
            }
        }
        if constexpr (ALIGN_EPI) { if (wr == 0) PG8_BAR; }
        if constexpr (!Epi::AFTER_DRAIN) { E(acc, cur, wr, wc, fr, fq); S.done(cur); }
        if (!has_next) break;
#pragma unroll
        for (int a = 0; a < 2; ++a)
#pragma unroll
            for (int b = 0; b < 2; ++b)
#pragma unroll
                for (int m = 0; m < 4; ++m)
#pragma unroll
                    for (int n = 0; n < 2; ++n) acc[a][b][m][n] = (f32x4){0.f, 0.f, 0.f, 0.f};
        cur = nxt; cA = nA; cB = nB; ++ui;
        if constexpr (ALIGN_EPI) { if (wr == 1) PG8_BAR; }
    }
    PG8_WAIT_V(0);
    if constexpr (!ALIGN_EPI) { if (wr == 0) PG8_BAR; }
    PG8_BAR;
    if constexpr (Epi::AFTER_DRAIN) { E.fused(acc, cur, wr, wc, fr, fq, lds, wid, lane); S.done(cur); }
#undef PG8_SA
#undef PG8_SB
#undef PG8_STAGE
#undef PG8_LDA
#undef PG8_LDB
#undef PG8_MMA
#undef PG8_WAIT_V
#undef PG8_WAIT_L
#undef PG8_BAR
#undef PG8_SCHED
}
}

#ifndef MK_N_LAUNCHES
#define MK_N_LAUNCHES 1
#endif
#ifndef REP_MASK
#define REP_MASK 0
#endif
#define LAS __attribute__((address_space(3)))
using pg8::bf16_t; using pg8::bf16x8; using pg8::f32x4; using pg8::u32x4;
typedef float f32x16 __attribute__((ext_vector_type(16)));
typedef __bf16 bf16x2_t __attribute__((ext_vector_type(2)));
typedef float f32x2_t __attribute__((ext_vector_type(2)));
typedef unsigned u32x2 __attribute__((ext_vector_type(2)));

constexpr int NWAVES = 8, NTHR = 512;
constexpr int D = 1024, MP = 16384, MS = 1024, M = MP + MS, NIN = 3840, PLD = 3584, FF = 2816, NUP = 2 * FF;
constexpr float EPS = 1e-6f;
constexpr size_t MiB = 1u << 20;
constexpr size_t WS_BAR = 26 * MiB + 768 * 1024, WS_WIN = 0, WS_WO = 8 * MiB, WS_W13 = 10 * MiB, WS_W2 = 21 * MiB, WS_RSTD1 = 27 * MiB, WS_SSQ2 = 28 * MiB, WS_LRA = 32 * MiB, WS_DCH = 34 * MiB,
                 WS_KDTS = 37 * MiB, WS_XB = 45 * MiB, WS_FB = 79 * MiB, WS_P = 113 * MiB, WS_END = 233 * MiB;
static_assert(WS_P + (size_t)(M + 32) * PLD * 2 <= WS_END && WS_XB + (size_t)M * D * 2 <= WS_FB && WS_FB + (size_t)M * 512 * 4 <= WS_P, "ws map");
constexpr size_t OUT_Y = 0, OUT_SAP = 17825792, OUT_SBP = 18087936, OUT_SAS = 18612224, OUT_SBS = 22806528;
constexpr int LDS_BYTES = 160768;

__device__ __forceinline__ unsigned pk_bf16(float lo, float hi) { f32x2_t v = {lo, hi}; bf16x2_t b = __builtin_convertvector(v, bf16x2_t); return __builtin_bit_cast(unsigned, b); }
__device__ __forceinline__ float bf_lo(unsigned u) { return __uint_as_float(u << 16); }
__device__ __forceinline__ float bf_hi(unsigned u) { return __uint_as_float(u & 0xffff0000u); }
__device__ __forceinline__ float bf_f(unsigned short u) { return __uint_as_float(((unsigned)u) << 16); }


template <int CTRL, int ROWMASK> __device__ __forceinline__ float dpp_f(float v) { return __builtin_bit_cast(float, __builtin_amdgcn_update_dpp(0, __builtin_bit_cast(int, v), CTRL, ROWMASK, 0xF, true)); }
__device__ __forceinline__ float row16_sum(float v) { v += dpp_f<0xB1, 0xF>(v); v += dpp_f<0x4E, 0xF>(v); v += dpp_f<0x141, 0xF>(v); v += dpp_f<0x140, 0xF>(v); return v; }
__device__ __forceinline__ float scan32(float a) {
    a += dpp_f<0x111, 0xF>(a); a += dpp_f<0x112, 0xF>(a); a += dpp_f<0x114, 0xF>(a); a += dpp_f<0x118, 0xF>(a); a += dpp_f<0x142, 0xA>(a); return a; }
template <int CTRL, int ROWMASK> __device__ __forceinline__ float dpp_f1(float v) { return __builtin_bit_cast(float, __builtin_amdgcn_update_dpp(0x3f800000, __builtin_bit_cast(int, v), CTRL, ROWMASK, 0xF, false)); }
__device__ __forceinline__ float scanmul32(float a) {
    a *= dpp_f1<0x111, 0xF>(a); a *= dpp_f1<0x112, 0xF>(a); a *= dpp_f1<0x114, 0xF>(a); a *= dpp_f1<0x118, 0xF>(a); a *= dpp_f1<0x142, 0xA>(a); return a; }
__device__ __forceinline__ float lane_bcast(float v, int l);
__device__ __forceinline__ float wave_sum(float v) { v = row16_sum(v); return (lane_bcast(v, 0) + lane_bcast(v, 16)) + (lane_bcast(v, 32) + lane_bcast(v, 48)); }
__device__ __forceinline__ float lane_bcast(float v, int l) { return __builtin_bit_cast(float, __builtin_amdgcn_readlane(__builtin_bit_cast(int, v), l)); }
#define LDS_WAIT() asm volatile("s_waitcnt lgkmcnt(0)" ::: "memory")
#define WG_BAR() do { asm volatile("s_waitcnt lgkmcnt(0)" ::: "memory"); __builtin_amdgcn_s_barrier(); asm volatile("" ::: "memory"); } while (0)
#define MFMA32(a, b, c) __builtin_amdgcn_mfma_f32_32x32x16_bf16((a), (b), (c), 0, 0, 0)
#define MFMA16(a, b, c) __builtin_amdgcn_mfma_f32_16x16x32_bf16((a), (b), (c), 0, 0, 0)

struct Ptrs {
    const float* in[17]; float* out;
    bf16_t *WinT, *WoT, *W13T, *W2T, *XB, *P, *KDTS, *OF, *X1B, *HID;
    float *RSTD1, *SSQ2, *LRA, *DCH, *FB, *OY; bf16_t *DUMP, *OX, *OI; bf16_t *PART, *PART4; float *SSQ3;
};

namespace pg8 {
struct EpiIn {
    static constexpr bool PERM = true, AFTER_DRAIN = false;
    bf16_t* P; float* FB; float* LRA; const float* rstd;
    __device__ __forceinline__ void operator()(const f32x4 (&acc)[2][2][4][2], const Unit& u, int wr, int wc, int fr, int fq) const {
        const int row0 = u.pm * BM + wr * 64 + fr, ct = wc * 32 + 8 * fq;
#pragma unroll
        for (int ai = 0; ai < 2; ++ai)
#pragma unroll
            for (int m = 0; m < 4; ++m) {
                const int row = row0 + ai * HALF + m * 16; const float rs = 1.0f;
#pragma unroll
                for (int bj = 0; bj < 2; ++bj) {
                    const f32x4 v0 = acc[ai][bj][m][0] * rs, v1 = acc[ai][bj][m][1] * rs; const int cl = bj * HALF + ct;
                    if (u.pn == 8 || u.pn == 9) { float* o = FB + (size_t)row * 512 + (u.pn - 8) * BM + cl; *(f32x4*)o = v0; *(f32x4*)(o + 4) = v1; }
                    else if (u.pn == 14) { if (cl < 16) { float* o = LRA + (size_t)row * 16 + cl; *(f32x4*)o = v0; *(f32x4*)(o + 4) = v1; } }
                    else { u32x4 w; w.x = cvt_pk_bf16(v0[0], v0[1]); w.y = cvt_pk_bf16(v0[2], v0[3]); w.z = cvt_pk_bf16(v1[0], v1[1]); w.w = cvt_pk_bf16(v1[2], v1[3]);
                           *(u32x4*)(P + (size_t)row * 3584 + u.pn * BM + cl) = w; }
                }
            }
    }
};
struct EpiRes1 {
    static constexpr bool PERM = true, AFTER_DRAIN = false;
    const float* xp; const float* xs; float* Y; bf16_t* X1B; float* SSQ;
    __device__ __forceinline__ void operator()(const f32x4 (&acc)[2][2][4][2], const Unit& u, int wr, int wc, int fr, int fq) const {
        const int row0 = u.pm * BM + wr * 64 + fr, ct = u.pn * BM + wc * 32 + 8 * fq;
#pragma unroll
        for (int ai = 0; ai < 2; ++ai) {
            f32x4 xv[4][2][2];
#pragma unroll
            for (int m = 0; m < 4; ++m) {
                const int row = row0 + ai * HALF + m * 16;
                const float* xr = row < 16384 ? xp + (size_t)row * 1024 : xs + (size_t)(row - 16384) * 1024;
#pragma unroll
                for (int bj = 0; bj < 2; ++bj) { xv[m][bj][0] = *(const f32x4*)(xr + ct + bj * HALF); xv[m][bj][1] = *(const f32x4*)(xr + ct + bj * HALF + 4); }
            }
            asm volatile("" ::: "memory");
#pragma unroll
            for (int m = 0; m < 4; ++m) {
                const int row = row0 + ai * HALF + m * 16; float ss = 0.f;
#pragma unroll
                for (int bj = 0; bj < 2; ++bj) {
                    const int col = ct + bj * HALF;
                    const f32x4 v0 = acc[ai][bj][m][0] + xv[m][bj][0], v1 = acc[ai][bj][m][1] + xv[m][bj][1];
                    u32x4 w; w.x = cvt_pk_bf16(v0[0], v0[1]); w.y = cvt_pk_bf16(v0[2], v0[3]); w.z = cvt_pk_bf16(v1[0], v1[1]); w.w = cvt_pk_bf16(v1[2], v1[3]);
                    *(u32x4*)(X1B + (size_t)row * 1024 + col) = w;
                    ss += (v0[0] * v0[0] + v0[1] * v0[1]) + (v0[2] * v0[2] + v0[3] * v0[3]) + (v1[0] * v1[0] + v1[1] * v1[1]) + (v1[2] * v1[2] + v1[3] * v1[3]);
                }
                ss += __shfl_xor(ss, 16); ss += __shfl_xor(ss, 32);
                if (fq == 0) SSQ[(size_t)row * 16 + u.pn * 4 + wc] = ss;
            }
        }
    }
};
struct EpiSwiglu {
    static constexpr bool PERM = true, AFTER_DRAIN = false;
    bf16_t* H; const float* SSQ;
    __device__ __forceinline__ void operator()(const f32x4 (&acc)[2][2][4][2], const Unit& u, int wr, int wc, int fr, int fq) const {
        const int row0 = u.pm * BM + wr * 64 + fr, hc = u.pn * 128 + wc * 32 + fq * 8;
#pragma unroll
        for (int ai = 0; ai < 2; ++ai)
#pragma unroll
            for (int m = 0; m < 4; ++m) {
                const int row = row0 + ai * HALF + m * 16;
                const float rs = SSQ[row];
                float h[8];
#pragma unroll
                for (int n = 0; n < 2; ++n) {
                    const f32x4 a = acc[ai][0][m][n] * rs, b = acc[ai][1][m][n] * rs;
#pragma unroll
                    for (int e = 0; e < 4; ++e) h[4 * n + e] = a[e] * __builtin_amdgcn_rcpf(1.0f + __expf(-a[e])) * b[e];
                }
                u32x4 w; w.x = cvt_pk_bf16(h[0], h[1]); w.y = cvt_pk_bf16(h[2], h[3]); w.z = cvt_pk_bf16(h[4], h[5]); w.w = cvt_pk_bf16(h[6], h[7]);
                *(u32x4*)(H + (size_t)row * 2816 + hc) = w;
            }
    }
};
struct EpiRes2 {
    static constexpr bool PERM = true, AFTER_DRAIN = false;
    float* Y; float sc; const bf16_t* X1B;
    __device__ __forceinline__ void operator()(const f32x4 (&acc)[2][2][4][2], const Unit& u, int wr, int wc, int fr, int fq) const {
        const int row0 = u.pm * BM + wr * 64 + fr, ct = u.pn * BM + wc * 32 + 8 * fq;
#pragma unroll
        for (int ai = 0; ai < 2; ++ai)
#pragma unroll
            for (int m = 0; m < 4; ++m) {
                float* yr = Y + (size_t)(row0 + ai * HALF + m * 16) * 1024;
#pragma unroll
                for (int bj = 0; bj < 2; ++bj) {
                    const int col = ct + bj * HALF;
                    const pg8::u32x4 xr = *(const pg8::u32x4*)(X1B + (size_t)(row0 + ai * HALF + m * 16) * 1024 + col);
                    const f32x4 v0 = acc[ai][bj][m][0] * sc + (f32x4){__uint_as_float(xr.x << 16), __uint_as_float(xr.x & 0xffff0000u), __uint_as_float(xr.y << 16), __uint_as_float(xr.y & 0xffff0000u)};
                    const f32x4 v1 = acc[ai][bj][m][1] * sc + (f32x4){__uint_as_float(xr.z << 16), __uint_as_float(xr.z & 0xffff0000u), __uint_as_float(xr.w << 16), __uint_as_float(xr.w & 0xffff0000u)};
                    *(f32x4*)(yr + col) = v0; *(f32x4*)(yr + col + 4) = v1;
                }
            }
    }
};
struct EpiPart {
    static constexpr bool PERM = true, AFTER_DRAIN = false;
    bf16_t* PART; int rowbase; float sc;
    __device__ __forceinline__ void operator()(const f32x4 (&acc)[2][2][4][2], const Unit& u, int wr, int wc, int fr, int fq) const {
        const int row0 = u.pm * BM + wr * 64 + fr - rowbase, ct = u.pn * BM + wc * 32 + 8 * fq;
        bf16_t* base = PART + (size_t)(u.k0 / u.nk) * 1024 * 1024;
#pragma unroll
        for (int ai = 0; ai < 2; ++ai)
#pragma unroll
            for (int m = 0; m < 4; ++m) {
                bf16_t* yr = base + (size_t)(row0 + ai * HALF + m * 16) * 1024;
#pragma unroll
                for (int bj = 0; bj < 2; ++bj) { const f32x4 v0 = acc[ai][bj][m][0] * sc, v1 = acc[ai][bj][m][1] * sc;
                    u32x4 w; w.x = cvt_pk_bf16(v0[0], v0[1]); w.y = cvt_pk_bf16(v0[2], v0[3]); w.z = cvt_pk_bf16(v1[0], v1[1]); w.w = cvt_pk_bf16(v1[2], v1[3]);
                    *(u32x4*)(yr + ct + bj * HALF) = w; }
            }
    }
};
}

__device__ __forceinline__ void tr_item(const float* colp, int ldw, const float* gain, int k0, int dcol, bf16_t* WT, int K, int nrow0, LAS float* scr, int lane) {
    float tv[32];
#pragma unroll
    for (int i = 0; i < 32; ++i) { const int kk = 2 * i + (lane >> 5); tv[i] = colp ? colp[(size_t)(k0 + kk) * ldw] : 0.f; }
    if (gain) {
        float gv[32];
#pragma unroll
        for (int i = 0; i < 32; ++i) gv[i] = gain[k0 + 2 * i + (lane >> 5)];
#pragma unroll
        for (int i = 0; i < 32; ++i) tv[i] *= gv[i];
    }
#pragma unroll
    for (int i = 0; i < 32; ++i) scr[(2 * i + (lane >> 5)) * 33 + dcol] = tv[i];
    LDS_WAIT();
    const int c = lane & 7;
#pragma unroll
    for (int j = 0; j < 4; ++j) {
        const int n = (lane >> 3) + 8 * j; const LAS float* s = scr + (8 * c) * 33 + n;
        u32x4 o; o.x = pk_bf16(s[0 * 33], s[1 * 33]); o.y = pk_bf16(s[2 * 33], s[3 * 33]); o.z = pk_bf16(s[4 * 33], s[5 * 33]); o.w = pk_bf16(s[6 * 33], s[7 * 33]);
        *(u32x4*)(WT + (size_t)(nrow0 + n) * K + k0 + 8 * c) = o;
    }
    LDS_WAIT();
}
__device__ __forceinline__ void weight_items(const Ptrs& c, LAS float* scr, int part, int gw, int NGW, int lane) {
    const int l31 = lane & 31;
    constexpr int I_IN = 16 * 120, I_O = 16 * 32, I_13 = 16 * 176, I_2 = 44 * 32;
    if (part == 0) {
        for (int r = gw; r < I_IN; r += NGW) { const int kb = r / 120, nb = r % 120, n = nb * 32 + l31;
            const int oc = n < 1536 ? n : (n < 3584 ? n + 16 : (n < 3600 ? n - 3584 + 1536 : -1));
            tr_item(oc >= 0 ? c.in[5] + oc : nullptr, 3600, c.in[4], kb * 64, l31, c.WinT, 1024, nb * 32, scr, lane); }
        return;
    }
    for (int it = gw; it < I_O + I_13 + I_2; it += NGW) {
        int r = it;
        if (r < I_O) { const int kb = r / 32, nb = r % 32; tr_item(c.in[11] + nb * 32 + l31, 1024, nullptr, kb * 64, l31, c.WoT, 1024, nb * 32, scr, lane); continue; }
        r -= I_O;
        if (r < I_13) { const int kb = r / 176, nb = r % 176, t = nb >> 3, wb = nb & 7; const bool is3 = wb >= 4; const int hcol = 128 * t + 32 * (wb & 3) + l31;
            tr_item((is3 ? c.in[14] : c.in[13]) + hcol, 2816, c.in[12], kb * 64, l31, c.W13T, 1024, nb * 32, scr, lane); continue; }
        r -= I_13;
        { const int kb = r / 32, nb = r % 32; tr_item(c.in[15] + nb * 32 + l31, 1024, nullptr, kb * 64, l31, c.W2T, 2816, nb * 32, scr, lane); }
    }
}
__device__ __forceinline__ void p0_prologue(const Ptrs& c, LAS unsigned char* lds, int G, int wave, int lane, bool all_weights) {
    LAS float* scr = (LAS float*)(lds + wave * 16384);
    const int gw = blockIdx.x * NWAVES + wave, NGW = G * NWAVES;
    weight_items(c, scr, 0, gw, NGW, lane);
    if (all_weights) weight_items(c, scr, 1, gw, NGW, lane);
    {
        f32x4 v[4], nv[4];
        { const int m0 = gw < M ? gw : M - 1; const float* xr = m0 < MP ? c.in[0] + (size_t)m0 * D : c.in[1] + (size_t)(m0 - MP) * D;
#pragma unroll
          for (int j = 0; j < 4; ++j) v[j] = *(const f32x4*)(xr + 4 * lane + 256 * j); }
        for (int m = gw; m < M; m += NGW) {
            { const int mn = m + NGW < M ? m + NGW : m; const float* xr = mn < MP ? c.in[0] + (size_t)mn * D : c.in[1] + (size_t)(mn - MP) * D;
#pragma unroll
              for (int j = 0; j < 4; ++j) nv[j] = *(const f32x4*)(xr + 4 * lane + 256 * j); }
            float s = 0.f;
#pragma unroll
            for (int j = 0; j < 4; ++j) s += (v[j][0] * v[j][0] + v[j][1] * v[j][1]) + (v[j][2] * v[j][2] + v[j][3] * v[j][3]);
            s = wave_sum(s);
            const float rs = __builtin_amdgcn_rsqf(s * (1.0f / D) + EPS);
#pragma unroll
            for (int j = 0; j < 4; ++j) { u32x2 w; w.x = pk_bf16(v[j][0] * rs, v[j][1] * rs); w.y = pk_bf16(v[j][2] * rs, v[j][3] * rs); *(u32x2*)(c.XB + (size_t)m * D + 4 * lane + 256 * j) = w; }
#pragma unroll
            for (int j = 0; j < 4; ++j) v[j] = nv[j];
        }
    }
}

__device__ __forceinline__ int crow(int i, int h) { return (i & 3) + 8 * (i >> 2) + 4 * h; }
template <int K, bool GLA, bool ALLV>
__device__ __forceinline__ void pre_item(const Ptrs& c, int row0, int ntok, int hh, int item, bf16_t* kdt_base, int kdt_stride,
                                         const LAS float* wa2_l, const LAS float* ba_l, const LAS float* lb_l, LAS unsigned char* vt, int lane, bool dry) {
    const int r = lane & 31, kg = lane >> 5;
    const bool valid = ALLV || r < ntok;
    const int row = row0 + (valid ? r : 0), nt1 = ntok - 1;
    constexpr int NJ = K / 16;
    const int qcol0 = GLA ? hh * 64 : 1536 + hh * 128, kcol0 = 256 + hh * 64, vcol0 = GLA ? 512 + hh * 128 : 2560 + hh * 128, ocol0 = (GLA ? hh : 4 + hh) * 128;
    bf16_t* Prow = c.P + (size_t)row * PLD;
    LAS unsigned char* kt = vt + 8192;
    LAS unsigned char* dl = vt + 16384;
    float lra[16];
    if constexpr (GLA) {
#pragma unroll
        for (int i = 0; i < 4; ++i) { const f32x4 t = *(const f32x4*)(c.LRA + (size_t)row * 16 + 4 * i); lra[4 * i] = t[0]; lra[4 * i + 1] = t[1]; lra[4 * i + 2] = t[2]; lra[4 * i + 3] = t[3]; }
    }
    const bf16_t* qptr = Prow + qcol0 + 8 * kg;
    const bf16_t* kptr = Prow + kcol0 + 8 * kg;
    const float* fptr = c.FB + (size_t)row * 512 + hh * 128 + 8 * kg;
    u32x4 qn = *(const u32x4*)qptr, kn = {0u, 0u, 0u, 0u}; f32x4 fn0 = {0.f, 0.f, 0.f, 0.f}, fn1 = fn0;
    if constexpr (GLA) kn = *(const u32x4*)kptr; else { fn0 = *(const f32x4*)fptr; fn1 = *(const f32x4*)(fptr + 4); }
    f32x16 att;
#pragma unroll
    for (int i = 0; i < 16; ++i) att[i] = 0.f;
    float* dch = c.DCH + (size_t)item * 128;
#pragma unroll 1
    for (int j = 0; j < NJ; ++j) {
        const int cl = 16 * j + 8 * kg;
        const u32x4 qr = qn, kr = kn; const f32x4 f0 = fn0, f1 = fn1;
        { const int jn = j + 1 < NJ ? j + 1 : j;
          qn = *(const u32x4*)(qptr + 16 * jn);
          if constexpr (GLA) kn = *(const u32x4*)(kptr + 16 * jn); else { fn0 = *(const f32x4*)(fptr + 16 * jn); fn1 = *(const f32x4*)(fptr + 16 * jn + 4); } }
        float la[8], kv[8], qv[8];
        if constexpr (GLA) {
            const LAS float* wl = wa2_l + hh * 64 + cl;
            f32x4 a0 = *(const LAS f32x4*)(ba_l + hh * 64 + cl), a1 = *(const LAS f32x4*)(ba_l + hh * 64 + cl + 4);
#pragma unroll
            for (int rb = 0; rb < 16; rb += 4) {
                f32x4 w[8];
#pragma unroll
                for (int rr = 0; rr < 4; ++rr) { w[2 * rr] = *(const LAS f32x4*)(wl + (rb + rr) * 256); w[2 * rr + 1] = *(const LAS f32x4*)(wl + (rb + rr) * 256 + 4); }
#pragma unroll
                for (int rr = 0; rr < 4; ++rr) { a0 += w[2 * rr] * lra[rb + rr]; a1 += w[2 * rr + 1] * lra[rb + rr]; }
            }
            float x[8], t[8];
#pragma unroll
            for (int e = 0; e < 8; ++e) x[e] = e < 4 ? a0[e & 3] : a1[e & 3];
#pragma unroll
            for (int e = 0; e < 8; ++e) t[e] = __expf(-fabsf(x[e]));
#pragma unroll
            for (int e = 0; e < 8; ++e) t[e] = __logf(1.0f + t[e]);
#pragma unroll
            for (int e = 0; e < 8; ++e) la[e] = (fminf(x[e], 0.f) - t[e]) * 0.0625f;
            kv[0] = bf_lo(kr.x); kv[1] = bf_hi(kr.x); kv[2] = bf_lo(kr.y); kv[3] = bf_hi(kr.y); kv[4] = bf_lo(kr.z); kv[5] = bf_hi(kr.z); kv[6] = bf_lo(kr.w); kv[7] = bf_hi(kr.w);
        } else {
            const f32x4 l0 = *(const LAS f32x4*)(lb_l + hh * 128 + cl), l1 = *(const LAS f32x4*)(lb_l + hh * 128 + cl + 4);
            float x[8], lbv[8], ex[8], inv[8];
#pragma unroll
            for (int e = 0; e < 8; ++e) { x[e] = e < 4 ? f0[e & 3] : f1[e & 3]; lbv[e] = e < 4 ? l0[e & 3] : l1[e & 3]; }
#pragma unroll
            for (int e = 0; e < 8; ++e) ex[e] = __expf(-fabsf(x[e]));
#pragma unroll
            for (int e = 0; e < 8; ++e) inv[e] = __builtin_amdgcn_rcpf(1.0f + ex[e]);
#pragma unroll
            for (int e = 0; e < 8; ++e) { const float ei = ex[e] * inv[e]; const float sg = x[e] >= 0.f ? inv[e] : ei, ng = x[e] >= 0.f ? ei : inv[e];
                la[e] = lbv[e] + (1.0f - lbv[e]) * sg; kv[e] = (1.0f - lbv[e]) * ng; }
        }
        qv[0] = bf_lo(qr.x); qv[1] = bf_hi(qr.x); qv[2] = bf_lo(qr.y); qv[3] = bf_hi(qr.y); qv[4] = bf_lo(qr.z); qv[5] = bf_hi(qr.z); qv[6] = bf_lo(qr.w); qv[7] = bf_hi(qr.w);
        float qi[8], ki[8], kd[8], eb[8], q[8], ea[8], ia[8];
        if constexpr (GLA) {
#pragma unroll
            for (int e = 0; e < 8; ++e) q[e] = qv[e] * 0.125f;
        } else {
#pragma unroll
            for (int e = 0; e < 8; ++e) q[e] = __expf(-qv[e]);
#pragma unroll
            for (int e = 0; e < 8; ++e) q[e] = __builtin_amdgcn_rcpf(1.0f + q[e]);
#pragma unroll
            for (int e = 0; e < 8; ++e) q[e] *= qv[e];
        }
        if (!ALLV) {
#pragma unroll
            for (int e = 0; e < 8; ++e) if (!valid) { q[e] = 0.f; kv[e] = 0.f; la[e] = GLA ? 0.f : 1.f; }
        }
        if constexpr (GLA) {
#pragma unroll
            for (int e = 0; e < 8; ++e) la[e] += dpp_f<0x111, 0xF>(la[e]);
#pragma unroll
            for (int e = 0; e < 8; ++e) la[e] += dpp_f<0x112, 0xF>(la[e]);
#pragma unroll
            for (int e = 0; e < 8; ++e) la[e] += dpp_f<0x114, 0xF>(la[e]);
#pragma unroll
            for (int e = 0; e < 8; ++e) la[e] += dpp_f<0x118, 0xF>(la[e]);
#pragma unroll
            for (int e = 0; e < 8; ++e) la[e] += dpp_f<0x142, 0xA>(la[e]);
#pragma unroll
            for (int e = 0; e < 8; ++e) ea[e] = __expf(fmaxf(la[e], -80.f));
        } else {
#pragma unroll
            for (int e = 0; e < 8; ++e) la[e] *= dpp_f1<0x111, 0xF>(la[e]);
#pragma unroll
            for (int e = 0; e < 8; ++e) la[e] *= dpp_f1<0x112, 0xF>(la[e]);
#pragma unroll
            for (int e = 0; e < 8; ++e) la[e] *= dpp_f1<0x114, 0xF>(la[e]);
#pragma unroll
            for (int e = 0; e < 8; ++e) la[e] *= dpp_f1<0x118, 0xF>(la[e]);
#pragma unroll
            for (int e = 0; e < 8; ++e) la[e] *= dpp_f1<0x142, 0xA>(la[e]);
#pragma unroll
            for (int e = 0; e < 8; ++e) ea[e] = fmaxf(la[e], 1e-35f);
        }
#pragma unroll
        for (int e = 0; e < 8; ++e) ia[e] = __builtin_amdgcn_rcpf(ea[e]);
#pragma unroll
        for (int e = 0; e < 8; ++e) { const float e31 = lane_bcast(ea[e], 31), e63 = lane_bcast(ea[e], 63); eb[e] = kg ? e63 : e31; }
#pragma unroll
        for (int e = 0; e < 8; ++e) { qi[e] = q[e] * ea[e]; ki[e] = kv[e] * ia[e]; kd[e] = ki[e] * eb[e]; }
        u32x4 qp, kp;
        qp.x = pk_bf16(qi[0], qi[1]); qp.y = pk_bf16(qi[2], qi[3]); qp.z = pk_bf16(qi[4], qi[5]); qp.w = pk_bf16(qi[6], qi[7]);
        kp.x = pk_bf16(ki[0], ki[1]); kp.y = pk_bf16(ki[2], ki[3]); kp.z = pk_bf16(ki[4], ki[5]); kp.w = pk_bf16(ki[6], ki[7]);
        att = MFMA32(__builtin_bit_cast(bf16x8, kp), __builtin_bit_cast(bf16x8, qp), att);
        *(LAS u32x4*)(vt + r * (K * 2) + ((((cl >> 3) ^ r) & (K / 8 - 1)) << 4)) = qp;
#pragma unroll
        for (int e = 0; e < 8; e += 2) {
            const unsigned pkd = pk_bf16(kd[e], kd[e + 1]);
            *(LAS unsigned short*)(kt + (cl + e) * 64 + r * 2) = (unsigned short)(pkd & 0xffffu);
            *(LAS unsigned short*)(kt + (cl + e + 1) * 64 + r * 2) = (unsigned short)(pkd >> 16);
        }
        if (r == 0) { f32x4 d0 = {eb[0], eb[1], eb[2], eb[3]}, d1 = {eb[4], eb[5], eb[6], eb[7]}; *(LAS f32x4*)(dl + cl * 4) = d0; *(LAS f32x4*)(dl + cl * 4 + 16) = d1; }
    }
    u32x4 vreg[8];
#pragma unroll
    for (int i = 0; i < 8; ++i) { const int p = lane + 64 * i, vr = (p >> 4) < nt1 ? (p >> 4) : nt1; vreg[i] = *(const u32x4*)(c.P + (size_t)(row0 + vr) * PLD + vcol0 + (p & 15) * 8); }
#pragma unroll
    for (int i = 0; i < K / 16; ++i) {
        const int p = lane + 64 * i, L = p * 8, qr_ = p / (K / 8), qc_ = p % (K / 8);
        if ((ALLV || qr_ < ntok) && !dry) *(u32x4*)(c.P + (size_t)(row0 + qr_) * PLD + qcol0 + qc_ * 8) = *(const LAS u32x4*)(vt + qr_ * (K * 2) + (((qc_ ^ qr_) & (K / 8 - 1)) << 4));
        *(u32x4*)(kdt_base + (size_t)(L / K) * kdt_stride + (L % K)) = *(const LAS u32x4*)(kt + p * 16);
    }
    if (lane < K / 4) *(f32x4*)(dch + lane * 4) = *(const LAS f32x4*)(dl + lane * 16);
#pragma unroll
    for (int i = 0; i < 8; ++i) { const int p = lane + 64 * i; *(LAS u32x4*)(vt + (p >> 4) * 256 + (p & 15) * 16) = vreg[i]; }
#pragma unroll
    for (int i = 0; i < 16; ++i) if (crow(i, kg) > r) att[i] = 0.f;
    u32x4 pa0, pa1;
    pa0.x = pk_bf16(att[0], att[1]); pa0.y = pk_bf16(att[2], att[3]); pa0.z = pk_bf16(att[4], att[5]); pa0.w = pk_bf16(att[6], att[7]);
    pa1.x = pk_bf16(att[8], att[9]); pa1.y = pk_bf16(att[10], att[11]); pa1.z = pk_bf16(att[12], att[13]); pa1.w = pk_bf16(att[14], att[15]);
#pragma unroll 1
    for (int vb = 0; vb < 4; ++vb) {
        unsigned short vs[16];
#pragma unroll
        for (int i = 0; i < 16; ++i) vs[i] = *(const LAS unsigned short*)(vt + crow(i, kg) * 256 + (vb * 32 + r) * 2);
        u32x4 b0, b1;
        b0.x = vs[0] | ((unsigned)vs[1] << 16); b0.y = vs[2] | ((unsigned)vs[3] << 16); b0.z = vs[4] | ((unsigned)vs[5] << 16); b0.w = vs[6] | ((unsigned)vs[7] << 16);
        b1.x = vs[8] | ((unsigned)vs[9] << 16); b1.y = vs[10] | ((unsigned)vs[11] << 16); b1.z = vs[12] | ((unsigned)vs[13] << 16); b1.w = vs[14] | ((unsigned)vs[15] << 16);
        f32x16 o;
#pragma unroll
        for (int i = 0; i < 16; ++i) o[i] = 0.f;
        o = MFMA32(__builtin_bit_cast(bf16x8, pa0), __builtin_bit_cast(bf16x8, b0), o);
        o = MFMA32(__builtin_bit_cast(bf16x8, pa1), __builtin_bit_cast(bf16x8, b1), o);
#pragma unroll
        for (int i = 0; i < 16; ++i) *(LAS unsigned short*)(kt + crow(i, kg) * 256 + (vb * 32 + r) * 2) = (unsigned short)(pk_bf16(o[i], 0.f) & 0xffffu);
    }
#pragma unroll
    for (int i = 0; i < 8; ++i) {
        const int p = lane + 64 * i, t = p >> 4;
        if (t < ntok) *(u32x4*)(c.OI + (size_t)(row0 + t) * 1024 + ocol0 + (p & 15) * 8) = *(const LAS u32x4*)(kt + p * 16);
    }
}
__device__ __forceinline__ void p2_prepass(const Ptrs& c, LAS unsigned char* lds, int G, int tid, int wave, int lane, bool dry) {
    LAS float* wa2_l = (LAS float*)lds; LAS float* ba_l = wa2_l + 4096; LAS float* lb_l = ba_l + 256;
    for (int i = tid; i < 4096; i += NTHR) wa2_l[i] = c.in[6][i];
    if (tid < 256) ba_l[tid] = c.in[7][tid];
    { const float p0 = c.in[8][tid], p1 = c.in[8][512 + tid]; lb_l[tid] = 1.0f / (1.0f + __expf(p1 - p0)); }
    WG_BAR();
    const int gw = blockIdx.x * NWAVES + wave, NGW = G * NWAVES;
    const bool bal = (G == 256);
    const int n_it = bal ? 4096 : 4096 + 1024;
    for (int it0 = gw; ; it0 += NGW) {
        int it = it0;
        if (it0 >= n_it) { if (!bal || wave >= 4 || it0 >= n_it + NGW) break; it = 4096 + blockIdx.x * 4 + wave; }
        int row0, ntok, h; bf16_t* kdt; int kst;
        if (it < 4096) { h = it & 7; const int ch = (it >> 3) & 63, b = it >> 9; row0 = b * 2048 + ch * 32; ntok = 32; kst = PLD;
                         kdt = c.P + (size_t)row0 * PLD + (h < 4 ? 256 + h * 64 : 2048 + (h - 4) * 128); }
        else { const int j = it - 4096; h = j & 7; row0 = MP + (j >> 3) * 8; ntok = 8; kst = h < 4 ? 64 : 128; kdt = c.KDTS + (size_t)j * 4096; }
        if (dry) { kst = h < 4 ? 64 : 128; kdt = (bf16_t*)((unsigned char*)c.DUMP + 203 * MiB) + (size_t)(it & 2047) * 4096; }
        if (it < 4096) { if (h < 4) pre_item<64, true, true>(c, row0, ntok, h, it, kdt, kst, wa2_l, ba_l, lb_l, lds + 20480 + wave * 16896, lane, dry);
                         else pre_item<128, false, true>(c, row0, ntok, h - 4, it, kdt, kst, wa2_l, ba_l, lb_l, lds + 20480 + wave * 16896, lane, dry); }
        else { if (h < 4) pre_item<64, true, false>(c, row0, ntok, h, it, kdt, kst, wa2_l, ba_l, lb_l, lds + 20480 + wave * 16896, lane, dry);
               else pre_item<128, false, false>(c, row0, ntok, h - 4, it, kdt, kst, wa2_l, ba_l, lb_l, lds + 20480 + wave * 16896, lane, dry); }
    }
}

template <int K>
__device__ __forceinline__ void seq_item(const Ptrs& c, LAS unsigned char* lds, int row0, int nch, int ntok, int h8, int colbase, int ncw, const float* S0, float* Sout,
                                         const bf16_t* kdt0, int kdt_rstride, size_t kdt_cstep, const float* dch0, size_t dch_cstep, int tid, int wave, int lane) {
    constexpr int QROW = 2 * K + 16, VROW = 272;
    constexpr int KOFF = 8704, DOFF = 18944, VOFF = 19456, BUFB = 28160, NMB = K / 16, NPC = 4 * K;
    const int n = lane & 15, q = lane >> 4, col = colbase + 16 * (wave < ncw ? wave : 0) + n;
    const bool cw = wave < ncw;
    const bool gla = h8 < 4; const int hh = h8 & 3;
    const int qcol0 = gla ? hh * 64 : 1536 + hh * 128, vcol0 = gla ? 512 + hh * 128 : 2560 + hh * 128, ocol = h8 * 128 + col;
    f32x4 S[NMB];
#pragma unroll
    for (int mb = 0; mb < NMB; ++mb)
#pragma unroll
        for (int i = 0; i < 4; ++i) S[mb][i] = (S0 && cw) ? S0[(size_t)(16 * mb + 4 * q + i) * 128 + col] : 0.f;
    const int nt1 = ntok - 1;
    const int pq = tid % NPC, prow_q = pq / (K / 8), pc8 = pq % (K / 8), prq = prow_q < nt1 ? prow_q : nt1;
    const int vrow = tid >> 4, vc8 = tid & 15, vr = vrow < nt1 ? vrow : nt1;
    const int dpi = tid % (K / 4);
    const bf16_t* gq = c.P + (size_t)(row0 + prq) * PLD + qcol0 + pc8 * 8;
    const bf16_t* gk = kdt0 + (size_t)prow_q * kdt_rstride + pc8 * 8;
    const float* gd = dch0 + dpi * 4;
    const bf16_t* gvp = c.P + (size_t)(row0 + vr) * PLD + vcol0 + vc8 * 8;
    struct Stage { u32x4 q, k, v; f32x4 d; };
    const int nch1 = nch - 1;
#define SEQ_LOAD(R, cc) do { const int c_ = (cc) < nch1 ? (cc) : nch1; const size_t ro_ = (size_t)c_ * 32; \
        R.q = *(const u32x4*)(gq + ro_ * PLD); R.k = *(const u32x4*)(gk + (size_t)c_ * kdt_cstep); R.d = *(const f32x4*)(gd + (size_t)c_ * dch_cstep); \
        R.v = *(const u32x4*)(gvp + ro_ * PLD); } while (0)
#define SEQ_STORE(R, buf) do { LAS unsigned char* B_ = lds + (buf) * BUFB; \
        *(LAS u32x4*)(B_ + prow_q * QROW + pc8 * 16) = R.q; *(LAS u32x4*)(B_ + KOFF + (pq >> 2) * 80 + (pq & 3) * 16) = R.k; *(LAS f32x4*)(B_ + DOFF + dpi * 16) = R.d; \
        *(LAS u32x4*)(B_ + VOFF + vrow * VROW + vc8 * 16) = R.v; } while (0)
#define SEQ_ITER(ci, buf, RST) do { \
        const LAS unsigned char* B = lds + (buf) * BUFB; \
        if (cw) { \
        f32x4 o[2] = {{0.f, 0.f, 0.f, 0.f}, {0.f, 0.f, 0.f, 0.f}}; \
        _Pragma("unroll") for (int js = 0; js < K / 32; ++js) { \
            u32x4 sb; sb.x = pk_bf16(S[2 * js][0], S[2 * js][1]); sb.y = pk_bf16(S[2 * js][2], S[2 * js][3]); sb.z = pk_bf16(S[2 * js + 1][0], S[2 * js + 1][1]); sb.w = pk_bf16(S[2 * js + 1][2], S[2 * js + 1][3]); \
            _Pragma("unroll") for (int mb2 = 0; mb2 < 2; ++mb2) { \
                const LAS unsigned char* qp = B + (16 * mb2 + n) * QROW + (32 * js + 4 * q) * 2; \
                const u32x2 lo = *(const LAS u32x2*)qp, hi = *(const LAS u32x2*)(qp + 32); \
                u32x4 qa; qa.x = lo.x; qa.y = lo.y; qa.z = hi.x; qa.w = hi.y; \
                o[mb2] = MFMA16(__builtin_bit_cast(bf16x8, qa), __builtin_bit_cast(bf16x8, sb), o[mb2]); } } \
        { unsigned short vs[8]; \
            _Pragma("unroll") for (int j = 0; j < 8; ++j) vs[j] = *(const LAS unsigned short*)(B + VOFF + (8 * q + j) * VROW + col * 2); \
            u32x4 vb; vb.x = vs[0] | ((unsigned)vs[1] << 16); vb.y = vs[2] | ((unsigned)vs[3] << 16); vb.z = vs[4] | ((unsigned)vs[5] << 16); vb.w = vs[6] | ((unsigned)vs[7] << 16); \
            _Pragma("unroll") for (int mb = 0; mb < NMB; ++mb) { \
                const u32x4 ka = *(const LAS u32x4*)(B + KOFF + (16 * mb + n) * 80 + q * 16); \
                const f32x4 dv = *(const LAS f32x4*)(B + DOFF + (16 * mb + 4 * q) * 4); \
                S[mb] = S[mb] * dv; \
                S[mb] = MFMA16(__builtin_bit_cast(bf16x8, ka), __builtin_bit_cast(bf16x8, vb), S[mb]); } } \
        bf16_t* ob = c.OX + (size_t)(row0 + 32 * (ci)) * 1024 + ocol; \
        _Pragma("unroll") for (int x = 0; x < 8; x += 2) { \
            const int t = 16 * (x >> 2) + 4 * q + (x & 3); const unsigned pv = pk_bf16(o[x >> 2][x & 3], o[x >> 2][(x & 3) + 1]); \
            bf16_t* d0 = t < ntok ? ob + (size_t)t * 1024 : c.DUMP + tid; bf16_t* d1 = t + 1 < ntok ? ob + (size_t)(t + 1) * 1024 : c.DUMP + tid; \
            *d0 = (bf16_t)(pv & 0xffffu); *d1 = (bf16_t)(pv >> 16); } \
        } \
        WG_BAR(); \
        SEQ_STORE(RST, buf); \
    } while (0)
    Stage R0, R1, R2, R3;
    SEQ_LOAD(R0, 0); SEQ_STORE(R0, 0);
    SEQ_LOAD(R1, 1); SEQ_LOAD(R2, 2); SEQ_LOAD(R3, 3); SEQ_LOAD(R0, 4);
    SEQ_STORE(R1, 1);
    WG_BAR();
    for (int ci = 0; ci < nch; ci += 4) {
        SEQ_LOAD(R1, ci + 5); SEQ_ITER(ci, 0, R2);
        if (ci + 1 >= nch) break;
        SEQ_LOAD(R2, ci + 6); SEQ_ITER(ci + 1, 1, R3);
        if (ci + 2 >= nch) break;
        SEQ_LOAD(R3, ci + 7); SEQ_ITER(ci + 2, 0, R0);
        if (ci + 3 >= nch) break;
        SEQ_LOAD(R0, ci + 8); SEQ_ITER(ci + 3, 1, R1);
    }
    if (cw) {
#pragma unroll
    for (int mb = 0; mb < NMB; ++mb)
#pragma unroll
        for (int i = 0; i < 4; ++i) Sout[(size_t)(16 * mb + 4 * q + i) * 128 + col] = S[mb][i];
    }
    WG_BAR();
#undef SEQ_LOAD
#undef SEQ_STORE
#undef SEQ_ITER
}
__device__ __forceinline__ void seq_dispatch(const Ptrs& c, LAS unsigned char* lds, int item, int tid, int wave, int lane) {
    int row0, nch, ntok, h8, colbase, ncw; const float* S0; float* Sout; const bf16_t* kdt0; int kst; size_t kcs, dcs; const float* dch0;
    if (item < 128) {
        const int bh = item >> 1, b = bh >> 3; h8 = bh & 7; const int hh = h8 & 3; row0 = b * 2048; nch = 64; ntok = 32; S0 = nullptr; colbase = (item & 1) * 64; ncw = 4;
        Sout = h8 < 4 ? c.out + OUT_SAP + (size_t)(b * 4 + hh) * 64 * 128 : c.out + OUT_SBP + (size_t)(b * 4 + hh) * 128 * 128;
        kdt0 = c.P + (size_t)row0 * PLD + (h8 < 4 ? 256 + hh * 64 : 2048 + hh * 128); kst = PLD; kcs = (size_t)32 * PLD;
        dch0 = c.DCH + (size_t)(b * 64 * 8 + h8) * 128; dcs = 8 * 128;
    } else {
        const int j = item - 128, b = j >> 3; h8 = j & 7; const int hh = h8 & 3; row0 = MP + b * 8; nch = 1; ntok = 8; colbase = 0; ncw = 8;
        S0 = h8 < 4 ? c.in[2] + (size_t)(b * 4 + hh) * 64 * 128 : c.in[3] + (size_t)(b * 4 + hh) * 128 * 128;
        Sout = h8 < 4 ? c.out + OUT_SAS + (size_t)(b * 4 + hh) * 64 * 128 : c.out + OUT_SBS + (size_t)(b * 4 + hh) * 128 * 128;
        kdt0 = c.KDTS + (size_t)j * 4096; kst = h8 < 4 ? 64 : 128; kcs = 0; dch0 = c.DCH + (size_t)(4096 + j) * 128; dcs = 0;
    }
    if (h8 < 4) seq_item<64>(c, lds, row0, nch, ntok, h8, colbase, ncw, S0, Sout, kdt0, kst, kcs, dch0, dcs, tid, wave, lane);
    else seq_item<128>(c, lds, row0, nch, ntok, h8, colbase, ncw, S0, Sout, kdt0, kst, kcs, dch0, dcs, tid, wave, lane);
}
__device__ __forceinline__ void p3b_finalize(const Ptrs& c, int G, int wave, int lane) {
    const int gw = blockIdx.x * NWAVES + wave, NGW = G * NWAVES, h8 = lane >> 3, cw = (lane & 7) * 16;
    const float* gp = (h8 < 4 ? c.in[9] : c.in[10]) + cw;
    f32x4 gn[4];
#pragma unroll
    for (int j = 0; j < 4; ++j) gn[j] = *(const f32x4*)(gp + 4 * j);
    const int gcol = (h8 < 4 ? 1024 + h8 * 128 : 3072 + (h8 - 4) * 128) + cw;
    u32x4 nx[2], ng[2], noi[2];
    { const int m0 = gw < M ? gw : M - 1;
#pragma unroll
      for (int j = 0; j < 2; ++j) { noi[j] = *(const u32x4*)(c.OI + (size_t)m0 * 1024 + lane * 16 + 8 * j); nx[j] = *(const u32x4*)(c.OX + (size_t)m0 * 1024 + lane * 16 + 8 * j); ng[j] = *(const u32x4*)(c.P + (size_t)m0 * PLD + gcol + 8 * j); } }
    for (int m = gw; m < M; m += NGW) {
        f32x4 o[4]; u32x4 x[2], g[2], oi[2];
#pragma unroll
        for (int j = 0; j < 2; ++j) { oi[j] = noi[j]; x[j] = nx[j]; g[j] = ng[j]; }
        { const int mn = m + NGW < M ? m + NGW : m;
#pragma unroll
          for (int j = 0; j < 2; ++j) { noi[j] = *(const u32x4*)(c.OI + (size_t)mn * 1024 + lane * 16 + 8 * j); nx[j] = *(const u32x4*)(c.OX + (size_t)mn * 1024 + lane * 16 + 8 * j); ng[j] = *(const u32x4*)(c.P + (size_t)mn * PLD + gcol + 8 * j); } }
        o[0][0] = bf_lo(oi[0].x); o[0][1] = bf_hi(oi[0].x); o[0][2] = bf_lo(oi[0].y); o[0][3] = bf_hi(oi[0].y); o[1][0] = bf_lo(oi[0].z); o[1][1] = bf_hi(oi[0].z); o[1][2] = bf_lo(oi[0].w); o[1][3] = bf_hi(oi[0].w);
        o[2][0] = bf_lo(oi[1].x); o[2][1] = bf_hi(oi[1].x); o[2][2] = bf_lo(oi[1].y); o[2][3] = bf_hi(oi[1].y); o[3][0] = bf_lo(oi[1].z); o[3][1] = bf_hi(oi[1].z); o[3][2] = bf_lo(oi[1].w); o[3][3] = bf_hi(oi[1].w);
        float ss = 0.f;
#pragma unroll
        for (int j = 0; j < 4; ++j) {
            const unsigned w0 = j < 2 ? (j == 0 ? x[0].x : x[0].z) : (j == 2 ? x[1].x : x[1].z), w1 = j < 2 ? (j == 0 ? x[0].y : x[0].w) : (j == 2 ? x[1].y : x[1].w);
            o[j][0] += bf_lo(w0); o[j][1] += bf_hi(w0); o[j][2] += bf_lo(w1); o[j][3] += bf_hi(w1);
            ss += (o[j][0] * o[j][0] + o[j][1] * o[j][1]) + (o[j][2] * o[j][2] + o[j][3] * o[j][3]);
        }
        ss += dpp_f<0xB1, 0xF>(ss); ss += dpp_f<0x4E, 0xF>(ss); ss += dpp_f<0x141, 0xF>(ss);
        const float rs = __builtin_amdgcn_rsqf(ss * (1.0f / 128.0f) + EPS);
        u32x4 w[2];
#pragma unroll
        for (int j = 0; j < 4; ++j) {
            const unsigned g0 = j < 2 ? (j == 0 ? g[0].x : g[0].z) : (j == 2 ? g[1].x : g[1].z), g1 = j < 2 ? (j == 0 ? g[0].y : g[0].w) : (j == 2 ? g[1].y : g[1].w);
            float gg[4] = {bf_lo(g0), bf_hi(g0), bf_lo(g1), bf_hi(g1)}, v[4];
#pragma unroll
            for (int e = 0; e < 4; ++e) v[e] = o[j][e] * rs * gn[j][e] * (gg[e] * __builtin_amdgcn_rcpf(1.0f + __expf(-gg[e])));
            const unsigned p0 = pk_bf16(v[0], v[1]), p1 = pk_bf16(v[2], v[3]);
            if (j == 0) { w[0].x = p0; w[0].y = p1; } else if (j == 1) { w[0].z = p0; w[0].w = p1; } else if (j == 2) { w[1].x = p0; w[1].y = p1; } else { w[1].z = p0; w[1].w = p1; }
        }
        *(u32x4*)(c.OF + (size_t)m * 1024 + lane * 16) = w[0]; *(u32x4*)(c.OF + (size_t)m * 1024 + lane * 16 + 8) = w[1];
    }
}
#define XB_TMO      128
#define XB_XCNT(j)  (256  + 64 * (j))
#define XB_XSUB(j)  (1280 + 64 * (j))
#define XB_XGEN(j)  (2304 + 64 * (j))
#define XB_TOP      3328
#define XB_TOPGEN   3392
#define XCD_BAR_WORDS 3456
#define XB_SPIN_CAP (1u << 18)

__device__ __forceinline__ unsigned xb_ld(unsigned* p)              { return __hip_atomic_load(p, __ATOMIC_RELAXED, __HIP_MEMORY_SCOPE_AGENT); }
__device__ __forceinline__ unsigned xb_add(unsigned* p, unsigned v) { return __hip_atomic_fetch_add(p, v, __ATOMIC_RELAXED, __HIP_MEMORY_SCOPE_AGENT); }
__device__ __forceinline__ unsigned xb_xcc_id() { return (unsigned)__builtin_amdgcn_s_getreg((3 << 11) | 20) & 0xFu; }
#define XB_SPIN(cond, bar) do { unsigned _sp = 0; while (cond) { __builtin_amdgcn_s_sleep(1); \
    if ((++_sp & 255u) == 0u) { if (xb_ld(&(bar)[XB_TMO])) break; if (_sp > XB_SPIN_CAP) { atomicAdd(&(bar)[XB_TMO], 1u); break; } } } } while (0)

struct XcdBarrier {
    unsigned* bar; unsigned x;
    volatile LAS unsigned* st;
};

__device__ __forceinline__ XcdBarrier xcd_barrier_post(unsigned* bar, volatile LAS unsigned* st) {
    XcdBarrier b; b.bar = bar; b.x = xb_xcc_id(); b.st = st;
    if (threadIdx.x == 0) (void)xb_add(&bar[XB_XCNT(b.x)], 1u);
    return b;
}
__device__ __forceinline__ void xcd_barrier_complete(unsigned* bar, unsigned x, unsigned& nloc, unsigned& nx) {
    const unsigned G = gridDim.x * gridDim.y * gridDim.z;
    unsigned sum, cnt, mine, sp = 0u;
    for (;;) {
        sum = 0u; cnt = 0u; mine = 0u;
#pragma unroll
        for (unsigned j = 0; j < 16; ++j) { const unsigned c = xb_ld(&bar[XB_XCNT(j)]); sum += c; cnt += (c > 0u) ? 1u : 0u; mine = (j == x) ? c : mine; }
        if (sum == G) break;
        __builtin_amdgcn_s_sleep(1);
        if ((++sp & 255u) == 0u) { if (xb_ld(&bar[XB_TMO])) break; if (sp > XB_SPIN_CAP) { atomicAdd(&bar[XB_TMO], 1u); break; } }
    }
    nloc = mine > 0u ? mine : 1u; nx = cnt > 0u ? cnt : 1u;
}

__device__ __forceinline__ void xcd_barrier(const XcdBarrier& b) {
    asm volatile("s_waitcnt vmcnt(0)" ::: "memory");
    __syncthreads();
    if (threadIdx.x == 0) {
        unsigned* bar = b.bar;
        __builtin_amdgcn_s_waitcnt(0);
        unsigned nloc = b.st[0], nx = b.st[1];
        if (nloc == 0u) { xcd_barrier_complete(bar, b.x, nloc, nx); b.st[0] = nloc; b.st[1] = nx; }
        const unsigned old = xb_add(&bar[XB_XSUB(b.x)], 1u);
        const unsigned gen = old / nloc;
        if (old + 1u == (gen + 1u) * nloc) {
            __builtin_amdgcn_fence(__ATOMIC_RELEASE, "agent");
            asm volatile("s_waitcnt vmcnt(0)" ::: "memory");
            const unsigned og = xb_add(&bar[XB_TOP], 1u);
            const unsigned tg = og / nx;
            if (og + 1u == (tg + 1u) * nx) xb_add(&bar[XB_TOPGEN], 1u);
            else XB_SPIN(xb_ld(&bar[XB_TOPGEN]) == tg, bar);
            __builtin_amdgcn_fence(__ATOMIC_ACQUIRE, "agent");
            xb_add(&bar[XB_XGEN(b.x)], 1u);
            asm volatile("s_waitcnt vmcnt(0)" ::: "memory");
        } else {
            XB_SPIN(xb_ld(&bar[XB_XGEN(b.x)]) == gen, bar);
            __builtin_amdgcn_fence(__ATOMIC_ACQUIRE, "agent");
            asm volatile("s_waitcnt vmcnt(0)" ::: "memory");
        }
    }
    __syncthreads();
}


struct EpiRes2Norm {
    static constexpr bool PERM = true, AFTER_DRAIN = true;
    float* Y; const bf16_t* X1B; float* SSQ; const float* gfin; XcdBarrier xb;
    __device__ __forceinline__ void fused(pg8::f32x4 (&acc)[2][2][4][2], const pg8::Unit& u, int wr, int wc, int fr, int fq, LAS unsigned char* lds, int wid, int lane) const {
        using pg8::BM; using pg8::HALF;
        const int row0 = u.pm * BM + wr * 64 + fr, ct = u.pn * BM + wc * 32 + 8 * fq;
        LAS float* ssl = (LAS float*)lds;
        f32x4 gv[2][2];
#pragma unroll
        for (int bj = 0; bj < 2; ++bj) { gv[bj][0] = *(const f32x4*)(gfin + ct + bj * HALF); gv[bj][1] = *(const f32x4*)(gfin + ct + bj * HALF + 4); }
#pragma unroll
        for (int ai = 0; ai < 2; ++ai) {
            pg8::u32x4 xr[4][2];
#pragma unroll
            for (int m = 0; m < 4; ++m)
#pragma unroll
                for (int bj = 0; bj < 2; ++bj) xr[m][bj] = *(const pg8::u32x4*)(X1B + (size_t)(row0 + ai * HALF + m * 16) * 1024 + ct + bj * HALF);
#pragma unroll
            for (int m = 0; m < 4; ++m) {
                float ss = 0.f;
#pragma unroll
                for (int bj = 0; bj < 2; ++bj) {
                    const pg8::u32x4 x = xr[m][bj];
                    acc[ai][bj][m][0] += (f32x4){bf_lo(x.x), bf_hi(x.x), bf_lo(x.y), bf_hi(x.y)}; acc[ai][bj][m][1] += (f32x4){bf_lo(x.z), bf_hi(x.z), bf_lo(x.w), bf_hi(x.w)};
                    const f32x4 v0 = acc[ai][bj][m][0], v1 = acc[ai][bj][m][1];
                    ss += (v0[0] * v0[0] + v0[1] * v0[1]) + (v0[2] * v0[2] + v0[3] * v0[3]) + (v1[0] * v1[0] + v1[1] * v1[1]) + (v1[2] * v1[2] + v1[3] * v1[3]);
                }
                ss += __shfl_xor(ss, 16); ss += __shfl_xor(ss, 32);
                if (fq == 0) ssl[(ai * HALF + wr * 64 + m * 16 + fr) * 4 + wc] = ss;
            }
        }
        WG_BAR();
        { const int t = wid * 64 + lane; if (t < 256) { const f32x4 p = *(const LAS f32x4*)(ssl + t * 4); SSQ[(size_t)(u.pm * BM + t) * 4 + u.pn] = (p[0] + p[1]) + (p[2] + p[3]); } }
        xcd_barrier(xb);
        f32x4 st[2][4];
#pragma unroll
        for (int ai = 0; ai < 2; ++ai)
#pragma unroll
            for (int m = 0; m < 4; ++m) st[ai][m] = *(const f32x4*)(SSQ + (size_t)(row0 + ai * HALF + m * 16) * 4);
#pragma unroll
        for (int ai = 0; ai < 2; ++ai)
#pragma unroll
            for (int m = 0; m < 4; ++m) {
                float* yr = Y + (size_t)(row0 + ai * HALF + m * 16) * 1024;
                const float rs = __builtin_amdgcn_rsqf(((st[ai][m][0] + st[ai][m][1]) + (st[ai][m][2] + st[ai][m][3])) * (1.0f / 1024.0f) + EPS);
#pragma unroll
                for (int bj = 0; bj < 2; ++bj) {
                    const int col = ct + bj * HALF;
                    *(f32x4*)(yr + col) = acc[ai][bj][m][0] * rs * gv[bj][0]; *(f32x4*)(yr + col + 4) = acc[ai][bj][m][1] * rs * gv[bj][1];
                }
            }
    }
};

struct Args { const float* in[17]; float* out; unsigned char* ws; int ph_lo, ph_hi, aux, pad; };
constexpr int NPHASE = 9;
__device__ __forceinline__ void fill_ptrs(Ptrs& c, const Args& args) {
#pragma unroll
    for (int i = 0; i < 17; ++i) c.in[i] = args.in[i];
    c.out = args.out;
    unsigned char* ws = args.ws;
    c.WinT = (bf16_t*)(ws + WS_WIN); c.WoT = (bf16_t*)(ws + WS_WO); c.W13T = (bf16_t*)(ws + WS_W13); c.W2T = (bf16_t*)(ws + WS_W2);
    c.XB = (bf16_t*)(ws + WS_XB); c.OF = (bf16_t*)(ws + WS_XB); c.P = (bf16_t*)(ws + WS_P); c.HID = (bf16_t*)(ws + WS_P); c.KDTS = (bf16_t*)(ws + WS_KDTS);
    c.X1B = (bf16_t*)(ws + WS_FB); c.FB = (float*)(ws + WS_FB);
    c.RSTD1 = (float*)(ws + WS_RSTD1); c.SSQ2 = (float*)(ws + WS_SSQ2); c.LRA = (float*)(ws + WS_LRA); c.DCH = (float*)(ws + WS_DCH); c.OY = args.out + OUT_Y; c.DUMP = (bf16_t*)(ws + 30 * MiB); c.OX = (bf16_t*)(ws + WS_FB); c.OI = (bf16_t*)(ws + WS_XB); c.PART = (bf16_t*)(ws + 208 * MiB); c.PART4 = (bf16_t*)(ws + WS_P); c.SSQ3 = (float*)(ws + 30 * MiB + 65536);
}

__global__ void __launch_bounds__(NTHR, 2) hymba_fwd(Args args) {
    extern __shared__ __attribute__((aligned(16))) unsigned char lds_raw[];
    LAS unsigned char* lds = (LAS unsigned char*)lds_raw;
    const int tid = threadIdx.x, lane = tid & 63, wave = __builtin_amdgcn_readfirstlane(tid >> 6), G = gridDim.x;
    unsigned char* ws = args.ws;
    const int lo = args.ph_lo, hi = args.ph_hi;
    volatile LAS unsigned* xst = (volatile LAS unsigned*)(lds + 160256);
    if (tid == 0) { xst[0] = 0u; xst[1] = 0u; }
    __syncthreads();
    XcdBarrier xbar; xbar.bar = (unsigned*)(ws + WS_BAR); xbar.x = 0; xbar.st = xst;
    if (hi - lo > 1) xbar = xcd_barrier_post((unsigned*)(ws + WS_BAR), xst);
#define IN(k) (lo <= (k) && (k) < hi)
#define SEAM(k) do { if (IN(k) && IN((k) + 1)) { if (args.pad != 0) cg::this_grid().sync(); else xcd_barrier(xbar); } } while (0)
    if (IN(0)) { Ptrs c; fill_ptrs(c, args); p0_prologue(c, lds, G, wave, lane, G != 256); }
    SEAM(0);
    if (IN(1)) { Ptrs c; fill_ptrs(c, args);
        pg8::Gemm g{c.XB, c.WinT, M, NIN, D}; pg8::StaticOrder S; S.init(M, NIN, G, (int)blockIdx.x, D);
        pg8::EpiIn E{c.P, c.FB, c.LRA, c.RSTD1};
        pg8::gemm_phase<pg8::EpiIn, pg8::StaticOrder, true, true>(lds, g, S, E);
    }
    SEAM(1);
    if (IN(2)) { Ptrs c; fill_ptrs(c, args); p2_prepass(c, lds, G, tid, wave, lane, args.aux != 0); }
    SEAM(2);
    if (IN(3)) { Ptrs c; fill_ptrs(c, args);
        const int wg = blockIdx.x;
        if (G >= 256) {
            if (wg < 128) seq_dispatch(c, lds, wg, tid, wave, lane);
            else { for (int j = wg - 128; j < 1024; j += G - 128) seq_dispatch(c, lds, 128 + j, tid, wave, lane);
                   weight_items(c, (LAS float*)(lds + wave * 16384), 1, (wg - 128) * NWAVES + wave, (G - 128) * NWAVES, lane); }
        }
        else for (int it = wg; it < 128 + 1024; it += G) seq_dispatch(c, lds, it, tid, wave, lane);
    }
    SEAM(3);
    if (IN(4)) { Ptrs c; fill_ptrs(c, args); p3b_finalize(c, G, wave, lane); }
    SEAM(4);
    if (IN(5)) { Ptrs c; fill_ptrs(c, args);
        pg8::Gemm g{c.OF, c.WoT, M, D, D};
        { pg8::StaticOrder S; S.init(MP, D, G, (int)blockIdx.x, D); pg8::EpiRes1 E{c.in[0], c.in[1], c.OY, c.X1B, c.SSQ2};
          pg8::gemm_phase<pg8::EpiRes1, pg8::StaticOrder, true, true>(lds, g, S, E); }
        { pg8::TailOrder S{G, (int)blockIdx.x, 8, D / 64, MP / 256, 4, 16}; pg8::EpiPart E{c.PART4, MP, 1.f};
          pg8::gemm_phase<pg8::EpiPart, pg8::TailOrder, true, true>(lds, g, S, E); }
        if (hi - lo > 1) xcd_barrier(xbar);
        {
            const int gw = blockIdx.x * NWAVES + wave, NGW = G * NWAVES;
            for (int r = gw; r < MS; r += NGW) {
                const int m = MP + r; f32x4 v[4]; float ss = 0.f;
#pragma unroll
                for (int j = 0; j < 4; ++j) v[j] = *(const f32x4*)(c.in[1] + (size_t)r * D + 4 * lane + 256 * j);
#pragma unroll 1
                for (int ks = 0; ks < 8; ++ks)
#pragma unroll
                    for (int j = 0; j < 4; ++j) { const u32x2 pw = *(const u32x2*)(c.PART4 + ((size_t)ks * 1024 + r) * 1024 + 4 * lane + 256 * j); v[j] += (f32x4){bf_lo(pw.x), bf_hi(pw.x), bf_lo(pw.y), bf_hi(pw.y)}; }
#pragma unroll
                for (int j = 0; j < 4; ++j) {
                    *(f32x4*)(c.OY + (size_t)m * D + 4 * lane + 256 * j) = v[j];
                    u32x2 w; w.x = pk_bf16(v[j][0], v[j][1]); w.y = pk_bf16(v[j][2], v[j][3]); *(u32x2*)(c.X1B + (size_t)m * D + 4 * lane + 256 * j) = w;
                    ss += (v[j][0] * v[j][0] + v[j][1] * v[j][1]) + (v[j][2] * v[j][2] + v[j][3] * v[j][3]);
                }
                ss = wave_sum(ss);
                if (lane == 0) c.RSTD1[m] = __builtin_amdgcn_rsqf(ss * (1.0f / D) + EPS);
            }
            for (int r4 = gw; r4 < MP / 4; r4 += NGW) {
                const int m = 4 * r4 + (lane >> 4); float ss = c.SSQ2[(size_t)m * 16 + (lane & 15)];
                ss = row16_sum(ss);
                if ((lane & 15) == 0) c.RSTD1[m] = __builtin_amdgcn_rsqf(ss * (1.0f / D) + EPS);
            }
        }
    }
    SEAM(5);
    if (IN(6)) { Ptrs c; fill_ptrs(c, args);
        pg8::Gemm g{c.X1B, c.W13T, M, NUP, D}; pg8::StaticOrder S; S.init(M, NUP, G, (int)blockIdx.x, D);
        pg8::EpiSwiglu E{c.HID, c.RSTD1};
        pg8::gemm_phase<pg8::EpiSwiglu, pg8::StaticOrder, true, true>(lds, g, S, E);
    }
    SEAM(6);
    if (IN(7)) { Ptrs c; fill_ptrs(c, args);
        pg8::Gemm g{c.HID, c.W2T, M, D, FF};
        if (G == 256 && hi - lo > 1) {
            pg8::StaticOrder S; S.init(MP, D, G, (int)blockIdx.x, FF); EpiRes2Norm E{c.OY, c.X1B, c.SSQ3, c.in[16], xbar};
            pg8::gemm_phase<EpiRes2Norm, pg8::StaticOrder, true, true>(lds, g, S, E);
        } else {
            pg8::StaticOrder S; S.init(MP, D, G, (int)blockIdx.x, FF); pg8::EpiRes2 E{c.OY, args.aux ? 0.f : 1.f, c.X1B};
            pg8::gemm_phase<pg8::EpiRes2, pg8::StaticOrder, true, true>(lds, g, S, E);
        }
        { pg8::TailOrder S{G, (int)blockIdx.x, 11, FF / 64, MP / 256, 4, 16}; pg8::EpiPart E{c.PART, MP, args.aux ? 0.f : 1.f};
          pg8::gemm_phase<pg8::EpiPart, pg8::TailOrder, true, true>(lds, g, S, E); }
    }
    SEAM(7);
    if (IN(8)) { Ptrs c; fill_ptrs(c, args);
        const int NGW = G * NWAVES, gw = blockIdx.x * NWAVES + wave + ((G == 256 && hi - lo > 1) ? MP : 0);
        f32x4 gn[4];
#pragma unroll
        for (int j = 0; j < 4; ++j) gn[j] = *(const f32x4*)(c.in[16] + 4 * lane + 256 * j);
        if (G == 256 && hi - lo > 1) {
            const int r = blockIdx.x * NWAVES + wave;
            if (r < MS) {
                f32x4 v[4];
#pragma unroll
                for (int j = 0; j < 4; ++j) v[j] = *(const f32x4*)(c.OY + (size_t)(MP + r) * D + 4 * lane + 256 * j);
#pragma unroll
                for (int ks = 0; ks < 11; ++ks)
#pragma unroll
                    for (int j = 0; j < 4; ++j) { const u32x2 pw = *(const u32x2*)(c.PART + ((size_t)ks * 1024 + r) * 1024 + 4 * lane + 256 * j); v[j] += (f32x4){bf_lo(pw.x), bf_hi(pw.x), bf_lo(pw.y), bf_hi(pw.y)}; }
                float s = 0.f;
#pragma unroll
                for (int j = 0; j < 4; ++j) s += (v[j][0] * v[j][0] + v[j][1] * v[j][1]) + (v[j][2] * v[j][2] + v[j][3] * v[j][3]);
                const float rs = __builtin_amdgcn_rsqf(wave_sum(s) * (1.0f / D) + EPS);
#pragma unroll
                for (int j = 0; j < 4; ++j) *(f32x4*)(c.OY + (size_t)(MP + r) * D + 4 * lane + 256 * j) = v[j] * rs * gn[j];
            }
        } else {
        f32x4 v[4], nv[4];
        { const int m0 = gw < M ? gw : M - 1;
#pragma unroll
          for (int j = 0; j < 4; ++j) v[j] = *(const f32x4*)(c.OY + (size_t)m0 * D + 4 * lane + 256 * j); }
#define ADD_PARTS(vv, mm) do { if ((mm) >= MP) { _Pragma("unroll 1") for (int ks = 0; ks < 11; ++ks) { _Pragma("unroll") for (int j = 0; j < 4; ++j) \
            { const u32x2 pw_ = *(const u32x2*)(c.PART + ((size_t)ks * 1024 + ((mm) - MP)) * 1024 + 4 * lane + 256 * j); vv[j] += (f32x4){bf_lo(pw_.x), bf_hi(pw_.x), bf_lo(pw_.y), bf_hi(pw_.y)}; } } } } while (0)
        { const int m0 = gw < M ? gw : M - 1; ADD_PARTS(v, m0); }
        for (int m = gw; m < M; m += NGW) {
            float* yr = c.OY + (size_t)m * D; float s = 0.f;
            { const int mn = m + NGW < M ? m + NGW : m;
#pragma unroll
              for (int j = 0; j < 4; ++j) nv[j] = *(const f32x4*)(c.OY + (size_t)mn * D + 4 * lane + 256 * j);
              ADD_PARTS(nv, mn); }
#pragma unroll
            for (int j = 0; j < 4; ++j) s += (v[j][0] * v[j][0] + v[j][1] * v[j][1]) + (v[j][2] * v[j][2] + v[j][3] * v[j][3]);
            const float rs = __builtin_amdgcn_rsqf(wave_sum(s) * (1.0f / D) + EPS);
#pragma unroll
            for (int j = 0; j < 4; ++j) *(f32x4*)(yr + 4 * lane + 256 * j) = args.aux ? v[j] : v[j] * rs * gn[j];
#pragma unroll
            for (int j = 0; j < 4; ++j) v[j] = nv[j];
        }
        }
    }
#undef IN
#undef SEAM
}

extern "C" void kernel_launch(void* const* d_in, const int* in_sizes, int n_in, void* d_out, int out_size, void* d_ws, size_t ws_size, hipStream_t stream) {
    static int grid = 0;
    if (grid == 0) {
        if (n_in != 17 || ws_size < WS_END) { fprintf(stderr, "kernel_launch: unexpected n_in %d / ws %zu\n", n_in, ws_size); grid = -1; return; }
        int dev = 0, cus = 0, per_cu = 0;
        (void)hipGetDevice(&dev); (void)hipDeviceGetAttribute(&cus, hipDeviceAttributeMultiprocessorCount, dev);
        if (hipFuncSetAttribute((const void*)hymba_fwd, hipFuncAttributeMaxDynamicSharedMemorySize, LDS_BYTES) != hipSuccess) { fprintf(stderr, "kernel_launch: hipFuncSetAttribute failed\n"); grid = -1; return; }
        if (hipOccupancyMaxActiveBlocksPerMultiprocessor(&per_cu, (const void*)hymba_fwd, NTHR, LDS_BYTES) != hipSuccess || per_cu < 1) { fprintf(stderr, "kernel_launch: occupancy query says %d\n", per_cu); per_cu = 1; }
        (void)hipGetLastError();
        grid = cus * per_cu;
        if (grid <= 0) grid = 256;
    }
    if (grid < 0) return;
    if (hipMemsetAsync((char*)d_ws + WS_BAR, 0, 16384, stream) != hipSuccess) { fprintf(stderr, "kernel_launch: memset failed\n"); return; }
    Args a{};
    for (int i = 0; i < 17; ++i) a.in[i] = (const float*)d_in[i];
    a.out = (float*)d_out; a.ws = (unsigned char*)d_ws;
    if (MK_N_LAUNCHES == 1) {
        a.ph_lo = 0; a.ph_hi = NPHASE;
        void* kargs[] = {&a};
        hipError_t e = hipLaunchCooperativeKernel((const void*)hymba_fwd, dim3(grid), dim3(NTHR), kargs, LDS_BYTES, stream);
        if (e != hipSuccess) fprintf(stderr, "kernel_launch: cooperative launch failed: %s (grid %d)\n", hipGetErrorString(e), grid);
    } else {
        for (int p = 0; p < NPHASE; ++p) { a.ph_lo = p; a.ph_hi = p + 1; const int nrep = ((REP_MASK >> p) & 1) ? 3 : 1;
            for (int rr = 0; rr < nrep; ++rr) { a.aux = ((p == 2 || p == 7 || p == 8) && rr + 1 < nrep) ? 1 : 0; hipLaunchKernelGGL(hymba_fwd, dim3(grid), dim3(NTHR), LDS_BYTES, stream, a); } }
    }
}
```

```cpp
#include <hip/hip_runtime.h>
#include <hip/hip_cooperative_groups.h>
#include <cstdio>
#include <cstdint>
namespace cg = cooperative_groups;
namespace pg8 {
#define PG8_LAS __attribute__((address_space(3)))
typedef unsigned short bf16_t;
typedef short bf16x8 __attribute__((ext_vector_type(8)));
typedef float f32x4 __attribute__((ext_vector_type(4)));
typedef unsigned u32x4 __attribute__((ext_vector_type(4)));
constexpr int BM = 256, BK = 64, HALF = 128, HTB = HALF * BK * 2  , STAGE_BYTES = 8 * HTB, NXCD = 8, WGM = 8;

__host__ __device__ __forceinline__ int lds_byte(int r, int c) { const int st = (r >> 4) * 2 + (c >> 5), rr = r & 15, cc = c & 31, ob = rr * 64 + cc * 2; return st * 1024 + (ob ^ (((ob >> 9) & 1) << 5)); }
__host__ __device__ __forceinline__ void stage_rc(int b, int& R, int& C) { const int st = b / 1024, sb = b % 1024, swz = sb ^ (((sb >> 9) & 1) << 5); R = (st >> 1) * 16 + swz / 64; C = (st & 1) * 32 + (swz % 64) / 2; }
__host__ __device__ __forceinline__ int perm32(int rho) { const int n = rho >> 4, i = rho & 15; return 8 * (i >> 2) + 4 * n + (i & 3); }

struct Unit { int pm, pn, k0, nk; };
struct Gemm { const bf16_t* A; const bf16_t* Bt; int M, N, K; };

struct StaticOrder {
    int nM, nN, nwg, G, c, nkt;
    __host__ __device__ void init(int M, int N, int G_, int c_, int K_) { nM = M / BM; nN = N / BM; nwg = nM * nN; G = G_; c = c_; nkt = K_ / BK; }
    __host__ __device__ bool next(int i, Unit& u) const { return at((long)i * G + c, u); }
    __host__ __device__ bool at(long L, Unit& u) const {
        if (L >= nwg) return false;
        int wgid = (int)L; { const int q = nwg / NXCD, r = nwg % NXCD, xcd = wgid % NXCD, off = wgid / NXCD; wgid = (xcd < r ? xcd * (q + 1) : r * (q + 1) + (xcd - r) * q) + off; }
        const int nig = WGM * nN, gid = wgid / nig, fm = gid * WGM, gsz = (nM - fm) < WGM ? (nM - fm) : WGM;
        u.pm = fm + ((wgid % nig) % gsz); u.pn = (wgid % nig) / gsz; u.k0 = 0; u.nk = nkt; return true;
    }
    __device__ __forceinline__ void a_ready(const Unit&) const {}
    __device__ __forceinline__ void done(const Unit&) const {}
};


struct TailOrder {
    int G, c, NS, nkt, pm0, nN, ntu;
    __host__ __device__ bool next(int i, Unit& u) const {
        const int id = i * G + c; if (id >= ntu * NS) return false;
        const int tu = id / NS, ks = id % NS; u.pm = pm0 + tu / nN; u.pn = tu % nN; u.nk = nkt / NS; u.k0 = ks * u.nk; return true;
    }
    __device__ __forceinline__ void a_ready(const Unit&) const {}
    __device__ __forceinline__ void done(const Unit&) const {}
};

__device__ __forceinline__ unsigned cvt_pk_bf16(float lo, float hi) { unsigned r; asm volatile("v_cvt_pk_bf16_f32 %0, %1, %2" : "=v"(r) : "v"(lo), "v"(hi)); return r; }
typedef float f32x2 __attribute__((ext_vector_type(2)));

template <class Epi, class Sched, bool ALIGN_EPI = false, bool SP2 = false>
__device__ __forceinline__ void gemm_phase(PG8_LAS unsigned char* lds, const Gemm g, const Sched& S, const Epi& E) {
    const int tid = threadIdx.x, wid = __builtin_amdgcn_readfirstlane(tid >> 6), lane = tid & 63, wr = wid >> 2, wc = wid & 3, fr = lane & 15, fq = lane >> 4;
    const int K = g.K, nt = K / BK;
    unsigned voffA[2], voffB[2];
#pragma unroll
    for (int i = 0; i < 2; ++i) { int R, C; stage_rc(tid * 16 + i * 8192, R, C); const int Rb = Epi::PERM ? ((R & ~31) + perm32(R & 31)) : R;
        voffA[i] = (unsigned)(R * K + C) * 2u; voffB[i] = (unsigned)(Rb * K + C) * 2u; }
    const size_t kstep = (size_t)(BK * 2);
    const size_t hstep = (size_t)HALF * K * 2;
    const size_t tstep = 2 * hstep;
    const unsigned ldsw = (unsigned)wid * 1024u;
    const int aoff = lds_byte(wr * 64 + fr, fq * 8), boff = lds_byte(wc * 32 + fr, fq * 8);
#define PG8_SA(b, h) (((b) * 2 + (h)) * HTB)
#define PG8_SB(b, h) ((4 + (b) * 2 + (h)) * HTB)
#define PG8_STAGE(bufoff, gbase, voff) do { _Pragma("unroll") for (int _i = 0; _i < 2; ++_i) \
        __builtin_amdgcn_global_load_lds((const unsigned*)((const char*)(gbase) + (voff)[_i]), (PG8_LAS unsigned*)(lds + (bufoff) + ldsw + _i * 8192), 16, 0, 0); } while (0)
#define PG8_LDA(dst, b, h) do { _Pragma("unroll") for (int m = 0; m < 4; ++m) _Pragma("unroll") for (int k = 0; k < 2; ++k) dst[m][k] = *(const PG8_LAS bf16x8*)(lds + PG8_SA(b, h) + aoff + m * 2048 + k * 1024); } while (0)
#define PG8_LDB(dst, b, h) do { _Pragma("unroll") for (int n = 0; n < 2; ++n) _Pragma("unroll") for (int k = 0; k < 2; ++k) dst[n][k] = *(const PG8_LAS bf16x8*)(lds + PG8_SB(b, h) + boff + n * 2048 + k * 1024); } while (0)
#define PG8_MMA(ai, bj, At, Bt) do { __builtin_amdgcn_s_setprio(1); _Pragma("unroll") for (int m = 0; m < 4; ++m) _Pragma("unroll") for (int n = 0; n < 2; ++n) _Pragma("unroll") for (int k = 0; k < 2; ++k) \
        acc[ai][bj][m][n] = __builtin_amdgcn_mfma_f32_16x16x32_bf16(Bt[n][k], At[m][k], acc[ai][bj][m][n], 0, 0, 0); __builtin_amdgcn_s_setprio(0); } while (0)
#define PG8_WAIT_V(n) asm volatile("s_waitcnt vmcnt(" #n ")" ::: "memory")
#define PG8_WAIT_L(n) asm volatile("s_waitcnt lgkmcnt(" #n ")" ::: "memory")
#define PG8_BAR __builtin_amdgcn_s_barrier()
#define PG8_SCHED __builtin_amdgcn_sched_barrier(0)
    Unit cur, nxt; int ui = 0;
    if (!S.next(0, cur)) return;
    f32x4 acc[2][2][4][2];
#pragma unroll
    for (int a = 0; a < 2; ++a)
#pragma unroll
        for (int b = 0; b < 2; ++b)
#pragma unroll
            for (int m = 0; m < 4; ++m)
#pragma unroll
                for (int n = 0; n < 2; ++n) acc[a][b][m][n] = (f32x4){0.f, 0.f, 0.f, 0.f};
    bf16x8 At[4][2], B0[2][2], B1[2][2];
    const char* cA = (const char*)g.A + (size_t)cur.pm * tstep + (size_t)cur.k0 * kstep; const char* cB = (const char*)g.Bt + (size_t)cur.pn * tstep + (size_t)cur.k0 * kstep;
    S.a_ready(cur);
    if constexpr (SP2) {
        PG8_STAGE(PG8_SB(0, 0), cB, voffB); PG8_STAGE(PG8_SB(0, 1), cB + hstep, voffB); PG8_STAGE(PG8_SA(0, 0), cA, voffA); PG8_STAGE(PG8_SA(0, 1), cA + hstep, voffA);
        if (wr == 1) PG8_BAR;
        PG8_WAIT_V(2); PG8_BAR;
        PG8_STAGE(PG8_SB(1, 0), cB + kstep, voffB); PG8_STAGE(PG8_SA(1, 0), cA + kstep, voffA); PG8_STAGE(PG8_SB(1, 1), cB + hstep + kstep, voffB);
        PG8_WAIT_V(6); PG8_BAR;
    } else {
        PG8_STAGE(PG8_SB(0, 0), cB, voffB); PG8_STAGE(PG8_SA(0, 0), cA, voffA); PG8_STAGE(PG8_SB(0, 1), cB + hstep, voffB); PG8_STAGE(PG8_SA(0, 1), cA + hstep, voffA);
        if (wr == 1) PG8_BAR;
        PG8_WAIT_V(4); PG8_BAR;
        PG8_STAGE(PG8_SB(1, 0), cB + kstep, voffB); PG8_STAGE(PG8_SA(1, 0), cA + kstep, voffA); PG8_STAGE(PG8_SB(1, 1), cB + hstep + kstep, voffB);
        PG8_WAIT_V(6); PG8_BAR;
    }
    for (;;) {
        const bool has_next = S.next(ui + 1, nxt);
        const char* nA = has_next ? (const char*)g.A + (size_t)nxt.pm * tstep + (size_t)nxt.k0 * kstep : cA; const char* nB = has_next ? (const char*)g.Bt + (size_t)nxt.pn * tstep + (size_t)nxt.k0 * kstep : cB;
        const int ntc = cur.nk;
        for (int t = 0; t < ntc; t += 2) {
            const bool last = (t == ntc - 2);
            const char* a1 = cA + (size_t)(t + 1) * kstep;
            const char* a2 = last ? nA : cA + (size_t)(t + 2) * kstep; const char* b2 = last ? nB : cB + (size_t)(t + 2) * kstep;
            const char* a3 = a2 + kstep; const char* b3 = b2 + kstep;
            if (last && has_next) S.a_ready(nxt);
            if constexpr (SP2) {
            PG8_LDB(B0, 0, 0); PG8_LDB(B1, 0, 1); PG8_SCHED; PG8_LDA(At, 0, 0); PG8_STAGE(PG8_SA(1, 1), a1 + hstep, voffA);
            PG8_WAIT_V(8); PG8_WAIT_L(0); PG8_BAR; PG8_MMA(0, 0, At, B0); PG8_MMA(0, 1, At, B1); PG8_BAR; PG8_SCHED;
            PG8_LDA(At, 0, 1); PG8_STAGE(PG8_SB(0, 0), b2, voffB); PG8_STAGE(PG8_SB(0, 1), b2 + hstep, voffB); PG8_STAGE(PG8_SA(0, 0), a2, voffA);
            PG8_WAIT_V(8); PG8_WAIT_L(0); PG8_BAR; PG8_MMA(1, 0, At, B0); PG8_MMA(1, 1, At, B1); PG8_BAR; PG8_SCHED;
            PG8_LDB(B0, 1, 0); PG8_LDB(B1, 1, 1); PG8_SCHED; PG8_LDA(At, 1, 0); PG8_STAGE(PG8_SA(0, 1), a2 + hstep, voffA);
            PG8_WAIT_V(8); PG8_WAIT_L(0); PG8_BAR; PG8_MMA(0, 0, At, B0); PG8_MMA(0, 1, At, B1); PG8_BAR; PG8_SCHED;
            PG8_LDA(At, 1, 1); PG8_STAGE(PG8_SB(1, 0), b3, voffB); PG8_STAGE(PG8_SB(1, 1), b3 + hstep, voffB); PG8_STAGE(PG8_SA(1, 0), a3, voffA);
            PG8_WAIT_V(8); PG8_WAIT_L(0); PG8_BAR; PG8_MMA(1, 0, At, B0); PG8_MMA(1, 1, At, B1); PG8_BAR; PG8_SCHED;
            } else {
            PG8_LDB(B0, 0, 0); PG8_SCHED; PG8_LDA(At, 0, 0); PG8_STAGE(PG8_SA(1, 1), a1 + hstep, voffA);
            PG8_WAIT_L(8); PG8_BAR; PG8_WAIT_L(0); PG8_MMA(0, 0, At, B0); PG8_BAR; PG8_SCHED;
            PG8_LDB(B1, 0, 1); PG8_STAGE(PG8_SB(0, 0), b2, voffB);
            PG8_BAR; PG8_WAIT_L(0); PG8_MMA(0, 1, At, B1); PG8_BAR;
            PG8_LDA(At, 0, 1); PG8_STAGE(PG8_SA(0, 0), a2, voffA);
            PG8_BAR; PG8_WAIT_L(0); PG8_MMA(1, 0, At, B0); PG8_BAR; PG8_SCHED;
            PG8_STAGE(PG8_SB(0, 1), b2 + hstep, voffB);
            PG8_WAIT_V(6); PG8_BAR; PG8_MMA(1, 1, At, B1); PG8_BAR;
            PG8_LDB(B0, 1, 0); PG8_SCHED; PG8_LDA(At, 1, 0); PG8_STAGE(PG8_SA(0, 1), a2 + hstep, voffA);
            PG8_WAIT_L(8); PG8_BAR; PG8_WAIT_L(0); PG8_MMA(0, 0, At, B0); PG8_BAR; PG8_SCHED;
            PG8_LDB(B1, 1, 1); PG8_STAGE(PG8_SB(1, 0), b3, voffB);
            PG8_BAR; PG8_WAIT_L(0); PG8_MMA(0, 1, At, B1); PG8_BAR;
            PG8_LDA(At, 1, 1); PG8_STAGE(PG8_SA(1, 0), a3, voffA);
            PG8_BAR; PG8_WAIT_L(0); PG8_MMA(1, 0, At, B0); PG8_BAR; PG8_SCHED;
            PG8_STAGE(PG8_SB(1, 1), b3 + hstep, voffB);
            PG8_WAIT_V(6); PG8_BAR; PG8_MMA(1, 1, At, B1); PG8_BAR;
            }
        }
        if constexpr (ALIGN_EPI) { if (wr == 0) PG8_BAR; }
        if constexpr (!Epi::AFTER_DRAIN) { E(acc, cur, wr, wc, fr, fq); S.done(cur); }
        if (!has_next) break;
#pragma unroll
        for (int a = 0; a < 2; ++a)
#pragma unroll
            for (int b = 0; b < 2; ++b)
#pragma unroll
                for (int m = 0; m < 4; ++m)
#pragma unroll
                    for (int n = 0; n < 2; ++n) acc[a][b][m][n] = (f32x4){0.f, 0.f, 0.f, 0.f};
        cur = nxt; cA = nA; cB = nB; ++ui;
        if constexpr (ALIGN_EPI) { if (wr == 1) PG8_BAR; }
    }
    PG8_WAIT_V(0);
    if constexpr (!ALIGN_EPI) { if (wr == 0) PG8_BAR; }
    PG8_BAR;
    if constexpr (Epi::AFTER_DRAIN) { E.fused(acc, cur, wr, wc, fr, fq, lds, wid, lane); S.done(cur); }
#undef PG8_SA
#undef PG8_SB
#undef PG8_STAGE
#undef PG8_LDA
#undef PG8_LDB
#undef PG8_MMA
#undef PG8_WAIT_V
#undef PG8_WAIT_L
#undef PG8_BAR
#undef PG8_SCHED
}
}

#ifndef MK_N_LAUNCHES
#define MK_N_LAUNCHES 1
#endif
#ifndef REP_MASK
#define REP_MASK 0
#endif
#define LAS __attribute__((address_space(3)))
using pg8::bf16_t; using pg8::bf16x8; using pg8::f32x4; using pg8::u32x4;
typedef float f32x16 __attribute__((ext_vector_type(16)));
typedef __bf16 bf16x2_t __attribute__((ext_vector_type(2)));
typedef float f32x2_t __attribute__((ext_vector_type(2)));
typedef unsigned u32x2 __attribute__((ext_vector_type(2)));

constexpr int NWAVES = 8, NTHR = 512;
constexpr int D = 1024, MP = 16384, MS = 1024, M = MP + MS, NIN = 3840, PLD = 3584, FF = 2816, NUP = 2 * FF;
constexpr float EPS = 1e-6f;
constexpr size_t MiB = 1u << 20;
constexpr size_t WS_BAR = 26 * MiB + 768 * 1024, WS_WIN = 0, WS_WO = 8 * MiB, WS_W13 = 10 * MiB, WS_W2 = 21 * MiB, WS_RSTD1 = 27 * MiB, WS_SSQ2 = 28 * MiB, WS_LRA = 32 * MiB, WS_DCH = 34 * MiB,
                 WS_KDTS = 37 * MiB, WS_XB = 45 * MiB, WS_FB = 79 * MiB, WS_P = 113 * MiB, WS_END = 233 * MiB;
static_assert(WS_P + (size_t)(M + 32) * PLD * 2 <= WS_END && WS_XB + (size_t)M * D * 2 <= WS_FB && WS_FB + (size_t)M * 512 * 4 <= WS_P, "ws map");
constexpr size_t OUT_Y = 0, OUT_SAP = 17825792, OUT_SBP = 18087936, OUT_SAS = 18612224, OUT_SBS = 22806528;
constexpr int LDS_BYTES = 160768;

__device__ __forceinline__ unsigned pk_bf16(float lo, float hi) { f32x2_t v = {lo, hi}; bf16x2_t b = __builtin_convertvector(v, bf16x2_t); return __builtin_bit_cast(unsigned, b); }
__device__ __forceinline__ float bf_lo(unsigned u) { return __uint_as_float(u << 16); }
__device__ __forceinline__ float bf_hi(unsigned u) { return __uint_as_float(u & 0xffff0000u); }
__device__ __forceinline__ float bf_f(unsigned short u) { return __uint_as_float(((unsigned)u) << 16); }


template <int CTRL, int ROWMASK> __device__ __forceinline__ float dpp_f(float v) { return __builtin_bit_cast(float, __builtin_amdgcn_update_dpp(0, __builtin_bit_cast(int, v), CTRL, ROWMASK, 0xF, true)); }
__device__ __forceinline__ float row16_sum(float v) { v += dpp_f<0xB1, 0xF>(v); v += dpp_f<0x4E, 0xF>(v); v += dpp_f<0x141, 0xF>(v); v += dpp_f<0x140, 0xF>(v); return v; }
__device__ __forceinline__ float scan32(float a) {
    a += dpp_f<0x111, 0xF>(a); a += dpp_f<0x112, 0xF>(a); a += dpp_f<0x114, 0xF>(a); a += dpp_f<0x118, 0xF>(a); a += dpp_f<0x142, 0xA>(a); return a; }
template <int CTRL, int ROWMASK> __device__ __forceinline__ float dpp_f1(float v) { return __builtin_bit_cast(float, __builtin_amdgcn_update_dpp(0x3f800000, __builtin_bit_cast(int, v), CTRL, ROWMASK, 0xF, false)); }
__device__ __forceinline__ float scanmul32(float a) {
    a *= dpp_f1<0x111, 0xF>(a); a *= dpp_f1<0x112, 0xF>(a); a *= dpp_f1<0x114, 0xF>(a); a *= dpp_f1<0x118, 0xF>(a); a *= dpp_f1<0x142, 0xA>(a); return a; }
__device__ __forceinline__ float lane_bcast(float v, int l);
__device__ __forceinline__ float wave_sum(float v) { v = row16_sum(v); return (lane_bcast(v, 0) + lane_bcast(v, 16)) + (lane_bcast(v, 32) + lane_bcast(v, 48)); }
__device__ __forceinline__ float lane_bcast(float v, int l) { return __builtin_bit_cast(float, __builtin_amdgcn_readlane(__builtin_bit_cast(int, v), l)); }
#define LDS_WAIT() asm volatile("s_waitcnt lgkmcnt(0)" ::: "memory")
#define WG_BAR() do { asm volatile("s_waitcnt lgkmcnt(0)" ::: "memory"); __builtin_amdgcn_s_barrier(); asm volatile("" ::: "memory"); } while (0)
#define MFMA32(a, b, c) __builtin_amdgcn_mfma_f32_32x32x16_bf16((a), (b), (c), 0, 0, 0)
#define MFMA16(a, b, c) __builtin_amdgcn_mfma_f32_16x16x32_bf16((a), (b), (c), 0, 0, 0)

struct Ptrs {
    const float* in[17]; float* out;
    bf16_t *WinT, *WoT, *W13T, *W2T, *XB, *P, *KDTS, *OF, *X1B, *HID;
    float *RSTD1, *SSQ2, *LRA, *DCH, *FB, *OY; bf16_t *DUMP, *OX, *OI; bf16_t *PART, *PART4; float *SSQ3;
};

namespace pg8 {
struct EpiIn {
    static constexpr bool PERM = true, AFTER_DRAIN = false;
    bf16_t* P; float* FB; float* LRA; const float* rstd;
    __device__ __forceinline__ void operator()(const f32x4 (&acc)[2][2][4][2], const Unit& u, int wr, int wc, int fr, int fq) const {
        const int row0 = u.pm * BM + wr * 64 + fr, ct = wc * 32 + 8 * fq;
#pragma unroll
        for (int ai = 0; ai < 2; ++ai)
#pragma unroll
            for (int m = 0; m < 4; ++m) {
                const int row = row0 + ai * HALF + m * 16; const float rs = 1.0f;
#pragma unroll
                for (int bj = 0; bj < 2; ++bj) {
                    const f32x4 v0 = acc[ai][bj][m][0] * rs, v1 = acc[ai][bj][m][1] * rs; const int cl = bj * HALF + ct;
                    if (u.pn == 14) { if (cl < 16) { float* o = LRA + (size_t)row * 16 + cl; *(f32x4*)o = v0; *(f32x4*)(o + 4) = v1; } }
                    else { u32x4 w; w.x = cvt_pk_bf16(v0[0], v0[1]); w.y = cvt_pk_bf16(v0[2], v0[3]); w.z = cvt_pk_bf16(v1[0], v1[1]); w.w = cvt_pk_bf16(v1[2], v1[3]);
                           *(u32x4*)(P + (size_t)row * 3584 + u.pn * BM + cl) = w; }
                }
            }
    }
};
struct EpiRes1 {
    static constexpr bool PERM = true, AFTER_DRAIN = false;
    const float* xp; const float* xs; float* Y; bf16_t* X1B; float* SSQ;
    __device__ __forceinline__ void operator()(const f32x4 (&acc)[2][2][4][2], const Unit& u, int wr, int wc, int fr, int fq) const {
        const int row0 = u.pm * BM + wr * 64 + fr, ct = u.pn * BM + wc * 32 + 8 * fq;
#pragma unroll
        for (int ai = 0; ai < 2; ++ai) {
            f32x4 xv[4][2][2];
#pragma unroll
            for (int m = 0; m < 4; ++m) {
                const int row = row0 + ai * HALF + m * 16;
                const float* xr = row < 16384 ? xp + (size_t)row * 1024 : xs + (size_t)(row - 16384) * 1024;
#pragma unroll
                for (int bj = 0; bj < 2; ++bj) { xv[m][bj][0] = *(const f32x4*)(xr + ct + bj * HALF); xv[m][bj][1] = *(const f32x4*)(xr + ct + bj * HALF + 4); }
            }
            asm volatile("" ::: "memory");
#pragma unroll
            for (int m = 0; m < 4; ++m) {
                const int row = row0 + ai * HALF + m * 16; float ss = 0.f;
#pragma unroll
                for (int bj = 0; bj < 2; ++bj) {
                    const int col = ct + bj * HALF;
                    const f32x4 v0 = acc[ai][bj][m][0] + xv[m][bj][0], v1 = acc[ai][bj][m][1] + xv[m][bj][1];
                    u32x4 w; w.x = cvt_pk_bf16(v0[0], v0[1]); w.y = cvt_pk_bf16(v0[2], v0[3]); w.z = cvt_pk_bf16(v1[0], v1[1]); w.w = cvt_pk_bf16(v1[2], v1[3]);
                    *(u32x4*)(X1B + (size_t)row * 1024 + col) = w;
                    ss += (v0[0] * v0[0] + v0[1] * v0[1]) + (v0[2] * v0[2] + v0[3] * v0[3]) + (v1[0] * v1[0] + v1[1] * v1[1]) + (v1[2] * v1[2] + v1[3] * v1[3]);
                }
                ss += __shfl_xor(ss, 16); ss += __shfl_xor(ss, 32);
                if (fq == 0) SSQ[(size_t)row * 16 + u.pn * 4 + wc] = ss;
            }
        }
    }
};
struct EpiSwiglu {
    static constexpr bool PERM = true, AFTER_DRAIN = false;
    bf16_t* H; const float* SSQ;
    __device__ __forceinline__ void operator()(const f32x4 (&acc)[2][2][4][2], const Unit& u, int wr, int wc, int fr, int fq) const {
        const int row0 = u.pm * BM + wr * 64 + fr, hc = u.pn * 128 + wc * 32 + fq * 8;
#pragma unroll
        for (int ai = 0; ai < 2; ++ai)
#pragma unroll
            for (int m = 0; m < 4; ++m) {
                const int row = row0 + ai * HALF + m * 16;
                const float rs = SSQ[row];
                float h[8];
#pragma unroll
                for (int n = 0; n < 2; ++n) {
                    const f32x4 a = acc[ai][0][m][n] * rs, b = acc[ai][1][m][n] * rs;
#pragma unroll
                    for (int e = 0; e < 4; ++e) h[4 * n + e] = a[e] * __builtin_amdgcn_rcpf(1.0f + __expf(-a[e])) * b[e];
                }
                u32x4 w; w.x = cvt_pk_bf16(h[0], h[1]); w.y = cvt_pk_bf16(h[2], h[3]); w.z = cvt_pk_bf16(h[4], h[5]); w.w = cvt_pk_bf16(h[6], h[7]);
                *(u32x4*)(H + (size_t)row * 2816 + hc) = w;
            }
    }
};
struct EpiRes2 {
    static constexpr bool PERM = true, AFTER_DRAIN = false;
    float* Y; float sc; const bf16_t* X1B;
    __device__ __forceinline__ void operator()(const f32x4 (&acc)[2][2][4][2], const Unit& u, int wr, int wc, int fr, int fq) const {
        const int row0 = u.pm * BM + wr * 64 + fr, ct = u.pn * BM + wc * 32 + 8 * fq;
#pragma unroll
        for (int ai = 0; ai < 2; ++ai)
#pragma unroll
            for (int m = 0; m < 4; ++m) {
                float* yr = Y + (size_t)(row0 + ai * HALF + m * 16) * 1024;
#pragma unroll
                for (int bj = 0; bj < 2; ++bj) {
                    const int col = ct + bj * HALF;
                    const pg8::u32x4 xr = *(const pg8::u32x4*)(X1B + (size_t)(row0 + ai * HALF + m * 16) * 1024 + col);
                    const f32x4 v0 = acc[ai][bj][m][0] * sc + (f32x4){__uint_as_float(xr.x << 16), __uint_as_float(xr.x & 0xffff0000u), __uint_as_float(xr.y << 16), __uint_as_float(xr.y & 0xffff0000u)};
                    const f32x4 v1 = acc[ai][bj][m][1] * sc + (f32x4){__uint_as_float(xr.z << 16), __uint_as_float(xr.z & 0xffff0000u), __uint_as_float(xr.w << 16), __uint_as_float(xr.w & 0xffff0000u)};
                    *(f32x4*)(yr + col) = v0; *(f32x4*)(yr + col + 4) = v1;
                }
            }
    }
};
struct EpiPart {
    static constexpr bool PERM = true, AFTER_DRAIN = false;
    bf16_t* PART; int rowbase; float sc;
    __device__ __forceinline__ void operator()(const f32x4 (&acc)[2][2][4][2], const Unit& u, int wr, int wc, int fr, int fq) const {
        const int row0 = u.pm * BM + wr * 64 + fr - rowbase, ct = u.pn * BM + wc * 32 + 8 * fq;
        bf16_t* base = PART + (size_t)(u.k0 / u.nk) * 1024 * 1024;
#pragma unroll
        for (int ai = 0; ai < 2; ++ai)
#pragma unroll
            for (int m = 0; m < 4; ++m) {
                bf16_t* yr = base + (size_t)(row0 + ai * HALF + m * 16) * 1024;
#pragma unroll
                for (int bj = 0; bj < 2; ++bj) { const f32x4 v0 = acc[ai][bj][m][0] * sc, v1 = acc[ai][bj][m][1] * sc;
                    u32x4 w; w.x = cvt_pk_bf16(v0[0], v0[1]); w.y = cvt_pk_bf16(v0[2], v0[3]); w.z = cvt_pk_bf16(v1[0], v1[1]); w.w = cvt_pk_bf16(v1[2], v1[3]);
                    *(u32x4*)(yr + ct + bj * HALF) = w; }
            }
    }
};
}

__device__ __forceinline__ void tr_item(const float* colp, int ldw, const float* gain, int k0, int dcol, bf16_t* WT, int K, int nrow0, LAS float* scr, int lane) {
    float tv[32];
#pragma unroll
    for (int i = 0; i < 32; ++i) { const int kk = 2 * i + (lane >> 5); tv[i] = colp ? colp[(size_t)(k0 + kk) * ldw] : 0.f; }
    if (gain) {
        float gv[32];
#pragma unroll
        for (int i = 0; i < 32; ++i) gv[i] = gain[k0 + 2 * i + (lane >> 5)];
#pragma unroll
        for (int i = 0; i < 32; ++i) tv[i] *= gv[i];
    }
#pragma unroll
    for (int i = 0; i < 32; ++i) scr[(2 * i + (lane >> 5)) * 33 + dcol] = tv[i];
    LDS_WAIT();
    const int c = lane & 7;
#pragma unroll
    for (int j = 0; j < 4; ++j) {
        const int n = (lane >> 3) + 8 * j; const LAS float* s = scr + (8 * c) * 33 + n;
        u32x4 o; o.x = pk_bf16(s[0 * 33], s[1 * 33]); o.y = pk_bf16(s[2 * 33], s[3 * 33]); o.z = pk_bf16(s[4 * 33], s[5 * 33]); o.w = pk_bf16(s[6 * 33], s[7 * 33]);
        *(u32x4*)(WT + (size_t)(nrow0 + n) * K + k0 + 8 * c) = o;
    }
    LDS_WAIT();
}
__device__ __forceinline__ void weight_items(const Ptrs& c, LAS float* scr, int part, int gw, int NGW, int lane) {
    const int l31 = lane & 31;
    constexpr int I_IN = 16 * 120, I_O = 16 * 32, I_13 = 16 * 176, I_2 = 44 * 32;
    if (part == 0) {
        for (int r = gw; r < I_IN; r += NGW) { const int kb = r / 120, nb = r % 120, n = nb * 32 + l31;
            const int oc = n < 1536 ? n : (n < 3584 ? n + 16 : (n < 3600 ? n - 3584 + 1536 : -1));
            tr_item(oc >= 0 ? c.in[5] + oc : nullptr, 3600, c.in[4], kb * 64, l31, c.WinT, 1024, nb * 32, scr, lane); }
        return;
    }
    for (int it = gw; it < I_O + I_13 + I_2; it += NGW) {
        int r = it;
        if (r < I_O) { const int kb = r / 32, nb = r % 32; tr_item(c.in[11] + nb * 32 + l31, 1024, nullptr, kb * 64, l31, c.WoT, 1024, nb * 32, scr, lane); continue; }
        r -= I_O;
        if (r < I_13) { const int kb = r / 176, nb = r % 176, t = nb >> 3, wb = nb & 7; const bool is3 = wb >= 4; const int hcol = 128 * t + 32 * (wb & 3) + l31;
            tr_item((is3 ? c.in[14] : c.in[13]) + hcol, 2816, c.in[12], kb * 64, l31, c.W13T, 1024, nb * 32, scr, lane); continue; }
        r -= I_13;
        { const int kb = r / 32, nb = r % 32; tr_item(c.in[15] + nb * 32 + l31, 1024, nullptr, kb * 64, l31, c.W2T, 2816, nb * 32, scr, lane); }
    }
}
__device__ __forceinline__ void p0_prologue(const Ptrs& c, LAS unsigned char* lds, int G, int wave, int lane, bool all_weights) {
    LAS float* scr = (LAS float*)(lds + wave * 16384);
    const int gw = blockIdx.x * NWAVES + wave, NGW = G * NWAVES;
    weight_items(c, scr, 0, gw, NGW, lane);
    if (all_weights) weight_items(c, scr, 1, gw, NGW, lane);
    {
        f32x4 v[4], nv[4];
        { const int m0 = gw < M ? gw : M - 1; const float* xr = m0 < MP ? c.in[0] + (size_t)m0 * D : c.in[1] + (size_t)(m0 - MP) * D;
#pragma unroll
          for (int j = 0; j < 4; ++j) v[j] = *(const f32x4*)(xr + 4 * lane + 256 * j); }
        for (int m = gw; m < M; m += NGW) {
            { const int mn = m + NGW < M ? m + NGW : m; const float* xr = mn < MP ? c.in[0] + (size_t)mn * D : c.in[1] + (size_t)(mn - MP) * D;
#pragma unroll
              for (int j = 0; j < 4; ++j) nv[j] = *(const f32x4*)(xr + 4 * lane + 256 * j); }
            float s = 0.f;
#pragma unroll
            for (int j = 0; j < 4; ++j) s += (v[j][0] * v[j][0] + v[j][1] * v[j][1]) + (v[j][2] * v[j][2] + v[j][3] * v[j][3]);
            s = wave_sum(s);
            const float rs = __builtin_amdgcn_rsqf(s * (1.0f / D) + EPS);
#pragma unroll
            for (int j = 0; j < 4; ++j) { u32x2 w; w.x = pk_bf16(v[j][0] * rs, v[j][1] * rs); w.y = pk_bf16(v[j][2] * rs, v[j][3] * rs); *(u32x2*)(c.XB + (size_t)m * D + 4 * lane + 256 * j) = w; }
#pragma unroll
            for (int j = 0; j < 4; ++j) v[j] = nv[j];
        }
    }
}

__device__ __forceinline__ int crow(int i, int h) { return (i & 3) + 8 * (i >> 2) + 4 * h; }
template <int K, bool GLA, bool ALLV>
__device__ __forceinline__ void pre_item(const Ptrs& c, int row0, int ntok, int hh, int item, bf16_t* kdt_base, int kdt_stride,
                                         const LAS float* wa2_l, const LAS float* ba_l, const LAS float* lb_l, LAS unsigned char* vt, int lane, bool dry) {
    const int r = lane & 31, kg = lane >> 5;
    const bool valid = ALLV || r < ntok;
    const int row = row0 + (valid ? r : 0), nt1 = ntok - 1;
    constexpr int NJ = K / 16;
    const int qcol0 = GLA ? hh * 64 : 1536 + hh * 128, kcol0 = 256 + hh * 64, vcol0 = GLA ? 512 + hh * 128 : 2560 + hh * 128, ocol0 = (GLA ? hh : 4 + hh) * 128;
    bf16_t* Prow = c.P + (size_t)row * PLD;
    LAS unsigned char* kt = vt + 8192;
    LAS unsigned char* dl = vt + 16384;
    float lra[16];
    if constexpr (GLA) {
#pragma unroll
        for (int i = 0; i < 4; ++i) { const f32x4 t = *(const f32x4*)(c.LRA + (size_t)row * 16 + 4 * i); lra[4 * i] = t[0]; lra[4 * i + 1] = t[1]; lra[4 * i + 2] = t[2]; lra[4 * i + 3] = t[3]; }
    }
    const bf16_t* qptr = Prow + qcol0 + 8 * kg;
    const bf16_t* kptr = Prow + kcol0 + 8 * kg;
    const bf16_t* fptr = Prow + 2048 + hh * 128 + 8 * kg;
    u32x4 qn = *(const u32x4*)qptr, kn = {0u, 0u, 0u, 0u}; f32x4 fn0 = {0.f, 0.f, 0.f, 0.f}, fn1 = fn0;
    if constexpr (GLA) kn = *(const u32x4*)kptr; else { const u32x4 fr_ = *(const u32x4*)fptr; fn0 = (f32x4){bf_lo(fr_.x), bf_hi(fr_.x), bf_lo(fr_.y), bf_hi(fr_.y)}; fn1 = (f32x4){bf_lo(fr_.z), bf_hi(fr_.z), bf_lo(fr_.w), bf_hi(fr_.w)}; }
    f32x16 att;
#pragma unroll
    for (int i = 0; i < 16; ++i) att[i] = 0.f;
    float* dch = c.DCH + (size_t)item * 128;
#pragma unroll 1
    for (int j = 0; j < NJ; ++j) {
        const int cl = 16 * j + 8 * kg;
        const u32x4 qr = qn, kr = kn; const f32x4 f0 = fn0, f1 = fn1;
        { const int jn = j + 1 < NJ ? j + 1 : j;
          qn = *(const u32x4*)(qptr + 16 * jn);
          if constexpr (GLA) kn = *(const u32x4*)(kptr + 16 * jn); else { const u32x4 fr_ = *(const u32x4*)(fptr + 16 * jn); fn0 = (f32x4){bf_lo(fr_.x), bf_hi(fr_.x), bf_lo(fr_.y), bf_hi(fr_.y)}; fn1 = (f32x4){bf_lo(fr_.z), bf_hi(fr_.z), bf_lo(fr_.w), bf_hi(fr_.w)}; } }
        float la[8], kv[8], qv[8];
        if constexpr (GLA) {
            const LAS float* wl = wa2_l + hh * 64 + cl;
            f32x4 a0 = *(const LAS f32x4*)(ba_l + hh * 64 + cl), a1 = *(const LAS f32x4*)(ba_l + hh * 64 + cl + 4);
#pragma unroll
            for (int rb = 0; rb < 16; rb += 4) {
                f32x4 w[8];
#pragma unroll
                for (int rr = 0; rr < 4; ++rr) { w[2 * rr] = *(const LAS f32x4*)(wl + (rb + rr) * 256); w[2 * rr + 1] = *(const LAS f32x4*)(wl + (rb + rr) * 256 + 4); }
#pragma unroll
                for (int rr = 0; rr < 4; ++rr) { a0 += w[2 * rr] * lra[rb + rr]; a1 += w[2 * rr + 1] * lra[rb + rr]; }
            }
            float x[8], t[8];
#pragma unroll
            for (int e = 0; e < 8; ++e) x[e] = e < 4 ? a0[e & 3] : a1[e & 3];
#pragma unroll
            for (int e = 0; e < 8; ++e) t[e] = __expf(-fabsf(x[e]));
#pragma unroll
            for (int e = 0; e < 8; ++e) t[e] = __logf(1.0f + t[e]);
#pragma unroll
            for (int e = 0; e < 8; ++e) la[e] = (fminf(x[e], 0.f) - t[e]) * 0.0625f;
            kv[0] = bf_lo(kr.x); kv[1] = bf_hi(kr.x); kv[2] = bf_lo(kr.y); kv[3] = bf_hi(kr.y); kv[4] = bf_lo(kr.z); kv[5] = bf_hi(kr.z); kv[6] = bf_lo(kr.w); kv[7] = bf_hi(kr.w);
        } else {
            const f32x4 l0 = *(const LAS f32x4*)(lb_l + hh * 128 + cl), l1 = *(const LAS f32x4*)(lb_l + hh * 128 + cl + 4);
            float x[8], lbv[8], ex[8], inv[8];
#pragma unroll
            for (int e = 0; e < 8; ++e) { x[e] = e < 4 ? f0[e & 3] : f1[e & 3]; lbv[e] = e < 4 ? l0[e & 3] : l1[e & 3]; }
#pragma unroll
            for (int e = 0; e < 8; ++e) ex[e] = __expf(-fabsf(x[e]));
#pragma unroll
            for (int e = 0; e < 8; ++e) inv[e] = __builtin_amdgcn_rcpf(1.0f + ex[e]);
#pragma unroll
            for (int e = 0; e < 8; ++e) { const float ei = ex[e] * inv[e]; const float sg = x[e] >= 0.f ? inv[e] : ei, ng = x[e] >= 0.f ? ei : inv[e];
                la[e] = lbv[e] + (1.0f - lbv[e]) * sg; kv[e] = (1.0f - lbv[e]) * ng; }
        }
        qv[0] = bf_lo(qr.x); qv[1] = bf_hi(qr.x); qv[2] = bf_lo(qr.y); qv[3] = bf_hi(qr.y); qv[4] = bf_lo(qr.z); qv[5] = bf_hi(qr.z); qv[6] = bf_lo(qr.w); qv[7] = bf_hi(qr.w);
        float qi[8], ki[8], kd[8], eb[8], q[8], ea[8], ia[8];
        if constexpr (GLA) {
#pragma unroll
            for (int e = 0; e < 8; ++e) q[e] = qv[e] * 0.125f;
        } else {
#pragma unroll
            for (int e = 0; e < 8; ++e) q[e] = __expf(-qv[e]);
#pragma unroll
            for (int e = 0; e < 8; ++e) q[e] = __builtin_amdgcn_rcpf(1.0f + q[e]);
#pragma unroll
            for (int e = 0; e < 8; ++e) q[e] *= qv[e];
        }
        if (!ALLV) {
#pragma unroll
            for (int e = 0; e < 8; ++e) if (!valid) { q[e] = 0.f; kv[e] = 0.f; la[e] = GLA ? 0.f : 1.f; }
        }
        if constexpr (GLA) {
#pragma unroll
            for (int e = 0; e < 8; ++e) la[e] += dpp_f<0x111, 0xF>(la[e]);
#pragma unroll
            for (int e = 0; e < 8; ++e) la[e] += dpp_f<0x112, 0xF>(la[e]);
#pragma unroll
            for (int e = 0; e < 8; ++e) la[e] += dpp_f<0x114, 0xF>(la[e]);
#pragma unroll
            for (int e = 0; e < 8; ++e) la[e] += dpp_f<0x118, 0xF>(la[e]);
#pragma unroll
            for (int e = 0; e < 8; ++e) la[e] += dpp_f<0x142, 0xA>(la[e]);
#pragma unroll
            for (int e = 0; e < 8; ++e) ea[e] = __expf(fmaxf(la[e], -80.f));
        } else {
#pragma unroll
            for (int e = 0; e < 8; ++e) la[e] *= dpp_f1<0x111, 0xF>(la[e]);
#pragma unroll
            for (int e = 0; e < 8; ++e) la[e] *= dpp_f1<0x112, 0xF>(la[e]);
#pragma unroll
            for (int e = 0; e < 8; ++e) la[e] *= dpp_f1<0x114, 0xF>(la[e]);
#pragma unroll
            for (int e = 0; e < 8; ++e) la[e] *= dpp_f1<0x118, 0xF>(la[e]);
#pragma unroll
            for (int e = 0; e < 8; ++e) la[e] *= dpp_f1<0x142, 0xA>(la[e]);
#pragma unroll
            for (int e = 0; e < 8; ++e) ea[e] = fmaxf(la[e], 1e-35f);
        }
#pragma unroll
        for (int e = 0; e < 8; ++e) ia[e] = __builtin_amdgcn_rcpf(ea[e]);
#pragma unroll
        for (int e = 0; e < 8; ++e) { const float e31 = lane_bcast(ea[e], 31), e63 = lane_bcast(ea[e], 63); eb[e] = kg ? e63 : e31; }
#pragma unroll
        for (int e = 0; e < 8; ++e) { qi[e] = q[e] * ea[e]; ki[e] = kv[e] * ia[e]; kd[e] = ki[e] * eb[e]; }
        u32x4 qp, kp;
        qp.x = pk_bf16(qi[0], qi[1]); qp.y = pk_bf16(qi[2], qi[3]); qp.z = pk_bf16(qi[4], qi[5]); qp.w = pk_bf16(qi[6], qi[7]);
        kp.x = pk_bf16(ki[0], ki[1]); kp.y = pk_bf16(ki[2], ki[3]); kp.z = pk_bf16(ki[4], ki[5]); kp.w = pk_bf16(ki[6], ki[7]);
        att = MFMA32(__builtin_bit_cast(bf16x8, kp), __builtin_bit_cast(bf16x8, qp), att);
        *(LAS u32x4*)(vt + r * (K * 2) + ((((cl >> 3) ^ r) & (K / 8 - 1)) << 4)) = qp;
#pragma unroll
        for (int e = 0; e < 8; e += 2) {
            const unsigned pkd = pk_bf16(kd[e], kd[e + 1]);
            *(LAS unsigned short*)(kt + (cl + e) * 64 + r * 2) = (unsigned short)(pkd & 0xffffu);
            *(LAS unsigned short*)(kt + (cl + e + 1) * 64 + r * 2) = (unsigned short)(pkd >> 16);
        }
        if (r == 0) { f32x4 d0 = {eb[0], eb[1], eb[2], eb[3]}, d1 = {eb[4], eb[5], eb[6], eb[7]}; *(LAS f32x4*)(dl + cl * 4) = d0; *(LAS f32x4*)(dl + cl * 4 + 16) = d1; }
    }
    u32x4 vreg[8];
#pragma unroll
    for (int i = 0; i < 8; ++i) { const int p = lane + 64 * i, vr = (p >> 4) < nt1 ? (p >> 4) : nt1; vreg[i] = *(const u32x4*)(c.P + (size_t)(row0 + vr) * PLD + vcol0 + (p & 15) * 8); }
#pragma unroll
    for (int i = 0; i < K / 16; ++i) {
        const int p = lane + 64 * i, L = p * 8, qr_ = p / (K / 8), qc_ = p % (K / 8);
        if ((ALLV || qr_ < ntok) && !dry) *(u32x4*)(c.P + (size_t)(row0 + qr_) * PLD + qcol0 + qc_ * 8) = *(const LAS u32x4*)(vt + qr_ * (K * 2) + (((qc_ ^ qr_) & (K / 8 - 1)) << 4));
        *(u32x4*)(kdt_base + (size_t)(L / K) * kdt_stride + (L % K)) = *(const LAS u32x4*)(kt + p * 16);
    }
    if (lane < K / 4) *(f32x4*)(dch + lane * 4) = *(const LAS f32x4*)(dl + lane * 16);
#pragma unroll
    for (int i = 0; i < 8; ++i) { const int p = lane + 64 * i; *(LAS u32x4*)(vt + (p >> 4) * 256 + (p & 15) * 16) = vreg[i]; }
#pragma unroll
    for (int i = 0; i < 16; ++i) if (crow(i, kg) > r) att[i] = 0.f;
    u32x4 pa0, pa1;
    pa0.x = pk_bf16(att[0], att[1]); pa0.y = pk_bf16(att[2], att[3]); pa0.z = pk_bf16(att[4], att[5]); pa0.w = pk_bf16(att[6], att[7]);
    pa1.x = pk_bf16(att[8], att[9]); pa1.y = pk_bf16(att[10], att[11]); pa1.z = pk_bf16(att[12], att[13]); pa1.w = pk_bf16(att[14], att[15]);
#pragma unroll 1
    for (int vb = 0; vb < 4; ++vb) {
        unsigned short vs[16];
#pragma unroll
        for (int i = 0; i < 16; ++i) vs[i] = *(const LAS unsigned short*)(vt + crow(i, kg) * 256 + (vb * 32 + r) * 2);
        u32x4 b0, b1;
        b0.x = vs[0] | ((unsigned)vs[1] << 16); b0.y = vs[2] | ((unsigned)vs[3] << 16); b0.z = vs[4] | ((unsigned)vs[5] << 16); b0.w = vs[6] | ((unsigned)vs[7] << 16);
        b1.x = vs[8] | ((unsigned)vs[9] << 16); b1.y = vs[10] | ((unsigned)vs[11] << 16); b1.z = vs[12] | ((unsigned)vs[13] << 16); b1.w = vs[14] | ((unsigned)vs[15] << 16);
        f32x16 o;
#pragma unroll
        for (int i = 0; i < 16; ++i) o[i] = 0.f;
        o = MFMA32(__builtin_bit_cast(bf16x8, pa0), __builtin_bit_cast(bf16x8, b0), o);
        o = MFMA32(__builtin_bit_cast(bf16x8, pa1), __builtin_bit_cast(bf16x8, b1), o);
#pragma unroll
        for (int i = 0; i < 16; ++i) *(LAS unsigned short*)(kt + crow(i, kg) * 256 + (vb * 32 + r) * 2) = (unsigned short)(pk_bf16(o[i], 0.f) & 0xffffu);
    }
#pragma unroll
    for (int i = 0; i < 8; ++i) {
        const int p = lane + 64 * i, t = p >> 4;
        if (t < ntok) *(u32x4*)(c.OI + (size_t)(row0 + t) * 1024 + ocol0 + (p & 15) * 8) = *(const LAS u32x4*)(kt + p * 16);
    }
}
__device__ __forceinline__ void p2_prepass(const Ptrs& c, LAS unsigned char* lds, int G, int tid, int wave, int lane, bool dry) {
    LAS float* wa2_l = (LAS float*)lds; LAS float* ba_l = wa2_l + 4096; LAS float* lb_l = ba_l + 256;
    for (int i = tid; i < 4096; i += NTHR) wa2_l[i] = c.in[6][i];
    if (tid < 256) ba_l[tid] = c.in[7][tid];
    { const float p0 = c.in[8][tid], p1 = c.in[8][512 + tid]; lb_l[tid] = 1.0f / (1.0f + __expf(p1 - p0)); }
    WG_BAR();
    const int gw = blockIdx.x * NWAVES + wave, NGW = G * NWAVES;
    const bool bal = (G == 256);
    const int n_it = bal ? 4096 : 4096 + 1024;
    for (int it0 = gw; ; it0 += NGW) {
        int it = it0;
        if (it0 >= n_it) { if (!bal || wave >= 4 || it0 >= n_it + NGW) break; it = 4096 + blockIdx.x * 4 + wave; }
        int row0, ntok, h; bf16_t* kdt; int kst;
        if (it < 4096) { h = it & 7; const int ch = (it >> 3) & 63, b = it >> 9; row0 = b * 2048 + ch * 32; ntok = 32; kst = PLD;
                         kdt = c.P + (size_t)row0 * PLD + (h < 4 ? 256 + h * 64 : 2048 + (h - 4) * 128); }
        else { const int j = it - 4096; h = j & 7; row0 = MP + (j >> 3) * 8; ntok = 8; kst = h < 4 ? 64 : 128; kdt = c.KDTS + (size_t)j * 4096; }
        if (dry) { kst = h < 4 ? 64 : 128; kdt = (bf16_t*)((unsigned char*)c.DUMP + 203 * MiB) + (size_t)(it & 2047) * 4096; }
        if (it < 4096) { if (h < 4) pre_item<64, true, true>(c, row0, ntok, h, it, kdt, kst, wa2_l, ba_l, lb_l, lds + 20480 + wave * 16896, lane, dry);
                         else pre_item<128, false, true>(c, row0, ntok, h - 4, it, kdt, kst, wa2_l, ba_l, lb_l, lds + 20480 + wave * 16896, lane, dry); }
        else { if (h < 4) pre_item<64, true, false>(c, row0, ntok, h, it, kdt, kst, wa2_l, ba_l, lb_l, lds + 20480 + wave * 16896, lane, dry);
               else pre_item<128, false, false>(c, row0, ntok, h - 4, it, kdt, kst, wa2_l, ba_l, lb_l, lds + 20480 + wave * 16896, lane, dry); }
    }
}

template <int K>
__device__ __forceinline__ void seq_item(const Ptrs& c, LAS unsigned char* lds, int row0, int nch, int ntok, int h8, int colbase, int ncw, const float* S0, float* Sout,
                                         const bf16_t* kdt0, int kdt_rstride, size_t kdt_cstep, const float* dch0, size_t dch_cstep, int tid, int wave, int lane) {
    constexpr int QROW = 2 * K + 16, VROW = 272;
    constexpr int KOFF = 8704, DOFF = 18944, VOFF = 19456, BUFB = 28160, NMB = K / 16, NPC = 4 * K;
    const int n = lane & 15, q = lane >> 4, col = colbase + 16 * (wave < ncw ? wave : 0) + n;
    const bool cw = wave < ncw;
    const bool gla = h8 < 4; const int hh = h8 & 3;
    const int qcol0 = gla ? hh * 64 : 1536 + hh * 128, vcol0 = gla ? 512 + hh * 128 : 2560 + hh * 128, ocol = h8 * 128 + col;
    f32x4 S[NMB];
#pragma unroll
    for (int mb = 0; mb < NMB; ++mb)
#pragma unroll
        for (int i = 0; i < 4; ++i) S[mb][i] = (S0 && cw) ? S0[(size_t)(16 * mb + 4 * q + i) * 128 + col] : 0.f;
    const int nt1 = ntok - 1;
    const int pq = tid % NPC, prow_q = pq / (K / 8), pc8 = pq % (K / 8), prq = prow_q < nt1 ? prow_q : nt1;
    const int vrow = tid >> 4, vc8 = tid & 15, vr = vrow < nt1 ? vrow : nt1;
    const int dpi = tid % (K / 4);
    const bf16_t* gq = c.P + (size_t)(row0 + prq) * PLD + qcol0 + pc8 * 8;
    const bf16_t* gk = kdt0 + (size_t)prow_q * kdt_rstride + pc8 * 8;
    const float* gd = dch0 + dpi * 4;
    const bf16_t* gvp = c.P + (size_t)(row0 + vr) * PLD + vcol0 + vc8 * 8;
    struct Stage { u32x4 q, k, v; f32x4 d; };
    const int nch1 = nch - 1;
#define SEQ_LOAD(R, cc) do { const int c_ = (cc) < nch1 ? (cc) : nch1; const size_t ro_ = (size_t)c_ * 32; \
        R.q = *(const u32x4*)(gq + ro_ * PLD); R.k = *(const u32x4*)(gk + (size_t)c_ * kdt_cstep); R.d = *(const f32x4*)(gd + (size_t)c_ * dch_cstep); \
        R.v = *(const u32x4*)(gvp + ro_ * PLD); } while (0)
#define SEQ_STORE(R, buf) do { LAS unsigned char* B_ = lds + (buf) * BUFB; \
        *(LAS u32x4*)(B_ + prow_q * QROW + pc8 * 16) = R.q; *(LAS u32x4*)(B_ + KOFF + (pq >> 2) * 80 + (pq & 3) * 16) = R.k; *(LAS f32x4*)(B_ + DOFF + dpi * 16) = R.d; \
        *(LAS u32x4*)(B_ + VOFF + vrow * VROW + vc8 * 16) = R.v; } while (0)
#define SEQ_ITER(ci, buf, RST) do { \
        const LAS unsigned char* B = lds + (buf) * BUFB; \
        if (cw) { \
        f32x4 o[2] = {{0.f, 0.f, 0.f, 0.f}, {0.f, 0.f, 0.f, 0.f}}; \
        _Pragma("unroll") for (int js = 0; js < K / 32; ++js) { \
            u32x4 sb; sb.x = pk_bf16(S[2 * js][0], S[2 * js][1]); sb.y = pk_bf16(S[2 * js][2], S[2 * js][3]); sb.z = pk_bf16(S[2 * js + 1][0], S[2 * js + 1][1]); sb.w = pk_bf16(S[2 * js + 1][2], S[2 * js + 1][3]); \
            _Pragma("unroll") for (int mb2 = 0; mb2 < 2; ++mb2) { \
                const LAS unsigned char* qp = B + (16 * mb2 + n) * QROW + (32 * js + 4 * q) * 2; \
                const u32x2 lo = *(const LAS u32x2*)qp, hi = *(const LAS u32x2*)(qp + 32); \
                u32x4 qa; qa.x = lo.x; qa.y = lo.y; qa.z = hi.x; qa.w = hi.y; \
                o[mb2] = MFMA16(__builtin_bit_cast(bf16x8, qa), __builtin_bit_cast(bf16x8, sb), o[mb2]); } } \
        { unsigned short vs[8]; \
            _Pragma("unroll") for (int j = 0; j < 8; ++j) vs[j] = *(const LAS unsigned short*)(B + VOFF + (8 * q + j) * VROW + col * 2); \
            u32x4 vb; vb.x = vs[0] | ((unsigned)vs[1] << 16); vb.y = vs[2] | ((unsigned)vs[3] << 16); vb.z = vs[4] | ((unsigned)vs[5] << 16); vb.w = vs[6] | ((unsigned)vs[7] << 16); \
            _Pragma("unroll") for (int mb = 0; mb < NMB; ++mb) { \
                const u32x4 ka = *(const LAS u32x4*)(B + KOFF + (16 * mb + n) * 80 + q * 16); \
                const f32x4 dv = *(const LAS f32x4*)(B + DOFF + (16 * mb + 4 * q) * 4); \
                S[mb] = S[mb] * dv; \
                S[mb] = MFMA16(__builtin_bit_cast(bf16x8, ka), __builtin_bit_cast(bf16x8, vb), S[mb]); } } \
        bf16_t* ob = c.OX + (size_t)(row0 + 32 * (ci)) * 1024 + ocol; \
        _Pragma("unroll") for (int x = 0; x < 8; x += 2) { \
            const int t = 16 * (x >> 2) + 4 * q + (x & 3); const unsigned pv = pk_bf16(o[x >> 2][x & 3], o[x >> 2][(x & 3) + 1]); \
            bf16_t* d0 = t < ntok ? ob + (size_t)t * 1024 : c.DUMP + tid; bf16_t* d1 = t + 1 < ntok ? ob + (size_t)(t + 1) * 1024 : c.DUMP + tid; \
            *d0 = (bf16_t)(pv & 0xffffu); *d1 = (bf16_t)(pv >> 16); } \
        } \
        WG_BAR(); \
        SEQ_STORE(RST, buf); \
    } while (0)
    Stage R0, R1, R2, R3;
    SEQ_LOAD(R0, 0); SEQ_STORE(R0, 0);
    SEQ_LOAD(R1, 1); SEQ_LOAD(R2, 2); SEQ_LOAD(R3, 3); SEQ_LOAD(R0, 4);
    SEQ_STORE(R1, 1);
    WG_BAR();
    for (int ci = 0; ci < nch; ci += 4) {
        SEQ_LOAD(R1, ci + 5); SEQ_ITER(ci, 0, R2);
        if (ci + 1 >= nch) break;
        SEQ_LOAD(R2, ci + 6); SEQ_ITER(ci + 1, 1, R3);
        if (ci + 2 >= nch) break;
        SEQ_LOAD(R3, ci + 7); SEQ_ITER(ci + 2, 0, R0);
        if (ci + 3 >= nch) break;
        SEQ_LOAD(R0, ci + 8); SEQ_ITER(ci + 3, 1, R1);
    }
    if (cw) {
#pragma unroll
    for (int mb = 0; mb < NMB; ++mb)
#pragma unroll
        for (int i = 0; i < 4; ++i) Sout[(size_t)(16 * mb + 4 * q + i) * 128 + col] = S[mb][i];
    }
    WG_BAR();
#undef SEQ_LOAD
#undef SEQ_STORE
#undef SEQ_ITER
}
__device__ __forceinline__ void seq_dispatch(const Ptrs& c, LAS unsigned char* lds, int item, int tid, int wave, int lane) {
    int row0, nch, ntok, h8, colbase, ncw; const float* S0; float* Sout; const bf16_t* kdt0; int kst; size_t kcs, dcs; const float* dch0;
    if (item < 128) {
        const int bh = item >> 1, b = bh >> 3; h8 = bh & 7; const int hh = h8 & 3; row0 = b * 2048; nch = 64; ntok = 32; S0 = nullptr; colbase = (item & 1) * 64; ncw = 4;
        Sout = h8 < 4 ? c.out + OUT_SAP + (size_t)(b * 4 + hh) * 64 * 128 : c.out + OUT_SBP + (size_t)(b * 4 + hh) * 128 * 128;
        kdt0 = c.P + (size_t)row0 * PLD + (h8 < 4 ? 256 + hh * 64 : 2048 + hh * 128); kst = PLD; kcs = (size_t)32 * PLD;
        dch0 = c.DCH + (size_t)(b * 64 * 8 + h8) * 128; dcs = 8 * 128;
    } else {
        const int j = item - 128, b = j >> 3; h8 = j & 7; const int hh = h8 & 3; row0 = MP + b * 8; nch = 1; ntok = 8; colbase = 0; ncw = 8;
        S0 = h8 < 4 ? c.in[2] + (size_t)(b * 4 + hh) * 64 * 128 : c.in[3] + (size_t)(b * 4 + hh) * 128 * 128;
        Sout = h8 < 4 ? c.out + OUT_SAS + (size_t)(b * 4 + hh) * 64 * 128 : c.out + OUT_SBS + (size_t)(b * 4 + hh) * 128 * 128;
        kdt0 = c.KDTS + (size_t)j * 4096; kst = h8 < 4 ? 64 : 128; kcs = 0; dch0 = c.DCH + (size_t)(4096 + j) * 128; dcs = 0;
    }
    if (h8 < 4) seq_item<64>(c, lds, row0, nch, ntok, h8, colbase, ncw, S0, Sout, kdt0, kst, kcs, dch0, dcs, tid, wave, lane);
    else seq_item<128>(c, lds, row0, nch, ntok, h8, colbase, ncw, S0, Sout, kdt0, kst, kcs, dch0, dcs, tid, wave, lane);
}
__device__ __forceinline__ void p3b_finalize(const Ptrs& c, int G, int wave, int lane) {
    const int gw = blockIdx.x * NWAVES + wave, NGW = G * NWAVES, h8 = lane >> 3, cw = (lane & 7) * 16;
    const float* gp = (h8 < 4 ? c.in[9] : c.in[10]) + cw;
    f32x4 gn[4];
#pragma unroll
    for (int j = 0; j < 4; ++j) gn[j] = *(const f32x4*)(gp + 4 * j);
    const int gcol = (h8 < 4 ? 1024 + h8 * 128 : 3072 + (h8 - 4) * 128) + cw;
    u32x4 nx[2], ng[2], noi[2];
    { const int m0 = gw < M ? gw : M - 1;
#pragma unroll
      for (int j = 0; j < 2; ++j) { noi[j] = *(const u32x4*)(c.OI + (size_t)m0 * 1024 + lane * 16 + 8 * j); nx[j] = *(const u32x4*)(c.OX + (size_t)m0 * 1024 + lane * 16 + 8 * j); ng[j] = *(const u32x4*)(c.P + (size_t)m0 * PLD + gcol + 8 * j); } }
    for (int m = gw; m < M; m += NGW) {
        f32x4 o[4]; u32x4 x[2], g[2], oi[2];
#pragma unroll
        for (int j = 0; j < 2; ++j) { oi[j] = noi[j]; x[j] = nx[j]; g[j] = ng[j]; }
        { const int mn = m + NGW < M ? m + NGW : m;
#pragma unroll
          for (int j = 0; j < 2; ++j) { noi[j] = *(const u32x4*)(c.OI + (size_t)mn * 1024 + lane * 16 + 8 * j); nx[j] = *(const u32x4*)(c.OX + (size_t)mn * 1024 + lane * 16 + 8 * j); ng[j] = *(const u32x4*)(c.P + (size_t)mn * PLD + gcol + 8 * j); } }
        o[0][0] = bf_lo(oi[0].x); o[0][1] = bf_hi(oi[0].x); o[0][2] = bf_lo(oi[0].y); o[0][3] = bf_hi(oi[0].y); o[1][0] = bf_lo(oi[0].z); o[1][1] = bf_hi(oi[0].z); o[1][2] = bf_lo(oi[0].w); o[1][3] = bf_hi(oi[0].w);
        o[2][0] = bf_lo(oi[1].x); o[2][1] = bf_hi(oi[1].x); o[2][2] = bf_lo(oi[1].y); o[2][3] = bf_hi(oi[1].y); o[3][0] = bf_lo(oi[1].z); o[3][1] = bf_hi(oi[1].z); o[3][2] = bf_lo(oi[1].w); o[3][3] = bf_hi(oi[1].w);
        float ss = 0.f;
#pragma unroll
        for (int j = 0; j < 4; ++j) {
            const unsigned w0 = j < 2 ? (j == 0 ? x[0].x : x[0].z) : (j == 2 ? x[1].x : x[1].z), w1 = j < 2 ? (j == 0 ? x[0].y : x[0].w) : (j == 2 ? x[1].y : x[1].w);
            o[j][0] += bf_lo(w0); o[j][1] += bf_hi(w0); o[j][2] += bf_lo(w1); o[j][3] += bf_hi(w1);
            ss += (o[j][0] * o[j][0] + o[j][1] * o[j][1]) + (o[j][2] * o[j][2] + o[j][3] * o[j][3]);
        }
        ss += dpp_f<0xB1, 0xF>(ss); ss += dpp_f<0x4E, 0xF>(ss); ss += dpp_f<0x141, 0xF>(ss);
        const float rs = __builtin_amdgcn_rsqf(ss * (1.0f / 128.0f) + EPS);
        u32x4 w[2];
#pragma unroll
        for (int j = 0; j < 4; ++j) {
            const unsigned g0 = j < 2 ? (j == 0 ? g[0].x : g[0].z) : (j == 2 ? g[1].x : g[1].z), g1 = j < 2 ? (j == 0 ? g[0].y : g[0].w) : (j == 2 ? g[1].y : g[1].w);
            float gg[4] = {bf_lo(g0), bf_hi(g0), bf_lo(g1), bf_hi(g1)}, v[4];
#pragma unroll
            for (int e = 0; e < 4; ++e) v[e] = o[j][e] * rs * gn[j][e] * (gg[e] * __builtin_amdgcn_rcpf(1.0f + __expf(-gg[e])));
            const unsigned p0 = pk_bf16(v[0], v[1]), p1 = pk_bf16(v[2], v[3]);
            if (j == 0) { w[0].x = p0; w[0].y = p1; } else if (j == 1) { w[0].z = p0; w[0].w = p1; } else if (j == 2) { w[1].x = p0; w[1].y = p1; } else { w[1].z = p0; w[1].w = p1; }
        }
        *(u32x4*)(c.OF + (size_t)m * 1024 + lane * 16) = w[0]; *(u32x4*)(c.OF + (size_t)m * 1024 + lane * 16 + 8) = w[1];
    }
}
#define XB_TMO      128
#define XB_XCNT(j)  (256  + 64 * (j))
#define XB_XSUB(j)  (1280 + 64 * (j))
#define XB_XGEN(j)  (2304 + 64 * (j))
#define XB_TOP      3328
#define XB_TOPGEN   3392
#define XCD_BAR_WORDS 3456
#define XB_SPIN_CAP (1u << 18)

__device__ __forceinline__ unsigned xb_ld(unsigned* p)              { return __hip_atomic_load(p, __ATOMIC_RELAXED, __HIP_MEMORY_SCOPE_AGENT); }
__device__ __forceinline__ unsigned xb_add(unsigned* p, unsigned v) { return __hip_atomic_fetch_add(p, v, __ATOMIC_RELAXED, __HIP_MEMORY_SCOPE_AGENT); }
__device__ __forceinline__ unsigned xb_xcc_id() { return (unsigned)__builtin_amdgcn_s_getreg((3 << 11) | 20) & 0xFu; }
#define XB_SPIN(cond, bar) do { unsigned _sp = 0; while (cond) { __builtin_amdgcn_s_sleep(1); \
    if ((++_sp & 255u) == 0u) { if (xb_ld(&(bar)[XB_TMO])) break; if (_sp > XB_SPIN_CAP) { atomicAdd(&(bar)[XB_TMO], 1u); break; } } } } while (0)

struct XcdBarrier {
    unsigned* bar; unsigned x;
    volatile LAS unsigned* st;
};

__device__ __forceinline__ XcdBarrier xcd_barrier_post(unsigned* bar, volatile LAS unsigned* st) {
    XcdBarrier b; b.bar = bar; b.x = xb_xcc_id(); b.st = st;
    if (threadIdx.x == 0) (void)xb_add(&bar[XB_XCNT(b.x)], 1u);
    return b;
}
__device__ __forceinline__ void xcd_barrier_complete(unsigned* bar, unsigned x, unsigned& nloc, unsigned& nx) {
    const unsigned G = gridDim.x * gridDim.y * gridDim.z;
    unsigned sum, cnt, mine, sp = 0u;
    for (;;) {
        sum = 0u; cnt = 0u; mine = 0u;
#pragma unroll
        for (unsigned j = 0; j < 16; ++j) { const unsigned c = xb_ld(&bar[XB_XCNT(j)]); sum += c; cnt += (c > 0u) ? 1u : 0u; mine = (j == x) ? c : mine; }
        if (sum == G) break;
        __builtin_amdgcn_s_sleep(1);
        if ((++sp & 255u) == 0u) { if (xb_ld(&bar[XB_TMO])) break; if (sp > XB_SPIN_CAP) { atomicAdd(&bar[XB_TMO], 1u); break; } }
    }
    nloc = mine > 0u ? mine : 1u; nx = cnt > 0u ? cnt : 1u;
}

__device__ __forceinline__ void xcd_barrier(const XcdBarrier& b) {
    asm volatile("s_waitcnt vmcnt(0)" ::: "memory");
    __syncthreads();
    if (threadIdx.x == 0) {
        unsigned* bar = b.bar;
        __builtin_amdgcn_s_waitcnt(0);
        unsigned nloc = b.st[0], nx = b.st[1];
        if (nloc == 0u) { xcd_barrier_complete(bar, b.x, nloc, nx); b.st[0] = nloc; b.st[1] = nx; }
        const unsigned old = xb_add(&bar[XB_XSUB(b.x)], 1u);
        const unsigned gen = old / nloc;
        if (old + 1u == (gen + 1u) * nloc) {
            __builtin_amdgcn_fence(__ATOMIC_RELEASE, "agent");
            asm volatile("s_waitcnt vmcnt(0)" ::: "memory");
            const unsigned og = xb_add(&bar[XB_TOP], 1u);
            const unsigned tg = og / nx;
            if (og + 1u == (tg + 1u) * nx) xb_add(&bar[XB_TOPGEN], 1u);
            else XB_SPIN(xb_ld(&bar[XB_TOPGEN]) == tg, bar);
            __builtin_amdgcn_fence(__ATOMIC_ACQUIRE, "agent");
            xb_add(&bar[XB_XGEN(b.x)], 1u);
            asm volatile("s_waitcnt vmcnt(0)" ::: "memory");
        } else {
            XB_SPIN(xb_ld(&bar[XB_XGEN(b.x)]) == gen, bar);
            __builtin_amdgcn_fence(__ATOMIC_ACQUIRE, "agent");
            asm volatile("s_waitcnt vmcnt(0)" ::: "memory");
        }
    }
    __syncthreads();
}


struct EpiRes2Norm {
    static constexpr bool PERM = true, AFTER_DRAIN = true;
    float* Y; const bf16_t* X1B; float* SSQ; const float* gfin; XcdBarrier xb;
    __device__ __forceinline__ void fused(pg8::f32x4 (&acc)[2][2][4][2], const pg8::Unit& u, int wr, int wc, int fr, int fq, LAS unsigned char* lds, int wid, int lane) const {
        using pg8::BM; using pg8::HALF;
        const int row0 = u.pm * BM + wr * 64 + fr, ct = u.pn * BM + wc * 32 + 8 * fq;
        LAS float* ssl = (LAS float*)lds;
        f32x4 gv[2][2];
#pragma unroll
        for (int bj = 0; bj < 2; ++bj) { gv[bj][0] = *(const f32x4*)(gfin + ct + bj * HALF); gv[bj][1] = *(const f32x4*)(gfin + ct + bj * HALF + 4); }
#pragma unroll
        for (int ai = 0; ai < 2; ++ai) {
            pg8::u32x4 xr[4][2];
#pragma unroll
            for (int m = 0; m < 4; ++m)
#pragma unroll
                for (int bj = 0; bj < 2; ++bj) xr[m][bj] = *(const pg8::u32x4*)(X1B + (size_t)(row0 + ai * HALF + m * 16) * 1024 + ct + bj * HALF);
#pragma unroll
            for (int m = 0; m < 4; ++m) {
                float ss = 0.f;
#pragma unroll
                for (int bj = 0; bj < 2; ++bj) {
                    const pg8::u32x4 x = xr[m][bj];
                    acc[ai][bj][m][0] += (f32x4){bf_lo(x.x), bf_hi(x.x), bf_lo(x.y), bf_hi(x.y)}; acc[ai][bj][m][1] += (f32x4){bf_lo(x.z), bf_hi(x.z), bf_lo(x.w), bf_hi(x.w)};
                    const f32x4 v0 = acc[ai][bj][m][0], v1 = acc[ai][bj][m][1];
                    ss += (v0[0] * v0[0] + v0[1] * v0[1]) + (v0[2] * v0[2] + v0[3] * v0[3]) + (v1[0] * v1[0] + v1[1] * v1[1]) + (v1[2] * v1[2] + v1[3] * v1[3]);
                }
                ss += __shfl_xor(ss, 16); ss += __shfl_xor(ss, 32);
                if (fq == 0) ssl[(ai * HALF + wr * 64 + m * 16 + fr) * 4 + wc] = ss;
            }
        }
        WG_BAR();
        { const int t = wid * 64 + lane; if (t < 256) { const f32x4 p = *(const LAS f32x4*)(ssl + t * 4); SSQ[(size_t)(u.pm * BM + t) * 4 + u.pn] = (p[0] + p[1]) + (p[2] + p[3]); } }
        xcd_barrier(xb);
        f32x4 st[2][4];
#pragma unroll
        for (int ai = 0; ai < 2; ++ai)
#pragma unroll
            for (int m = 0; m < 4; ++m) st[ai][m] = *(const f32x4*)(SSQ + (size_t)(row0 + ai * HALF + m * 16) * 4);
#pragma unroll
        for (int ai = 0; ai < 2; ++ai)
#pragma unroll
            for (int m = 0; m < 4; ++m) {
                float* yr = Y + (size_t)(row0 + ai * HALF + m * 16) * 1024;
                const float rs = __builtin_amdgcn_rsqf(((st[ai][m][0] + st[ai][m][1]) + (st[ai][m][2] + st[ai][m][3])) * (1.0f / 1024.0f) + EPS);
#pragma unroll
                for (int bj = 0; bj < 2; ++bj) {
                    const int col = ct + bj * HALF;
                    *(f32x4*)(yr + col) = acc[ai][bj][m][0] * rs * gv[bj][0]; *(f32x4*)(yr + col + 4) = acc[ai][bj][m][1] * rs * gv[bj][1];
                }
            }
    }
};

struct Args { const float* in[17]; float* out; unsigned char* ws; int ph_lo, ph_hi, aux, pad; };
constexpr int NPHASE = 9;
__device__ __forceinline__ void fill_ptrs(Ptrs& c, const Args& args) {
#pragma unroll
    for (int i = 0; i < 17; ++i) c.in[i] = args.in[i];
    c.out = args.out;
    unsigned char* ws = args.ws;
    c.WinT = (bf16_t*)(ws + WS_WIN); c.WoT = (bf16_t*)(ws + WS_WO); c.W13T = (bf16_t*)(ws + WS_W13); c.W2T = (bf16_t*)(ws + WS_W2);
    c.XB = (bf16_t*)(ws + WS_XB); c.OF = (bf16_t*)(ws + WS_XB); c.P = (bf16_t*)(ws + WS_P); c.HID = (bf16_t*)(ws + WS_P); c.KDTS = (bf16_t*)(ws + WS_KDTS);
    c.X1B = (bf16_t*)(ws + WS_FB); c.FB = (float*)(ws + WS_FB);
    c.RSTD1 = (float*)(ws + WS_RSTD1); c.SSQ2 = (float*)(ws + WS_SSQ2); c.LRA = (float*)(ws + WS_LRA); c.DCH = (float*)(ws + WS_DCH); c.OY = args.out + OUT_Y; c.DUMP = (bf16_t*)(ws + 30 * MiB); c.OX = (bf16_t*)(ws + WS_FB); c.OI = (bf16_t*)(ws + WS_XB); c.PART = (bf16_t*)(ws + 208 * MiB); c.PART4 = (bf16_t*)(ws + WS_P); c.SSQ3 = (float*)(ws + 30 * MiB + 65536);
}

__global__ void __launch_bounds__(NTHR, 2) hymba_fwd(Args args) {
    extern __shared__ __attribute__((aligned(16))) unsigned char lds_raw[];
    LAS unsigned char* lds = (LAS unsigned char*)lds_raw;
    const int tid = threadIdx.x, lane = tid & 63, wave = __builtin_amdgcn_readfirstlane(tid >> 6), G = gridDim.x;
    unsigned char* ws = args.ws;
    const int lo = args.ph_lo, hi = args.ph_hi;
    volatile LAS unsigned* xst = (volatile LAS unsigned*)(lds + 160256);
    if (tid == 0) { xst[0] = 0u; xst[1] = 0u; }
    __syncthreads();
    XcdBarrier xbar; xbar.bar = (unsigned*)(ws + WS_BAR); xbar.x = 0; xbar.st = xst;
    if (hi - lo > 1) xbar = xcd_barrier_post((unsigned*)(ws + WS_BAR), xst);
#define IN(k) (lo <= (k) && (k) < hi)
#define SEAM(k) do { if (IN(k) && IN((k) + 1)) { if (args.pad != 0) cg::this_grid().sync(); else xcd_barrier(xbar); } } while (0)
    if (IN(0)) { Ptrs c; fill_ptrs(c, args); p0_prologue(c, lds, G, wave, lane, G != 256); }
    SEAM(0);
    if (IN(1)) { Ptrs c; fill_ptrs(c, args);
        pg8::Gemm g{c.XB, c.WinT, M, NIN, D}; pg8::StaticOrder S; S.init(M, NIN, G, (int)blockIdx.x, D);
        pg8::EpiIn E{c.P, c.FB, c.LRA, c.RSTD1};
        pg8::gemm_phase<pg8::EpiIn, pg8::StaticOrder, true, true>(lds, g, S, E);
    }
    SEAM(1);
    if (IN(2)) { Ptrs c; fill_ptrs(c, args); p2_prepass(c, lds, G, tid, wave, lane, args.aux != 0); }
    SEAM(2);
    if (IN(3)) { Ptrs c; fill_ptrs(c, args);
        const int wg = blockIdx.x;
        if (G >= 256) {
            if (wg < 128) seq_dispatch(c, lds, wg, tid, wave, lane);
            else { for (int j = wg - 128; j < 1024; j += G - 128) seq_dispatch(c, lds, 128 + j, tid, wave, lane);
                   weight_items(c, (LAS float*)(lds + wave * 16384), 1, (wg - 128) * NWAVES + wave, (G - 128) * NWAVES, lane); }
        }
        else for (int it = wg; it < 128 + 1024; it += G) seq_dispatch(c, lds, it, tid, wave, lane);
    }
    SEAM(3);
    if (IN(4)) { Ptrs c; fill_ptrs(c, args); p3b_finalize(c, G, wave, lane); }
    SEAM(4);
    if (IN(5)) { Ptrs c; fill_ptrs(c, args);
        pg8::Gemm g{c.OF, c.WoT, M, D, D};
        { pg8::StaticOrder S; S.init(MP, D, G, (int)blockIdx.x, D); pg8::EpiRes1 E{c.in[0], c.in[1], c.OY, c.X1B, c.SSQ2};
          pg8::gemm_phase<pg8::EpiRes1, pg8::StaticOrder, true, true>(lds, g, S, E); }
        { pg8::TailOrder S{G, (int)blockIdx.x, 8, D / 64, MP / 256, 4, 16}; pg8::EpiPart E{c.PART4, MP, 1.f};
          pg8::gemm_phase<pg8::EpiPart, pg8::TailOrder, true, true>(lds, g, S, E); }
        if (hi - lo > 1) xcd_barrier(xbar);
        {
            const int gw = blockIdx.x * NWAVES + wave, NGW = G * NWAVES;
            for (int r = gw; r < MS; r += NGW) {
                const int m = MP + r; f32x4 v[4]; float ss = 0.f;
#pragma unroll
                for (int j = 0; j < 4; ++j) v[j] = *(const f32x4*)(c.in[1] + (size_t)r * D + 4 * lane + 256 * j);
#pragma unroll 1
                for (int ks = 0; ks < 8; ++ks)
#pragma unroll
                    for (int j = 0; j < 4; ++j) { const u32x2 pw = *(const u32x2*)(c.PART4 + ((size_t)ks * 1024 + r) * 1024 + 4 * lane + 256 * j); v[j] += (f32x4){bf_lo(pw.x), bf_hi(pw.x), bf_lo(pw.y), bf_hi(pw.y)}; }
#pragma unroll
                for (int j = 0; j < 4; ++j) {
                    *(f32x4*)(c.OY + (size_t)m * D + 4 * lane + 256 * j) = v[j];
                    u32x2 w; w.x = pk_bf16(v[j][0], v[j][1]); w.y = pk_bf16(v[j][2], v[j][3]); *(u32x2*)(c.X1B + (size_t)m * D + 4 * lane + 256 * j) = w;
                    ss += (v[j][0] * v[j][0] + v[j][1] * v[j][1]) + (v[j][2] * v[j][2] + v[j][3] * v[j][3]);
                }
                ss = wave_sum(ss);
                if (lane == 0) c.RSTD1[m] = __builtin_amdgcn_rsqf(ss * (1.0f / D) + EPS);
            }
            for (int r4 = gw; r4 < MP / 4; r4 += NGW) {
                const int m = 4 * r4 + (lane >> 4); float ss = c.SSQ2[(size_t)m * 16 + (lane & 15)];
                ss = row16_sum(ss);
                if ((lane & 15) == 0) c.RSTD1[m] = __builtin_amdgcn_rsqf(ss * (1.0f / D) + EPS);
            }
        }
    }
    SEAM(5);
    if (IN(6)) { Ptrs c; fill_ptrs(c, args);
        pg8::Gemm g{c.X1B, c.W13T, M, NUP, D}; pg8::StaticOrder S; S.init(M, NUP, G, (int)blockIdx.x, D);
        pg8::EpiSwiglu E{c.HID, c.RSTD1};
        pg8::gemm_phase<pg8::EpiSwiglu, pg8::StaticOrder, true, true>(lds, g, S, E);
    }
    SEAM(6);
    if (IN(7)) { Ptrs c; fill_ptrs(c, args);
        pg8::Gemm g{c.HID, c.W2T, M, D, FF};
        if (G == 256 && hi - lo > 1) {
            pg8::StaticOrder S; S.init(MP, D, G, (int)blockIdx.x, FF); EpiRes2Norm E{c.OY, c.X1B, c.SSQ3, c.in[16], xbar};
            pg8::gemm_phase<EpiRes2Norm, pg8::StaticOrder, true, true>(lds, g, S, E);
        } else {
            pg8::StaticOrder S; S.init(MP, D, G, (int)blockIdx.x, FF); pg8::EpiRes2 E{c.OY, args.aux ? 0.f : 1.f, c.X1B};
            pg8::gemm_phase<pg8::EpiRes2, pg8::StaticOrder, true, true>(lds, g, S, E);
        }
        { pg8::TailOrder S{G, (int)blockIdx.x, 11, FF / 64, MP / 256, 4, 16}; pg8::EpiPart E{c.PART, MP, args.aux ? 0.f : 1.f};
          pg8::gemm_phase<pg8::EpiPart, pg8::TailOrder, true, true>(lds, g, S, E); }
    }
    SEAM(7);
    if (IN(8)) { Ptrs c; fill_ptrs(c, args);
        const int NGW = G * NWAVES, gw = blockIdx.x * NWAVES + wave + ((G == 256 && hi - lo > 1) ? MP : 0);
        f32x4 gn[4];
#pragma unroll
        for (int j = 0; j < 4; ++j) gn[j] = *(const f32x4*)(c.in[16] + 4 * lane + 256 * j);
        if (G == 256 && hi - lo > 1) {
            const int r = blockIdx.x * NWAVES + wave;
            if (r < MS) {
                f32x4 v[4];
#pragma unroll
                for (int j = 0; j < 4; ++j) v[j] = *(const f32x4*)(c.OY + (size_t)(MP + r) * D + 4 * lane + 256 * j);
#pragma unroll
                for (int ks = 0; ks < 11; ++ks)
#pragma unroll
                    for (int j = 0; j < 4; ++j) { const u32x2 pw = *(const u32x2*)(c.PART + ((size_t)ks * 1024 + r) * 1024 + 4 * lane + 256 * j); v[j] += (f32x4){bf_lo(pw.x), bf_hi(pw.x), bf_lo(pw.y), bf_hi(pw.y)}; }
                float s = 0.f;
#pragma unroll
                for (int j = 0; j < 4; ++j) s += (v[j][0] * v[j][0] + v[j][1] * v[j][1]) + (v[j][2] * v[j][2] + v[j][3] * v[j][3]);
                const float rs = __builtin_amdgcn_rsqf(wave_sum(s) * (1.0f / D) + EPS);
#pragma unroll
                for (int j = 0; j < 4; ++j) *(f32x4*)(c.OY + (size_t)(MP + r) * D + 4 * lane + 256 * j) = v[j] * rs * gn[j];
            }
        } else {
        f32x4 v[4], nv[4];
        { const int m0 = gw < M ? gw : M - 1;
#pragma unroll
          for (int j = 0; j < 4; ++j) v[j] = *(const f32x4*)(c.OY + (size_t)m0 * D + 4 * lane + 256 * j); }
#define ADD_PARTS(vv, mm) do { if ((mm) >= MP) { _Pragma("unroll 1") for (int ks = 0; ks < 11; ++ks) { _Pragma("unroll") for (int j = 0; j < 4; ++j) \
            { const u32x2 pw_ = *(const u32x2*)(c.PART + ((size_t)ks * 1024 + ((mm) - MP)) * 1024 + 4 * lane + 256 * j); vv[j] += (f32x4){bf_lo(pw_.x), bf_hi(pw_.x), bf_lo(pw_.y), bf_hi(pw_.y)}; } } } } while (0)
        { const int m0 = gw < M ? gw : M - 1; ADD_PARTS(v, m0); }
        for (int m = gw; m < M; m += NGW) {
            float* yr = c.OY + (size_t)m * D; float s = 0.f;
            { const int mn = m + NGW < M ? m + NGW : m;
#pragma unroll
              for (int j = 0; j < 4; ++j) nv[j] = *(const f32x4*)(c.OY + (size_t)mn * D + 4 * lane + 256 * j);
              ADD_PARTS(nv, mn); }
#pragma unroll
            for (int j = 0; j < 4; ++j) s += (v[j][0] * v[j][0] + v[j][1] * v[j][1]) + (v[j][2] * v[j][2] + v[j][3] * v[j][3]);
            const float rs = __builtin_amdgcn_rsqf(wave_sum(s) * (1.0f / D) + EPS);
#pragma unroll
            for (int j = 0; j < 4; ++j) *(f32x4*)(yr + 4 * lane + 256 * j) = args.aux ? v[j] : v[j] * rs * gn[j];
#pragma unroll
            for (int j = 0; j < 4; ++j) v[j] = nv[j];
        }
        }
    }
#undef IN
#undef SEAM
}

extern "C" void kernel_launch(void* const* d_in, const int* in_sizes, int n_in, void* d_out, int out_size, void* d_ws, size_t ws_size, hipStream_t stream) {
    static int grid = 0;
    if (grid == 0) {
        if (n_in != 17 || ws_size < WS_END) { fprintf(stderr, "kernel_launch: unexpected n_in %d / ws %zu\n", n_in, ws_size); grid = -1; return; }
        int dev = 0, cus = 0, per_cu = 0;
        (void)hipGetDevice(&dev); (void)hipDeviceGetAttribute(&cus, hipDeviceAttributeMultiprocessorCount, dev);
        if (hipFuncSetAttribute((const void*)hymba_fwd, hipFuncAttributeMaxDynamicSharedMemorySize, LDS_BYTES) != hipSuccess) { fprintf(stderr, "kernel_launch: hipFuncSetAttribute failed\n"); grid = -1; return; }
        if (hipOccupancyMaxActiveBlocksPerMultiprocessor(&per_cu, (const void*)hymba_fwd, NTHR, LDS_BYTES) != hipSuccess || per_cu < 1) { fprintf(stderr, "kernel_launch: occupancy query says %d\n", per_cu); per_cu = 1; }
        (void)hipGetLastError();
        grid = cus * per_cu;
        if (grid <= 0) grid = 256;
    }
    if (grid < 0) return;
    if (hipMemsetAsync((char*)d_ws + WS_BAR, 0, 16384, stream) != hipSuccess) { fprintf(stderr, "kernel_launch: memset failed\n"); return; }
    Args a{};
    for (int i = 0; i < 17; ++i) a.in[i] = (const float*)d_in[i];
    a.out = (float*)d_out; a.ws = (unsigned char*)d_ws;
    if (MK_N_LAUNCHES == 1) {
        a.ph_lo = 0; a.ph_hi = NPHASE;
        void* kargs[] = {&a};
        hipError_t e = hipLaunchCooperativeKernel((const void*)hymba_fwd, dim3(grid), dim3(NTHR), kargs, LDS_BYTES, stream);
        if (e != hipSuccess) fprintf(stderr, "kernel_launch: cooperative launch failed: %s (grid %d)\n", hipGetErrorString(e), grid);
    } else {
        for (int p = 0; p < NPHASE; ++p) { a.ph_lo = p; a.ph_hi = p + 1; const int nrep = ((REP_MASK >> p) & 1) ? 3 : 1;
            for (int rr = 0; rr < nrep; ++rr) { a.aux = ((p == 2 || p == 7 || p == 8) && rr + 1 < nrep) ? 1 : 0; hipLaunchKernelGGL(hymba_fwd, dim3(grid), dim3(NTHR), LDS_BYTES, stream, a); } }
    }
}
```
